# Optimizing an MI355X kernel written in HIP

```python
import math
import jax, jax.numpy as jnp
from jax import lax
import numpy as np

D_MODEL = 1024
BATCH = 4
SEQ = 8192
DEPTH = 2

MLA_HEADS = 8
MLA_Q_RANK = 512
MLA_KV_RANK = 256
MLA_NOPE = 128
MLA_ROPE = 64
MLA_V = 128
ROPE_THETA = 10000.0
Q_BLOCK = 128

NSA_HEADS = 16
NSA_GROUPS = 4
NSA_DK = 96
NSA_DV = 64
CMP_LEN = 32
CMP_STRIDE = 16
SEL_BLOCK = 64
SEL_TOPN = 16
WINDOW = 512
NSA_Q_BLOCK = 64
N_BRANCH = 3
FORCE = 1e6

REL_BUCKETS = 32
REL_MAX_DIST = 128

D_FF = 2816
N_EXPERTS = 8
TOP_K = 2
D_FF_EXPERT = 3584
MOE_BLOCK = 256

LN_EPS = 1e-5
RMS_EPS = 1e-6

kernel_name = 'hybrid_mla_nsa_deepnorm_moe'


def layer_norm(x, g, b):
    xf = x.astype(jnp.float32)
    mu = jnp.mean(xf, -1, keepdims=True)
    var = jnp.mean(jnp.square(xf - mu), -1, keepdims=True)
    return ((xf - mu) * lax.rsqrt(var + LN_EPS) * g + b).astype(x.dtype)


def rms_norm(x, g):
    xf = x.astype(jnp.float32)
    return (xf * lax.rsqrt(jnp.mean(xf * xf, -1, keepdims=True) + RMS_EPS) * g).astype(x.dtype)


def rope(x, pos):
    half = x.shape[-1] // 2
    freq = ROPE_THETA ** (-jnp.arange(half, dtype=jnp.float32) / half)
    ang = pos.astype(jnp.float32)[:, None] * freq[None, :]
    shp = (x.shape[1],) + (1,) * (x.ndim - 3) + (half,)
    cos, sin = jnp.cos(ang).reshape(shp), jnp.sin(ang).reshape(shp)
    x1, x2 = x[..., :half], x[..., half:]
    return jnp.concatenate([x1 * cos - x2 * sin, x1 * sin + x2 * cos], -1).astype(x.dtype)


def rel_bucket(dist):
    n = jnp.maximum(dist, 0)
    max_exact = REL_BUCKETS // 2
    nf = jnp.maximum(n, 1).astype(jnp.float32)
    large = max_exact + (jnp.log(nf / max_exact) / math.log(REL_MAX_DIST / max_exact)
                         * (REL_BUCKETS - max_exact)).astype(jnp.int32)
    large = jnp.minimum(large, REL_BUCKETS - 1)
    return jnp.where(n < max_exact, n, large)


def masked_softmax(s, mask):
    s = jnp.where(mask, s.astype(jnp.float32), -jnp.inf)
    m = jnp.max(s, -1, keepdims=True)
    m = jnp.where(jnp.isfinite(m), m, 0.0)
    p = jnp.exp(s - m)
    return p / jnp.maximum(jnp.sum(p, -1, keepdims=True), 1e-30)


def mla_mixer(x, w_in, q_norm, w_q_up, kv_norm, w_kv_up, w_out):
    B, S, _ = x.shape
    H = MLA_HEADS
    pos = jnp.arange(S)
    lat = x @ w_in
    q_lat, kv_lat, k_rope = jnp.split(lat, [MLA_Q_RANK, MLA_Q_RANK + MLA_KV_RANK], axis=-1)
    q = (rms_norm(q_lat, q_norm) @ w_q_up).reshape(B, S, H, MLA_NOPE + MLA_ROPE)
    q_nope, q_rope = q[..., :MLA_NOPE], rope(q[..., MLA_NOPE:], pos)
    kv = (rms_norm(kv_lat, kv_norm) @ w_kv_up).reshape(B, S, H, MLA_NOPE + MLA_V)
    k_nope, v = kv[..., :MLA_NOPE], kv[..., MLA_NOPE:]
    k_rope = rope(k_rope, pos)
    scale = (MLA_NOPE + MLA_ROPE) ** -0.5

    def block(i):
        s0 = i * Q_BLOCK
        qn = lax.dynamic_slice_in_dim(q_nope, s0, Q_BLOCK, 1)
        qr = lax.dynamic_slice_in_dim(q_rope, s0, Q_BLOCK, 1)
        s = (jnp.einsum('bqhd,bkhd->bhqk', qn, k_nope)
             + jnp.einsum('bqhr,bkr->bhqk', qr, k_rope)) * scale
        qpos = s0 + jnp.arange(Q_BLOCK)
        p = masked_softmax(s, qpos[:, None] >= pos[None, :])
        return jnp.einsum('bhqk,bkhd->bqhd', p.astype(v.dtype), v)

    o = lax.map(block, jnp.arange(S // Q_BLOCK))
    o = jnp.moveaxis(o, 0, 1).reshape(B, S, H * MLA_V)
    return o @ w_out


def compress_blocks(blocks, pe, w1, w2):
    h = jnp.einsum('bnlgd,lde->bnge', blocks + pe[:, None, :], w1)
    return jax.nn.gelu(h) @ w2


def nsa_mixer(x, w_in, pe_k, w1_k, w2_k, pe_v, w1_v, w2_v, rel_bias, w_out):
    B, S, _ = x.shape
    H, G, DK, DV = NSA_HEADS, NSA_GROUPS, NSA_DK, NSA_DV
    HG = H // G
    sizes = [H * DK, G * DK, G * DV, G * DK, G * DV, G * DK, G * DV, H * N_BRANCH]
    cuts = [int(c) for c in np.cumsum(sizes)[:-1]]
    q, kc_tok, vc_tok, ks_tok, vs_tok, kw_tok, vw_tok, gate = jnp.split(x @ w_in, cuts, axis=-1)
    q = q.reshape(B, S, G, HG, DK)
    kc_tok, ks_tok, kw_tok = (t.reshape(B, S, G, DK) for t in (kc_tok, ks_tok, kw_tok))
    vc_tok, vs_tok, vw_tok = (t.reshape(B, S, G, DV) for t in (vc_tok, vs_tok, vw_tok))
    gate = jax.nn.sigmoid(gate.astype(jnp.float32)).reshape(B, S, G, HG, N_BRANCH)
    scale = DK ** -0.5
    rb = rel_bias.reshape(REL_BUCKETS, G, HG)

    nc = (S - CMP_LEN) // CMP_STRIDE + 1
    cstart = jnp.arange(nc) * CMP_STRIDE
    cend = cstart + CMP_LEN - 1
    tok = cstart[:, None] + jnp.arange(CMP_LEN)[None, :]
    k_cmp = compress_blocks(kc_tok[:, tok], pe_k, w1_k, w2_k)
    v_cmp = compress_blocks(vc_tok[:, tok], pe_v, w1_v, w2_v)

    nb = S // SEL_BLOCK
    n_sel = min(SEL_TOPN, nb)
    sstart = jnp.arange(nb) * SEL_BLOCK
    overlap = ((cstart[:, None] <= sstart[None, :] + SEL_BLOCK - 1)
               & (cend[:, None] >= sstart[None, :])).astype(jnp.float32)
    k_blk = ks_tok.reshape(B, nb, SEL_BLOCK, G, DK).transpose(0, 3, 1, 2, 4)
    v_blk = vs_tok.reshape(B, nb, SEL_BLOCK, G, DV).transpose(0, 3, 1, 2, 4)
    b_ix = jnp.arange(B)[:, None, None, None]
    g_ix = jnp.arange(G)[None, :, None, None]
    g_ix5 = jnp.arange(G)[None, :, None, None, None]

    kw_pad = jnp.pad(kw_tok, ((0, 0), (WINDOW, 0), (0, 0), (0, 0)))
    vw_pad = jnp.pad(vw_tok, ((0, 0), (WINDOW, 0), (0, 0), (0, 0)))
    QB = NSA_Q_BLOCK
    span = WINDOW + QB

    def head_bias(bucket):
        return rb[bucket].transpose(2, 3, 0, 1)

    def block(i):
        s0 = i * QB
        qpos = s0 + jnp.arange(QB)
        qi = lax.dynamic_slice_in_dim(q, s0, QB, 1)
        gi = lax.dynamic_slice_in_dim(gate, s0, QB, 1)
        dist_c = qpos[:, None] - cend[None, :]
        s_c = jnp.einsum('bqghd,bngd->bghqn', qi, k_cmp) * scale + head_bias(rel_bucket(dist_c))
        p_c = masked_softmax(s_c, dist_c >= 0)
        o_c = jnp.einsum('bghqn,bngd->bqghd', p_c.astype(v_cmp.dtype), v_cmp)
        imp = jnp.einsum('bghqn,nj->bgqj', p_c, overlap)
        cur = (qpos // SEL_BLOCK)[:, None]
        blk = jnp.arange(nb)[None, :]
        forced = (blk == 0) | (blk == cur) | (blk == cur - 1)
        imp = jnp.where(blk > cur, -FORCE, jnp.where(forced, FORCE, imp))
        _, sel = lax.top_k(imp, n_sel)
        k_s = k_blk[b_ix, g_ix, sel]
        v_s = v_blk[b_ix, g_ix, sel]
        dist_s = qpos[:, None, None] - (sel[..., None] * SEL_BLOCK + jnp.arange(SEL_BLOCK))
        bias_s = rb[rel_bucket(dist_s), g_ix5].transpose(0, 1, 5, 2, 3, 4)
        s_s = jnp.einsum('bqghd,bgqnkd->bghqnk', qi, k_s) * scale + bias_s
        m = n_sel * SEL_BLOCK
        p_s = masked_softmax(s_s.reshape(B, G, HG, QB, m), (dist_s >= 0).reshape(B, G, 1, QB, m))
        o_s = jnp.einsum('bghqm,bgqmd->bqghd', p_s.astype(v_s.dtype), v_s.reshape(B, G, QB, m, DV))
        k_w = lax.dynamic_slice_in_dim(kw_pad, s0, span, 1)
        v_w = lax.dynamic_slice_in_dim(vw_pad, s0, span, 1)
        kpos_w = s0 - WINDOW + jnp.arange(span)
        dist_w = qpos[:, None] - kpos_w[None, :]
        mask_w = (dist_w >= 0) & (dist_w < WINDOW) & (kpos_w[None, :] >= 0)
        s_w = jnp.einsum('bqghd,bkgd->bghqk', qi, k_w) * scale + head_bias(rel_bucket(dist_w))
        p_w = masked_softmax(s_w, mask_w)
        o_w = jnp.einsum('bghqk,bkgd->bqghd', p_w.astype(v_w.dtype), v_w)
        o = gi[..., 0:1] * o_c + gi[..., 1:2] * o_s + gi[..., 2:3] * o_w
        return o.astype(x.dtype)

    o = lax.map(block, jnp.arange(S // QB))
    o = jnp.moveaxis(o, 0, 1).reshape(B, S, H * DV)
    return o @ w_out


def swiglu(x, w_gate, w_up, w_down):
    return (jax.nn.silu(x @ w_gate) * (x @ w_up)) @ w_down


def moe_swiglu(x, w_router, w_gate, w_up, w_down):
    B, S, D = x.shape
    T = B * S
    A = T * TOP_K
    xt = x.reshape(T, D)
    logits = (xt @ w_router).astype(jnp.float32)
    top_val, top_idx = lax.top_k(logits, TOP_K)
    wts = jax.nn.softmax(top_val, -1)
    exp_flat = top_idx.reshape(A)
    order = jnp.argsort(exp_flat)
    exp_sorted = exp_flat[order]
    tok_sorted = order // TOP_K
    w_sorted = wts.reshape(A)[order]
    counts = jnp.bincount(exp_flat, length=N_EXPERTS)
    padded = ((counts + MOE_BLOCK - 1) // MOE_BLOCK) * MOE_BLOCK
    grp_start = jnp.cumsum(counts) - counts
    pad_end = jnp.cumsum(padded)
    pad_start = pad_end - padded
    dest = pad_start[exp_sorted] + (jnp.arange(A) - grp_start[exp_sorted])
    n_blocks = (A + MOE_BLOCK - 1) // MOE_BLOCK + N_EXPERTS
    R = n_blocks * MOE_BLOCK
    row_tok = jnp.zeros((R,), jnp.int32).at[dest].set(tok_sorted.astype(jnp.int32))
    row_w = jnp.zeros((R,), jnp.float32).at[dest].set(w_sorted)
    block_expert = jnp.minimum(
        jnp.searchsorted(pad_end, jnp.arange(n_blocks) * MOE_BLOCK, side='right'), N_EXPERTS - 1)

    def expert_block(args):
        toks, wr, e = args
        xb = xt[toks]
        h = jax.nn.silu(xb @ w_gate[e]) * (xb @ w_up[e])
        return (h @ w_down[e]) * wr[:, None].astype(xb.dtype)

    out = lax.map(expert_block, (row_tok.reshape(n_blocks, MOE_BLOCK),
                                 row_w.reshape(n_blocks, MOE_BLOCK), block_expert))
    y = jnp.zeros_like(xt).at[row_tok].add(out.reshape(R, D))
    return y.reshape(B, S, D)


def setup_inputs(seed: int = 0) -> dict:
    key = jax.random.key(seed)
    ks = jax.random.split(key, 28)
    f32 = jnp.float32
    ne, no = (DEPTH + 1) // 2, DEPTH // 2
    beta = (8.0 * DEPTH) ** -0.25
    D = D_MODEL
    nsa_in = (NSA_HEADS * NSA_DK + 3 * NSA_GROUPS * NSA_DK + 3 * NSA_GROUPS * NSA_DV
              + NSA_HEADS * N_BRANCH)

    def w(k, shape, fan_in, s=1.0):
        return jax.random.normal(k, shape, f32) * (s * fan_in ** -0.5)

    def gain(k, shape):
        return 1.0 + 0.02 * jax.random.normal(k, shape, f32)

    def small(k, shape, s=0.02):
        return s * jax.random.normal(k, shape, f32)

    return {
        'x': jax.random.normal(ks[0], (BATCH, SEQ, D), f32),
        'mla_w_in': w(ks[1], (ne, D, MLA_Q_RANK + MLA_KV_RANK + MLA_ROPE), D),
        'mla_q_norm': gain(ks[2], (ne, MLA_Q_RANK)),
        'mla_w_q_up': w(ks[3], (ne, MLA_Q_RANK, MLA_HEADS * (MLA_NOPE + MLA_ROPE)), MLA_Q_RANK),
        'mla_kv_norm': gain(ks[4], (ne, MLA_KV_RANK)),
        'mla_w_kv_up': w(ks[5], (ne, MLA_KV_RANK, MLA_HEADS * (MLA_NOPE + MLA_V)), MLA_KV_RANK),
        'mla_w_out': w(ks[6], (ne, MLA_HEADS * MLA_V, D), MLA_HEADS * MLA_V, beta),
        'nsa_w_in': w(ks[7], (no, D, nsa_in), D),
        'nsa_cmp_pe_k': small(ks[8], (no, CMP_LEN, NSA_DK), 0.1),
        'nsa_cmp_w1_k': w(ks[9], (no, CMP_LEN, NSA_DK, NSA_DK), CMP_LEN * NSA_DK),
        'nsa_cmp_w2_k': w(ks[10], (no, NSA_DK, NSA_DK), NSA_DK),
        'nsa_cmp_pe_v': small(ks[11], (no, CMP_LEN, NSA_DV), 0.1),
        'nsa_cmp_w1_v': w(ks[12], (no, CMP_LEN, NSA_DV, NSA_DV), CMP_LEN * NSA_DV),
        'nsa_cmp_w2_v': w(ks[13], (no, NSA_DV, NSA_DV), NSA_DV),
        'nsa_w_out': w(ks[14], (no, NSA_HEADS * NSA_DV, D), NSA_HEADS * NSA_DV, beta),
        'rel_bias': small(ks[15], (REL_BUCKETS, NSA_HEADS), 0.3),
        'ffn_w_gate': w(ks[16], (ne, D, D_FF), D),
        'ffn_w_up': w(ks[17], (ne, D, D_FF), D),
        'ffn_w_down': w(ks[18], (ne, D_FF, D), D_FF, beta),
        'moe_w_router': w(ks[19], (no, D, N_EXPERTS), D),
        'moe_w_gate': w(ks[20], (no, N_EXPERTS, D, D_FF_EXPERT), D),
        'moe_w_up': w(ks[21], (no, N_EXPERTS, D, D_FF_EXPERT), D),
        'moe_w_down': w(ks[22], (no, N_EXPERTS, D_FF_EXPERT, D), D_FF_EXPERT, beta),
        'ln_mix_g': gain(ks[23], (DEPTH, D)),
        'ln_mix_b': small(ks[24], (DEPTH, D)),
        'ln_ffn_g': gain(ks[25], (DEPTH, D)),
        'ln_ffn_b': small(ks[26], (DEPTH, D)),
    }


def reference(x, mla_w_in, mla_q_norm, mla_w_q_up, mla_kv_norm, mla_w_kv_up, mla_w_out,
              nsa_w_in, nsa_cmp_pe_k, nsa_cmp_w1_k, nsa_cmp_w2_k, nsa_cmp_pe_v, nsa_cmp_w1_v,
              nsa_cmp_w2_v, nsa_w_out, rel_bias, ffn_w_gate, ffn_w_up, ffn_w_down,
              moe_w_router, moe_w_gate, moe_w_up, moe_w_down,
              ln_mix_g, ln_mix_b, ln_ffn_g, ln_ffn_b):
    alpha = (2.0 * DEPTH) ** 0.25
    for i in range(DEPTH):
        j = i // 2
        if i % 2 == 0:
            h = mla_mixer(x, mla_w_in[j], mla_q_norm[j], mla_w_q_up[j], mla_kv_norm[j],
                          mla_w_kv_up[j], mla_w_out[j])
        else:
            h = nsa_mixer(x, nsa_w_in[j], nsa_cmp_pe_k[j], nsa_cmp_w1_k[j], nsa_cmp_w2_k[j],
                          nsa_cmp_pe_v[j], nsa_cmp_w1_v[j], nsa_cmp_w2_v[j], rel_bias, nsa_w_out[j])
        x = layer_norm(alpha * x + h, ln_mix_g[i], ln_mix_b[i])
        if i % 2 == 0:
            f = swiglu(x, ffn_w_gate[j], ffn_w_up[j], ffn_w_down[j])
        else:
            f = moe_swiglu(x, moe_w_router[j], moe_w_gate[j], moe_w_up[j], moe_w_down[j])
        x = layer_norm(alpha * x + f, ln_ffn_g[i], ln_ffn_b[i])
    return x
```

```cpp
#define MK_PER_PHASE 1
#include <hip/hip_runtime.h>
#include <cstdio>
#include <cstdint>

#define LAS __attribute__((address_space(3)))
#define GAS __attribute__((address_space(1)))
typedef unsigned short bf16_t;
typedef short bf16x8 __attribute__((ext_vector_type(8)));
typedef short s16x4 __attribute__((ext_vector_type(4)));
typedef float f32x4 __attribute__((ext_vector_type(4)));
typedef float f32x2 __attribute__((ext_vector_type(2)));
typedef float f32x16 __attribute__((ext_vector_type(16)));
typedef unsigned u32x4 __attribute__((ext_vector_type(4)));
typedef unsigned u32x2 __attribute__((ext_vector_type(2)));

constexpr int NB = 4, SEQ = 8192, T = NB * SEQ, D = 1024;
constexpr int MLA_H = 8, MLA_QR = 512, MLA_KVR = 256, MLA_DQK = 192, MLA_DV = 128, MLA_IN = 832;
constexpr int NSA_G = 4, NSA_DK = 96, NSA_DV = 64, NSA_IN = 3504, NSA_INP = 3584;
constexpr int FF = 2816, NE = 8, FFE = 3584, ECAP = 32768;
constexpr float ALPHA = 1.41421356237309515f;
constexpr float LOG2E = 1.4426950408889634f;
constexpr float C2_MLA = 0.07216878364870323f * LOG2E;
constexpr float C2_NSA = 0.10206207261596577f * LOG2E;

__device__ __forceinline__ unsigned cvt_pk_bf16(float lo, float hi) { unsigned r; asm volatile("v_cvt_pk_bf16_f32 %0, %1, %2" : "=v"(r) : "v"(lo), "v"(hi)); return r; }
__device__ __forceinline__ float bf2f(unsigned short h) { return __uint_as_float(((unsigned)h) << 16); }
__device__ __forceinline__ float bflo(unsigned w) { return __uint_as_float(w << 16); }
__device__ __forceinline__ float bfhi(unsigned w) { return __uint_as_float(w & 0xffff0000u); }
__device__ __forceinline__ float fast_exp2(float x) { return __builtin_amdgcn_exp2f(x); }
__device__ __forceinline__ float fast_rcp(float x) { return __builtin_amdgcn_rcpf(x); }
__device__ __forceinline__ float silu_f(float x) { return x * fast_rcp(1.f + fast_exp2(-x * LOG2E)); }
__device__ __forceinline__ float sigmoid_f(float x) { return fast_rcp(1.f + fast_exp2(-x * LOG2E)); }
__device__ __forceinline__ float gelu_tanh_f(float x) {
    const float z = 0.7978845608028654f * (x + 0.044715f * x * x * x);
    return x * fast_rcp(1.f + fast_exp2(-2.f * LOG2E * z));
}

namespace pg8 {
constexpr int BM = 256, BK = 64, HALF = 128, HTB = HALF * BK * 2, STAGE_BYTES = 8 * HTB, NXCD = 8, WGM = 8;
__host__ __device__ __forceinline__ int lds_byte(int r, int c) { const int st = (r >> 4) * 2 + (c >> 5), rr = r & 15, cc = c & 31, ob = rr * 64 + cc * 2; return st * 1024 + (ob ^ (((ob >> 9) & 1) << 5)); }
__host__ __device__ __forceinline__ void stage_rc(int b, int& R, int& C) { const int st = b / 1024, sb = b % 1024, swz = sb ^ (((sb >> 9) & 1) << 5); R = (st >> 1) * 16 + swz / 64; C = (st & 1) * 32 + (swz % 64) / 2; }
__host__ __device__ __forceinline__ int perm32(int rho) { const int n = rho >> 4, i = rho & 15; return 8 * (i >> 2) + 4 * n + (i & 3); }

struct Unit { int pm, pn; };
struct Gemm { const bf16_t* A; const bf16_t* Bt; int lda, ldb, K; };

struct StaticOrder {
    int nM, nN, nwg, G, c;
    __device__ void init(int nM_, int nN_, int G_, int c_) { nM = nM_; nN = nN_; nwg = nM * nN; G = G_; c = c_; }
    __device__ bool next(int i, Unit& u) const {
        const long L = (long)i * G + c; if (L >= nwg) return false;
        int wgid = (int)L; { const int q = nwg / NXCD, r = nwg % NXCD, xcd = wgid % NXCD, off = wgid / NXCD; wgid = (xcd < r ? xcd * (q + 1) : r * (q + 1) + (xcd - r) * q) + off; }
        const int nig = WGM * nN, gid = wgid / nig, fm = gid * WGM, gsz = (nM - fm) < WGM ? (nM - fm) : WGM;
        u.pm = fm + ((wgid % nig) % gsz); u.pn = (wgid % nig) / gsz; return true;
    }
};
struct SchedPlain {
    StaticOrder so;
    __device__ void init(int nM, int nN, int G, int c) { so.init(nM, nN, G, c); }
    __device__ __forceinline__ bool next(int i, Unit& u) const { return so.next(i, u); }
    __device__ __forceinline__ size_t a_off(const Unit& u, const Gemm& g) const { return (size_t)u.pm * 256 * g.lda * 2; }
    __device__ __forceinline__ size_t b_off(const Unit& u, const Gemm& g) const { return (size_t)u.pn * 256 * g.ldb * 2; }
    __device__ __forceinline__ unsigned a_row(const Unit&, int) const { return 0u; }
};

template <class F> struct EpiRow8 {
    static constexpr bool PERM = true;
    F f;
    __device__ __forceinline__ void operator()(const f32x4 (&acc)[2][2][4][2], const Unit& u, int wr, int wc, int fr, int fq) const {
#pragma unroll
        for (int ai = 0; ai < 2; ++ai)
#pragma unroll
            for (int m = 0; m < 4; ++m) { const int row = u.pm * BM + ai * HALF + wr * 64 + m * 16 + fr;
#pragma unroll
                for (int bj = 0; bj < 2; ++bj) f(row, u.pn * BM + bj * HALF + wc * 32 + 8 * fq, acc[ai][bj][m][0], acc[ai][bj][m][1]); }
    }
};
template <class F> struct EpiGateUp {
    static constexpr bool PERM = true;
    F f;
    __device__ __forceinline__ void operator()(const f32x4 (&acc)[2][2][4][2], const Unit& u, int wr, int wc, int fr, int fq) const {
#pragma unroll
        for (int ai = 0; ai < 2; ++ai)
#pragma unroll
            for (int m = 0; m < 4; ++m) { const int row = u.pm * BM + ai * HALF + wr * 64 + m * 16 + fr;
                f(row, u.pn * HALF + wc * 32 + 8 * fq, acc[ai][0][m][0], acc[ai][0][m][1], acc[ai][1][m][0], acc[ai][1][m][1]); }
    }
};

template <class Epi, class Sched, bool ALIGN_EPI, bool GATHER>
__device__ __forceinline__ void gemm_phase(LAS unsigned char* lds, const Gemm g, const Sched& S, const Epi& E) {
    int tid = threadIdx.x; asm volatile("" : "+v"(tid));
    const int wid = __builtin_amdgcn_readfirstlane(tid >> 6), lane = tid & 63, wr = wid >> 2, wc = wid & 3, fr = lane & 15, fq = lane >> 4;
    const int K = g.K, nt = K / BK;
    int sR[2], sC[2]; unsigned voffB[2];
#pragma unroll
    for (int i = 0; i < 2; ++i) { int R, C; stage_rc(tid * 16 + i * 8192, R, C); sR[i] = R; sC[i] = C; const int Rb = Epi::PERM ? ((R & ~31) + perm32(R & 31)) : R; voffB[i] = (unsigned)(Rb * g.ldb + C) * 2u; }
    const int kstep = BK * 2;
    const int hstepB = HALF * g.ldb * 2;
    const auto rsA = __builtin_amdgcn_make_buffer_rsrc((void*)g.A, 0, 0x7fffffff, 0x00020000);
    const auto rsB = __builtin_amdgcn_make_buffer_rsrc((void*)g.Bt, 0, 0x7fffffff, 0x00020000);
    const unsigned ldsw = (unsigned)wid * 1024u;
    const int aoff = lds_byte(wr * 64 + fr, fq * 8), boff = lds_byte(wc * 32 + fr, fq * 8);
#define PG8_SA(b, h) (((b) * 2 + (h)) * HTB)
#define PG8_SB(b, h) ((4 + (b) * 2 + (h)) * HTB)
#define PG8_STAGE2(bufoff, rsrc, soff, o0, o1) do { \
        __builtin_amdgcn_raw_ptr_buffer_load_lds(rsrc, (LAS unsigned*)(lds + (bufoff) + ldsw), 16, (int)(o0), (int)(soff), 0, 0); \
        __builtin_amdgcn_raw_ptr_buffer_load_lds(rsrc, (LAS unsigned*)(lds + (bufoff) + ldsw + 8192), 16, (int)(o1), (int)(soff), 0, 0); } while (0)
#define PG8_STAGEA(bufoff, soff, o0, o1) PG8_STAGE2(bufoff, rsA, soff, o0, o1)
#define PG8_STAGEB(bufoff, soff) PG8_STAGE2(bufoff, rsB, soff, voffB[0], voffB[1])
#define PG8_LDA(dst, b, h) do { _Pragma("unroll") for (int m = 0; m < 4; ++m) _Pragma("unroll") for (int k = 0; k < 2; ++k) dst[m][k] = *(const LAS bf16x8*)(lds + PG8_SA(b, h) + aoff + m * 2048 + k * 1024); } while (0)
#define PG8_LDB(dst, b, h) do { _Pragma("unroll") for (int n = 0; n < 2; ++n) _Pragma("unroll") for (int k = 0; k < 2; ++k) dst[n][k] = *(const LAS bf16x8*)(lds + PG8_SB(b, h) + boff + n * 2048 + k * 1024); } while (0)
#define PG8_MMA(ai, bj, At, Bt) do { __builtin_amdgcn_s_setprio(1); _Pragma("unroll") for (int m = 0; m < 4; ++m) _Pragma("unroll") for (int n = 0; n < 2; ++n) _Pragma("unroll") for (int k = 0; k < 2; ++k) \
        acc[ai][bj][m][n] = __builtin_amdgcn_mfma_f32_16x16x32_bf16(Bt[n][k], At[m][k], acc[ai][bj][m][n], 0, 0, 0); __builtin_amdgcn_s_setprio(0); } while (0)
#define PG8_WAIT_V(n) asm volatile("s_waitcnt vmcnt(" #n ")" ::: "memory")
#define PG8_WAIT_L(n) asm volatile("s_waitcnt lgkmcnt(" #n ")" ::: "memory")
#define PG8_BAR __builtin_amdgcn_s_barrier()
#define PG8_SCHED __builtin_amdgcn_sched_barrier(0)
    Unit cur, nxt; int ui = 0;
    if (!S.next(0, cur)) return;
    f32x4 acc[2][2][4][2];
#pragma unroll
    for (int a = 0; a < 2; ++a)
#pragma unroll
        for (int b = 0; b < 2; ++b)
#pragma unroll
            for (int m = 0; m < 4; ++m)
#pragma unroll
                for (int n = 0; n < 2; ++n) acc[a][b][m][n] = (f32x4){0.f, 0.f, 0.f, 0.f};
    bf16x8 At[4][2], B0[2][2], B1[2][2];
    unsigned vc[2][2], vn[2][2];
#pragma unroll
    for (int h = 0; h < 2; ++h)
#pragma unroll
        for (int i = 0; i < 2; ++i) { vc[h][i] = GATHER ? S.a_row(cur, h * HALF + sR[i]) + (unsigned)sC[i] * 2u : (unsigned)((h * HALF + sR[i]) * g.lda + sC[i]) * 2u; vn[h][i] = vc[h][i]; }
    int cA = (int)S.a_off(cur, g), cB = (int)S.b_off(cur, g);
    PG8_STAGEB(PG8_SB(0, 0), cB); PG8_STAGEB(PG8_SB(0, 1), cB + hstepB); PG8_STAGEA(PG8_SA(0, 0), cA, vc[0][0], vc[0][1]); PG8_STAGEA(PG8_SA(0, 1), cA, vc[1][0], vc[1][1]);
    if (wr == 1) PG8_BAR;
    PG8_WAIT_V(2); PG8_BAR;
    PG8_STAGEB(PG8_SB(1, 0), cB + kstep); PG8_STAGEA(PG8_SA(1, 0), cA + kstep, vc[0][0], vc[0][1]); PG8_STAGEB(PG8_SB(1, 1), cB + hstepB + kstep);
    PG8_WAIT_V(6); PG8_BAR;
    for (;;) {
        const bool has_next = S.next(ui + 1, nxt);
        const int nA = has_next ? (int)S.a_off(nxt, g) : cA, nB = has_next ? (int)S.b_off(nxt, g) : cB;
        if (GATHER) {
#pragma unroll
            for (int h = 0; h < 2; ++h)
#pragma unroll
                for (int i = 0; i < 2; ++i) vn[h][i] = has_next ? S.a_row(nxt, h * HALF + sR[i]) + (unsigned)sC[i] * 2u : vc[h][i];
        }
        for (int t = 0; t < nt; t += 2) {
            const bool last = (t == nt - 2);
            const int a1 = cA + (t + 1) * kstep;
            const int a2 = last ? nA : cA + (t + 2) * kstep, b2 = last ? nB : cB + (t + 2) * kstep;
            const int a3 = a2 + kstep, b3 = b2 + kstep;
            unsigned w00, w01, w10, w11;
            if (GATHER) { w00 = last ? vn[0][0] : vc[0][0]; w01 = last ? vn[0][1] : vc[0][1]; w10 = last ? vn[1][0] : vc[1][0]; w11 = last ? vn[1][1] : vc[1][1]; }
            else { w00 = vc[0][0]; w01 = vc[0][1]; w10 = vc[1][0]; w11 = vc[1][1]; }
            PG8_LDB(B0, 0, 0); PG8_LDB(B1, 0, 1); PG8_SCHED; PG8_LDA(At, 0, 0); PG8_STAGEA(PG8_SA(1, 1), a1, vc[1][0], vc[1][1]);
            PG8_WAIT_V(8); PG8_WAIT_L(0); PG8_BAR; PG8_MMA(0, 0, At, B0); PG8_MMA(0, 1, At, B1); PG8_BAR; PG8_SCHED;
            PG8_LDA(At, 0, 1); PG8_STAGEB(PG8_SB(0, 0), b2); PG8_STAGEB(PG8_SB(0, 1), b2 + hstepB); PG8_STAGEA(PG8_SA(0, 0), a2, w00, w01);
            PG8_WAIT_V(8); PG8_WAIT_L(0); PG8_BAR; PG8_MMA(1, 0, At, B0); PG8_MMA(1, 1, At, B1); PG8_BAR; PG8_SCHED;
            PG8_LDB(B0, 1, 0); PG8_LDB(B1, 1, 1); PG8_SCHED; PG8_LDA(At, 1, 0); PG8_STAGEA(PG8_SA(0, 1), a2, w10, w11);
            PG8_WAIT_V(8); PG8_WAIT_L(0); PG8_BAR; PG8_MMA(0, 0, At, B0); PG8_MMA(0, 1, At, B1); PG8_BAR; PG8_SCHED;
            PG8_LDA(At, 1, 1); PG8_STAGEB(PG8_SB(1, 0), b3); PG8_STAGEB(PG8_SB(1, 1), b3 + hstepB); PG8_STAGEA(PG8_SA(1, 0), a3, w00, w01);
            PG8_WAIT_V(8); PG8_WAIT_L(0); PG8_BAR; PG8_MMA(1, 0, At, B0); PG8_MMA(1, 1, At, B1); PG8_BAR; PG8_SCHED;
        }
        if constexpr (ALIGN_EPI) { if (wr == 0) PG8_BAR; }
        E(acc, cur, wr, wc, fr, fq);
        if (!has_next) break;
#pragma unroll
        for (int a = 0; a < 2; ++a)
#pragma unroll
            for (int b = 0; b < 2; ++b)
#pragma unroll
                for (int m = 0; m < 4; ++m)
#pragma unroll
                    for (int n = 0; n < 2; ++n) acc[a][b][m][n] = (f32x4){0.f, 0.f, 0.f, 0.f};
        cur = nxt; cA = nA; cB = nB; ++ui;
        if (GATHER) {
#pragma unroll
            for (int h = 0; h < 2; ++h)
#pragma unroll
                for (int i = 0; i < 2; ++i) vc[h][i] = vn[h][i];
        }
        if constexpr (ALIGN_EPI) { if (wr == 1) PG8_BAR; }
    }
    PG8_WAIT_V(0);
    if constexpr (!ALIGN_EPI) { if (wr == 0) PG8_BAR; }
    PG8_BAR;
#undef PG8_SA
#undef PG8_SB
#undef PG8_STAGE2
#undef PG8_STAGEA
#undef PG8_STAGEB
#undef PG8_LDA
#undef PG8_LDB
#undef PG8_MMA
#undef PG8_WAIT_V
#undef PG8_WAIT_L
#undef PG8_BAR
#undef PG8_SCHED
}
}
namespace att {
__device__ __forceinline__ int crow(int r, int hi) { return (r & 3) + 8 * (r >> 2) + 4 * hi; }
constexpr float THR = 6.f;
template <int DQK, int DV> struct Geo {
    static constexpr int KROW = DQK * 2 + 16, VROW = DV * 2 + 64, KT = 64 * KROW, VT = 64 * VROW;
    static constexpr int KCH = DQK / 8, VCH = DV / 8;
    static constexpr int KN = (64 * KCH + 511) / 512, VN = (64 * VCH + 511) / 512;
    static constexpr int LDS_K = 0, LDS_V = 2 * KT, LDS_END = 2 * KT + 2 * VT;
};
template <int DQK, int DV, class Src> struct Stg {
    using G = Geo<DQK, DV>;
    bf16x8 k[G::KN], v[G::VN];
    __device__ __forceinline__ void load(const Src& s, int t, int tid) {
#pragma unroll
        for (int i = 0; i < G::KN; ++i) { const int c = tid + 512 * i; if ((64 * G::KCH) % 512 == 0 || c < 64 * G::KCH) { const int row = c / G::KCH, cc = c % G::KCH; k[i] = *(const bf16x8*)s.kptr(t, row, cc); } }
#pragma unroll
        for (int i = 0; i < G::VN; ++i) { const int c = tid + 512 * i; if ((64 * G::VCH) % 512 == 0 || c < 64 * G::VCH) { const int row = c / G::VCH, cc = c % G::VCH; v[i] = *(const bf16x8*)s.vptr(t, row, cc); } }
    }
    __device__ __forceinline__ void store(LAS char* lds, int buf, int tid) const {
#pragma unroll
        for (int i = 0; i < G::KN; ++i) { const int c = tid + 512 * i; if ((64 * G::KCH) % 512 == 0 || c < 64 * G::KCH) { const int row = c / G::KCH, cc = c % G::KCH; *(LAS bf16x8*)(lds + G::LDS_K + buf * G::KT + row * G::KROW + cc * 16) = k[i]; } }
#pragma unroll
        for (int i = 0; i < G::VN; ++i) { const int c = tid + 512 * i; if ((64 * G::VCH) % 512 == 0 || c < 64 * G::VCH) { const int row = c / G::VCH, cc = c % G::VCH; *(LAS bf16x8*)(lds + G::LDS_V + buf * G::VT + row * G::VROW + cc * 16) = v[i]; } }
    }
};
template <int DQK> __device__ __forceinline__ void qk_tile(f32x16& p0, f32x16& p1, LAS const char* Kb, int r32, int hi, const bf16x8* qr) {
    constexpr int KROW = DQK * 2 + 16;
    p0 = f32x16{}; p1 = f32x16{};
    LAS const char* a = Kb + r32 * KROW + hi * 16;
#pragma unroll
    for (int d0 = 0; d0 < DQK / 16; ++d0) {
        const bf16x8 k0 = *(LAS const bf16x8*)(a + d0 * 32);
        const bf16x8 k1 = *(LAS const bf16x8*)(a + 32 * KROW + d0 * 32);
        p0 = __builtin_amdgcn_mfma_f32_32x32x16_bf16(k0, qr[d0], p0, 0, 0, 0);
        p1 = __builtin_amdgcn_mfma_f32_32x32x16_bf16(k1, qr[d0], p1, 0, 0, 0);
    }
}
template <int DV> __device__ __forceinline__ void pv_tile(f32x16* o, unsigned vaddr, bf16x8 pa0, bf16x8 pa1, bf16x8 pa2, bf16x8 pa3) {
    constexpr int VROW = DV * 2 + 64;
#define ATT_TRRD(dst, off) asm volatile("ds_read_b64_tr_b16 %0, %1 offset:%2" : "=&v"(dst) : "v"(vaddr), "i"(off) : "memory")
#pragma unroll
    for (int d0 = 0; d0 < DV / 32; ++d0) {
        s16x4 l0, l1, h0, h1;
        ATT_TRRD(l0, (0 * 16 + 0) * VROW + d0 * 64); ATT_TRRD(h0, (0 * 16 + 4) * VROW + d0 * 64);
        ATT_TRRD(l1, (1 * 16 + 0) * VROW + d0 * 64); ATT_TRRD(h1, (1 * 16 + 4) * VROW + d0 * 64);
        asm volatile("s_waitcnt lgkmcnt(0)" ::: "memory"); __builtin_amdgcn_sched_barrier(0);
        o[d0] = __builtin_amdgcn_mfma_f32_32x32x16_bf16(pa0, (bf16x8){l0[0], l0[1], l0[2], l0[3], h0[0], h0[1], h0[2], h0[3]}, o[d0], 0, 0, 0);
        o[d0] = __builtin_amdgcn_mfma_f32_32x32x16_bf16(pa1, (bf16x8){l1[0], l1[1], l1[2], l1[3], h1[0], h1[1], h1[2], h1[3]}, o[d0], 0, 0, 0);
        s16x4 l2, l3, h2, h3;
        ATT_TRRD(l2, (2 * 16 + 0) * VROW + d0 * 64); ATT_TRRD(h2, (2 * 16 + 4) * VROW + d0 * 64);
        ATT_TRRD(l3, (3 * 16 + 0) * VROW + d0 * 64); ATT_TRRD(h3, (3 * 16 + 4) * VROW + d0 * 64);
        asm volatile("s_waitcnt lgkmcnt(0)" ::: "memory"); __builtin_amdgcn_sched_barrier(0);
        o[d0] = __builtin_amdgcn_mfma_f32_32x32x16_bf16(pa2, (bf16x8){l2[0], l2[1], l2[2], l2[3], h2[0], h2[1], h2[2], h2[3]}, o[d0], 0, 0, 0);
        o[d0] = __builtin_amdgcn_mfma_f32_32x32x16_bf16(pa3, (bf16x8){l3[0], l3[1], l3[2], l3[3], h3[0], h3[1], h3[2], h3[3]}, o[d0], 0, 0, 0);
    }
#undef ATT_TRRD
}
__device__ __forceinline__ float lane_pair_max(float v) { auto rr = __builtin_amdgcn_permlane32_swap(__float_as_uint(v), __float_as_uint(v), false, false); return fmaxf(__uint_as_float(rr[0]), __uint_as_float(rr[1])); }
__device__ __forceinline__ float lane_pair_sum(float v) { auto rr = __builtin_amdgcn_permlane32_swap(__float_as_uint(v), __float_as_uint(v), false, false); return __uint_as_float(rr[0]) + __uint_as_float(rr[1]); }
__device__ __forceinline__ void pack_p(const f32x16& p0, const f32x16& p1, bf16x8& pa0, bf16x8& pa1, bf16x8& pa2, bf16x8& pa3) {
#define ATT_PK4(P, B_, OUT) do { unsigned a0 = cvt_pk_bf16(P[B_ + 0], P[B_ + 1]), a1 = cvt_pk_bf16(P[B_ + 2], P[B_ + 3]); \
        unsigned b0 = cvt_pk_bf16(P[B_ + 4], P[B_ + 5]), b1 = cvt_pk_bf16(P[B_ + 6], P[B_ + 7]); \
        auto r0 = __builtin_amdgcn_permlane32_swap(a0, b0, false, false); auto r1 = __builtin_amdgcn_permlane32_swap(a1, b1, false, false); \
        u32x4 w = {r0[0], r1[0], r0[1], r1[1]}; OUT = __builtin_bit_cast(bf16x8, w); } while (0)
    ATT_PK4(p0, 0, pa0); ATT_PK4(p0, 8, pa1); ATT_PK4(p1, 0, pa2); ATT_PK4(p1, 8, pa3);
#undef ATT_PK4
}
template <int DQK, int DV, bool DO_PV, class Src, class Msk>
__device__ __forceinline__ void run_online(LAS char* lds, LAS float* wsc, int nt, const Src& src, const Msk& msk, const bf16x8* qr, float& m_reg, float& l_reg, f32x16* o, int tid, int lane) {
    using G = Geo<DQK, DV>;
    const int r32 = lane & 31, hi = lane >> 5;
    if (nt <= 0) return;
    Stg<DQK, DV, Src> st;
    st.load(src, 0, tid); st.store(lds, 0, tid); __syncthreads();
    const unsigned vlane = (unsigned)((8 * hi + ((lane & 15) >> 2)) * G::VROW + (16 * ((lane >> 4) & 1) + 4 * (lane & 3)) * 2);
    for (int t = 0; t < nt; ++t) {
        const int buf = t & 1;
        if (t + 1 < nt) st.load(src, t + 1, tid);
        const int kind = msk.kind(t);
        if (kind) {
            f32x16 p0, p1;
            qk_tile<DQK>(p0, p1, lds + G::LDS_K + buf * G::KT, r32, hi, qr);
            if (kind >= 2) msk.apply(p0, p1, t, kind);
            float pmax = p0[0];
#pragma unroll
            for (int r = 1; r < 16; ++r) pmax = fmaxf(pmax, p0[r]);
#pragma unroll
            for (int r = 0; r < 16; ++r) pmax = fmaxf(pmax, p1[r]);
            pmax = lane_pair_max(pmax);
            float mn, alpha;
            if (__all(pmax <= m_reg + THR)) { mn = m_reg; alpha = 1.f; }
            else { mn = fmaxf(m_reg, pmax); alpha = fast_exp2(m_reg - mn); m_reg = mn; }
#pragma unroll
            for (int r = 0; r < 16; ++r) { p0[r] = fast_exp2(p0[r] - mn); p1[r] = fast_exp2(p1[r] - mn); }
            float ps = 0.f;
#pragma unroll
            for (int r = 0; r < 16; ++r) ps += p0[r] + p1[r];
            ps = lane_pair_sum(ps);
            l_reg = l_reg * alpha + ps;
            if (DO_PV) {
                if (__any(alpha < 1.f)) {
                    if (hi == 0) wsc[32 + r32] = alpha;
                    asm volatile("s_waitcnt lgkmcnt(0)" ::: "memory");
#pragma unroll
                    for (int r = 0; r < 16; ++r) { const float a = wsc[32 + crow(r, hi)];
#pragma unroll
                        for (int d = 0; d < DV / 32; ++d) o[d][r] *= a; }
                }
                bf16x8 pa0, pa1, pa2, pa3; pack_p(p0, p1, pa0, pa1, pa2, pa3);
                pv_tile<DV>(o, (unsigned)(uintptr_t)(lds + G::LDS_V + buf * G::VT) + vlane, pa0, pa1, pa2, pa3);
            }
        }
        if (t + 1 < nt) st.store(lds, buf ^ 1, tid);
        __syncthreads();
    }
}
}
namespace mla {
constexpr int DQK = 192, DV = 128;
using G = att::Geo<DQK, DV>;
struct Src {
    const bf16_t* kn; const bf16_t* kr; const bf16_t* v;
    __device__ __forceinline__ const bf16_t* kptr(int t, int row, int cc) const { const int key = 64 * t + row; return cc < 16 ? kn + (size_t)key * 128 + cc * 8 : kr + (size_t)key * 64 + (cc - 16) * 8; }
    __device__ __forceinline__ const bf16_t* vptr(int t, int row, int cc) const { return v + (size_t)(64 * t + row) * 128 + cc * 8; }
};
struct Msk {
    int qlo, qpos;
    int hi;
    __device__ __forceinline__ int kind(int t) const { const int kb = 64 * t; return kb > qlo + 31 ? 0 : (kb + 63 <= qlo ? 1 : 2); }
    __device__ __forceinline__ void apply(f32x16& p0, f32x16& p1, int t, int) const {
        const float NEG = -__builtin_inff(); const int d = qpos - 64 * t - 4 * hi;
#pragma unroll
        for (int r = 0; r < 16; ++r) { const int c = (r & 3) + 8 * (r >> 2); if (c > d) p0[r] = NEG; if (c + 32 > d) p1[r] = NEG; }
    }
};
__device__ __forceinline__ void unit(LAS char* lds, int b, int h, int qb, const bf16_t* Q, const bf16_t* KN, const bf16_t* KR, const bf16_t* V, bf16_t* O, int tid, int lane_, int wid) {
    asm volatile("" : "+v"(tid)); const int lane = tid & 63;
    const int r32 = lane & 31, hi = lane >> 5;
    LAS float* wsc = (LAS float*)(lds + G::LDS_END) + wid * 64;
    const int q0 = qb * 256 + wid * 32;
    const size_t trow = (size_t)b * SEQ + q0 + r32;
    bf16x8 qr[DQK / 16];
#pragma unroll
    for (int d0 = 0; d0 < DQK / 16; ++d0) qr[d0] = *(const bf16x8*)(Q + trow * 1536 + h * 192 + d0 * 16 + hi * 8);
    Src src{KN + (size_t)(b * MLA_H + h) * SEQ * 128, KR + (size_t)b * SEQ * 64, V + (size_t)(b * MLA_H + h) * SEQ * 128};
    Msk msk{q0, q0 + r32, hi};
    float m_reg = -1e30f, l_reg = 0.f; f32x16 o[DV / 32] = {};
    att::run_online<DQK, DV, true>(lds, wsc, 4 * (qb + 1), src, msk, qr, m_reg, l_reg, o, tid, lane);
    if (hi == 0) wsc[r32] = l_reg;
    asm volatile("s_waitcnt lgkmcnt(0)" ::: "memory");
    bf16_t* Ow = O + ((size_t)b * SEQ + q0) * 1024 + h * 128;
#pragma unroll
    for (int r = 0; r < 16; ++r) { const int orow = att::crow(r, hi); const float l = wsc[orow]; const float rl = l > 0.f ? fast_rcp(l) : 0.f;
#pragma unroll
        for (int d0 = 0; d0 < DV / 32; ++d0) { const float v = o[d0][r] * rl; const float vn = __shfl_xor(v, 1);
            if ((r32 & 1) == 0) *(unsigned*)(Ow + (size_t)orow * 1024 + d0 * 32 + r32) = cvt_pk_bf16(v, vn); } }
    asm volatile("s_waitcnt lgkmcnt(0)" ::: "memory");
}
}

namespace nsa {
constexpr int DQK = 96, DV = 64;
using G = att::Geo<DQK, DV>;
constexpr int L_WSC = G::LDS_END;
constexpr int L_TAB = L_WSC + 8 * 256;
constexpr int TABW = 132;
constexpr int L_PSUM = L_TAB + 4 * TABW * 4;
constexpr int PSW = 68;
constexpr int L_IMP = L_PSUM + 8 * 8 * PSW * 4;
constexpr int L_SELW = L_IMP + 8 * 8 * 128 * 4;
constexpr int L_END = L_SELW + 8 * 8 * 4 * 4;
struct Src {
    const bf16_t* k; const bf16_t* v; int j0;
    __device__ __forceinline__ const bf16_t* kptr(int t, int row, int cc) const { return k + (size_t)(64 * (j0 + t) + row) * 96 + cc * 8; }
    __device__ __forceinline__ const bf16_t* vptr(int t, int row, int cc) const { return v + (size_t)(64 * (j0 + t) + row) * 64 + cc * 8; }
};
struct MskCmp {
    int qlo, qpos, hi; const LAS float* tab;
    __device__ __forceinline__ int kind(int t) const {
        const int n0 = 64 * t;
        if (qlo + 7 - (16 * n0 + 31) < 0) return 0;
        return (qlo - (16 * (n0 + 63) + 31) >= 128) ? 1 : 2;
    }
    __device__ __forceinline__ void apply(f32x16& p0, f32x16& p1, int t, int) const {
        const float NEG = -__builtin_inff(); const int dq = qpos - 31 - 16 * (64 * t + 4 * hi);
#pragma unroll
        for (int r = 0; r < 16; ++r) { const int c = 16 * ((r & 3) + 8 * (r >> 2));
            { const int d = dq - c; const float bv = ((const volatile LAS float*)tab)[(unsigned)d < 128u ? d : 128]; p0[r] = d >= 0 ? p0[r] + bv : NEG; }
            { const int d = dq - c - 512; const float bv = ((const volatile LAS float*)tab)[(unsigned)d < 128u ? d : 128]; p1[r] = d >= 0 ? p1[r] + bv : NEG; } }
    }
};
struct MskSel {
    int qpos, hi, cur; const LAS float* tab; const LAS unsigned* selw;
    __device__ __forceinline__ bool mine(int j) const { return (selw[j >> 5] >> (j & 31)) & 1u; }
    __device__ __forceinline__ int kind(int j) const {
        const bool s = mine(j);
        if (!__any(s)) return 0;
        if (j >= cur - 2) return 2;
        return __all(s) ? 1 : 3;
    }
    __device__ __forceinline__ void apply(f32x16& p0, f32x16& p1, int j, int kind) const {
        const float NEG = -__builtin_inff(); const bool s = mine(j);
        if (kind == 3) {
#pragma unroll
            for (int r = 0; r < 16; ++r) { p0[r] = s ? p0[r] : NEG; p1[r] = s ? p1[r] : NEG; }
        } else { const int dq = qpos - 64 * j - 4 * hi;
#pragma unroll
            for (int r = 0; r < 16; ++r) { const int c = (r & 3) + 8 * (r >> 2);
                { const int d = dq - c; const float bv = ((const volatile LAS float*)tab)[(unsigned)d < 128u ? d : 128]; p0[r] = (s && d >= 0) ? p0[r] + bv : NEG; }
                { const int d = dq - c - 32; const float bv = ((const volatile LAS float*)tab)[(unsigned)d < 128u ? d : 128]; p1[r] = (s && d >= 0) ? p1[r] + bv : NEG; } }
        }
    }
};
struct MskWin {
    int qpos, hi, cur, j0; const LAS float* tab;
    __device__ __forceinline__ int kind(int t) const { const int j = j0 + t; return (j >= cur - 2 || j <= cur - 8) ? 2 : 1; }
    __device__ __forceinline__ void apply(f32x16& p0, f32x16& p1, int t, int) const {
        const float NEG = -__builtin_inff(); const int dq = qpos - 64 * (j0 + t) - 4 * hi;
#pragma unroll
        for (int r = 0; r < 16; ++r) { const int c = (r & 3) + 8 * (r >> 2);
            { const int d = dq - c; const float bv = ((const volatile LAS float*)tab)[(unsigned)d < 128u ? d : 128]; p0[r] = (unsigned)d < 512u ? p0[r] + bv : NEG; }
            { const int d = dq - c - 32; const float bv = ((const volatile LAS float*)tab)[(unsigned)d < 128u ? d : 128]; p1[r] = (unsigned)d < 512u ? p1[r] + bv : NEG; } }
    }
};
__device__ __forceinline__ void fold(f32x16* ofin, const f32x16* o, float f, LAS float* wsc, int r32, int hi) {
    if (hi == 0) wsc[r32] = f;
    asm volatile("s_waitcnt lgkmcnt(0)" ::: "memory");
#pragma unroll
    for (int r = 0; r < 16; ++r) { const float a = wsc[att::crow(r, hi)];
#pragma unroll
        for (int d = 0; d < DV / 32; ++d) ofin[d][r] += o[d][r] * a; }
    asm volatile("s_waitcnt lgkmcnt(0)" : "+v"(ofin[0]), "+v"(ofin[1]) :: "memory");
}
struct Tensors { const bf16_t *NQ, *KCMP, *VCMP, *KS, *VS, *KW, *VW; const float *GT, *RBT; bf16_t* O; };
#define NSA_LAUNDER() int tid = tid0; asm volatile("" : "+v"(tid)); const int lane = tid & 63, r32 = lane & 31, hi = lane >> 5, qi = r32 >> 2, hg = r32 & 3; \
    LAS float* wsc = (LAS float*)(lds + L_WSC) + wid * 64; const LAS float* tab = (LAS float*)(lds + L_TAB) + hg * TABW; const int qpos = qlo + qi;
__device__ __forceinline__ void unit(LAS char* lds, const Tensors& X, int b, int g, int qblk, int tid0, int lane0, int wid) {
    const int s0 = qblk * 64, cur = qblk, qlo = s0 + 8 * wid;
    const int bg = b * NSA_G + g;
    bf16x8 qr[DQK / 16]; float gc, gs, gw;
    f32x16 ofin[DV / 32] = {};
    LAS float* imp = (LAS float*)(lds + L_IMP) + wid * 8 * 128;
    LAS unsigned* selw = (LAS unsigned*)(lds + L_SELW) + wid * 32;
    {
    NSA_LAUNDER();
    LAS float* tabs = (LAS float*)(lds + L_TAB);
    LAS float* psum = (LAS float*)(lds + L_PSUM) + wid * 8 * PSW;
    for (int i = tid; i < 4 * TABW; i += 512) tabs[i] = X.RBT[(g * 4 + i / TABW) * TABW + i % TABW];
    for (int i = lane; i < 8 * 128; i += 64) imp[i] = 0.f;
    if (lane < 8) psum[lane * PSW] = 0.f;
    if (lane < 32) selw[lane] = 0u;
    const size_t trow = (size_t)b * SEQ + qpos;
#pragma unroll
    for (int d0 = 0; d0 < DQK / 16; ++d0) qr[d0] = *(const bf16x8*)(X.NQ + trow * 1536 + (g * 4 + hg) * 96 + d0 * 16 + hi * 8);
    gc = X.GT[trow * 48 + (g * 4 + hg) * 3 + 0]; gs = X.GT[trow * 48 + (g * 4 + hg) * 3 + 1]; gw = X.GT[trow * 48 + (g * 4 + hg) * 3 + 2];
    __syncthreads();
    }
    const int ncv = (s0 + 63 >= 31) ? ((s0 + 63 - 31) >> 4) + 1 : 0;
    const int ntc = (ncv + 63) >> 6;
#ifndef NSA_NO_CMP
    {
        NSA_LAUNDER();
        Src srcC{X.KCMP + (size_t)bg * 512 * 96, X.VCMP + (size_t)bg * 512 * 64, 0};
        MskCmp mc{qlo, qpos, hi, tab};
        LAS float* psum = (LAS float*)(lds + L_PSUM) + wid * 8 * PSW;
        float m_reg = -1e30f, l_reg = 0.f; f32x16 od[DV / 32];
        att::run_online<DQK, DV, false>(lds, wsc, ntc, srcC, mc, qr, m_reg, l_reg, od, tid, lane);
        const float inv_l = l_reg > 0.f ? fast_rcp(l_reg) : 0.f;
        f32x16 o[DV / 32] = {};
        if (ntc > 0) {
            att::Stg<DQK, DV, Src> st;
            st.load(srcC, 0, tid); st.store(lds, 0, tid); __syncthreads();
            const unsigned vlane = (unsigned)((8 * hi + ((lane & 15) >> 2)) * G::VROW + (16 * ((lane >> 4) & 1) + 4 * (lane & 3)) * 2);
            for (int t = 0; t < ntc; ++t) {
                const int buf = t & 1;
                if (t + 1 < ntc) st.load(srcC, t + 1, tid);
                const int kind = mc.kind(t);
                if (kind) {
                    f32x16 p0, p1;
                    att::qk_tile<DQK>(p0, p1, lds + G::LDS_K + buf * G::KT, r32, hi, qr);
                    if (kind >= 2) mc.apply(p0, p1, t, kind);
#pragma unroll
                    for (int r = 0; r < 16; ++r) { p0[r] = fast_exp2(p0[r] - m_reg) * inv_l; p1[r] = fast_exp2(p1[r] - m_reg) * inv_l; }
#pragma unroll
                    for (int r = 0; r < 16; ++r) {
                        float a = p0[r]; a += __shfl_xor(a, 1); a += __shfl_xor(a, 2);
                        float c = p1[r]; c += __shfl_xor(c, 1); c += __shfl_xor(c, 2);
                        if (hg == 0) { psum[qi * PSW + 1 + att::crow(r, hi)] = a; psum[qi * PSW + 33 + att::crow(r, hi)] = c; }
                    }
                    asm volatile("s_waitcnt lgkmcnt(0)" ::: "memory");
                    {
                        const int q = lane >> 3;
#pragma unroll
                        for (int e = 0; e < 2; ++e) { const int jl = (lane & 7) * 2 + e; const LAS float* ps = psum + q * PSW + 4 * jl;
                            imp[q * 128 + 16 * t + jl] = (ps[0] + ps[1]) + (ps[2] + ps[3]) + ps[4]; }
                    }
                    asm volatile("s_waitcnt lgkmcnt(0)" ::: "memory");
                    if (lane < 8) psum[lane * PSW] = psum[lane * PSW + 64];
                    asm volatile("s_waitcnt lgkmcnt(0)" ::: "memory");
                    bf16x8 pa0, pa1, pa2, pa3; att::pack_p(p0, p1, pa0, pa1, pa2, pa3);
                    att::pv_tile<DV>(o, (unsigned)(uintptr_t)(lds + G::LDS_V + buf * G::VT) + vlane, pa0, pa1, pa2, pa3);
                }
                if (t + 1 < ntc) st.store(lds, buf ^ 1, tid);
                __syncthreads();
            }
        }
        fold(ofin, o, gc, wsc, r32, hi);
    }
#endif
#ifndef NSA_NO_TOPK
    {
        NSA_LAUNDER();
        const int q = lane >> 3, jl = lane & 7;
        float v[16]; int rk[16];
#pragma unroll
        for (int i = 0; i < 16; ++i) { const int j = jl + 8 * i; const float x = imp[q * 128 + j];
            v[i] = (j == 0 || j == cur || j == cur - 1) ? 1e6f : (j > cur ? -1e6f : x); rk[i] = 0; }
        for (int jp = 0; jp <= cur; ++jp) {
            const float x = imp[q * 128 + jp]; const float w = (jp == 0 || jp == cur || jp == cur - 1) ? 1e6f : x;
#pragma unroll
            for (int i = 0; i < 16; ++i) { const int j = jl + 8 * i; rk[i] += (w > v[i] || (w == v[i] && jp < j)) ? 1 : 0; }
        }
        unsigned wd[4] = {0u, 0u, 0u, 0u};
#pragma unroll
        for (int i = 0; i < 16; ++i) { const int j = jl + 8 * i; if (j <= cur && rk[i] < 16) wd[i >> 2] |= 1u << (jl + 8 * (i & 3)); }
#pragma unroll
        for (int w = 0; w < 4; ++w) if (wd[w]) atomicOr((unsigned*)(selw + q * 4 + w), wd[w]);
        asm volatile("s_waitcnt lgkmcnt(0)" ::: "memory");
    }
#endif
#ifndef NSA_NO_SEL
    {
        NSA_LAUNDER();
        Src srcS{X.KS + (size_t)bg * SEQ * 96, X.VS + (size_t)bg * SEQ * 64, 0};
        MskSel ms{qpos, hi, cur, tab, selw + qi * 4};
        float m_reg = -1e30f, l_reg = 0.f; f32x16 o[DV / 32] = {};
        att::run_online<DQK, DV, true>(lds, wsc, cur + 1, srcS, ms, qr, m_reg, l_reg, o, tid, lane);
        fold(ofin, o, l_reg > 0.f ? gs * fast_rcp(l_reg) : 0.f, wsc, r32, hi);
    }
#endif
#ifndef NSA_NO_WIN
    {
        NSA_LAUNDER();
        const int j0 = cur >= 8 ? cur - 8 : 0;
        Src srcW{X.KW + (size_t)bg * SEQ * 96, X.VW + (size_t)bg * SEQ * 64, j0};
        MskWin mw{qpos, hi, cur, j0, tab};
        float m_reg = -1e30f, l_reg = 0.f; f32x16 o[DV / 32] = {};
        att::run_online<DQK, DV, true>(lds, wsc, cur - j0 + 1, srcW, mw, qr, m_reg, l_reg, o, tid, lane);
        fold(ofin, o, l_reg > 0.f ? gw * fast_rcp(l_reg) : 0.f, wsc, r32, hi);
    }
#endif
    NSA_LAUNDER();
    bf16_t* Ow = X.O + ((size_t)b * SEQ + qlo) * 1024 + g * 256;
#pragma unroll
    for (int r = 0; r < 16; ++r) { const int orow = att::crow(r, hi);
#pragma unroll
        for (int d0 = 0; d0 < DV / 32; ++d0) { const float v = ofin[d0][r]; const float vn = __shfl_xor(v, 1);
            if ((r32 & 1) == 0) *(unsigned*)(Ow + (size_t)(orow >> 2) * 1024 + (orow & 3) * 64 + d0 * 32 + r32) = cvt_pk_bf16(v, vn); } }
    __syncthreads();
}
}
constexpr size_t MiB = 1u << 20;
constexpr size_t WS_CTL = 0, CTL_ZERO_BYTES = 1 * MiB;
constexpr size_t WS_W_MLAIN = 1 * MiB;
constexpr size_t WS_W_QUP   = 3 * MiB;
constexpr size_t WS_W_KVUP  = WS_W_QUP + 1536 * 1024;
constexpr size_t WS_W_MLAOUT = WS_W_KVUP + 1 * MiB;
constexpr size_t WS_W_FFNGU = WS_W_MLAOUT + 2 * MiB;
constexpr size_t WS_W_FFND  = WS_W_FFNGU + 11 * MiB;
constexpr size_t WS_W_NSAIN = WS_W_FFND + 5632 * 1024;
constexpr size_t WS_W_NSAOUT = WS_W_NSAIN + 7 * MiB;
constexpr size_t WS_W_C1K = WS_W_NSAOUT + 2 * MiB;
constexpr size_t WS_W_C1V = WS_W_C1K + 256 * 3072 * 2;
constexpr size_t WS_W_C2K = WS_W_C1V + 256 * 2048 * 2;
constexpr size_t WS_W_C2V = WS_W_C2K + 256 * 128 * 2;
constexpr size_t WS_ROPE  = WS_W_C2V + 256 * 128 * 2;
constexpr size_t WS_CBIAS = WS_ROPE + 2 * MiB;
constexpr size_t WS_RBT   = WS_CBIAS + 1024;
constexpr size_t WS_ROWTOK = 38 * MiB;
constexpr size_t WS_TOKINFO = 39 * MiB;
constexpr size_t WS_TOKW = WS_TOKINFO + 256 * 1024;
static_assert(WS_RBT + 16 * 132 * 4 <= WS_ROWTOK && WS_TOKW + 256 * 1024 <= 40 * MiB, "small region");
constexpr size_t WS_XB = 40 * MiB, WS_LAT = 104 * MiB, WS_QN = 168 * MiB, WS_KVN = 200 * MiB, WS_KR = 216 * MiB, WS_Q = 220 * MiB, WS_KN = 316 * MiB, WS_V = 380 * MiB;
constexpr size_t WS_O = 40 * MiB, WS_X1 = 104 * MiB, WS_ACT = 168 * MiB, WS_X2 = 40 * MiB;
constexpr size_t WS_NQ = 104 * MiB, WS_KC = 200 * MiB, WS_VC = 224 * MiB, WS_KS = 240 * MiB, WS_VS = 264 * MiB, WS_KW = 280 * MiB, WS_VW = 304 * MiB, WS_GT = 320 * MiB;
static_assert(WS_KS - WS_KC == 40 * MiB && WS_KW - WS_KS == 40 * MiB && WS_VS - WS_VC == 40 * MiB && WS_VW - WS_VS == 40 * MiB, "FNsaIn segment stride");
constexpr size_t WS_HK = 328 * MiB, WS_HV = 330 * MiB, WS_KCMP = 332 * MiB, WS_VCMP = 334 * MiB;
constexpr size_t WS_ONSA = 348 * MiB, WS_X3 = 412 * MiB;
constexpr size_t WS_MOE_GU = 40 * MiB, WS_MOE_D = 152 * MiB, WS_DOUT = 208 * MiB;
constexpr size_t WS_END = 476 * MiB;
constexpr int CW_BAR = 4096;
constexpr int CW_ECNT = 16384;
constexpr int RING_BYTES = 131072;
constexpr int MISC_OFF = RING_BYTES + 320;
constexpr int LDS_BYTES = 147456;
constexpr int NWAVES = 8;
static_assert(nsa::L_END <= RING_BYTES && mla::G::LDS_END + 2048 <= RING_BYTES, "attention LDS");

#define RLX_AGENT __ATOMIC_RELAXED, __HIP_MEMORY_SCOPE_AGENT
#define LDS_WAIT() asm volatile("s_waitcnt lgkmcnt(0)" ::: "memory")
#define VM_WAIT() asm volatile("s_waitcnt vmcnt(0)" ::: "memory")
__device__ __forceinline__ unsigned f2bf(float f) { unsigned u = __builtin_bit_cast(unsigned, f); return (u + 0x7fffu + ((u >> 16) & 1u)) >> 16; }
__device__ __forceinline__ unsigned pk2(float lo, float hi) { return f2bf(lo) | (f2bf(hi) << 16); }

#define XB_TMO      128
#define XB_XCNT(j)  (256  + 64 * (j))
#define XB_XSUB(j)  (1280 + 64 * (j))
#define XB_XGEN(j)  (2304 + 64 * (j))
#define XB_TOP      3328
#define XB_TOPGEN   3392
#define XCD_BAR_WORDS 3456
#define XB_SPIN_CAP (1u << 20)
__device__ __forceinline__ unsigned xb_ld(unsigned* p)              { return __hip_atomic_load(p, __ATOMIC_RELAXED, __HIP_MEMORY_SCOPE_AGENT); }
__device__ __forceinline__ unsigned xb_add(unsigned* p, unsigned v) { return __hip_atomic_fetch_add(p, v, __ATOMIC_RELAXED, __HIP_MEMORY_SCOPE_AGENT); }
__device__ __forceinline__ unsigned xb_xcc_id() { return (unsigned)__builtin_amdgcn_s_getreg((3 << 11) | 20) & 0xFu; }
#define XB_SPIN(cond, bar) do { unsigned _sp = 0; while (cond) { __builtin_amdgcn_s_sleep(1); \
    if ((++_sp & 255u) == 0u) { if (xb_ld(&(bar)[XB_TMO])) break; if (_sp > XB_SPIN_CAP) { atomicAdd(&(bar)[XB_TMO], 1u); break; } } } } while (0)
struct XcdBarrier { unsigned* bar; unsigned x; volatile LAS unsigned* st; };
__device__ __forceinline__ XcdBarrier xcd_barrier_post(unsigned* bar, volatile LAS unsigned* st) {
    XcdBarrier b; b.bar = bar; b.x = xb_xcc_id(); b.st = st;
    if (threadIdx.x == 0) (void)xb_add(&bar[XB_XCNT(b.x)], 1u);
    return b;
}
__device__ __forceinline__ void xcd_barrier_complete(unsigned* bar, unsigned x, unsigned& nloc, unsigned& nx) {
    const unsigned G = gridDim.x * gridDim.y * gridDim.z;
    unsigned sum, cnt, mine, sp = 0u;
    for (;;) {
        sum = 0u; cnt = 0u; mine = 0u;
#pragma unroll
        for (unsigned j = 0; j < 16; ++j) { const unsigned c = xb_ld(&bar[XB_XCNT(j)]); sum += c; cnt += (c > 0u) ? 1u : 0u; mine = (j == x) ? c : mine; }
        if (sum == G) break;
        __builtin_amdgcn_s_sleep(1);
        if ((++sp & 255u) == 0u) { if (xb_ld(&bar[XB_TMO])) break; if (sp > XB_SPIN_CAP) { atomicAdd(&bar[XB_TMO], 1u); break; } }
    }
    nloc = mine > 0u ? mine : 1u; nx = cnt > 0u ? cnt : 1u;
}
__device__ __forceinline__ void xcd_barrier(const XcdBarrier& b) {
    asm volatile("s_waitcnt vmcnt(0)" ::: "memory");
    __syncthreads();
    if (threadIdx.x == 0) {
        unsigned* bar = b.bar;
        __builtin_amdgcn_s_waitcnt(0);
        unsigned nloc = b.st[0], nx = b.st[1];
        if (nloc == 0u) { xcd_barrier_complete(bar, b.x, nloc, nx); b.st[0] = nloc; b.st[1] = nx; }
        const unsigned old = xb_add(&bar[XB_XSUB(b.x)], 1u);
        const unsigned gen = old / nloc;
        if (old + 1u == (gen + 1u) * nloc) {
            __builtin_amdgcn_fence(__ATOMIC_RELEASE, "agent");
            asm volatile("s_waitcnt vmcnt(0)" ::: "memory");
            const unsigned og = xb_add(&bar[XB_TOP], 1u);
            const unsigned tg = og / nx;
            if (og + 1u == (tg + 1u) * nx) xb_add(&bar[XB_TOPGEN], 1u);
            else XB_SPIN(xb_ld(&bar[XB_TOPGEN]) == tg, bar);
            __builtin_amdgcn_fence(__ATOMIC_ACQUIRE, "agent");
            xb_add(&bar[XB_XGEN(b.x)], 1u);
            asm volatile("s_waitcnt vmcnt(0)" ::: "memory");
        } else {
            XB_SPIN(xb_ld(&bar[XB_XGEN(b.x)]) == gen, bar);
            __builtin_amdgcn_fence(__ATOMIC_ACQUIRE, "agent");
            asm volatile("s_waitcnt vmcnt(0)" ::: "memory");
        }
    }
    __syncthreads();
}

__device__ __forceinline__ float wave_sum(float v) {
#pragma unroll
    for (int o = 1; o < 64; o <<= 1) v += __shfl_xor(v, o);
    return v;
}
template <class RM> __device__ __forceinline__ void tr_item(const float* W, int K, int N, bf16_t* WT, int ldk, const RM& rowmap, LAS float* scr, int item, int lane) {
    const int nblk = (N + 31) / 32, kb = item / nblk, nb = item % nblk, k0 = 64 * kb, n0 = 32 * nb;
    const bool nok = n0 + (lane & 31) < N;
#pragma unroll 8
    for (int i = 0; i < 32; ++i) { const int kk = 2 * i + (lane >> 5); scr[kk * 33 + (lane & 31)] = nok ? W[(size_t)(k0 + kk) * N + n0 + (lane & 31)] : 0.f; }
    LDS_WAIT(); asm volatile("" ::: "memory");
    const int c = lane & 7;
#pragma unroll
    for (int j = 0; j < 4; ++j) { const int nl = (lane >> 3) + 8 * j; const LAS float* s = scr + (8 * c) * 33 + nl;
        u32x4 o; o.x = pk2(s[0 * 33], s[1 * 33]); o.y = pk2(s[2 * 33], s[3 * 33]); o.z = pk2(s[4 * 33], s[5 * 33]); o.w = pk2(s[6 * 33], s[7 * 33]);
        if (n0 + nl < N) *(u32x4*)(WT + (size_t)rowmap(n0 + nl) * ldk + k0 + 8 * c) = o; }
    LDS_WAIT(); asm volatile("" ::: "memory");
}
struct RmId { int off; __device__ __forceinline__ int operator()(int n) const { return off + n; } };
struct RmGU { int off; __device__ __forceinline__ int operator()(int n) const { return off + (n >> 7) * 256 + (n & 127); } };
struct RmQup { __device__ __forceinline__ int operator()(int n) const { const int h = n / 192, j = n % 192; if (j < 128) return n; const int i = j - 128, ii = i & 31; return h * 192 + 128 + 8 * (ii >> 2) + (ii & 3) + ((i >> 5) << 2); } };
template <class RM> __device__ __forceinline__ void tr_matrix(const float* W, int K, int N, bf16_t* WT, int ldk, const RM& rm, LAS float* scr, int gw, int ngw, int lane) {
    const int nitems = (K / 64) * ((N + 31) / 32);
    for (int it = gw; it < nitems; it += ngw) tr_item(W, K, N, WT, ldk, rm, scr, it, lane);
}
__device__ __forceinline__ void ln_inplace(f32x4 (&v)[4], const float* g, const float* b, int lane) {
    float s = 0.f;
#pragma unroll
    for (int j = 0; j < 4; ++j) s += (v[j].x + v[j].y) + (v[j].z + v[j].w);
    const float mean = wave_sum(s) * (1.f / D); float s2 = 0.f;
#pragma unroll
    for (int j = 0; j < 4; ++j) { v[j] = v[j] - mean; s2 += (v[j].x * v[j].x + v[j].y * v[j].y) + (v[j].z * v[j].z + v[j].w * v[j].w); }
    const float rstd = 1.f / sqrtf(wave_sum(s2) * (1.f / D) + 1e-5f);
#pragma unroll
    for (int j = 0; j < 4; ++j) { const f32x4 gg = *((const f32x4*)g + lane + 64 * j), bb = *((const f32x4*)b + lane + 64 * j); v[j] = v[j] * rstd * gg + bb; }
}
__device__ __forceinline__ void store_row_bf16(bf16_t* orow, const f32x4 (&v)[4], int lane) {
    u32x2* o8 = (u32x2*)orow + lane;
#pragma unroll
    for (int j = 0; j < 4; ++j) { u32x2 w; w.x = cvt_pk_bf16(v[j].x, v[j].y); w.y = cvt_pk_bf16(v[j].z, v[j].w); o8[64 * j] = w; }
}
__device__ __forceinline__ f32x4 bf4_to_f32(u32x2 w) { return (f32x4){bflo(w.x), bfhi(w.x), bflo(w.y), bfhi(w.y)}; }

__device__ __forceinline__ u32x4 pack8(f32x4 a, f32x4 b) { u32x4 w; w.x = cvt_pk_bf16(a[0], a[1]); w.y = cvt_pk_bf16(a[2], a[3]); w.z = cvt_pk_bf16(b[0], b[1]); w.w = cvt_pk_bf16(b[2], b[3]); return w; }
struct FBf16 { bf16_t* O; int ld; int rowoff;
    __device__ __forceinline__ void operator()(int row, int col, f32x4 a, f32x4 b) const { *(u32x4*)(O + (size_t)(rowoff + row) * ld + col) = pack8(a, b); } };
struct FQup { bf16_t* Q; const float* cs; const float* sn;
    __device__ __forceinline__ void operator()(int row, int col, f32x4 a, f32x4 b) const {
        const int j = col % 192;
        if (j >= 128) { const int i0 = ((j - 128) >> 3) * 4, s = row & (SEQ - 1);
            const f32x4 c = *(const f32x4*)(cs + s * 32 + i0), sv = *(const f32x4*)(sn + s * 32 + i0);
            const f32x4 o1 = a * c - b * sv, o2 = a * sv + b * c; a = o1; b = o2; }
        *(u32x4*)(Q + (size_t)row * 1536 + col) = pack8(a * C2_MLA, b * C2_MLA); } };
struct FKvup { bf16_t* KN; bf16_t* V;
    __device__ __forceinline__ void operator()(int row, int col, f32x4 a, f32x4 b) const {
        const int h = col >> 8, j = col & 255, bb = row >> 13, s = row & (SEQ - 1);
        bf16_t* base = (j < 128 ? KN : V) + ((size_t)(bb * MLA_H + h) * SEQ + s) * 128 + (j & 127);
        *(u32x4*)base = pack8(a, b); } };
struct FResF32 { float* P; const float* rf; const bf16_t* rb;
    __device__ __forceinline__ void operator()(int row, int col, f32x4 a, f32x4 b) const {
        const size_t o = (size_t)row * D + col; f32x4 r0, r1;
        if (rf) { r0 = *(const f32x4*)(rf + o); r1 = *(const f32x4*)(rf + o + 4); }
        else { const u32x4 w = *(const u32x4*)(rb + o); r0 = (f32x4){bflo(w.x), bfhi(w.x), bflo(w.y), bfhi(w.y)}; r1 = (f32x4){bflo(w.z), bfhi(w.z), bflo(w.w), bfhi(w.w)}; }
        *(f32x4*)(P + o) = r0 * ALPHA + a; *(f32x4*)(P + o + 4) = r1 * ALPHA + b; } };
struct FSwiglu { bf16_t* A; int ld; int rowoff;
    __device__ __forceinline__ void operator()(int row, int col, f32x4 g0, f32x4 g1, f32x4 u0, f32x4 u1) const {
        f32x4 a, b;
#pragma unroll
        for (int e = 0; e < 4; ++e) { a[e] = silu_f(g0[e]) * u0[e]; b[e] = silu_f(g1[e]) * u1[e]; }
        *(u32x4*)(A + (size_t)(rowoff + row) * ld + col) = pack8(a, b); } };
struct FNsaIn { bf16_t *NQ, *KC, *VC; float* GT;
    __device__ __forceinline__ void operator()(int row, int col, f32x4 a, f32x4 b) const {
        const int bb = row >> 13, s = row & (SEQ - 1);
        if (col < 1536) { *(u32x4*)(NQ + (size_t)row * 1536 + col) = pack8(a * C2_NSA, b * C2_NSA); return; }
        if (col >= 3504) return;
        if (col >= 3456) { float* gp = GT + (size_t)row * 48 + (col - 3456);
            f32x4 x, y;
#pragma unroll
            for (int e = 0; e < 4; ++e) { x[e] = sigmoid_f(a[e]); y[e] = sigmoid_f(b[e]); }
            *(f32x4*)gp = x; *(f32x4*)(gp + 4) = y; return; }
        int cc = col - 1536; const int seg = cc / 640; cc -= seg * 640;
        const bool isk = cc < 384; if (!isk) cc -= 384;
        bf16_t* base = (isk ? KC : VC) + (size_t)seg * (40u * 1024u * 1024u / 2u);
        const int dd = isk ? 96 : 64, g = cc / dd, d = cc - g * dd;
        *(u32x4*)(base + ((size_t)(bb * NSA_G + g) * SEQ + s) * dd + d) = pack8(a, b); } };
struct FCmp1 { bf16_t* H; const float* bias;
    __device__ __forceinline__ void operator()(int row, int col, f32x4 a, f32x4 b) const {
        if (col >= 128) return;
        const f32x4 b0 = *(const f32x4*)(bias + col), b1 = *(const f32x4*)(bias + col + 4); f32x4 x, y;
#pragma unroll
        for (int e = 0; e < 4; ++e) { x[e] = gelu_tanh_f(a[e] + b0[e]); y[e] = gelu_tanh_f(b[e] + b1[e]); }
        *(u32x4*)(H + (size_t)row * 128 + col) = pack8(x, y); } };
struct FCmp2 { bf16_t* O; int nd;
    __device__ __forceinline__ void operator()(int row, int col, f32x4 a, f32x4 b) const {
        if (col >= nd) return;
        if ((row & 511) == 511) { a = (f32x4){0.f, 0.f, 0.f, 0.f}; b = a; }
        *(u32x4*)(O + (size_t)row * nd + col) = pack8(a, b); } };

struct MoeInfo { int cnt[NE]; int ts[NE + 1];
    __device__ __forceinline__ int expert_of(int ct) const { int e = 0;
#pragma unroll
        for (int i = 1; i < NE; ++i) e += (ct >= ts[i]) ? 1 : 0; return e; } };
struct SchedMoeGU {
    pg8::StaticOrder so; MoeInfo mi; int ct0; const int* rowtok;
    __device__ __forceinline__ bool next(int i, pg8::Unit& u) const { return so.next(i, u); }
    __device__ __forceinline__ size_t a_off(const pg8::Unit&, const pg8::Gemm&) const { return 0; }
    __device__ __forceinline__ size_t b_off(const pg8::Unit& u, const pg8::Gemm& g) const { const int e = mi.expert_of(ct0 + u.pm); return ((size_t)e * (2 * FFE) + (size_t)u.pn * 256) * g.ldb * 2; }
    __device__ __forceinline__ unsigned a_row(const pg8::Unit& u, int r) const {
        const int ct = ct0 + u.pm, e = mi.expert_of(ct); int c = 0, t0 = 0;
#pragma unroll
        for (int i = 0; i < NE; ++i) { c = (i == e) ? mi.cnt[i] : c; t0 = (i == e) ? mi.ts[i] : t0; }
        const int pos = (ct - t0) * 256 + r; const int tok = pos < c ? rowtok[e * ECAP + pos] : 0;
        return (unsigned)tok * (unsigned)(D * 2); }
};
struct SchedMoeD {
    pg8::StaticOrder so; MoeInfo mi; int ct0;
    __device__ __forceinline__ bool next(int i, pg8::Unit& u) const { return so.next(i, u); }
    __device__ __forceinline__ size_t a_off(const pg8::Unit& u, const pg8::Gemm& g) const { return (size_t)u.pm * 256 * g.lda * 2; }
    __device__ __forceinline__ size_t b_off(const pg8::Unit& u, const pg8::Gemm& g) const { const int e = mi.expert_of(ct0 + u.pm); return ((size_t)e * D + (size_t)u.pn * 256) * g.ldb * 2; }
    __device__ __forceinline__ unsigned a_row(const pg8::Unit&, int) const { return 0u; }
};
constexpr int N_PHASES = 28;
struct Args { const float* in[27]; float* out; unsigned char* ws; int ph_lo, ph_hi; };
enum { I_X = 0, I_MLA_WIN, I_MLA_QN, I_MLA_WQ, I_MLA_KVN, I_MLA_WKV, I_MLA_WO, I_NSA_WIN, I_PE_K, I_W1_K, I_W2_K, I_PE_V, I_W1_V, I_W2_V, I_NSA_WO, I_RELB,
       I_FFN_G, I_FFN_U, I_FFN_D, I_ROUTER, I_MOE_G, I_MOE_U, I_MOE_D, I_LNM_G, I_LNM_B, I_LNF_G, I_LNF_B };

__device__ __forceinline__ int rel_bucket_dev(int n) {
    if (n < 16) return n;
    int bkt = 16;
    bkt += n >= 19; bkt += n >= 21; bkt += n >= 24; bkt += n >= 27; bkt += n >= 31; bkt += n >= 35; bkt += n >= 40; bkt += n >= 46;
    bkt += n >= 52; bkt += n >= 59; bkt += n >= 67; bkt += n >= 77; bkt += n >= 87; bkt += n >= 99; bkt += n >= 113;
    return bkt;
}

__global__ void __launch_bounds__(NWAVES * 64, 2) fwd(Args args) {
    extern __shared__ __attribute__((aligned(16))) unsigned char lds_raw[];
    LAS unsigned char* lds = (LAS unsigned char*)lds_raw;
    volatile LAS unsigned* MISC = (volatile LAS unsigned*)(lds + MISC_OFF);
    const int tid_ = threadIdx.x, wave = __builtin_amdgcn_readfirstlane(tid_ >> 6);
    const int G = gridDim.x, bx = blockIdx.x;
    const int vcu = (G % 8 == 0) ? (bx % 8) * (G / 8) + bx / 8 : bx;
    const int NGW = G * NWAVES;
    unsigned char* ws = args.ws;
    unsigned* ctl = (unsigned*)(ws + WS_CTL);
    for (int u = tid_; u < (LDS_BYTES - RING_BYTES) / 4; u += NWAVES * 64) ((LAS unsigned*)(lds + RING_BYTES))[u] = 0u;
    __syncthreads();
    XcdBarrier bar = xcd_barrier_post(ctl + CW_BAR, MISC + 8);
    const int lo = args.ph_lo, hi_ph = args.ph_hi;
#ifndef PHMASK
#define PHMASK 0xFFFFFFFFu
#endif
#define IN(k) (((PHMASK >> (k)) & 1u) && lo <= (k) && (k) < hi_ph)
#define SEAM(k) do { if (IN(k) && IN((k) + 1)) xcd_barrier(bar); } while (0)
#define W_MLAIN ((bf16_t*)(ws + WS_W_MLAIN))
#define W_QUP ((bf16_t*)(ws + WS_W_QUP))
#define W_KVUP ((bf16_t*)(ws + WS_W_KVUP))
#define W_MLAOUT ((bf16_t*)(ws + WS_W_MLAOUT))
#define W_FFNGU ((bf16_t*)(ws + WS_W_FFNGU))
#define W_FFND ((bf16_t*)(ws + WS_W_FFND))
#define W_NSAIN ((bf16_t*)(ws + WS_W_NSAIN))
#define W_NSAOUT ((bf16_t*)(ws + WS_W_NSAOUT))
#define W_C1K ((bf16_t*)(ws + WS_W_C1K))
#define W_C1V ((bf16_t*)(ws + WS_W_C1V))
#define W_C2K ((bf16_t*)(ws + WS_W_C2K))
#define W_C2V ((bf16_t*)(ws + WS_W_C2V))
#define ROPE_C ((float*)(ws + WS_ROPE))
#define CBIAS ((float*)(ws + WS_CBIAS))
#define RBT ((float*)(ws + WS_RBT))
#define ROWTOK ((int*)(ws + WS_ROWTOK))
#define TOKINFO ((unsigned*)(ws + WS_TOKINFO))
#define TOKW ((float*)(ws + WS_TOKW))
#define XB ((bf16_t*)(ws + WS_XB))
#define LAT ((bf16_t*)(ws + WS_LAT))
#define QN ((bf16_t*)(ws + WS_QN))
#define KVN ((bf16_t*)(ws + WS_KVN))
#define KR ((bf16_t*)(ws + WS_KR))
#define Q ((bf16_t*)(ws + WS_Q))
#define KN ((bf16_t*)(ws + WS_KN))
#define V ((bf16_t*)(ws + WS_V))
#define O ((bf16_t*)(ws + WS_O))
#define X1 ((bf16_t*)(ws + WS_X1))
#define ACT ((bf16_t*)(ws + WS_ACT))
#define X2 ((bf16_t*)(ws + WS_X2))
#define NQ ((bf16_t*)(ws + WS_NQ))
#define KC ((bf16_t*)(ws + WS_KC))
#define VC ((bf16_t*)(ws + WS_VC))
#define KS ((bf16_t*)(ws + WS_KS))
#define VS ((bf16_t*)(ws + WS_VS))
#define KW ((bf16_t*)(ws + WS_KW))
#define VW ((bf16_t*)(ws + WS_VW))
#define GT ((float*)(ws + WS_GT))
#define HK ((bf16_t*)(ws + WS_HK))
#define HV ((bf16_t*)(ws + WS_HV))
#define KCMP ((bf16_t*)(ws + WS_KCMP))
#define VCMP ((bf16_t*)(ws + WS_VCMP))
#define ONSA ((bf16_t*)(ws + WS_ONSA))
#define X3 ((bf16_t*)(ws + WS_X3))
#define W_MOEGU ((bf16_t*)(ws + WS_MOE_GU))
#define W_MOED ((bf16_t*)(ws + WS_MOE_D))
#define DOUT ((bf16_t*)(ws + WS_DOUT))
#define ROPE_S (ROPE_C + SEQ * 32)
#define P (args.out)
#define ACTC ((bf16_t*)args.out)
    typedef pg8::SchedPlain SP;
#define PH_LAUNDER() int tid = tid_; asm volatile("" : "+v"(tid)); const int lane = tid & 63; const int gw = vcu * NWAVES + wave; LAS float* scr = (LAS float*)(lds + wave * 8704); (void)lane; (void)gw; (void)scr;

    if (IN(0)) {
        PH_LAUNDER();
        const float* const* in = args.in;
        tr_matrix(in[I_MLA_WIN], D, MLA_IN, W_MLAIN, D, RmId{0}, scr, gw, NGW, lane);
        tr_matrix(in[I_MLA_WQ], MLA_QR, 1536, W_QUP, MLA_QR, RmQup{}, scr, gw, NGW, lane);
        tr_matrix(in[I_MLA_WKV], MLA_KVR, 2048, W_KVUP, MLA_KVR, RmId{0}, scr, gw, NGW, lane);
        tr_matrix(in[I_MLA_WO], D, D, W_MLAOUT, D, RmId{0}, scr, gw, NGW, lane);
        tr_matrix(in[I_FFN_G], D, FF, W_FFNGU, D, RmGU{0}, scr, gw, NGW, lane);
        tr_matrix(in[I_FFN_U], D, FF, W_FFNGU, D, RmGU{128}, scr, gw, NGW, lane);
        tr_matrix(in[I_FFN_D], FF, D, W_FFND, FF, RmId{0}, scr, gw, NGW, lane);
        tr_matrix(in[I_NSA_WIN], D, NSA_IN, W_NSAIN, D, RmId{0}, scr, gw, NGW, lane);
        tr_matrix(in[I_NSA_WO], D, D, W_NSAOUT, D, RmId{0}, scr, gw, NGW, lane);
        const int gt = vcu * 512 + tid, NGT = G * 512;
        for (int i = gt; i < (1024 - MLA_IN) * D / 8; i += NGT) ((u32x4*)(W_MLAIN + (size_t)MLA_IN * D))[i] = (u32x4){0u, 0u, 0u, 0u};
        for (int i = gt; i < (NSA_INP - NSA_IN) * D / 8; i += NGT) ((u32x4*)(W_NSAIN + (size_t)NSA_IN * D))[i] = (u32x4){0u, 0u, 0u, 0u};
        for (int i = gt; i < 256 * 3072; i += NGT) { const int n = i / 3072, k = i % 3072; W_C1K[i] = (bf16_t)(n < 96 ? f2bf(in[I_W1_K][(size_t)k * 96 + n]) : 0u); }
        for (int i = gt; i < 256 * 2048; i += NGT) { const int n = i / 2048, k = i % 2048; W_C1V[i] = (bf16_t)(n < 64 ? f2bf(in[I_W1_V][(size_t)k * 64 + n]) : 0u); }
        for (int i = gt; i < 256 * 128; i += NGT) { const int n = i / 128, k = i % 128;
            W_C2K[i] = (bf16_t)((n < 96 && k < 96) ? f2bf(in[I_W2_K][k * 96 + n]) : 0u); W_C2V[i] = (bf16_t)((n < 64 && k < 64) ? f2bf(in[I_W2_V][k * 64 + n]) : 0u); }
        for (int i = gt; i < 256; i += NGT) { const int isv = i >> 7, e = i & 127; const int nd = isv ? 64 : 96; float s = 0.f;
            if (e < nd) { const float* pe = in[isv ? I_PE_V : I_PE_K]; const float* w1 = in[isv ? I_W1_V : I_W1_K]; for (int k = 0; k < 32 * nd; ++k) s += pe[k] * w1[(size_t)k * nd + e]; }
            CBIAS[i] = s; }
        for (int i = gt; i < SEQ * 32; i += NGT) { const int pos = i >> 5, j = i & 31; const float fr = (float)pow(10000.0, -(double)j / 32.0); const float ang = (float)pos * fr;
            ROPE_C[i] = (float)cos((double)ang); ROPE_S[i] = (float)sin((double)ang); }
        for (int i = gt; i < 16 * nsa::TABW; i += NGT) { const int h = i / nsa::TABW, d = i % nsa::TABW; const float* rb = in[I_RELB];
            RBT[i] = d < 128 ? (rb[rel_bucket_dev(d) * 16 + h] - rb[31 * 16 + h]) * LOG2E : 0.f; }
        for (int m = gw; m < T; m += NGW) { const f32x4* xr = (const f32x4*)(in[I_X] + (size_t)m * D) + lane; f32x4 v[4];
#pragma unroll
            for (int j = 0; j < 4; ++j) v[j] = xr[64 * j];
            store_row_bf16(XB + (size_t)m * D, v, lane); }
    }
    SEAM(0);
    if (IN(1)) { pg8::Gemm g{XB, W_MLAIN, D, D, D}; SP S; S.init(T / 256, 4, G, bx);
        pg8::EpiRow8<FBf16> E{FBf16{LAT, 1024, 0}}; pg8::gemm_phase<pg8::EpiRow8<FBf16>, SP, true, false>(lds, g, S, E); }
    SEAM(1);
    if (IN(2)) {
        PH_LAUNDER();
        const float* qg = args.in[I_MLA_QN]; const float* kg = args.in[I_MLA_KVN];
        for (int m = gw; m < T; m += NGW) {
            const bf16_t* row = LAT + (size_t)m * 1024;
            const u32x4 wq = *((const u32x4*)row + lane);
            const u32x2 wk = *((const u32x2*)(row + 512) + lane);
            float q[8] = {bflo(wq.x), bfhi(wq.x), bflo(wq.y), bfhi(wq.y), bflo(wq.z), bfhi(wq.z), bflo(wq.w), bfhi(wq.w)};
            float k[4] = {bflo(wk.x), bfhi(wk.x), bflo(wk.y), bfhi(wk.y)};
            float sq = 0.f, sk = 0.f;
#pragma unroll
            for (int e = 0; e < 8; ++e) sq += q[e] * q[e];
#pragma unroll
            for (int e = 0; e < 4; ++e) sk += k[e] * k[e];
            const float rq = 1.f / sqrtf(wave_sum(sq) * (1.f / 512.f) + 1e-6f), rk = 1.f / sqrtf(wave_sum(sk) * (1.f / 256.f) + 1e-6f);
            const f32x4 g0 = *((const f32x4*)qg + 2 * lane), g1 = *((const f32x4*)qg + 2 * lane + 1), g2 = *((const f32x4*)kg + lane);
            u32x4 oq; oq.x = cvt_pk_bf16(q[0] * rq * g0[0], q[1] * rq * g0[1]); oq.y = cvt_pk_bf16(q[2] * rq * g0[2], q[3] * rq * g0[3]);
            oq.z = cvt_pk_bf16(q[4] * rq * g1[0], q[5] * rq * g1[1]); oq.w = cvt_pk_bf16(q[6] * rq * g1[2], q[7] * rq * g1[3]);
            *((u32x4*)(QN + (size_t)m * 512) + lane) = oq;
            u32x2 ok; ok.x = cvt_pk_bf16(k[0] * rk * g2[0], k[1] * rk * g2[1]); ok.y = cvt_pk_bf16(k[2] * rk * g2[2], k[3] * rk * g2[3]);
            *((u32x2*)(KVN + (size_t)m * 256) + lane) = ok;
            if (lane < 32) { const float x1 = bf2f(row[768 + lane]), x2 = bf2f(row[800 + lane]); const int s = m & (SEQ - 1);
                const float c = ROPE_C[s * 32 + lane], sn = ROPE_S[s * 32 + lane]; const int p = 8 * (lane >> 2) + (lane & 3);
                bf16_t* kr = KR + (size_t)m * 64; kr[p] = (bf16_t)f2bf(x1 * c - x2 * sn); kr[p + 4] = (bf16_t)f2bf(x1 * sn + x2 * c); }
        }
    }
    SEAM(2);
    if (IN(3)) { pg8::Gemm g{QN, W_QUP, MLA_QR, MLA_QR, MLA_QR}; SP S; S.init(T / 256, 6, G, bx);
        pg8::EpiRow8<FQup> E{FQup{Q, ROPE_C, ROPE_S}}; pg8::gemm_phase<pg8::EpiRow8<FQup>, SP, true, false>(lds, g, S, E); }
    SEAM(3);
    if (IN(4)) { pg8::Gemm g{KVN, W_KVUP, MLA_KVR, MLA_KVR, MLA_KVR}; SP S; S.init(T / 256, 8, G, bx);
        pg8::EpiRow8<FKvup> E{FKvup{KN, V}}; pg8::gemm_phase<pg8::EpiRow8<FKvup>, SP, true, false>(lds, g, S, E); }
    SEAM(4);
    if (IN(5)) {
        PH_LAUNDER();
        for (int it2 = 2 * bx; it2 < 2 * NB * MLA_H * 16; it2 += (it2 & 1) ? 2 * G - 1 : 1) { const int it = it2 >> 1, bh = it & 31, x = it >> 5;
            mla::unit((LAS char*)lds, bh >> 3, bh & 7, (it2 & 1) ? x : 31 - x, Q, KN, KR, V, O, tid, lane, wave); }
    }
    SEAM(5);
    if (IN(6)) { pg8::Gemm g{O, W_MLAOUT, D, D, D}; SP S; S.init(T / 256, 4, G, bx);
        pg8::EpiRow8<FResF32> E{FResF32{P, args.in[I_X], nullptr}}; pg8::gemm_phase<pg8::EpiRow8<FResF32>, SP, true, false>(lds, g, S, E); }
    SEAM(6);
    if (IN(7)) {
        PH_LAUNDER();
        for (int m = gw; m < T; m += NGW) { const f32x4* pr = (const f32x4*)(P + (size_t)m * D) + lane; f32x4 v[4];
#pragma unroll
            for (int j = 0; j < 4; ++j) v[j] = pr[64 * j];
            ln_inplace(v, args.in[I_LNM_G], args.in[I_LNM_B], lane); store_row_bf16(X1 + (size_t)m * D, v, lane); }
    }
    SEAM(7);
    if (IN(8)) { pg8::Gemm g{X1, W_FFNGU, D, D, D}; SP S; S.init(T / 256, 22, G, bx);
        pg8::EpiGateUp<FSwiglu> E{FSwiglu{ACT, FF, 0}}; pg8::gemm_phase<pg8::EpiGateUp<FSwiglu>, SP, true, false>(lds, g, S, E); }
    SEAM(8);
    if (IN(9)) { pg8::Gemm g{ACT, W_FFND, FF, FF, FF}; SP S; S.init(T / 256, 4, G, bx);
        pg8::EpiRow8<FResF32> E{FResF32{P, nullptr, X1}}; pg8::gemm_phase<pg8::EpiRow8<FResF32>, SP, true, false>(lds, g, S, E); }
    SEAM(9);
    if (IN(10)) {
        PH_LAUNDER();
        for (int m = gw; m < T; m += NGW) { const f32x4* pr = (const f32x4*)(P + (size_t)m * D) + lane; f32x4 v[4];
#pragma unroll
            for (int j = 0; j < 4; ++j) v[j] = pr[64 * j];
            ln_inplace(v, args.in[I_LNF_G], args.in[I_LNF_B], lane); store_row_bf16(X2 + (size_t)m * D, v, lane); }
    }
    SEAM(10);
    if (IN(11)) { pg8::Gemm g{X2, W_NSAIN, D, D, D}; SP S; S.init(T / 256, NSA_INP / 256, G, bx);
        pg8::EpiRow8<FNsaIn> E{FNsaIn{NQ, KC, VC, GT}}; pg8::gemm_phase<pg8::EpiRow8<FNsaIn>, SP, true, false>(lds, g, S, E); }
    SEAM(11);
    if (IN(12)) {
        { pg8::Gemm g{KC, W_C1K, 16 * 96, 3072, 3072}; SP S; S.init(32, 1, G, bx);
          pg8::EpiRow8<FCmp1> E{FCmp1{HK, CBIAS}}; pg8::gemm_phase<pg8::EpiRow8<FCmp1>, SP, false, false>(lds, g, S, E); }
        { pg8::Gemm g{VC, W_C1V, 16 * 64, 2048, 2048}; SP S; S.init(32, 1, G, (bx + G / 2) % G);
          pg8::EpiRow8<FCmp1> E{FCmp1{HV, CBIAS + 128}}; pg8::gemm_phase<pg8::EpiRow8<FCmp1>, SP, false, false>(lds, g, S, E); }
    }
    SEAM(12);
    if (IN(13)) {
        { pg8::Gemm g{HK, W_C2K, 128, 128, 128}; SP S; S.init(32, 1, G, bx);
          pg8::EpiRow8<FCmp2> E{FCmp2{KCMP, 96}}; pg8::gemm_phase<pg8::EpiRow8<FCmp2>, SP, false, false>(lds, g, S, E); }
        { pg8::Gemm g{HV, W_C2V, 128, 128, 128}; SP S; S.init(32, 1, G, (bx + G / 2) % G);
          pg8::EpiRow8<FCmp2> E{FCmp2{VCMP, 64}}; pg8::gemm_phase<pg8::EpiRow8<FCmp2>, SP, false, false>(lds, g, S, E); }
    }
    SEAM(13);
    if (IN(14)) {
        PH_LAUNDER();
        const nsa::Tensors X{NQ, KCMP, VCMP, KS, VS, KW, VW, GT, RBT, ONSA};
        for (int it2 = 2 * bx; it2 < 2 * NB * NSA_G * 64; it2 += (it2 & 1) ? 2 * G - 1 : 1) { const int it = it2 >> 1, bg = it & 15, x = it >> 4;
            nsa::unit((LAS char*)lds, X, bg >> 2, bg & 3, (it2 & 1) ? x : 127 - x, tid, lane, wave); }
    }
    SEAM(14);
    if (IN(15)) { pg8::Gemm g{ONSA, W_NSAOUT, D, D, D}; SP S; S.init(T / 256, 4, G, bx);
        pg8::EpiRow8<FResF32> E{FResF32{P, nullptr, X2}}; pg8::gemm_phase<pg8::EpiRow8<FResF32>, SP, true, false>(lds, g, S, E); }
    SEAM(15);
    if (IN(16)) {
        PH_LAUNDER();
        LAS float* wr = (LAS float*)(lds + 69632);
        LAS unsigned* lcnt = (LAS unsigned*)(lds + 69632 + 32768);
        LAS unsigned* lrec = lcnt + 16;
        for (int i = tid; i < D * NE; i += 512) wr[i] = args.in[I_ROUTER][i];
        if (tid < 16) lcnt[tid] = 0u;
        __syncthreads();
        int nrec = 0;
        for (int m = gw; m < T; m += NGW, ++nrec) { const f32x4* pr = (const f32x4*)(P + (size_t)m * D) + lane; f32x4 v[4];
#pragma unroll
            for (int j = 0; j < 4; ++j) v[j] = pr[64 * j];
            ln_inplace(v, args.in[I_LNM_G] + D, args.in[I_LNM_B] + D, lane); store_row_bf16(X3 + (size_t)m * D, v, lane);
            float lg[NE];
#pragma unroll
            for (int e = 0; e < NE; ++e) lg[e] = 0.f;
#pragma unroll
            for (int j = 0; j < 4; ++j)
#pragma unroll
                for (int c = 0; c < 4; ++c) { const int k = 4 * lane + 256 * j + c; const f32x4 w0 = *(const LAS f32x4*)(wr + k * 8), w1 = *(const LAS f32x4*)(wr + k * 8 + 4); const float xv = v[j][c];
                    lg[0] += xv * w0[0]; lg[1] += xv * w0[1]; lg[2] += xv * w0[2]; lg[3] += xv * w0[3]; lg[4] += xv * w1[0]; lg[5] += xv * w1[1]; lg[6] += xv * w1[2]; lg[7] += xv * w1[3]; }
#pragma unroll
            for (int e = 0; e < NE; ++e) lg[e] = wave_sum(lg[e]);
            int e0 = 0; float v0 = lg[0];
#pragma unroll
            for (int e = 1; e < NE; ++e) if (lg[e] > v0) { v0 = lg[e]; e0 = e; }
            int e1 = -1; float v1 = -__builtin_inff();
#pragma unroll
            for (int e = 0; e < NE; ++e) if (e != e0 && lg[e] > v1) { v1 = lg[e]; e1 = e; }
            const float w1s = fast_rcp(1.f + __expf(v0 - v1)), w0s = 1.f - w1s;
            if (lane == 0) { const unsigned p0 = atomicAdd((unsigned*)(lcnt + e0), 1u), p1 = atomicAdd((unsigned*)(lcnt + e1), 1u);
                LAS unsigned* r = lrec + (wave * 32 + nrec) * 4; r[0] = (unsigned)m; r[1] = (unsigned)e0 | (p0 << 8); r[2] = (unsigned)e1 | (p1 << 8);
                TOKW[2 * m] = w0s; TOKW[2 * m + 1] = w1s; }
        }
        __syncthreads();
        if (tid < NE) lcnt[8 + tid] = __hip_atomic_fetch_add(ctl + CW_ECNT + 64 * tid, lcnt[tid], RLX_AGENT);
        __syncthreads();
        if (lane == 0) for (int i = 0; i < nrec; ++i) { const LAS unsigned* r = lrec + (wave * 32 + i) * 4; const unsigned m = r[0];
#pragma unroll
            for (int k = 0; k < 2; ++k) { const unsigned e = r[1 + k] & 255u, pos = lcnt[8 + e] + (r[1 + k] >> 8); ROWTOK[e * ECAP + pos] = (int)m; TOKINFO[2 * m + k] = (e << 16) | pos; } }
        for (int e = 0; e < NE; ++e) {
            tr_matrix(args.in[I_MOE_G] + (size_t)e * D * FFE, D, FFE, W_MOEGU + (size_t)e * 2 * FFE * D, D, RmGU{0}, scr, gw, NGW, lane);
            tr_matrix(args.in[I_MOE_U] + (size_t)e * D * FFE, D, FFE, W_MOEGU + (size_t)e * 2 * FFE * D, D, RmGU{128}, scr, gw, NGW, lane);
            tr_matrix(args.in[I_MOE_D] + (size_t)e * FFE * D, FFE, D, W_MOED + (size_t)e * D * FFE, FFE, RmId{0}, scr, gw, NGW, lane);
        }
    }
    SEAM(16);
    if (hi_ph > 17 && lo < 27) {
        MoeInfo mi; int acc_t = 0;
#pragma unroll
        for (int e = 0; e < NE; ++e) { const int c = (int)__builtin_amdgcn_readfirstlane(__hip_atomic_load(ctl + CW_ECNT + 64 * e, RLX_AGENT)); mi.cnt[e] = c; mi.ts[e] = acc_t; acc_t += (c + 255) >> 8; }
        mi.ts[NE] = acc_t;
        for (int c = 0; c < 5; ++c) {
            const int ct0 = 64 * c; int nM = acc_t - ct0; nM = nM < 0 ? 0 : (nM > 64 ? 64 : nM);
            if (IN(17 + 2 * c) && nM > 0) { pg8::Gemm g{X3, W_MOEGU, D, D, D}; SchedMoeGU S; S.so.init(nM, 2 * FFE / 256, G, bx); S.mi = mi; S.ct0 = ct0; S.rowtok = ROWTOK;
                pg8::EpiGateUp<FSwiglu> E{FSwiglu{ACTC, FFE, 0}}; pg8::gemm_phase<pg8::EpiGateUp<FSwiglu>, SchedMoeGU, true, true>(lds, g, S, E); }
            SEAM(17 + 2 * c);
            if (IN(18 + 2 * c) && nM > 0) { pg8::Gemm g{ACTC, W_MOED, FFE, FFE, FFE}; SchedMoeD S; S.so.init(nM, 4, G, bx); S.mi = mi; S.ct0 = ct0;
                pg8::EpiRow8<FBf16> E{FBf16{DOUT, D, ct0 * 256}}; pg8::gemm_phase<pg8::EpiRow8<FBf16>, SchedMoeD, true, false>(lds, g, S, E); }
            SEAM(18 + 2 * c);
        }
    }
    if (IN(27)) {
        PH_LAUNDER();
        int ts[NE]; { int acc_t = 0;
#pragma unroll
            for (int e = 0; e < NE; ++e) { const int c = (int)__builtin_amdgcn_readfirstlane(__hip_atomic_load(ctl + CW_ECNT + 64 * e, RLX_AGENT)); ts[e] = acc_t; acc_t += (c + 255) >> 8; } }
        for (int m = gw; m < T; m += NGW) {
            const unsigned i0 = TOKINFO[2 * m], i1 = TOKINFO[2 * m + 1]; const float w0 = TOKW[2 * m], w1 = TOKW[2 * m + 1];
            int t0 = 0, t1 = 0;
#pragma unroll
            for (int e = 0; e < NE; ++e) { t0 = ((int)(i0 >> 16) == e) ? ts[e] : t0; t1 = ((int)(i1 >> 16) == e) ? ts[e] : t1; }
            const size_t r0 = (size_t)t0 * 256 + (i0 & 0xffffu), r1 = (size_t)t1 * 256 + (i1 & 0xffffu);
            const u32x2* xr = (const u32x2*)(X3 + (size_t)m * D) + lane; const u32x2* d0 = (const u32x2*)(DOUT + r0 * D) + lane; const u32x2* d1 = (const u32x2*)(DOUT + r1 * D) + lane;
            f32x4 v[4];
#pragma unroll
            for (int j = 0; j < 4; ++j) v[j] = bf4_to_f32(xr[64 * j]) * ALPHA + (bf4_to_f32(d0[64 * j]) * w0 + bf4_to_f32(d1[64 * j]) * w1);
            ln_inplace(v, args.in[I_LNF_G] + D, args.in[I_LNF_B] + D, lane);
            f32x4* orow = (f32x4*)(args.out + (size_t)m * D) + lane;
#pragma unroll
            for (int j = 0; j < 4; ++j) orow[64 * j] = v[j];
        }
    }
#undef IN
#undef SEAM
#undef W_MLAIN
#undef W_QUP
#undef W_KVUP
#undef W_MLAOUT
#undef W_FFNGU
#undef W_FFND
#undef W_NSAIN
#undef W_NSAOUT
#undef W_C1K
#undef W_C1V
#undef W_C2K
#undef W_C2V
#undef ROPE_C
#undef CBIAS
#undef RBT
#undef ROWTOK
#undef TOKINFO
#undef TOKW
#undef XB
#undef LAT
#undef QN
#undef KVN
#undef KR
#undef Q
#undef KN
#undef V
#undef O
#undef X1
#undef ACT
#undef X2
#undef NQ
#undef KC
#undef VC
#undef KS
#undef VS
#undef KW
#undef VW
#undef GT
#undef HK
#undef HV
#undef KCMP
#undef VCMP
#undef ONSA
#undef X3
#undef W_MOEGU
#undef W_MOED
#undef DOUT
#undef ROPE_S
#undef P
#undef ACTC
#undef PH_LAUNDER
}

#ifndef MK_PER_PHASE
#define MK_PER_PHASE 0
#endif
extern "C" void kernel_launch(void* const* d_in, const int* in_sizes, int n_in, void* d_out, int out_size, void* d_ws, size_t ws_size, hipStream_t stream) {
    static int grid = 0;
    if (grid == 0) {
        if (n_in != 27 || out_size != T * D || ws_size < WS_END) { fprintf(stderr, "kernel_launch: unexpected shapes (n_in %d out %d ws %zu)\n", n_in, out_size, ws_size); grid = -1; return; }
        int dev = 0, cus = 0, per_cu = 0;
        if (hipGetDevice(&dev) != hipSuccess || hipDeviceGetAttribute(&cus, hipDeviceAttributeMultiprocessorCount, dev) != hipSuccess) { grid = -1; return; }
        if (hipFuncSetAttribute((const void*)fwd, hipFuncAttributeMaxDynamicSharedMemorySize, LDS_BYTES) != hipSuccess) { fprintf(stderr, "kernel_launch: hipFuncSetAttribute failed\n"); grid = -1; return; }
        if (hipOccupancyMaxActiveBlocksPerMultiprocessor(&per_cu, (const void*)fwd, NWAVES * 64, LDS_BYTES) != hipSuccess || per_cu < 1) { fprintf(stderr, "kernel_launch: occupancy query reports %d\n", per_cu); }
        (void)hipGetLastError();
        grid = cus;
    }
    if (grid < 0) return;
    if (hipMemsetAsync((char*)d_ws + WS_CTL, 0, CTL_ZERO_BYTES, stream) != hipSuccess) return;
    Args a{};
    for (int i = 0; i < 27; ++i) a.in[i] = (const float*)d_in[i];
    a.out = (float*)d_out; a.ws = (unsigned char*)d_ws;
#if MK_PER_PHASE
    for (int p = 0; p < N_PHASES; ++p) { a.ph_lo = p; a.ph_hi = p + 1; hipLaunchKernelGGL(fwd, dim3(grid), dim3(NWAVES * 64), LDS_BYTES, stream, a); }
#else
    a.ph_lo = 0; a.ph_hi = N_PHASES;
    hipLaunchKernelGGL(fwd, dim3(grid), dim3(NWAVES * 64), LDS_BYTES, stream, a);
#endif
}
```

```cpp
#include <hip/hip_runtime.h>
#include <cstdio>
#include <cstdint>

#define LAS __attribute__((address_space(3)))
#define GAS __attribute__((address_space(1)))
typedef unsigned short bf16_t;
typedef short bf16x8 __attribute__((ext_vector_type(8)));
typedef short s16x4 __attribute__((ext_vector_type(4)));
typedef float f32x4 __attribute__((ext_vector_type(4)));
typedef float f32x2 __attribute__((ext_vector_type(2)));
typedef float f32x16 __attribute__((ext_vector_type(16)));
typedef unsigned u32x4 __attribute__((ext_vector_type(4)));
typedef unsigned u32x2 __attribute__((ext_vector_type(2)));

constexpr int NB = 4, SEQ = 8192, T = NB * SEQ, D = 1024;
constexpr int MLA_H = 8, MLA_QR = 512, MLA_KVR = 256, MLA_DQK = 192, MLA_DV = 128, MLA_IN = 832;
constexpr int NSA_G = 4, NSA_DK = 96, NSA_DV = 64, NSA_IN = 3504, NSA_INP = 3584;
constexpr int FF = 2816, NE = 8, FFE = 3584, ECAP = 32768;
constexpr float ALPHA = 1.41421356237309515f;
constexpr float LOG2E = 1.4426950408889634f;
constexpr float C2_MLA = 0.07216878364870323f * LOG2E;
constexpr float C2_NSA = 0.10206207261596577f * LOG2E;

__device__ __forceinline__ unsigned cvt_pk_bf16(float lo, float hi) { unsigned r; asm volatile("v_cvt_pk_bf16_f32 %0, %1, %2" : "=v"(r) : "v"(lo), "v"(hi)); return r; }
__device__ __forceinline__ float bf2f(unsigned short h) { return __uint_as_float(((unsigned)h) << 16); }
__device__ __forceinline__ float bflo(unsigned w) { return __uint_as_float(w << 16); }
__device__ __forceinline__ float bfhi(unsigned w) { return __uint_as_float(w & 0xffff0000u); }
__device__ __forceinline__ float fast_exp2(float x) { return __builtin_amdgcn_exp2f(x); }
__device__ __forceinline__ float fast_rcp(float x) { return __builtin_amdgcn_rcpf(x); }
__device__ __forceinline__ float silu_f(float x) { return x * fast_rcp(1.f + fast_exp2(-x * LOG2E)); }
__device__ __forceinline__ float sigmoid_f(float x) { return fast_rcp(1.f + fast_exp2(-x * LOG2E)); }
__device__ __forceinline__ float gelu_tanh_f(float x) {
    const float z = 0.7978845608028654f * (x + 0.044715f * x * x * x);
    return x * fast_rcp(1.f + fast_exp2(-2.f * LOG2E * z));
}

namespace pg8 {
constexpr int BM = 256, BK = 64, HALF = 128, HTB = HALF * BK * 2, STAGE_BYTES = 8 * HTB, NXCD = 8, WGM = 8;
__host__ __device__ __forceinline__ int lds_byte(int r, int c) { const int st = (r >> 4) * 2 + (c >> 5), rr = r & 15, cc = c & 31, ob = rr * 64 + cc * 2; return st * 1024 + (ob ^ (((ob >> 9) & 1) << 5)); }
__host__ __device__ __forceinline__ void stage_rc(int b, int& R, int& C) { const int st = b / 1024, sb = b % 1024, swz = sb ^ (((sb >> 9) & 1) << 5); R = (st >> 1) * 16 + swz / 64; C = (st & 1) * 32 + (swz % 64) / 2; }
__host__ __device__ __forceinline__ int perm32(int rho) { const int n = rho >> 4, i = rho & 15; return 8 * (i >> 2) + 4 * n + (i & 3); }

struct Unit { int pm, pn; };
struct Gemm { const bf16_t* A; const bf16_t* Bt; int lda, ldb, K; };

struct StaticOrder {
    int nM, nN, nwg, G, c;
    __device__ void init(int nM_, int nN_, int G_, int c_) { nM = nM_; nN = nN_; nwg = nM * nN; G = G_; c = c_; }
    __device__ bool next(int i, Unit& u) const {
        const long L = (long)i * G + c; if (L >= nwg) return false;
        int wgid = (int)L; { const int q = nwg / NXCD, r = nwg % NXCD, xcd = wgid % NXCD, off = wgid / NXCD; wgid = (xcd < r ? xcd * (q + 1) : r * (q + 1) + (xcd - r) * q) + off; }
        const int nig = WGM * nN, gid = wgid / nig, fm = gid * WGM, gsz = (nM - fm) < WGM ? (nM - fm) : WGM;
        u.pm = fm + ((wgid % nig) % gsz); u.pn = (wgid % nig) / gsz; return true;
    }
};
struct SchedPlain {
    StaticOrder so;
    __device__ void init(int nM, int nN, int G, int c) { so.init(nM, nN, G, c); }
    __device__ __forceinline__ bool next(int i, Unit& u) const { return so.next(i, u); }
    __device__ __forceinline__ size_t a_off(const Unit& u, const Gemm& g) const { return (size_t)u.pm * 256 * g.lda * 2; }
    __device__ __forceinline__ size_t b_off(const Unit& u, const Gemm& g) const { return (size_t)u.pn * 256 * g.ldb * 2; }
    __device__ __forceinline__ unsigned a_row(const Unit&, int) const { return 0u; }
};

template <class F> struct EpiRow8 {
    static constexpr bool PERM = true;
    F f;
    __device__ __forceinline__ void operator()(const f32x4 (&acc)[2][2][4][2], const Unit& u, int wr, int wc, int fr, int fq) const {
#pragma unroll
        for (int ai = 0; ai < 2; ++ai)
#pragma unroll
            for (int m = 0; m < 4; ++m) { const int row = u.pm * BM + ai * HALF + wr * 64 + m * 16 + fr;
#pragma unroll
                for (int bj = 0; bj < 2; ++bj) f(row, u.pn * BM + bj * HALF + wc * 32 + 8 * fq, acc[ai][bj][m][0], acc[ai][bj][m][1]); }
    }
};
template <class F> struct EpiGateUp {
    static constexpr bool PERM = true;
    F f;
    __device__ __forceinline__ void operator()(const f32x4 (&acc)[2][2][4][2], const Unit& u, int wr, int wc, int fr, int fq) const {
#pragma unroll
        for (int ai = 0; ai < 2; ++ai)
#pragma unroll
            for (int m = 0; m < 4; ++m) { const int row = u.pm * BM + ai * HALF + wr * 64 + m * 16 + fr;
                f(row, u.pn * HALF + wc * 32 + 8 * fq, acc[ai][0][m][0], acc[ai][0][m][1], acc[ai][1][m][0], acc[ai][1][m][1]); }
    }
};

template <class Epi, class Sched, bool ALIGN_EPI, bool GATHER>
__device__ __forceinline__ void gemm_phase(LAS unsigned char* lds, const Gemm g, const Sched& S, const Epi& E) {
    int tid = threadIdx.x; asm volatile("" : "+v"(tid));
    const int wid = __builtin_amdgcn_readfirstlane(tid >> 6), lane = tid & 63, wr = wid >> 2, wc = wid & 3, fr = lane & 15, fq = lane >> 4;
    const int K = g.K, nt = K / BK;
    int sR[2], sC[2]; unsigned voffB[2];
#pragma unroll
    for (int i = 0; i < 2; ++i) { int R, C; stage_rc(tid * 16 + i * 8192, R, C); sR[i] = R; sC[i] = C; const int Rb = Epi::PERM ? ((R & ~31) + perm32(R & 31)) : R; voffB[i] = (unsigned)(Rb * g.ldb + C) * 2u; }
    const int kstep = BK * 2;
    const int hstepB = HALF * g.ldb * 2;
    const auto rsA = __builtin_amdgcn_make_buffer_rsrc((void*)g.A, 0, 0x7fffffff, 0x00020000);
    const auto rsB = __builtin_amdgcn_make_buffer_rsrc((void*)g.Bt, 0, 0x7fffffff, 0x00020000);
    const unsigned ldsw = (unsigned)wid * 1024u;
    const int aoff = lds_byte(wr * 64 + fr, fq * 8), boff = lds_byte(wc * 32 + fr, fq * 8);
#define PG8_SA(b, h) (((b) * 2 + (h)) * HTB)
#define PG8_SB(b, h) ((4 + (b) * 2 + (h)) * HTB)
#define PG8_STAGE2(bufoff, rsrc, soff, o0, o1) do { \
        __builtin_amdgcn_raw_ptr_buffer_load_lds(rsrc, (LAS unsigned*)(lds + (bufoff) + ldsw), 16, (int)(o0), (int)(soff), 0, 0); \
        __builtin_amdgcn_raw_ptr_buffer_load_lds(rsrc, (LAS unsigned*)(lds + (bufoff) + ldsw + 8192), 16, (int)(o1), (int)(soff), 0, 0); } while (0)
#define PG8_STAGEA(bufoff, soff, o0, o1) PG8_STAGE2(bufoff, rsA, soff, o0, o1)
#define PG8_STAGEB(bufoff, soff) PG8_STAGE2(bufoff, rsB, soff, voffB[0], voffB[1])
#define PG8_LDA(dst, b, h) do { _Pragma("unroll") for (int m = 0; m < 4; ++m) _Pragma("unroll") for (int k = 0; k < 2; ++k) dst[m][k] = *(const LAS bf16x8*)(lds + PG8_SA(b, h) + aoff + m * 2048 + k * 1024); } while (0)
#define PG8_LDB(dst, b, h) do { _Pragma("unroll") for (int n = 0; n < 2; ++n) _Pragma("unroll") for (int k = 0; k < 2; ++k) dst[n][k] = *(const LAS bf16x8*)(lds + PG8_SB(b, h) + boff + n * 2048 + k * 1024); } while (0)
#define PG8_MMA(ai, bj, At, Bt) do { __builtin_amdgcn_s_setprio(1); _Pragma("unroll") for (int m = 0; m < 4; ++m) _Pragma("unroll") for (int n = 0; n < 2; ++n) _Pragma("unroll") for (int k = 0; k < 2; ++k) \
        acc[ai][bj][m][n] = __builtin_amdgcn_mfma_f32_16x16x32_bf16(Bt[n][k], At[m][k], acc[ai][bj][m][n], 0, 0, 0); __builtin_amdgcn_s_setprio(0); } while (0)
#define PG8_WAIT_V(n) asm volatile("s_waitcnt vmcnt(" #n ")" ::: "memory")
#define PG8_WAIT_L(n) asm volatile("s_waitcnt lgkmcnt(" #n ")" ::: "memory")
#define PG8_BAR __builtin_amdgcn_s_barrier()
#define PG8_SCHED __builtin_amdgcn_sched_barrier(0)
    Unit cur, nxt; int ui = 0;
    if (!S.next(0, cur)) return;
    f32x4 acc[2][2][4][2];
#pragma unroll
    for (int a = 0; a < 2; ++a)
#pragma unroll
        for (int b = 0; b < 2; ++b)
#pragma unroll
            for (int m = 0; m < 4; ++m)
#pragma unroll
                for (int n = 0; n < 2; ++n) acc[a][b][m][n] = (f32x4){0.f, 0.f, 0.f, 0.f};
    bf16x8 At[4][2], B0[2][2], B1[2][2];
    unsigned vc[2][2], vn[2][2];
#pragma unroll
    for (int h = 0; h < 2; ++h)
#pragma unroll
        for (int i = 0; i < 2; ++i) { vc[h][i] = GATHER ? S.a_row(cur, h * HALF + sR[i]) + (unsigned)sC[i] * 2u : (unsigned)((h * HALF + sR[i]) * g.lda + sC[i]) * 2u; vn[h][i] = vc[h][i]; }
    int cA = (int)S.a_off(cur, g), cB = (int)S.b_off(cur, g);
    PG8_STAGEB(PG8_SB(0, 0), cB); PG8_STAGEB(PG8_SB(0, 1), cB + hstepB); PG8_STAGEA(PG8_SA(0, 0), cA, vc[0][0], vc[0][1]); PG8_STAGEA(PG8_SA(0, 1), cA, vc[1][0], vc[1][1]);
    if (wr == 1) PG8_BAR;
    PG8_WAIT_V(2); PG8_BAR;
    PG8_STAGEB(PG8_SB(1, 0), cB + kstep); PG8_STAGEA(PG8_SA(1, 0), cA + kstep, vc[0][0], vc[0][1]); PG8_STAGEB(PG8_SB(1, 1), cB + hstepB + kstep);
    PG8_WAIT_V(6); PG8_BAR;
    for (;;) {
        const bool has_next = S.next(ui + 1, nxt);
        const int nA = has_next ? (int)S.a_off(nxt, g) : cA, nB = has_next ? (int)S.b_off(nxt, g) : cB;
        if (GATHER) {
#pragma unroll
            for (int h = 0; h < 2; ++h)
#pragma unroll
                for (int i = 0; i < 2; ++i) vn[h][i] = has_next ? S.a_row(nxt, h * HALF + sR[i]) + (unsigned)sC[i] * 2u : vc[h][i];
        }
        for (int t = 0; t < nt; t += 2) {
            const bool last = (t == nt - 2);
            const int a1 = cA + (t + 1) * kstep;
            const int a2 = last ? nA : cA + (t + 2) * kstep, b2 = last ? nB : cB + (t + 2) * kstep;
            const int a3 = a2 + kstep, b3 = b2 + kstep;
            unsigned w00, w01, w10, w11;
            if (GATHER) { w00 = last ? vn[0][0] : vc[0][0]; w01 = last ? vn[0][1] : vc[0][1]; w10 = last ? vn[1][0] : vc[1][0]; w11 = last ? vn[1][1] : vc[1][1]; }
            else { w00 = vc[0][0]; w01 = vc[0][1]; w10 = vc[1][0]; w11 = vc[1][1]; }
            PG8_LDB(B0, 0, 0); PG8_LDB(B1, 0, 1); PG8_SCHED; PG8_LDA(At, 0, 0); PG8_STAGEA(PG8_SA(1, 1), a1, vc[1][0], vc[1][1]);
            PG8_WAIT_V(8); PG8_WAIT_L(0); PG8_BAR; PG8_MMA(0, 0, At, B0); PG8_MMA(0, 1, At, B1); PG8_BAR; PG8_SCHED;
            PG8_LDA(At, 0, 1); PG8_STAGEB(PG8_SB(0, 0), b2); PG8_STAGEB(PG8_SB(0, 1), b2 + hstepB); PG8_STAGEA(PG8_SA(0, 0), a2, w00, w01);
            PG8_WAIT_V(8); PG8_WAIT_L(0); PG8_BAR; PG8_MMA(1, 0, At, B0); PG8_MMA(1, 1, At, B1); PG8_BAR; PG8_SCHED;
            PG8_LDB(B0, 1, 0); PG8_LDB(B1, 1, 1); PG8_SCHED; PG8_LDA(At, 1, 0); PG8_STAGEA(PG8_SA(0, 1), a2, w10, w11);
            PG8_WAIT_V(8); PG8_WAIT_L(0); PG8_BAR; PG8_MMA(0, 0, At, B0); PG8_MMA(0, 1, At, B1); PG8_BAR; PG8_SCHED;
            PG8_LDA(At, 1, 1); PG8_STAGEB(PG8_SB(1, 0), b3); PG8_STAGEB(PG8_SB(1, 1), b3 + hstepB); PG8_STAGEA(PG8_SA(1, 0), a3, w00, w01);
            PG8_WAIT_V(8); PG8_WAIT_L(0); PG8_BAR; PG8_MMA(1, 0, At, B0); PG8_MMA(1, 1, At, B1); PG8_BAR; PG8_SCHED;
        }
        if constexpr (ALIGN_EPI) { if (wr == 0) PG8_BAR; }
        E(acc, cur, wr, wc, fr, fq);
        if (!has_next) break;
#pragma unroll
        for (int a = 0; a < 2; ++a)
#pragma unroll
            for (int b = 0; b < 2; ++b)
#pragma unroll
                for (int m = 0; m < 4; ++m)
#pragma unroll
                    for (int n = 0; n < 2; ++n) acc[a][b][m][n] = (f32x4){0.f, 0.f, 0.f, 0.f};
        cur = nxt; cA = nA; cB = nB; ++ui;
        if (GATHER) {
#pragma unroll
            for (int h = 0; h < 2; ++h)
#pragma unroll
                for (int i = 0; i < 2; ++i) vc[h][i] = vn[h][i];
        }
        if constexpr (ALIGN_EPI) { if (wr == 1) PG8_BAR; }
    }
    PG8_WAIT_V(0);
    if constexpr (!ALIGN_EPI) { if (wr == 0) PG8_BAR; }
    PG8_BAR;
#undef PG8_SA
#undef PG8_SB
#undef PG8_STAGE2
#undef PG8_STAGEA
#undef PG8_STAGEB
#undef PG8_LDA
#undef PG8_LDB
#undef PG8_MMA
#undef PG8_WAIT_V
#undef PG8_WAIT_L
#undef PG8_BAR
#undef PG8_SCHED
}
}
namespace att {
__device__ __forceinline__ int crow(int r, int hi) { return (r & 3) + 8 * (r >> 2) + 4 * hi; }
constexpr float THR = 6.f;
template <int DQK, int DV> struct Geo {
    static constexpr int KROW = DQK * 2 + 16, VROW = DV * 2 + 64, KT = 64 * KROW, VT = 64 * VROW;
    static constexpr int KCH = DQK / 8, VCH = DV / 8;
    static constexpr int KN = (64 * KCH + 511) / 512, VN = (64 * VCH + 511) / 512;
    static constexpr int LDS_K = 0, LDS_V = 2 * KT, LDS_END = 2 * KT + 2 * VT;
};
template <int DQK, int DV, class Src> struct Stg {
    using G = Geo<DQK, DV>;
    bf16x8 k[G::KN], v[G::VN];
    __device__ __forceinline__ void load(const Src& s, int t, int tid) {
#pragma unroll
        for (int i = 0; i < G::KN; ++i) { const int c = tid + 512 * i; if ((64 * G::KCH) % 512 == 0 || c < 64 * G::KCH) { const int row = c / G::KCH, cc = c % G::KCH; k[i] = *(const bf16x8*)s.kptr(t, row, cc); } }
#pragma unroll
        for (int i = 0; i < G::VN; ++i) { const int c = tid + 512 * i; if ((64 * G::VCH) % 512 == 0 || c < 64 * G::VCH) { const int row = c / G::VCH, cc = c % G::VCH; v[i] = *(const bf16x8*)s.vptr(t, row, cc); } }
    }
    __device__ __forceinline__ void store(LAS char* lds, int buf, int tid) const {
#pragma unroll
        for (int i = 0; i < G::KN; ++i) { const int c = tid + 512 * i; if ((64 * G::KCH) % 512 == 0 || c < 64 * G::KCH) { const int row = c / G::KCH, cc = c % G::KCH; *(LAS bf16x8*)(lds + G::LDS_K + buf * G::KT + row * G::KROW + cc * 16) = k[i]; } }
#pragma unroll
        for (int i = 0; i < G::VN; ++i) { const int c = tid + 512 * i; if ((64 * G::VCH) % 512 == 0 || c < 64 * G::VCH) { const int row = c / G::VCH, cc = c % G::VCH; *(LAS bf16x8*)(lds + G::LDS_V + buf * G::VT + row * G::VROW + cc * 16) = v[i]; } }
    }
};
template <int DQK> __device__ __forceinline__ void qk_tile(f32x16& p0, f32x16& p1, LAS const char* Kb, int r32, int hi, const bf16x8* qr) {
    constexpr int KROW = DQK * 2 + 16;
    p0 = f32x16{}; p1 = f32x16{};
    LAS const char* a = Kb + r32 * KROW + hi * 16;
#pragma unroll
    for (int d0 = 0; d0 < DQK / 16; ++d0) {
        const bf16x8 k0 = *(LAS const bf16x8*)(a + d0 * 32);
        const bf16x8 k1 = *(LAS const bf16x8*)(a + 32 * KROW + d0 * 32);
        p0 = __builtin_amdgcn_mfma_f32_32x32x16_bf16(k0, qr[d0], p0, 0, 0, 0);
        p1 = __builtin_amdgcn_mfma_f32_32x32x16_bf16(k1, qr[d0], p1, 0, 0, 0);
    }
}
template <int DV> __device__ __forceinline__ void pv_tile(f32x16* o, unsigned vaddr, bf16x8 pa0, bf16x8 pa1, bf16x8 pa2, bf16x8 pa3) {
    constexpr int VROW = DV * 2 + 64;
#define ATT_TRRD(dst, off) asm volatile("ds_read_b64_tr_b16 %0, %1 offset:%2" : "=&v"(dst) : "v"(vaddr), "i"(off) : "memory")
#pragma unroll
    for (int d0 = 0; d0 < DV / 32; ++d0) {
        s16x4 l0, l1, h0, h1;
        ATT_TRRD(l0, (0 * 16 + 0) * VROW + d0 * 64); ATT_TRRD(h0, (0 * 16 + 4) * VROW + d0 * 64);
        ATT_TRRD(l1, (1 * 16 + 0) * VROW + d0 * 64); ATT_TRRD(h1, (1 * 16 + 4) * VROW + d0 * 64);
        asm volatile("s_waitcnt lgkmcnt(0)" ::: "memory"); __builtin_amdgcn_sched_barrier(0);
        o[d0] = __builtin_amdgcn_mfma_f32_32x32x16_bf16(pa0, (bf16x8){l0[0], l0[1], l0[2], l0[3], h0[0], h0[1], h0[2], h0[3]}, o[d0], 0, 0, 0);
        o[d0] = __builtin_amdgcn_mfma_f32_32x32x16_bf16(pa1, (bf16x8){l1[0], l1[1], l1[2], l1[3], h1[0], h1[1], h1[2], h1[3]}, o[d0], 0, 0, 0);
        s16x4 l2, l3, h2, h3;
        ATT_TRRD(l2, (2 * 16 + 0) * VROW + d0 * 64); ATT_TRRD(h2, (2 * 16 + 4) * VROW + d0 * 64);
        ATT_TRRD(l3, (3 * 16 + 0) * VROW + d0 * 64); ATT_TRRD(h3, (3 * 16 + 4) * VROW + d0 * 64);
        asm volatile("s_waitcnt lgkmcnt(0)" ::: "memory"); __builtin_amdgcn_sched_barrier(0);
        o[d0] = __builtin_amdgcn_mfma_f32_32x32x16_bf16(pa2, (bf16x8){l2[0], l2[1], l2[2], l2[3], h2[0], h2[1], h2[2], h2[3]}, o[d0], 0, 0, 0);
        o[d0] = __builtin_amdgcn_mfma_f32_32x32x16_bf16(pa3, (bf16x8){l3[0], l3[1], l3[2], l3[3], h3[0], h3[1], h3[2], h3[3]}, o[d0], 0, 0, 0);
    }
#undef ATT_TRRD
}
__device__ __forceinline__ float lane_pair_max(float v) { auto rr = __builtin_amdgcn_permlane32_swap(__float_as_uint(v), __float_as_uint(v), false, false); return fmaxf(__uint_as_float(rr[0]), __uint_as_float(rr[1])); }
__device__ __forceinline__ float lane_pair_sum(float v) { auto rr = __builtin_amdgcn_permlane32_swap(__float_as_uint(v), __float_as_uint(v), false, false); return __uint_as_float(rr[0]) + __uint_as_float(rr[1]); }
__device__ __forceinline__ void pack_p(const f32x16& p0, const f32x16& p1, bf16x8& pa0, bf16x8& pa1, bf16x8& pa2, bf16x8& pa3) {
#define ATT_PK4(P, B_, OUT) do { unsigned a0 = cvt_pk_bf16(P[B_ + 0], P[B_ + 1]), a1 = cvt_pk_bf16(P[B_ + 2], P[B_ + 3]); \
        unsigned b0 = cvt_pk_bf16(P[B_ + 4], P[B_ + 5]), b1 = cvt_pk_bf16(P[B_ + 6], P[B_ + 7]); \
        auto r0 = __builtin_amdgcn_permlane32_swap(a0, b0, false, false); auto r1 = __builtin_amdgcn_permlane32_swap(a1, b1, false, false); \
        u32x4 w = {r0[0], r1[0], r0[1], r1[1]}; OUT = __builtin_bit_cast(bf16x8, w); } while (0)
    ATT_PK4(p0, 0, pa0); ATT_PK4(p0, 8, pa1); ATT_PK4(p1, 0, pa2); ATT_PK4(p1, 8, pa3);
#undef ATT_PK4
}
template <int DQK, int DV, bool DO_PV, class Src, class Msk>
__device__ __forceinline__ void run_online(LAS char* lds, LAS float* wsc, int nt, const Src& src, const Msk& msk, const bf16x8* qr, float& m_reg, float& l_reg, f32x16* o, int tid, int lane) {
    using G = Geo<DQK, DV>;
    const int r32 = lane & 31, hi = lane >> 5;
    if (nt <= 0) return;
    Stg<DQK, DV, Src> st;
    st.load(src, 0, tid); st.store(lds, 0, tid); __syncthreads();
    const unsigned vlane = (unsigned)((8 * hi + ((lane & 15) >> 2)) * G::VROW + (16 * ((lane >> 4) & 1) + 4 * (lane & 3)) * 2);
    for (int t = 0; t < nt; ++t) {
        const int buf = t & 1;
        if (t + 1 < nt) st.load(src, t + 1, tid);
        const int kind = msk.kind(t);
        if (kind) {
            f32x16 p0, p1;
            qk_tile<DQK>(p0, p1, lds + G::LDS_K + buf * G::KT, r32, hi, qr);
            if (kind >= 2) msk.apply(p0, p1, t, kind);
            float pmax = p0[0];
#pragma unroll
            for (int r = 1; r < 16; ++r) pmax = fmaxf(pmax, p0[r]);
#pragma unroll
            for (int r = 0; r < 16; ++r) pmax = fmaxf(pmax, p1[r]);
            pmax = lane_pair_max(pmax);
            float mn, alpha;
            if (__all(pmax <= m_reg + THR)) { mn = m_reg; alpha = 1.f; }
            else { mn = fmaxf(m_reg, pmax); alpha = fast_exp2(m_reg - mn); m_reg = mn; }
#pragma unroll
            for (int r = 0; r < 16; ++r) { p0[r] = fast_exp2(p0[r] - mn); p1[r] = fast_exp2(p1[r] - mn); }
            float ps = 0.f;
#pragma unroll
            for (int r = 0; r < 16; ++r) ps += p0[r] + p1[r];
            ps = lane_pair_sum(ps);
            l_reg = l_reg * alpha + ps;
            if (DO_PV) {
                if (__any(alpha < 1.f)) {
                    if (hi == 0) wsc[32 + r32] = alpha;
                    asm volatile("s_waitcnt lgkmcnt(0)" ::: "memory");
#pragma unroll
                    for (int r = 0; r < 16; ++r) { const float a = wsc[32 + crow(r, hi)];
#pragma unroll
                        for (int d = 0; d < DV / 32; ++d) o[d][r] *= a; }
                }
                bf16x8 pa0, pa1, pa2, pa3; pack_p(p0, p1, pa0, pa1, pa2, pa3);
                pv_tile<DV>(o, (unsigned)(uintptr_t)(lds + G::LDS_V + buf * G::VT) + vlane, pa0, pa1, pa2, pa3);
            }
        }
        if (t + 1 < nt) st.store(lds, buf ^ 1, tid);
        __syncthreads();
    }
}
}
namespace mla {
constexpr int DQK = 192, DV = 128;
using G = att::Geo<DQK, DV>;
struct Src {
    const bf16_t* kn; const bf16_t* kr; const bf16_t* v;
    __device__ __forceinline__ const bf16_t* kptr(int t, int row, int cc) const { const int key = 64 * t + row; return cc < 16 ? kn + (size_t)key * 128 + cc * 8 : kr + (size_t)key * 64 + (cc - 16) * 8; }
    __device__ __forceinline__ const bf16_t* vptr(int t, int row, int cc) const { return v + (size_t)(64 * t + row) * 128 + cc * 8; }
};
struct Msk {
    int qlo, qpos;
    int hi;
    __device__ __forceinline__ int kind(int t) const { const int kb = 64 * t; return kb > qlo + 31 ? 0 : (kb + 63 <= qlo ? 1 : 2); }
    __device__ __forceinline__ void apply(f32x16& p0, f32x16& p1, int t, int) const {
        const float NEG = -__builtin_inff(); const int d = qpos - 64 * t - 4 * hi;
#pragma unroll
        for (int r = 0; r < 16; ++r) { const int c = (r & 3) + 8 * (r >> 2); if (c > d) p0[r] = NEG; if (c + 32 > d) p1[r] = NEG; }
    }
};
__device__ __forceinline__ void unit(LAS char* lds, int b, int h, int qb, const bf16_t* Q, const bf16_t* KN, const bf16_t* KR, const bf16_t* V, bf16_t* O, int tid, int lane_, int wid) {
    asm volatile("" : "+v"(tid)); const int lane = tid & 63;
    const int r32 = lane & 31, hi = lane >> 5;
    LAS float* wsc = (LAS float*)(lds + G::LDS_END) + wid * 64;
    const int q0 = qb * 256 + wid * 32;
    const size_t trow = (size_t)b * SEQ + q0 + r32;
    bf16x8 qr[DQK / 16];
#pragma unroll
    for (int d0 = 0; d0 < DQK / 16; ++d0) qr[d0] = *(const bf16x8*)(Q + trow * 1536 + h * 192 + d0 * 16 + hi * 8);
    Src src{KN + (size_t)(b * MLA_H + h) * SEQ * 128, KR + (size_t)b * SEQ * 64, V + (size_t)(b * MLA_H + h) * SEQ * 128};
    Msk msk{q0, q0 + r32, hi};
    float m_reg = -1e30f, l_reg = 0.f; f32x16 o[DV / 32] = {};
    att::run_online<DQK, DV, true>(lds, wsc, 4 * (qb + 1), src, msk, qr, m_reg, l_reg, o, tid, lane);
    if (hi == 0) wsc[r32] = l_reg;
    asm volatile("s_waitcnt lgkmcnt(0)" ::: "memory");
    bf16_t* Ow = O + ((size_t)b * SEQ + q0) * 1024 + h * 128;
#pragma unroll
    for (int r = 0; r < 16; ++r) { const int orow = att::crow(r, hi); const float l = wsc[orow]; const float rl = l > 0.f ? fast_rcp(l) : 0.f;
#pragma unroll
        for (int d0 = 0; d0 < DV / 32; ++d0) { const float v = o[d0][r] * rl; const float vn = __shfl_xor(v, 1);
            if ((r32 & 1) == 0) *(unsigned*)(Ow + (size_t)orow * 1024 + d0 * 32 + r32) = cvt_pk_bf16(v, vn); } }
    asm volatile("s_waitcnt lgkmcnt(0)" ::: "memory");
}
}

namespace nsa {
constexpr int DQK = 96, DV = 64;
using G = att::Geo<DQK, DV>;
constexpr int L_WSC = G::LDS_END;
constexpr int L_TAB = L_WSC + 8 * 256;
constexpr int TABW = 132;
constexpr int L_PSUM = L_TAB + 4 * TABW * 4;
constexpr int PSW = 68;
constexpr int L_IMP = L_PSUM + 8 * 8 * PSW * 4;
constexpr int L_SELW = L_IMP + 8 * 8 * 128 * 4;
constexpr int L_END = L_SELW + 8 * 8 * 4 * 4;
struct Src {
    const bf16_t* k; const bf16_t* v; int j0;
    __device__ __forceinline__ const bf16_t* kptr(int t, int row, int cc) const { return k + (size_t)(64 * (j0 + t) + row) * 96 + cc * 8; }
    __device__ __forceinline__ const bf16_t* vptr(int t, int row, int cc) const { return v + (size_t)(64 * (j0 + t) + row) * 64 + cc * 8; }
};
struct MskCmp {
    int qlo, qpos, hi; const LAS float* tab;
    __device__ __forceinline__ int kind(int t) const {
        const int n0 = 64 * t;
        if (qlo + 7 - (16 * n0 + 31) < 0) return 0;
        return (qlo - (16 * (n0 + 63) + 31) >= 128) ? 1 : 2;
    }
    __device__ __forceinline__ void apply(f32x16& p0, f32x16& p1, int t, int) const {
        const float NEG = -__builtin_inff(); const int dq = qpos - 31 - 16 * (64 * t + 4 * hi);
#pragma unroll
        for (int r = 0; r < 16; ++r) { const int c = 16 * ((r & 3) + 8 * (r >> 2));
            { const int d = dq - c; const float bv = ((const volatile LAS float*)tab)[(unsigned)d < 128u ? d : 128]; p0[r] = d >= 0 ? p0[r] + bv : NEG; }
            { const int d = dq - c - 512; const float bv = ((const volatile LAS float*)tab)[(unsigned)d < 128u ? d : 128]; p1[r] = d >= 0 ? p1[r] + bv : NEG; } }
    }
};
struct MskSel {
    int qpos, hi, cur; const LAS float* tab; const LAS unsigned* selw;
    __device__ __forceinline__ bool mine(int j) const { return (selw[j >> 5] >> (j & 31)) & 1u; }
    __device__ __forceinline__ int kind(int j) const {
        const bool s = mine(j);
        if (!__any(s)) return 0;
        if (j >= cur - 2) return 2;
        return __all(s) ? 1 : 3;
    }
    __device__ __forceinline__ void apply(f32x16& p0, f32x16& p1, int j, int kind) const {
        const float NEG = -__builtin_inff(); const bool s = mine(j);
        if (kind == 3) {
#pragma unroll
            for (int r = 0; r < 16; ++r) { p0[r] = s ? p0[r] : NEG; p1[r] = s ? p1[r] : NEG; }
        } else { const int dq = qpos - 64 * j - 4 * hi;
#pragma unroll
            for (int r = 0; r < 16; ++r) { const int c = (r & 3) + 8 * (r >> 2);
                { const int d = dq - c; const float bv = ((const volatile LAS float*)tab)[(unsigned)d < 128u ? d : 128]; p0[r] = (s && d >= 0) ? p0[r] + bv : NEG; }
                { const int d = dq - c - 32; const float bv = ((const volatile LAS float*)tab)[(unsigned)d < 128u ? d : 128]; p1[r] = (s && d >= 0) ? p1[r] + bv : NEG; } }
        }
    }
};
struct MskWin {
    int qpos, hi, cur, j0; const LAS float* tab;
    __device__ __forceinline__ int kind(int t) const { const int j = j0 + t; return (j >= cur - 2 || j <= cur - 8) ? 2 : 1; }
    __device__ __forceinline__ void apply(f32x16& p0, f32x16& p1, int t, int) const {
        const float NEG = -__builtin_inff(); const int dq = qpos - 64 * (j0 + t) - 4 * hi;
#pragma unroll
        for (int r = 0; r < 16; ++r) { const int c = (r & 3) + 8 * (r >> 2);
            { const int d = dq - c; const float bv = ((const volatile LAS float*)tab)[(unsigned)d < 128u ? d : 128]; p0[r] = (unsigned)d < 512u ? p0[r] + bv : NEG; }
            { const int d = dq - c - 32; const float bv = ((const volatile LAS float*)tab)[(unsigned)d < 128u ? d : 128]; p1[r] = (unsigned)d < 512u ? p1[r] + bv : NEG; } }
    }
};
__device__ __forceinline__ void fold(f32x16* ofin, const f32x16* o, float f, LAS float* wsc, int r32, int hi) {
    if (hi == 0) wsc[r32] = f;
    asm volatile("s_waitcnt lgkmcnt(0)" ::: "memory");
#pragma unroll
    for (int r = 0; r < 16; ++r) { const float a = wsc[att::crow(r, hi)];
#pragma unroll
        for (int d = 0; d < DV / 32; ++d) ofin[d][r] += o[d][r] * a; }
    asm volatile("s_waitcnt lgkmcnt(0)" : "+v"(ofin[0]), "+v"(ofin[1]) :: "memory");
}
struct Tensors { const bf16_t *NQ, *KCMP, *VCMP, *KS, *VS, *KW, *VW; const float *GT, *RBT; bf16_t* O; };
#define NSA_LAUNDER() int tid = tid0; asm volatile("" : "+v"(tid)); const int lane = tid & 63, r32 = lane & 31, hi = lane >> 5, qi = r32 >> 2, hg = r32 & 3; \
    LAS float* wsc = (LAS float*)(lds + L_WSC) + wid * 64; const LAS float* tab = (LAS float*)(lds + L_TAB) + hg * TABW; const int qpos = qlo + qi;
__device__ __forceinline__ void unit(LAS char* lds, const Tensors& X, int b, int g, int qblk, int tid0, int lane0, int wid) {
    const int s0 = qblk * 64, cur = qblk, qlo = s0 + 8 * wid;
    const int bg = b * NSA_G + g;
    bf16x8 qr[DQK / 16]; float gc, gs, gw;
    f32x16 ofin[DV / 32] = {};
    LAS float* imp = (LAS float*)(lds + L_IMP) + wid * 8 * 128;
    LAS unsigned* selw = (LAS unsigned*)(lds + L_SELW) + wid * 32;
    {
    NSA_LAUNDER();
    LAS float* tabs = (LAS float*)(lds + L_TAB);
    LAS float* psum = (LAS float*)(lds + L_PSUM) + wid * 8 * PSW;
    for (int i = tid; i < 4 * TABW; i += 512) tabs[i] = X.RBT[(g * 4 + i / TABW) * TABW + i % TABW];
    for (int i = lane; i < 8 * 128; i += 64) imp[i] = 0.f;
    if (lane < 8) psum[lane * PSW] = 0.f;
    if (lane < 32) selw[lane] = 0u;
    const size_t trow = (size_t)b * SEQ + qpos;
#pragma unroll
    for (int d0 = 0; d0 < DQK / 16; ++d0) qr[d0] = *(const bf16x8*)(X.NQ + trow * 1536 + (g * 4 + hg) * 96 + d0 * 16 + hi * 8);
    gc = X.GT[trow * 48 + (g * 4 + hg) * 3 + 0]; gs = X.GT[trow * 48 + (g * 4 + hg) * 3 + 1]; gw = X.GT[trow * 48 + (g * 4 + hg) * 3 + 2];
    __syncthreads();
    }
    const int ncv = (s0 + 63 >= 31) ? ((s0 + 63 - 31) >> 4) + 1 : 0;
    const int ntc = (ncv + 63) >> 6;
#ifndef NSA_NO_CMP
    {
        NSA_LAUNDER();
        Src srcC{X.KCMP + (size_t)bg * 512 * 96, X.VCMP + (size_t)bg * 512 * 64, 0};
        MskCmp mc{qlo, qpos, hi, tab};
        LAS float* psum = (LAS float*)(lds + L_PSUM) + wid * 8 * PSW;
        float m_reg = -1e30f, l_reg = 0.f; f32x16 od[DV / 32];
        att::run_online<DQK, DV, false>(lds, wsc, ntc, srcC, mc, qr, m_reg, l_reg, od, tid, lane);
        const float inv_l = l_reg > 0.f ? fast_rcp(l_reg) : 0.f;
        f32x16 o[DV / 32] = {};
        if (ntc > 0) {
            att::Stg<DQK, DV, Src> st;
            st.load(srcC, 0, tid); st.store(lds, 0, tid); __syncthreads();
            const unsigned vlane = (unsigned)((8 * hi + ((lane & 15) >> 2)) * G::VROW + (16 * ((lane >> 4) & 1) + 4 * (lane & 3)) * 2);
            for (int t = 0; t < ntc; ++t) {
                const int buf = t & 1;
                if (t + 1 < ntc) st.load(srcC, t + 1, tid);
                const int kind = mc.kind(t);
                if (kind) {
                    f32x16 p0, p1;
                    att::qk_tile<DQK>(p0, p1, lds + G::LDS_K + buf * G::KT, r32, hi, qr);
                    if (kind >= 2) mc.apply(p0, p1, t, kind);
#pragma unroll
                    for (int r = 0; r < 16; ++r) { p0[r] = fast_exp2(p0[r] - m_reg) * inv_l; p1[r] = fast_exp2(p1[r] - m_reg) * inv_l; }
#pragma unroll
                    for (int r = 0; r < 16; ++r) {
                        float a = p0[r]; a += __shfl_xor(a, 1); a += __shfl_xor(a, 2);
                        float c = p1[r]; c += __shfl_xor(c, 1); c += __shfl_xor(c, 2);
                        if (hg == 0) { psum[qi * PSW + 1 + att::crow(r, hi)] = a; psum[qi * PSW + 33 + att::crow(r, hi)] = c; }
                    }
                    asm volatile("s_waitcnt lgkmcnt(0)" ::: "memory");
                    {
                        const int q = lane >> 3;
#pragma unroll
                        for (int e = 0; e < 2; ++e) { const int jl = (lane & 7) * 2 + e; const LAS float* ps = psum + q * PSW + 4 * jl;
                            imp[q * 128 + 16 * t + jl] = (ps[0] + ps[1]) + (ps[2] + ps[3]) + ps[4]; }
                    }
                    asm volatile("s_waitcnt lgkmcnt(0)" ::: "memory");
                    if (lane < 8) psum[lane * PSW] = psum[lane * PSW + 64];
                    asm volatile("s_waitcnt lgkmcnt(0)" ::: "memory");
                    bf16x8 pa0, pa1, pa2, pa3; att::pack_p(p0, p1, pa0, pa1, pa2, pa3);
                    att::pv_tile<DV>(o, (unsigned)(uintptr_t)(lds + G::LDS_V + buf * G::VT) + vlane, pa0, pa1, pa2, pa3);
                }
                if (t + 1 < ntc) st.store(lds, buf ^ 1, tid);
                __syncthreads();
            }
        }
        fold(ofin, o, gc, wsc, r32, hi);
    }
#endif
#ifndef NSA_NO_TOPK
    {
        NSA_LAUNDER();
        const int q = lane >> 3, jl = lane & 7;
        float v[16]; int rk[16];
#pragma unroll
        for (int i = 0; i < 16; ++i) { const int j = jl + 8 * i; const float x = imp[q * 128 + j];
            v[i] = (j == 0 || j == cur || j == cur - 1) ? 1e6f : (j > cur ? -1e6f : x); rk[i] = 0; }
        for (int jp = 0; jp <= cur; ++jp) {
            const float x = imp[q * 128 + jp]; const float w = (jp == 0 || jp == cur || jp == cur - 1) ? 1e6f : x;
#pragma unroll
            for (int i = 0; i < 16; ++i) { const int j = jl + 8 * i; rk[i] += (w > v[i] || (w == v[i] && jp < j)) ? 1 : 0; }
        }
        unsigned wd[4] = {0u, 0u, 0u, 0u};
#pragma unroll
        for (int i = 0; i < 16; ++i) { const int j = jl + 8 * i; if (j <= cur && rk[i] < 16) wd[i >> 2] |= 1u << (jl + 8 * (i & 3)); }
#pragma unroll
        for (int w = 0; w < 4; ++w) if (wd[w]) atomicOr((unsigned*)(selw + q * 4 + w), wd[w]);
        asm volatile("s_waitcnt lgkmcnt(0)" ::: "memory");
    }
#endif
#ifndef NSA_NO_SEL
    {
        NSA_LAUNDER();
        Src srcS{X.KS + (size_t)bg * SEQ * 96, X.VS + (size_t)bg * SEQ * 64, 0};
        MskSel ms{qpos, hi, cur, tab, selw + qi * 4};
        float m_reg = -1e30f, l_reg = 0.f; f32x16 o[DV / 32] = {};
        att::run_online<DQK, DV, true>(lds, wsc, cur + 1, srcS, ms, qr, m_reg, l_reg, o, tid, lane);
        fold(ofin, o, l_reg > 0.f ? gs * fast_rcp(l_reg) : 0.f, wsc, r32, hi);
    }
#endif
#ifndef NSA_NO_WIN
    {
        NSA_LAUNDER();
        const int j0 = cur >= 8 ? cur - 8 : 0;
        Src srcW{X.KW + (size_t)bg * SEQ * 96, X.VW + (size_t)bg * SEQ * 64, j0};
        MskWin mw{qpos, hi, cur, j0, tab};
        float m_reg = -1e30f, l_reg = 0.f; f32x16 o[DV / 32] = {};
        att::run_online<DQK, DV, true>(lds, wsc, cur - j0 + 1, srcW, mw, qr, m_reg, l_reg, o, tid, lane);
        fold(ofin, o, l_reg > 0.f ? gw * fast_rcp(l_reg) : 0.f, wsc, r32, hi);
    }
#endif
    NSA_LAUNDER();
    bf16_t* Ow = X.O + ((size_t)b * SEQ + qlo) * 1024 + g * 256;
#pragma unroll
    for (int r = 0; r < 16; ++r) { const int orow = att::crow(r, hi);
#pragma unroll
        for (int d0 = 0; d0 < DV / 32; ++d0) { const float v = ofin[d0][r]; const float vn = __shfl_xor(v, 1);
            if ((r32 & 1) == 0) *(unsigned*)(Ow + (size_t)(orow >> 2) * 1024 + (orow & 3) * 64 + d0 * 32 + r32) = cvt_pk_bf16(v, vn); } }
    __syncthreads();
}
}
constexpr size_t MiB = 1u << 20;
constexpr size_t WS_CTL = 0, CTL_ZERO_BYTES = 1 * MiB;
constexpr size_t WS_W_MLAIN = 1 * MiB;
constexpr size_t WS_W_QUP   = 3 * MiB;
constexpr size_t WS_W_KVUP  = WS_W_QUP + 1536 * 1024;
constexpr size_t WS_W_MLAOUT = WS_W_KVUP + 1 * MiB;
constexpr size_t WS_W_FFNGU = WS_W_MLAOUT + 2 * MiB;
constexpr size_t WS_W_FFND  = WS_W_FFNGU + 11 * MiB;
constexpr size_t WS_W_NSAIN = WS_W_FFND + 5632 * 1024;
constexpr size_t WS_W_NSAOUT = WS_W_NSAIN + 7 * MiB;
constexpr size_t WS_W_C1K = WS_W_NSAOUT + 2 * MiB;
constexpr size_t WS_W_C1V = WS_W_C1K + 256 * 3072 * 2;
constexpr size_t WS_W_C2K = WS_W_C1V + 256 * 2048 * 2;
constexpr size_t WS_W_C2V = WS_W_C2K + 256 * 128 * 2;
constexpr size_t WS_ROPE  = WS_W_C2V + 256 * 128 * 2;
constexpr size_t WS_CBIAS = WS_ROPE + 2 * MiB;
constexpr size_t WS_RBT   = WS_CBIAS + 1024;
constexpr size_t WS_ROWTOK = 38 * MiB;
constexpr size_t WS_TOKINFO = 39 * MiB;
constexpr size_t WS_TOKW = WS_TOKINFO + 256 * 1024;
static_assert(WS_RBT + 16 * 132 * 4 <= WS_ROWTOK && WS_TOKW + 256 * 1024 <= 40 * MiB, "small region");
constexpr size_t WS_XB = 40 * MiB, WS_LAT = 104 * MiB, WS_QN = 168 * MiB, WS_KVN = 200 * MiB, WS_KR = 216 * MiB, WS_Q = 220 * MiB, WS_KN = 316 * MiB, WS_V = 380 * MiB;
constexpr size_t WS_O = 40 * MiB, WS_X1 = 104 * MiB, WS_ACT = 168 * MiB, WS_X2 = 40 * MiB;
constexpr size_t WS_NQ = 104 * MiB, WS_KC = 200 * MiB, WS_VC = 224 * MiB, WS_KS = 240 * MiB, WS_VS = 264 * MiB, WS_KW = 280 * MiB, WS_VW = 304 * MiB, WS_GT = 320 * MiB;
static_assert(WS_KS - WS_KC == 40 * MiB && WS_KW - WS_KS == 40 * MiB && WS_VS - WS_VC == 40 * MiB && WS_VW - WS_VS == 40 * MiB, "FNsaIn segment stride");
constexpr size_t WS_HK = 328 * MiB, WS_HV = 330 * MiB, WS_KCMP = 332 * MiB, WS_VCMP = 334 * MiB;
constexpr size_t WS_ONSA = 348 * MiB, WS_X3 = 412 * MiB;
constexpr size_t WS_MOE_GU = 40 * MiB, WS_MOE_D = 152 * MiB, WS_DOUT = 208 * MiB;
constexpr size_t WS_END = 476 * MiB;
constexpr int CW_BAR = 4096;
constexpr int CW_ECNT = 16384;
constexpr int RING_BYTES = 131072;
constexpr int MISC_OFF = RING_BYTES + 320;
constexpr int LDS_BYTES = 147456;
constexpr int NWAVES = 8;
static_assert(nsa::L_END <= RING_BYTES && mla::G::LDS_END + 2048 <= RING_BYTES, "attention LDS");

#define RLX_AGENT __ATOMIC_RELAXED, __HIP_MEMORY_SCOPE_AGENT
#define LDS_WAIT() asm volatile("s_waitcnt lgkmcnt(0)" ::: "memory")
#define VM_WAIT() asm volatile("s_waitcnt vmcnt(0)" ::: "memory")
__device__ __forceinline__ unsigned f2bf(float f) { unsigned u = __builtin_bit_cast(unsigned, f); return (u + 0x7fffu + ((u >> 16) & 1u)) >> 16; }
__device__ __forceinline__ unsigned pk2(float lo, float hi) { return f2bf(lo) | (f2bf(hi) << 16); }

#define XB_TMO      128
#define XB_XCNT(j)  (256  + 64 * (j))
#define XB_XSUB(j)  (1280 + 64 * (j))
#define XB_XGEN(j)  (2304 + 64 * (j))
#define XB_TOP      3328
#define XB_TOPGEN   3392
#define XCD_BAR_WORDS 3456
#define XB_SPIN_CAP (1u << 20)
__device__ __forceinline__ unsigned xb_ld(unsigned* p)              { return __hip_atomic_load(p, __ATOMIC_RELAXED, __HIP_MEMORY_SCOPE_AGENT); }
__device__ __forceinline__ unsigned xb_add(unsigned* p, unsigned v) { return __hip_atomic_fetch_add(p, v, __ATOMIC_RELAXED, __HIP_MEMORY_SCOPE_AGENT); }
__device__ __forceinline__ unsigned xb_xcc_id() { return (unsigned)__builtin_amdgcn_s_getreg((3 << 11) | 20) & 0xFu; }
#define XB_SPIN(cond, bar) do { unsigned _sp = 0; while (cond) { __builtin_amdgcn_s_sleep(1); \
    if ((++_sp & 255u) == 0u) { if (xb_ld(&(bar)[XB_TMO])) break; if (_sp > XB_SPIN_CAP) { atomicAdd(&(bar)[XB_TMO], 1u); break; } } } } while (0)
struct XcdBarrier { unsigned* bar; unsigned x; volatile LAS unsigned* st; };
__device__ __forceinline__ XcdBarrier xcd_barrier_post(unsigned* bar, volatile LAS unsigned* st) {
    XcdBarrier b; b.bar = bar; b.x = xb_xcc_id(); b.st = st;
    if (threadIdx.x == 0) (void)xb_add(&bar[XB_XCNT(b.x)], 1u);
    return b;
}
__device__ __forceinline__ void xcd_barrier_complete(unsigned* bar, unsigned x, unsigned& nloc, unsigned& nx) {
    const unsigned G = gridDim.x * gridDim.y * gridDim.z;
    unsigned sum, cnt, mine, sp = 0u;
    for (;;) {
        sum = 0u; cnt = 0u; mine = 0u;
#pragma unroll
        for (unsigned j = 0; j < 16; ++j) { const unsigned c = xb_ld(&bar[XB_XCNT(j)]); sum += c; cnt += (c > 0u) ? 1u : 0u; mine = (j == x) ? c : mine; }
        if (sum == G) break;
        __builtin_amdgcn_s_sleep(1);
        if ((++sp & 255u) == 0u) { if (xb_ld(&bar[XB_TMO])) break; if (sp > XB_SPIN_CAP) { atomicAdd(&bar[XB_TMO], 1u); break; } }
    }
    nloc = mine > 0u ? mine : 1u; nx = cnt > 0u ? cnt : 1u;
}
__device__ __forceinline__ void xcd_barrier(const XcdBarrier& b) {
    asm volatile("s_waitcnt vmcnt(0)" ::: "memory");
    __syncthreads();
    if (threadIdx.x == 0) {
        unsigned* bar = b.bar;
        __builtin_amdgcn_s_waitcnt(0);
        unsigned nloc = b.st[0], nx = b.st[1];
        if (nloc == 0u) { xcd_barrier_complete(bar, b.x, nloc, nx); b.st[0] = nloc; b.st[1] = nx; }
        const unsigned old = xb_add(&bar[XB_XSUB(b.x)], 1u);
        const unsigned gen = old / nloc;
        if (old + 1u == (gen + 1u) * nloc) {
            __builtin_amdgcn_fence(__ATOMIC_RELEASE, "agent");
            asm volatile("s_waitcnt vmcnt(0)" ::: "memory");
            const unsigned og = xb_add(&bar[XB_TOP], 1u);
            const unsigned tg = og / nx;
            if (og + 1u == (tg + 1u) * nx) xb_add(&bar[XB_TOPGEN], 1u);
            else XB_SPIN(xb_ld(&bar[XB_TOPGEN]) == tg, bar);
            __builtin_amdgcn_fence(__ATOMIC_ACQUIRE, "agent");
            xb_add(&bar[XB_XGEN(b.x)], 1u);
            asm volatile("s_waitcnt vmcnt(0)" ::: "memory");
        } else {
            XB_SPIN(xb_ld(&bar[XB_XGEN(b.x)]) == gen, bar);
            __builtin_amdgcn_fence(__ATOMIC_ACQUIRE, "agent");
            asm volatile("s_waitcnt vmcnt(0)" ::: "memory");
        }
    }
    __syncthreads();
}

__device__ __forceinline__ float wave_sum(float v) {
#pragma unroll
    for (int o = 1; o < 64; o <<= 1) v += __shfl_xor(v, o);
    return v;
}
template <class RM> __device__ __forceinline__ void tr_item(const float* W, int K, int N, bf16_t* WT, int ldk, const RM& rowmap, LAS float* scr, int item, int lane) {
    const int nblk = (N + 31) / 32, kb = item / nblk, nb = item % nblk, k0 = 64 * kb, n0 = 32 * nb;
    const bool nok = n0 + (lane & 31) < N;
#pragma unroll 8
    for (int i = 0; i < 32; ++i) { const int kk = 2 * i + (lane >> 5); scr[kk * 33 + (lane & 31)] = nok ? W[(size_t)(k0 + kk) * N + n0 + (lane & 31)] : 0.f; }
    LDS_WAIT(); asm volatile("" ::: "memory");
    const int c = lane & 7;
#pragma unroll
    for (int j = 0; j < 4; ++j) { const int nl = (lane >> 3) + 8 * j; const LAS float* s = scr + (8 * c) * 33 + nl;
        u32x4 o; o.x = pk2(s[0 * 33], s[1 * 33]); o.y = pk2(s[2 * 33], s[3 * 33]); o.z = pk2(s[4 * 33], s[5 * 33]); o.w = pk2(s[6 * 33], s[7 * 33]);
        if (n0 + nl < N) *(u32x4*)(WT + (size_t)rowmap(n0 + nl) * ldk + k0 + 8 * c) = o; }
    LDS_WAIT(); asm volatile("" ::: "memory");
}
struct RmId { int off; __device__ __forceinline__ int operator()(int n) const { return off + n; } };
struct RmGU { int off; __device__ __forceinline__ int operator()(int n) const { return off + (n >> 7) * 256 + (n & 127); } };
struct RmQup { __device__ __forceinline__ int operator()(int n) const { const int h = n / 192, j = n % 192; if (j < 128) return n; const int i = j - 128, ii = i & 31; return h * 192 + 128 + 8 * (ii >> 2) + (ii & 3) + ((i >> 5) << 2); } };
template <class RM> __device__ __forceinline__ void tr_matrix(const float* W, int K, int N, bf16_t* WT, int ldk, const RM& rm, LAS float* scr, int gw, int ngw, int lane) {
    const int nitems = (K / 64) * ((N + 31) / 32);
    for (int it = gw; it < nitems; it += ngw) tr_item(W, K, N, WT, ldk, rm, scr, it, lane);
}
__device__ __forceinline__ void ln_inplace(f32x4 (&v)[4], const float* g, const float* b, int lane) {
    float s = 0.f;
#pragma unroll
    for (int j = 0; j < 4; ++j) s += (v[j].x + v[j].y) + (v[j].z + v[j].w);
    const float mean = wave_sum(s) * (1.f / D); float s2 = 0.f;
#pragma unroll
    for (int j = 0; j < 4; ++j) { v[j] = v[j] - mean; s2 += (v[j].x * v[j].x + v[j].y * v[j].y) + (v[j].z * v[j].z + v[j].w * v[j].w); }
    const float rstd = 1.f / sqrtf(wave_sum(s2) * (1.f / D) + 1e-5f);
#pragma unroll
    for (int j = 0; j < 4; ++j) { const f32x4 gg = *((const f32x4*)g + lane + 64 * j), bb = *((const f32x4*)b + lane + 64 * j); v[j] = v[j] * rstd * gg + bb; }
}
__device__ __forceinline__ void store_row_bf16(bf16_t* orow, const f32x4 (&v)[4], int lane) {
    u32x2* o8 = (u32x2*)orow + lane;
#pragma unroll
    for (int j = 0; j < 4; ++j) { u32x2 w; w.x = cvt_pk_bf16(v[j].x, v[j].y); w.y = cvt_pk_bf16(v[j].z, v[j].w); o8[64 * j] = w; }
}
__device__ __forceinline__ f32x4 bf4_to_f32(u32x2 w) { return (f32x4){bflo(w.x), bfhi(w.x), bflo(w.y), bfhi(w.y)}; }

__device__ __forceinline__ u32x4 pack8(f32x4 a, f32x4 b) { u32x4 w; w.x = cvt_pk_bf16(a[0], a[1]); w.y = cvt_pk_bf16(a[2], a[3]); w.z = cvt_pk_bf16(b[0], b[1]); w.w = cvt_pk_bf16(b[2], b[3]); return w; }
struct FBf16 { bf16_t* O; int ld; int rowoff;
    __device__ __forceinline__ void operator()(int row, int col, f32x4 a, f32x4 b) const { *(u32x4*)(O + (size_t)(rowoff + row) * ld + col) = pack8(a, b); } };
struct FQup { bf16_t* Q; const float* cs; const float* sn;
    __device__ __forceinline__ void operator()(int row, int col, f32x4 a, f32x4 b) const {
        const int j = col % 192;
        if (j >= 128) { const int i0 = ((j - 128) >> 3) * 4, s = row & (SEQ - 1);
            const f32x4 c = *(const f32x4*)(cs + s * 32 + i0), sv = *(const f32x4*)(sn + s * 32 + i0);
            const f32x4 o1 = a * c - b * sv, o2 = a * sv + b * c; a = o1; b = o2; }
        *(u32x4*)(Q + (size_t)row * 1536 + col) = pack8(a * C2_MLA, b * C2_MLA); } };
struct FKvup { bf16_t* KN; bf16_t* V;
    __device__ __forceinline__ void operator()(int row, int col, f32x4 a, f32x4 b) const {
        const int h = col >> 8, j = col & 255, bb = row >> 13, s = row & (SEQ - 1);
        bf16_t* base = (j < 128 ? KN : V) + ((size_t)(bb * MLA_H + h) * SEQ + s) * 128 + (j & 127);
        *(u32x4*)base = pack8(a, b); } };
struct FResF32 { float* P; const float* rf; const bf16_t* rb;
    __device__ __forceinline__ void operator()(int row, int col, f32x4 a, f32x4 b) const {
        const size_t o = (size_t)row * D + col; f32x4 r0, r1;
        if (rf) { r0 = *(const f32x4*)(rf + o); r1 = *(const f32x4*)(rf + o + 4); }
        else { const u32x4 w = *(const u32x4*)(rb + o); r0 = (f32x4){bflo(w.x), bfhi(w.x), bflo(w.y), bfhi(w.y)}; r1 = (f32x4){bflo(w.z), bfhi(w.z), bflo(w.w), bfhi(w.w)}; }
        *(f32x4*)(P + o) = r0 * ALPHA + a; *(f32x4*)(P + o + 4) = r1 * ALPHA + b; } };
struct FSwiglu { bf16_t* A; int ld; int rowoff;
    __device__ __forceinline__ void operator()(int row, int col, f32x4 g0, f32x4 g1, f32x4 u0, f32x4 u1) const {
        f32x4 a, b;
#pragma unroll
        for (int e = 0; e < 4; ++e) { a[e] = silu_f(g0[e]) * u0[e]; b[e] = silu_f(g1[e]) * u1[e]; }
        *(u32x4*)(A + (size_t)(rowoff + row) * ld + col) = pack8(a, b); } };
struct FNsaIn { bf16_t *NQ, *KC, *VC; float* GT;
    __device__ __forceinline__ void operator()(int row, int col, f32x4 a, f32x4 b) const {
        const int bb = row >> 13, s = row & (SEQ - 1);
        if (col < 1536) { *(u32x4*)(NQ + (size_t)row * 1536 + col) = pack8(a * C2_NSA, b * C2_NSA); return; }
        if (col >= 3504) return;
        if (col >= 3456) { float* gp = GT + (size_t)row * 48 + (col - 3456);
            f32x4 x, y;
#pragma unroll
            for (int e = 0; e < 4; ++e) { x[e] = sigmoid_f(a[e]); y[e] = sigmoid_f(b[e]); }
            *(f32x4*)gp = x; *(f32x4*)(gp + 4) = y; return; }
        int cc = col - 1536; const int seg = cc / 640; cc -= seg * 640;
        const bool isk = cc < 384; if (!isk) cc -= 384;
        bf16_t* base = (isk ? KC : VC) + (size_t)seg * (40u * 1024u * 1024u / 2u);
        const int dd = isk ? 96 : 64, g = cc / dd, d = cc - g * dd;
        *(u32x4*)(base + ((size_t)(bb * NSA_G + g) * SEQ + s) * dd + d) = pack8(a, b); } };
struct FCmp1 { bf16_t* H; const float* bias;
    __device__ __forceinline__ void operator()(int row, int col, f32x4 a, f32x4 b) const {
        if (col >= 128) return;
        const f32x4 b0 = *(const f32x4*)(bias + col), b1 = *(const f32x4*)(bias + col + 4); f32x4 x, y;
#pragma unroll
        for (int e = 0; e < 4; ++e) { x[e] = gelu_tanh_f(a[e] + b0[e]); y[e] = gelu_tanh_f(b[e] + b1[e]); }
        *(u32x4*)(H + (size_t)row * 128 + col) = pack8(x, y); } };
struct FCmp2 { bf16_t* O; int nd;
    __device__ __forceinline__ void operator()(int row, int col, f32x4 a, f32x4 b) const {
        if (col >= nd) return;
        if ((row & 511) == 511) { a = (f32x4){0.f, 0.f, 0.f, 0.f}; b = a; }
        *(u32x4*)(O + (size_t)row * nd + col) = pack8(a, b); } };

struct MoeInfo { int cnt[NE]; int ts[NE + 1];
    __device__ __forceinline__ int expert_of(int ct) const { int e = 0;
#pragma unroll
        for (int i = 1; i < NE; ++i) e += (ct >= ts[i]) ? 1 : 0; return e; } };
struct SchedMoeGU {
    pg8::StaticOrder so; MoeInfo mi; int ct0; const int* rowtok;
    __device__ __forceinline__ bool next(int i, pg8::Unit& u) const { return so.next(i, u); }
    __device__ __forceinline__ size_t a_off(const pg8::Unit&, const pg8::Gemm&) const { return 0; }
    __device__ __forceinline__ size_t b_off(const pg8::Unit& u, const pg8::Gemm& g) const { const int e = mi.expert_of(ct0 + u.pm); return ((size_t)e * (2 * FFE) + (size_t)u.pn * 256) * g.ldb * 2; }
    __device__ __forceinline__ unsigned a_row(const pg8::Unit& u, int r) const {
        const int ct = ct0 + u.pm, e = mi.expert_of(ct); int c = 0, t0 = 0;
#pragma unroll
        for (int i = 0; i < NE; ++i) { c = (i == e) ? mi.cnt[i] : c; t0 = (i == e) ? mi.ts[i] : t0; }
        const int pos = (ct - t0) * 256 + r; const int tok = pos < c ? rowtok[e * ECAP + pos] : 0;
        return (unsigned)tok * (unsigned)(D * 2); }
};
struct SchedMoeD {
    pg8::StaticOrder so; MoeInfo mi; int ct0;
    __device__ __forceinline__ bool next(int i, pg8::Unit& u) const { return so.next(i, u); }
    __device__ __forceinline__ size_t a_off(const pg8::Unit& u, const pg8::Gemm& g) const { return (size_t)u.pm * 256 * g.lda * 2; }
    __device__ __forceinline__ size_t b_off(const pg8::Unit& u, const pg8::Gemm& g) const { const int e = mi.expert_of(ct0 + u.pm); return ((size_t)e * D + (size_t)u.pn * 256) * g.ldb * 2; }
    __device__ __forceinline__ unsigned a_row(const pg8::Unit&, int) const { return 0u; }
};
constexpr int N_PHASES = 28;
struct Args { const float* in[27]; float* out; unsigned char* ws; int ph_lo, ph_hi; };
enum { I_X = 0, I_MLA_WIN, I_MLA_QN, I_MLA_WQ, I_MLA_KVN, I_MLA_WKV, I_MLA_WO, I_NSA_WIN, I_PE_K, I_W1_K, I_W2_K, I_PE_V, I_W1_V, I_W2_V, I_NSA_WO, I_RELB,
       I_FFN_G, I_FFN_U, I_FFN_D, I_ROUTER, I_MOE_G, I_MOE_U, I_MOE_D, I_LNM_G, I_LNM_B, I_LNF_G, I_LNF_B };

__device__ __forceinline__ int rel_bucket_dev(int n) {
    if (n < 16) return n;
    int bkt = 16;
    bkt += n >= 19; bkt += n >= 21; bkt += n >= 24; bkt += n >= 27; bkt += n >= 31; bkt += n >= 35; bkt += n >= 40; bkt += n >= 46;
    bkt += n >= 52; bkt += n >= 59; bkt += n >= 67; bkt += n >= 77; bkt += n >= 87; bkt += n >= 99; bkt += n >= 113;
    return bkt;
}

__global__ void __launch_bounds__(NWAVES * 64, 2) fwd(Args args) {
    extern __shared__ __attribute__((aligned(16))) unsigned char lds_raw[];
    LAS unsigned char* lds = (LAS unsigned char*)lds_raw;
    volatile LAS unsigned* MISC = (volatile LAS unsigned*)(lds + MISC_OFF);
    const int tid_ = threadIdx.x, wave = __builtin_amdgcn_readfirstlane(tid_ >> 6);
    const int G = gridDim.x, bx = blockIdx.x;
    const int vcu = (G % 8 == 0) ? (bx % 8) * (G / 8) + bx / 8 : bx;
    const int NGW = G * NWAVES;
    unsigned char* ws = args.ws;
    unsigned* ctl = (unsigned*)(ws + WS_CTL);
    for (int u = tid_; u < (LDS_BYTES - RING_BYTES) / 4; u += NWAVES * 64) ((LAS unsigned*)(lds + RING_BYTES))[u] = 0u;
    __syncthreads();
    XcdBarrier bar = xcd_barrier_post(ctl + CW_BAR, MISC + 8);
    const int lo = args.ph_lo, hi_ph = args.ph_hi;
#ifndef PHMASK
#define PHMASK 0xFFFFFFFFu
#endif
#define IN(k) (((PHMASK >> (k)) & 1u) && lo <= (k) && (k) < hi_ph)
#define SEAM(k) do { if (IN(k) && IN((k) + 1)) xcd_barrier(bar); } while (0)
#define W_MLAIN ((bf16_t*)(ws + WS_W_MLAIN))
#define W_QUP ((bf16_t*)(ws + WS_W_QUP))
#define W_KVUP ((bf16_t*)(ws + WS_W_KVUP))
#define W_MLAOUT ((bf16_t*)(ws + WS_W_MLAOUT))
#define W_FFNGU ((bf16_t*)(ws + WS_W_FFNGU))
#define W_FFND ((bf16_t*)(ws + WS_W_FFND))
#define W_NSAIN ((bf16_t*)(ws + WS_W_NSAIN))
#define W_NSAOUT ((bf16_t*)(ws + WS_W_NSAOUT))
#define W_C1K ((bf16_t*)(ws + WS_W_C1K))
#define W_C1V ((bf16_t*)(ws + WS_W_C1V))
#define W_C2K ((bf16_t*)(ws + WS_W_C2K))
#define W_C2V ((bf16_t*)(ws + WS_W_C2V))
#define ROPE_C ((float*)(ws + WS_ROPE))
#define CBIAS ((float*)(ws + WS_CBIAS))
#define RBT ((float*)(ws + WS_RBT))
#define ROWTOK ((int*)(ws + WS_ROWTOK))
#define TOKINFO ((unsigned*)(ws + WS_TOKINFO))
#define TOKW ((float*)(ws + WS_TOKW))
#define XB ((bf16_t*)(ws + WS_XB))
#define LAT ((bf16_t*)(ws + WS_LAT))
#define QN ((bf16_t*)(ws + WS_QN))
#define KVN ((bf16_t*)(ws + WS_KVN))
#define KR ((bf16_t*)(ws + WS_KR))
#define Q ((bf16_t*)(ws + WS_Q))
#define KN ((bf16_t*)(ws + WS_KN))
#define V ((bf16_t*)(ws + WS_V))
#define O ((bf16_t*)(ws + WS_O))
#define X1 ((bf16_t*)(ws + WS_X1))
#define ACT ((bf16_t*)(ws + WS_ACT))
#define X2 ((bf16_t*)(ws + WS_X2))
#define NQ ((bf16_t*)(ws + WS_NQ))
#define KC ((bf16_t*)(ws + WS_KC))
#define VC ((bf16_t*)(ws + WS_VC))
#define KS ((bf16_t*)(ws + WS_KS))
#define VS ((bf16_t*)(ws + WS_VS))
#define KW ((bf16_t*)(ws + WS_KW))
#define VW ((bf16_t*)(ws + WS_VW))
#define GT ((float*)(ws + WS_GT))
#define HK ((bf16_t*)(ws + WS_HK))
#define HV ((bf16_t*)(ws + WS_HV))
#define KCMP ((bf16_t*)(ws + WS_KCMP))
#define VCMP ((bf16_t*)(ws + WS_VCMP))
#define ONSA ((bf16_t*)(ws + WS_ONSA))
#define X3 ((bf16_t*)(ws + WS_X3))
#define W_MOEGU ((bf16_t*)(ws + WS_MOE_GU))
#define W_MOED ((bf16_t*)(ws + WS_MOE_D))
#define DOUT ((bf16_t*)(ws + WS_DOUT))
#define ROPE_S (ROPE_C + SEQ * 32)
#define P (args.out)
#define ACTC ((bf16_t*)args.out)
    typedef pg8::SchedPlain SP;
#define PH_LAUNDER() int tid = tid_; asm volatile("" : "+v"(tid)); const int lane = tid & 63; const int gw = vcu * NWAVES + wave; LAS float* scr = (LAS float*)(lds + wave * 8704); (void)lane; (void)gw; (void)scr;

    if (IN(0)) {
        PH_LAUNDER();
        const float* const* in = args.in;
        tr_matrix(in[I_MLA_WIN], D, MLA_IN, W_MLAIN, D, RmId{0}, scr, gw, NGW, lane);
        tr_matrix(in[I_MLA_WQ], MLA_QR, 1536, W_QUP, MLA_QR, RmQup{}, scr, gw, NGW, lane);
        tr_matrix(in[I_MLA_WKV], MLA_KVR, 2048, W_KVUP, MLA_KVR, RmId{0}, scr, gw, NGW, lane);
        tr_matrix(in[I_MLA_WO], D, D, W_MLAOUT, D, RmId{0}, scr, gw, NGW, lane);
        tr_matrix(in[I_FFN_G], D, FF, W_FFNGU, D, RmGU{0}, scr, gw, NGW, lane);
        tr_matrix(in[I_FFN_U], D, FF, W_FFNGU, D, RmGU{128}, scr, gw, NGW, lane);
        tr_matrix(in[I_FFN_D], FF, D, W_FFND, FF, RmId{0}, scr, gw, NGW, lane);
        tr_matrix(in[I_NSA_WIN], D, NSA_IN, W_NSAIN, D, RmId{0}, scr, gw, NGW, lane);
        tr_matrix(in[I_NSA_WO], D, D, W_NSAOUT, D, RmId{0}, scr, gw, NGW, lane);
        const int gt = vcu * 512 + tid, NGT = G * 512;
        for (int i = gt; i < (1024 - MLA_IN) * D / 8; i += NGT) ((u32x4*)(W_MLAIN + (size_t)MLA_IN * D))[i] = (u32x4){0u, 0u, 0u, 0u};
        for (int i = gt; i < (NSA_INP - NSA_IN) * D / 8; i += NGT) ((u32x4*)(W_NSAIN + (size_t)NSA_IN * D))[i] = (u32x4){0u, 0u, 0u, 0u};
        for (int i = gt; i < 256 * 3072; i += NGT) { const int n = i / 3072, k = i % 3072; W_C1K[i] = (bf16_t)(n < 96 ? f2bf(in[I_W1_K][(size_t)k * 96 + n]) : 0u); }
        for (int i = gt; i < 256 * 2048; i += NGT) { const int n = i / 2048, k = i % 2048; W_C1V[i] = (bf16_t)(n < 64 ? f2bf(in[I_W1_V][(size_t)k * 64 + n]) : 0u); }
        for (int i = gt; i < 256 * 128; i += NGT) { const int n = i / 128, k = i % 128;
            W_C2K[i] = (bf16_t)((n < 96 && k < 96) ? f2bf(in[I_W2_K][k * 96 + n]) : 0u); W_C2V[i] = (bf16_t)((n < 64 && k < 64) ? f2bf(in[I_W2_V][k * 64 + n]) : 0u); }
        for (int i = gt; i < 256; i += NGT) { const int isv = i >> 7, e = i & 127; const int nd = isv ? 64 : 96; float s = 0.f;
            if (e < nd) { const float* pe = in[isv ? I_PE_V : I_PE_K]; const float* w1 = in[isv ? I_W1_V : I_W1_K]; for (int k = 0; k < 32 * nd; ++k) s += pe[k] * w1[(size_t)k * nd + e]; }
            CBIAS[i] = s; }
        for (int i = gt; i < SEQ * 32; i += NGT) { const int pos = i >> 5, j = i & 31; const float fr = (float)pow(10000.0, -(double)j / 32.0); const float ang = (float)pos * fr;
            ROPE_C[i] = (float)cos((double)ang); ROPE_S[i] = (float)sin((double)ang); }
        for (int i = gt; i < 16 * nsa::TABW; i += NGT) { const int h = i / nsa::TABW, d = i % nsa::TABW; const float* rb = in[I_RELB];
            RBT[i] = d < 128 ? (rb[rel_bucket_dev(d) * 16 + h] - rb[31 * 16 + h]) * LOG2E : 0.f; }
        for (int m = gw; m < T; m += NGW) { const f32x4* xr = (const f32x4*)(in[I_X] + (size_t)m * D) + lane; f32x4 v[4];
#pragma unroll
            for (int j = 0; j < 4; ++j) v[j] = xr[64 * j];
            store_row_bf16(XB + (size_t)m * D, v, lane); }
    }
    SEAM(0);
    if (IN(1)) { pg8::Gemm g{XB, W_MLAIN, D, D, D}; SP S; S.init(T / 256, 4, G, bx);
        pg8::EpiRow8<FBf16> E{FBf16{LAT, 1024, 0}}; pg8::gemm_phase<pg8::EpiRow8<FBf16>, SP, true, false>(lds, g, S, E); }
    SEAM(1);
    if (IN(2)) {
        PH_LAUNDER();
        const float* qg = args.in[I_MLA_QN]; const float* kg = args.in[I_MLA_KVN];
        for (int m = gw; m < T; m += NGW) {
            const bf16_t* row = LAT + (size_t)m * 1024;
            const u32x4 wq = *((const u32x4*)row + lane);
            const u32x2 wk = *((const u32x2*)(row + 512) + lane);
            float q[8] = {bflo(wq.x), bfhi(wq.x), bflo(wq.y), bfhi(wq.y), bflo(wq.z), bfhi(wq.z), bflo(wq.w), bfhi(wq.w)};
            float k[4] = {bflo(wk.x), bfhi(wk.x), bflo(wk.y), bfhi(wk.y)};
            float sq = 0.f, sk = 0.f;
#pragma unroll
            for (int e = 0; e < 8; ++e) sq += q[e] * q[e];
#pragma unroll
            for (int e = 0; e < 4; ++e) sk += k[e] * k[e];
            const float rq = 1.f / sqrtf(wave_sum(sq) * (1.f / 512.f) + 1e-6f), rk = 1.f / sqrtf(wave_sum(sk) * (1.f / 256.f) + 1e-6f);
            const f32x4 g0 = *((const f32x4*)qg + 2 * lane), g1 = *((const f32x4*)qg + 2 * lane + 1), g2 = *((const f32x4*)kg + lane);
            u32x4 oq; oq.x = cvt_pk_bf16(q[0] * rq * g0[0], q[1] * rq * g0[1]); oq.y = cvt_pk_bf16(q[2] * rq * g0[2], q[3] * rq * g0[3]);
            oq.z = cvt_pk_bf16(q[4] * rq * g1[0], q[5] * rq * g1[1]); oq.w = cvt_pk_bf16(q[6] * rq * g1[2], q[7] * rq * g1[3]);
            *((u32x4*)(QN + (size_t)m * 512) + lane) = oq;
            u32x2 ok; ok.x = cvt_pk_bf16(k[0] * rk * g2[0], k[1] * rk * g2[1]); ok.y = cvt_pk_bf16(k[2] * rk * g2[2], k[3] * rk * g2[3]);
            *((u32x2*)(KVN + (size_t)m * 256) + lane) = ok;
            if (lane < 32) { const float x1 = bf2f(row[768 + lane]), x2 = bf2f(row[800 + lane]); const int s = m & (SEQ - 1);
                const float c = ROPE_C[s * 32 + lane], sn = ROPE_S[s * 32 + lane]; const int p = 8 * (lane >> 2) + (lane & 3);
                bf16_t* kr = KR + (size_t)m * 64; kr[p] = (bf16_t)f2bf(x1 * c - x2 * sn); kr[p + 4] = (bf16_t)f2bf(x1 * sn + x2 * c); }
        }
    }
    SEAM(2);
    if (IN(3)) { pg8::Gemm g{QN, W_QUP, MLA_QR, MLA_QR, MLA_QR}; SP S; S.init(T / 256, 6, G, bx);
        pg8::EpiRow8<FQup> E{FQup{Q, ROPE_C, ROPE_S}}; pg8::gemm_phase<pg8::EpiRow8<FQup>, SP, true, false>(lds, g, S, E); }
    SEAM(3);
    if (IN(4)) { pg8::Gemm g{KVN, W_KVUP, MLA_KVR, MLA_KVR, MLA_KVR}; SP S; S.init(T / 256, 8, G, bx);
        pg8::EpiRow8<FKvup> E{FKvup{KN, V}}; pg8::gemm_phase<pg8::EpiRow8<FKvup>, SP, true, false>(lds, g, S, E); }
    SEAM(4);
    if (IN(5)) {
        PH_LAUNDER();
        for (int it2 = 2 * bx; it2 < 2 * NB * MLA_H * 16; it2 += (it2 & 1) ? 2 * G - 1 : 1) { const int it = it2 >> 1, bh = it & 31, x = it >> 5;
            mla::unit((LAS char*)lds, bh >> 3, bh & 7, (it2 & 1) ? x : 31 - x, Q, KN, KR, V, O, tid, lane, wave); }
    }
    SEAM(5);
    if (IN(6)) { pg8::Gemm g{O, W_MLAOUT, D, D, D}; SP S; S.init(T / 256, 4, G, bx);
        pg8::EpiRow8<FResF32> E{FResF32{P, args.in[I_X], nullptr}}; pg8::gemm_phase<pg8::EpiRow8<FResF32>, SP, true, false>(lds, g, S, E); }
    SEAM(6);
    if (IN(7)) {
        PH_LAUNDER();
        for (int m = gw; m < T; m += NGW) { const f32x4* pr = (const f32x4*)(P + (size_t)m * D) + lane; f32x4 v[4];
#pragma unroll
            for (int j = 0; j < 4; ++j) v[j] = pr[64 * j];
            ln_inplace(v, args.in[I_LNM_G], args.in[I_LNM_B], lane); store_row_bf16(X1 + (size_t)m * D, v, lane); }
    }
    SEAM(7);
    if (IN(8)) { pg8::Gemm g{X1, W_FFNGU, D, D, D}; SP S; S.init(T / 256, 22, G, bx);
        pg8::EpiGateUp<FSwiglu> E{FSwiglu{ACT, FF, 0}}; pg8::gemm_phase<pg8::EpiGateUp<FSwiglu>, SP, true, false>(lds, g, S, E); }
    SEAM(8);
    if (IN(9)) { pg8::Gemm g{ACT, W_FFND, FF, FF, FF}; SP S; S.init(T / 256, 4, G, bx);
        pg8::EpiRow8<FResF32> E{FResF32{P, nullptr, X1}}; pg8::gemm_phase<pg8::EpiRow8<FResF32>, SP, true, false>(lds, g, S, E); }
    SEAM(9);
    if (IN(10)) {
        PH_LAUNDER();
        for (int m = gw; m < T; m += NGW) { const f32x4* pr = (const f32x4*)(P + (size_t)m * D) + lane; f32x4 v[4];
#pragma unroll
            for (int j = 0; j < 4; ++j) v[j] = pr[64 * j];
            ln_inplace(v, args.in[I_LNF_G], args.in[I_LNF_B], lane); store_row_bf16(X2 + (size_t)m * D, v, lane); }
    }
    SEAM(10);
    if (IN(11)) { pg8::Gemm g{X2, W_NSAIN, D, D, D}; SP S; S.init(T / 256, NSA_INP / 256, G, bx);
        pg8::EpiRow8<FNsaIn> E{FNsaIn{NQ, KC, VC, GT}}; pg8::gemm_phase<pg8::EpiRow8<FNsaIn>, SP, true, false>(lds, g, S, E); }
    SEAM(11);
    if (IN(12)) {
        { pg8::Gemm g{KC, W_C1K, 16 * 96, 3072, 3072}; SP S; S.init(32, 1, G, bx);
          pg8::EpiRow8<FCmp1> E{FCmp1{HK, CBIAS}}; pg8::gemm_phase<pg8::EpiRow8<FCmp1>, SP, false, false>(lds, g, S, E); }
        { pg8::Gemm g{VC, W_C1V, 16 * 64, 2048, 2048}; SP S; S.init(32, 1, G, (bx + G / 2) % G);
          pg8::EpiRow8<FCmp1> E{FCmp1{HV, CBIAS + 128}}; pg8::gemm_phase<pg8::EpiRow8<FCmp1>, SP, false, false>(lds, g, S, E); }
    }
    SEAM(12);
    if (IN(13)) {
        { pg8::Gemm g{HK, W_C2K, 128, 128, 128}; SP S; S.init(32, 1, G, bx);
          pg8::EpiRow8<FCmp2> E{FCmp2{KCMP, 96}}; pg8::gemm_phase<pg8::EpiRow8<FCmp2>, SP, false, false>(lds, g, S, E); }
        { pg8::Gemm g{HV, W_C2V, 128, 128, 128}; SP S; S.init(32, 1, G, (bx + G / 2) % G);
          pg8::EpiRow8<FCmp2> E{FCmp2{VCMP, 64}}; pg8::gemm_phase<pg8::EpiRow8<FCmp2>, SP, false, false>(lds, g, S, E); }
    }
    SEAM(13);
    if (IN(14)) {
        PH_LAUNDER();
        const nsa::Tensors X{NQ, KCMP, VCMP, KS, VS, KW, VW, GT, RBT, ONSA};
        for (int it2 = 2 * bx; it2 < 2 * NB * NSA_G * 64; it2 += (it2 & 1) ? 2 * G - 1 : 1) { const int it = it2 >> 1, bg = it & 15, x = it >> 4;
            nsa::unit((LAS char*)lds, X, bg >> 2, bg & 3, (it2 & 1) ? x : 127 - x, tid, lane, wave); }
    }
    SEAM(14);
    if (IN(15)) { pg8::Gemm g{ONSA, W_NSAOUT, D, D, D}; SP S; S.init(T / 256, 4, G, bx);
        pg8::EpiRow8<FResF32> E{FResF32{P, nullptr, X2}}; pg8::gemm_phase<pg8::EpiRow8<FResF32>, SP, true, false>(lds, g, S, E); }
    SEAM(15);
    if (IN(16)) {
        PH_LAUNDER();
        LAS float* wr = (LAS float*)(lds + 69632);
        LAS unsigned* lcnt = (LAS unsigned*)(lds + 69632 + 32768);
        LAS unsigned* lrec = lcnt + 16;
        for (int i = tid; i < D * NE; i += 512) wr[i] = args.in[I_ROUTER][i];
        if (tid < 16) lcnt[tid] = 0u;
        __syncthreads();
        int nrec = 0;
        for (int m = gw; m < T; m += NGW, ++nrec) { const f32x4* pr = (const f32x4*)(P + (size_t)m * D) + lane; f32x4 v[4];
#pragma unroll
            for (int j = 0; j < 4; ++j) v[j] = pr[64 * j];
            ln_inplace(v, args.in[I_LNM_G] + D, args.in[I_LNM_B] + D, lane); store_row_bf16(X3 + (size_t)m * D, v, lane);
            float lg[NE];
#pragma unroll
            for (int e = 0; e < NE; ++e) lg[e] = 0.f;
#pragma unroll
            for (int j = 0; j < 4; ++j)
#pragma unroll
                for (int c = 0; c < 4; ++c) { const int k = 4 * lane + 256 * j + c; const f32x4 w0 = *(const LAS f32x4*)(wr + k * 8), w1 = *(const LAS f32x4*)(wr + k * 8 + 4); const float xv = v[j][c];
                    lg[0] += xv * w0[0]; lg[1] += xv * w0[1]; lg[2] += xv * w0[2]; lg[3] += xv * w0[3]; lg[4] += xv * w1[0]; lg[5] += xv * w1[1]; lg[6] += xv * w1[2]; lg[7] += xv * w1[3]; }
#pragma unroll
            for (int e = 0; e < NE; ++e) lg[e] = wave_sum(lg[e]);
            int e0 = 0; float v0 = lg[0];
#pragma unroll
            for (int e = 1; e < NE; ++e) if (lg[e] > v0) { v0 = lg[e]; e0 = e; }
            int e1 = -1; float v1 = -__builtin_inff();
#pragma unroll
            for (int e = 0; e < NE; ++e) if (e != e0 && lg[e] > v1) { v1 = lg[e]; e1 = e; }
            const float w1s = fast_rcp(1.f + __expf(v0 - v1)), w0s = 1.f - w1s;
            if (lane == 0) { const unsigned p0 = atomicAdd((unsigned*)(lcnt + e0), 1u), p1 = atomicAdd((unsigned*)(lcnt + e1), 1u);
                LAS unsigned* r = lrec + (wave * 32 + nrec) * 4; r[0] = (unsigned)m; r[1] = (unsigned)e0 | (p0 << 8); r[2] = (unsigned)e1 | (p1 << 8);
                TOKW[2 * m] = w0s; TOKW[2 * m + 1] = w1s; }
        }
        __syncthreads();
        if (tid < NE) lcnt[8 + tid] = __hip_atomic_fetch_add(ctl + CW_ECNT + 64 * tid, lcnt[tid], RLX_AGENT);
        __syncthreads();
        if (lane == 0) for (int i = 0; i < nrec; ++i) { const LAS unsigned* r = lrec + (wave * 32 + i) * 4; const unsigned m = r[0];
#pragma unroll
            for (int k = 0; k < 2; ++k) { const unsigned e = r[1 + k] & 255u, pos = lcnt[8 + e] + (r[1 + k] >> 8); ROWTOK[e * ECAP + pos] = (int)m; TOKINFO[2 * m + k] = (e << 16) | pos; } }
        for (int e = 0; e < NE; ++e) {
            tr_matrix(args.in[I_MOE_G] + (size_t)e * D * FFE, D, FFE, W_MOEGU + (size_t)e * 2 * FFE * D, D, RmGU{0}, scr, gw, NGW, lane);
            tr_matrix(args.in[I_MOE_U] + (size_t)e * D * FFE, D, FFE, W_MOEGU + (size_t)e * 2 * FFE * D, D, RmGU{128}, scr, gw, NGW, lane);
            tr_matrix(args.in[I_MOE_D] + (size_t)e * FFE * D, FFE, D, W_MOED + (size_t)e * D * FFE, FFE, RmId{0}, scr, gw, NGW, lane);
        }
    }
    SEAM(16);
    if (hi_ph > 17 && lo < 27) {
        MoeInfo mi; int acc_t = 0;
#pragma unroll
        for (int e = 0; e < NE; ++e) { const int c = (int)__builtin_amdgcn_readfirstlane(__hip_atomic_load(ctl + CW_ECNT + 64 * e, RLX_AGENT)); mi.cnt[e] = c; mi.ts[e] = acc_t; acc_t += (c + 255) >> 8; }
        mi.ts[NE] = acc_t;
        for (int c = 0; c < 5; ++c) {
            const int ct0 = 64 * c; int nM = acc_t - ct0; nM = nM < 0 ? 0 : (nM > 64 ? 64 : nM);
            if (IN(17 + 2 * c) && nM > 0) { pg8::Gemm g{X3, W_MOEGU, D, D, D}; SchedMoeGU S; S.so.init(nM, 2 * FFE / 256, G, bx); S.mi = mi; S.ct0 = ct0; S.rowtok = ROWTOK;
                pg8::EpiGateUp<FSwiglu> E{FSwiglu{ACTC, FFE, 0}}; pg8::gemm_phase<pg8::EpiGateUp<FSwiglu>, SchedMoeGU, true, true>(lds, g, S, E); }
            SEAM(17 + 2 * c);
            if (IN(18 + 2 * c) && nM > 0) { pg8::Gemm g{ACTC, W_MOED, FFE, FFE, FFE}; SchedMoeD S; S.so.init(nM, 4, G, bx); S.mi = mi; S.ct0 = ct0;
                pg8::EpiRow8<FBf16> E{FBf16{DOUT, D, ct0 * 256}}; pg8::gemm_phase<pg8::EpiRow8<FBf16>, SchedMoeD, true, false>(lds, g, S, E); }
            SEAM(18 + 2 * c);
        }
    }
    if (IN(27)) {
        PH_LAUNDER();
        int ts[NE]; { int acc_t = 0;
#pragma unroll
            for (int e = 0; e < NE; ++e) { const int c = (int)__builtin_amdgcn_readfirstlane(__hip_atomic_load(ctl + CW_ECNT + 64 * e, RLX_AGENT)); ts[e] = acc_t; acc_t += (c + 255) >> 8; } }
        for (int m = gw; m < T; m += NGW) {
            const unsigned i0 = TOKINFO[2 * m], i1 = TOKINFO[2 * m + 1]; const float w0 = TOKW[2 * m], w1 = TOKW[2 * m + 1];
            int t0 = 0, t1 = 0;
#pragma unroll
            for (int e = 0; e < NE; ++e) { t0 = ((int)(i0 >> 16) == e) ? ts[e] : t0; t1 = ((int)(i1 >> 16) == e) ? ts[e] : t1; }
            const size_t r0 = (size_t)t0 * 256 + (i0 & 0xffffu), r1 = (size_t)t1 * 256 + (i1 & 0xffffu);
            const u32x2* xr = (const u32x2*)(X3 + (size_t)m * D) + lane; const u32x2* d0 = (const u32x2*)(DOUT + r0 * D) + lane; const u32x2* d1 = (const u32x2*)(DOUT + r1 * D) + lane;
            f32x4 v[4];
#pragma unroll
            for (int j = 0; j < 4; ++j) v[j] = bf4_to_f32(xr[64 * j]) * ALPHA + (bf4_to_f32(d0[64 * j]) * w0 + bf4_to_f32(d1[64 * j]) * w1);
            ln_inplace(v, args.in[I_LNF_G] + D, args.in[I_LNF_B] + D, lane);
            f32x4* orow = (f32x4*)(args.out + (size_t)m * D) + lane;
#pragma unroll
            for (int j = 0; j < 4; ++j) orow[64 * j] = v[j];
        }
    }
#undef IN
#undef SEAM
#undef W_MLAIN
#undef W_QUP
#undef W_KVUP
#undef W_MLAOUT
#undef W_FFNGU
#undef W_FFND
#undef W_NSAIN
#undef W_NSAOUT
#undef W_C1K
#undef W_C1V
#undef W_C2K
#undef W_C2V
#undef ROPE_C
#undef CBIAS
#undef RBT
#undef ROWTOK
#undef TOKINFO
#undef TOKW
#undef XB
#undef LAT
#undef QN
#undef KVN
#undef KR
#undef Q
#undef KN
#undef V
#undef O
#undef X1
#undef ACT
#undef X2
#undef NQ
#undef KC
#undef VC
#undef KS
#undef VS
#undef KW
#undef VW
#undef GT
#undef HK
#undef HV
#undef KCMP
#undef VCMP
#undef ONSA
#undef X3
#undef W_MOEGU
#undef W_MOED
#undef DOUT
#undef ROPE_S
#undef P
#undef ACTC
#undef PH_LAUNDER
}

#ifndef MK_PER_PHASE
#define MK_PER_PHASE 0
#endif
extern "C" void kernel_launch(void* const* d_in, const int* in_sizes, int n_in, void* d_out, int out_size, void* d_ws, size_t ws_size, hipStream_t stream) {
    static int grid = 0;
    if (grid == 0) {
        if (n_in != 27 || out_size != T * D || ws_size < WS_END) { fprintf(stderr, "kernel_launch: unexpected shapes (n_in %d out %d ws %zu)\n", n_in, out_size, ws_size); grid = -1; return; }
        int dev = 0, cus = 0, per_cu = 0;
        if (hipGetDevice(&dev) != hipSuccess || hipDeviceGetAttribute(&cus, hipDeviceAttributeMultiprocessorCount, dev) != hipSuccess) { grid = -1; return; }
        if (hipFuncSetAttribute((const void*)fwd, hipFuncAttributeMaxDynamicSharedMemorySize, LDS_BYTES) != hipSuccess) { fprintf(stderr, "kernel_launch: hipFuncSetAttribute failed\n"); grid = -1; return; }
        if (hipOccupancyMaxActiveBlocksPerMultiprocessor(&per_cu, (const void*)fwd, NWAVES * 64, LDS_BYTES) != hipSuccess || per_cu < 1) { fprintf(stderr, "kernel_launch: occupancy query reports %d\n", per_cu); }
        (void)hipGetLastError();
        grid = cus;
    }
    if (grid < 0) return;
    if (hipMemsetAsync((char*)d_ws + WS_CTL, 0, CTL_ZERO_BYTES, stream) != hipSuccess) return;
    Args a{};
    for (int i = 0; i < 27; ++i) a.in[i] = (const float*)d_in[i];
    a.out = (float*)d_out; a.ws = (unsigned char*)d_ws;
#if MK_PER_PHASE
    for (int p = 0; p < N_PHASES; ++p) { a.ph_lo = p; a.ph_hi = p + 1; hipLaunchKernelGGL(fwd, dim3(grid), dim3(NWAVES * 64), LDS_BYTES, stream, a); }
#else
    a.ph_lo = 0; a.ph_hi = N_PHASES;
    hipLaunchKernelGGL(fwd, dim3(grid), dim3(NWAVES * 64), LDS_BYTES, stream, a);
#endif
}
```

```cpp
#include <hip/hip_runtime.h>
#include <cstdio>
#include <cstdint>

#define LAS __attribute__((address_space(3)))
#define GAS __attribute__((address_space(1)))
typedef unsigned short bf16_t;
typedef short bf16x8 __attribute__((ext_vector_type(8)));
typedef short s16x4 __attribute__((ext_vector_type(4)));
typedef float f32x4 __attribute__((ext_vector_type(4)));
typedef float f32x2 __attribute__((ext_vector_type(2)));
typedef float f32x16 __attribute__((ext_vector_type(16)));
typedef unsigned u32x4 __attribute__((ext_vector_type(4)));
typedef unsigned u32x2 __attribute__((ext_vector_type(2)));

constexpr int NB = 4, SEQ = 8192, T = NB * SEQ, D = 1024;
constexpr int MLA_H = 8, MLA_QR = 512, MLA_KVR = 256, MLA_DQK = 192, MLA_DV = 128, MLA_IN = 832;
constexpr int NSA_G = 4, NSA_DK = 96, NSA_DV = 64, NSA_IN = 3504, NSA_INP = 3584;
constexpr int FF = 2816, NE = 8, FFE = 3584, ECAP = 32768;
constexpr float ALPHA = 1.41421356237309515f;
constexpr float LOG2E = 1.4426950408889634f;
constexpr float C2_MLA = 0.07216878364870323f * LOG2E;
constexpr float C2_NSA = 0.10206207261596577f * LOG2E;

__device__ __forceinline__ unsigned cvt_pk_bf16(float lo, float hi) { unsigned r; asm volatile("v_cvt_pk_bf16_f32 %0, %1, %2" : "=v"(r) : "v"(lo), "v"(hi)); return r; }
__device__ __forceinline__ float bf2f(unsigned short h) { return __uint_as_float(((unsigned)h) << 16); }
__device__ __forceinline__ float bflo(unsigned w) { return __uint_as_float(w << 16); }
__device__ __forceinline__ float bfhi(unsigned w) { return __uint_as_float(w & 0xffff0000u); }
__device__ __forceinline__ float fast_exp2(float x) { return __builtin_amdgcn_exp2f(x); }
__device__ __forceinline__ float fast_rcp(float x) { return __builtin_amdgcn_rcpf(x); }
__device__ __forceinline__ float silu_f(float x) { return x * fast_rcp(1.f + fast_exp2(-x * LOG2E)); }
__device__ __forceinline__ float sigmoid_f(float x) { return fast_rcp(1.f + fast_exp2(-x * LOG2E)); }
__device__ __forceinline__ float gelu_tanh_f(float x) {
    const float z = 0.7978845608028654f * (x + 0.044715f * x * x * x);
    return x * fast_rcp(1.f + fast_exp2(-2.f * LOG2E * z));
}

namespace pg8 {
constexpr int BM = 256, BK = 64, HALF = 128, HTB = HALF * BK * 2, STAGE_BYTES = 8 * HTB, NXCD = 8, WGM = 8;
__host__ __device__ __forceinline__ int lds_byte(int r, int c) { const int st = (r >> 4) * 2 + (c >> 5), rr = r & 15, cc = c & 31, ob = rr * 64 + cc * 2; return st * 1024 + (ob ^ (((ob >> 9) & 1) << 5)); }
__host__ __device__ __forceinline__ void stage_rc(int b, int& R, int& C) { const int st = b / 1024, sb = b % 1024, swz = sb ^ (((sb >> 9) & 1) << 5); R = (st >> 1) * 16 + swz / 64; C = (st & 1) * 32 + (swz % 64) / 2; }
__host__ __device__ __forceinline__ int perm32(int rho) { const int n = rho >> 4, i = rho & 15; return 8 * (i >> 2) + 4 * n + (i & 3); }

struct Unit { int pm, pn; };
struct Gemm { const bf16_t* A; const bf16_t* Bt; int lda, ldb, K; };

struct StaticOrder {
    int nM, nN, nwg, G, c;
    __device__ void init(int nM_, int nN_, int G_, int c_) { nM = nM_; nN = nN_; nwg = nM * nN; G = G_; c = c_; }
    __device__ bool next(int i, Unit& u) const {
        const long L = (long)i * G + c; if (L >= nwg) return false;
        int wgid = (int)L; { const int q = nwg / NXCD, r = nwg % NXCD, xcd = wgid % NXCD, off = wgid / NXCD; wgid = (xcd < r ? xcd * (q + 1) : r * (q + 1) + (xcd - r) * q) + off; }
        const int nig = WGM * nN, gid = wgid / nig, fm = gid * WGM, gsz = (nM - fm) < WGM ? (nM - fm) : WGM;
        u.pm = fm + ((wgid % nig) % gsz); u.pn = (wgid % nig) / gsz; return true;
    }
};
struct SchedPlain {
    StaticOrder so;
    __device__ void init(int nM, int nN, int G, int c) { so.init(nM, nN, G, c); }
    __device__ __forceinline__ bool next(int i, Unit& u) const { return so.next(i, u); }
    __device__ __forceinline__ size_t a_off(const Unit& u, const Gemm& g) const { return (size_t)u.pm * 256 * g.lda * 2; }
    __device__ __forceinline__ size_t b_off(const Unit& u, const Gemm& g) const { return (size_t)u.pn * 256 * g.ldb * 2; }
    __device__ __forceinline__ unsigned a_row(const Unit&, int) const { return 0u; }
};

template <class F> struct EpiRow8 {
    static constexpr bool PERM = true;
    F f;
    __device__ __forceinline__ void operator()(const f32x4 (&acc)[2][2][4][2], const Unit& u, int wr, int wc, int fr, int fq) const {
#pragma unroll
        for (int ai = 0; ai < 2; ++ai)
#pragma unroll
            for (int m = 0; m < 4; ++m) { const int row = u.pm * BM + ai * HALF + wr * 64 + m * 16 + fr;
#pragma unroll
                for (int bj = 0; bj < 2; ++bj) f(row, u.pn * BM + bj * HALF + wc * 32 + 8 * fq, acc[ai][bj][m][0], acc[ai][bj][m][1]); }
    }
};
template <class F> struct EpiGateUp {
    static constexpr bool PERM = true;
    F f;
    __device__ __forceinline__ void operator()(const f32x4 (&acc)[2][2][4][2], const Unit& u, int wr, int wc, int fr, int fq) const {
#pragma unroll
        for (int ai = 0; ai < 2; ++ai)
#pragma unroll
            for (int m = 0; m < 4; ++m) { const int row = u.pm * BM + ai * HALF + wr * 64 + m * 16 + fr;
                f(row, u.pn * HALF + wc * 32 + 8 * fq, acc[ai][0][m][0], acc[ai][0][m][1], acc[ai][1][m][0], acc[ai][1][m][1]); }
    }
};

template <class Epi, class Sched, bool ALIGN_EPI, bool GATHER>
__device__ __forceinline__ void gemm_phase(LAS unsigned char* lds, const Gemm g, const Sched& S, const Epi& E) {
    int tid = threadIdx.x; asm volatile("" : "+v"(tid));
    const int wid = __builtin_amdgcn_readfirstlane(tid >> 6), lane = tid & 63, wr = wid >> 2, wc = wid & 3, fr = lane & 15, fq = lane >> 4;
    const int K = g.K, nt = K / BK;
    int sR[2], sC[2]; unsigned voffB[2];
#pragma unroll
    for (int i = 0; i < 2; ++i) { int R, C; stage_rc(tid * 16 + i * 8192, R, C); sR[i] = R; sC[i] = C; const int Rb = Epi::PERM ? ((R & ~31) + perm32(R & 31)) : R; voffB[i] = (unsigned)(Rb * g.ldb + C) * 2u; }
    const int kstep = BK * 2;
    const int hstepB = HALF * g.ldb * 2;
    const auto rsA = __builtin_amdgcn_make_buffer_rsrc((void*)g.A, 0, 0x7fffffff, 0x00020000);
    const auto rsB = __builtin_amdgcn_make_buffer_rsrc((void*)g.Bt, 0, 0x7fffffff, 0x00020000);
    const unsigned ldsw = (unsigned)wid * 1024u;
    const int aoff = lds_byte(wr * 64 + fr, fq * 8), boff = lds_byte(wc * 32 + fr, fq * 8);
#define PG8_SA(b, h) (((b) * 2 + (h)) * HTB)
#define PG8_SB(b, h) ((4 + (b) * 2 + (h)) * HTB)
#define PG8_STAGE2(bufoff, rsrc, soff, o0, o1) do { \
        __builtin_amdgcn_raw_ptr_buffer_load_lds(rsrc, (LAS unsigned*)(lds + (bufoff) + ldsw), 16, (int)(o0), (int)(soff), 0, 0); \
        __builtin_amdgcn_raw_ptr_buffer_load_lds(rsrc, (LAS unsigned*)(lds + (bufoff) + ldsw + 8192), 16, (int)(o1), (int)(soff), 0, 0); } while (0)
#define PG8_STAGEA(bufoff, soff, o0, o1) PG8_STAGE2(bufoff, rsA, soff, o0, o1)
#define PG8_STAGEB(bufoff, soff) PG8_STAGE2(bufoff, rsB, soff, voffB[0], voffB[1])
#define PG8_LDA(dst, b, h) do { _Pragma("unroll") for (int m = 0; m < 4; ++m) _Pragma("unroll") for (int k = 0; k < 2; ++k) dst[m][k] = *(const LAS bf16x8*)(lds + PG8_SA(b, h) + aoff + m * 2048 + k * 1024); } while (0)
#define PG8_LDB(dst, b, h) do { _Pragma("unroll") for (int n = 0; n < 2; ++n) _Pragma("unroll") for (int k = 0; k < 2; ++k) dst[n][k] = *(const LAS bf16x8*)(lds + PG8_SB(b, h) + boff + n * 2048 + k * 1024); } while (0)
#define PG8_MMA(ai, bj, At, Bt) do { __builtin_amdgcn_s_setprio(1); _Pragma("unroll") for (int m = 0; m < 4; ++m) _Pragma("unroll") for (int n = 0; n < 2; ++n) _Pragma("unroll") for (int k = 0; k < 2; ++k) \
        acc[ai][bj][m][n] = __builtin_amdgcn_mfma_f32_16x16x32_bf16(Bt[n][k], At[m][k], acc[ai][bj][m][n], 0, 0, 0); __builtin_amdgcn_s_setprio(0); } while (0)
#define PG8_WAIT_V(n) asm volatile("s_waitcnt vmcnt(" #n ")" ::: "memory")
#define PG8_WAIT_L(n) asm volatile("s_waitcnt lgkmcnt(" #n ")" ::: "memory")
#define PG8_BAR __builtin_amdgcn_s_barrier()
#define PG8_SCHED __builtin_amdgcn_sched_barrier(0)
    Unit cur, nxt; int ui = 0;
    if (!S.next(0, cur)) return;
    f32x4 acc[2][2][4][2];
#pragma unroll
    for (int a = 0; a < 2; ++a)
#pragma unroll
        for (int b = 0; b < 2; ++b)
#pragma unroll
            for (int m = 0; m < 4; ++m)
#pragma unroll
                for (int n = 0; n < 2; ++n) acc[a][b][m][n] = (f32x4){0.f, 0.f, 0.f, 0.f};
    bf16x8 At[4][2], B0[2][2], B1[2][2];
    unsigned vc[2][2], vn[2][2];
#pragma unroll
    for (int h = 0; h < 2; ++h)
#pragma unroll
        for (int i = 0; i < 2; ++i) { vc[h][i] = GATHER ? S.a_row(cur, h * HALF + sR[i]) + (unsigned)sC[i] * 2u : (unsigned)((h * HALF + sR[i]) * g.lda + sC[i]) * 2u; vn[h][i] = vc[h][i]; }
    int cA = (int)S.a_off(cur, g), cB = (int)S.b_off(cur, g);
    PG8_STAGEB(PG8_SB(0, 0), cB); PG8_STAGEB(PG8_SB(0, 1), cB + hstepB); PG8_STAGEA(PG8_SA(0, 0), cA, vc[0][0], vc[0][1]); PG8_STAGEA(PG8_SA(0, 1), cA, vc[1][0], vc[1][1]);
    if (wr == 1) PG8_BAR;
    PG8_WAIT_V(2); PG8_BAR;
    PG8_STAGEB(PG8_SB(1, 0), cB + kstep); PG8_STAGEA(PG8_SA(1, 0), cA + kstep, vc[0][0], vc[0][1]); PG8_STAGEB(PG8_SB(1, 1), cB + hstepB + kstep);
    PG8_WAIT_V(6); PG8_BAR;
    for (;;) {
        const bool has_next = S.next(ui + 1, nxt);
        const int nA = has_next ? (int)S.a_off(nxt, g) : cA, nB = has_next ? (int)S.b_off(nxt, g) : cB;
        if (GATHER) {
#pragma unroll
            for (int h = 0; h < 2; ++h)
#pragma unroll
                for (int i = 0; i < 2; ++i) vn[h][i] = has_next ? S.a_row(nxt, h * HALF + sR[i]) + (unsigned)sC[i] * 2u : vc[h][i];
        }
        for (int t = 0; t < nt; t += 2) {
            const bool last = (t == nt - 2);
            const int a1 = cA + (t + 1) * kstep;
            const int a2 = last ? nA : cA + (t + 2) * kstep, b2 = last ? nB : cB + (t + 2) * kstep;
            const int a3 = a2 + kstep, b3 = b2 + kstep;
            unsigned w00, w01, w10, w11;
            if (GATHER) { w00 = last ? vn[0][0] : vc[0][0]; w01 = last ? vn[0][1] : vc[0][1]; w10 = last ? vn[1][0] : vc[1][0]; w11 = last ? vn[1][1] : vc[1][1]; }
            else { w00 = vc[0][0]; w01 = vc[0][1]; w10 = vc[1][0]; w11 = vc[1][1]; }
            PG8_LDB(B0, 0, 0); PG8_LDB(B1, 0, 1); PG8_SCHED; PG8_LDA(At, 0, 0); PG8_STAGEA(PG8_SA(1, 1), a1, vc[1][0], vc[1][1]);
            PG8_WAIT_V(8); PG8_WAIT_L(0); PG8_BAR; PG8_MMA(0, 0, At, B0); PG8_MMA(0, 1, At, B1); PG8_BAR; PG8_SCHED;
            PG8_LDA(At, 0, 1); PG8_STAGEB(PG8_SB(0, 0), b2); PG8_STAGEB(PG8_SB(0, 1), b2 + hstepB); PG8_STAGEA(PG8_SA(0, 0), a2, w00, w01);
            PG8_WAIT_V(8); PG8_WAIT_L(0); PG8_BAR; PG8_MMA(1, 0, At, B0); PG8_MMA(1, 1, At, B1); PG8_BAR; PG8_SCHED;
            PG8_LDB(B0, 1, 0); PG8_LDB(B1, 1, 1); PG8_SCHED; PG8_LDA(At, 1, 0); PG8_STAGEA(PG8_SA(0, 1), a2, w10, w11);
            PG8_WAIT_V(8); PG8_WAIT_L(0); PG8_BAR; PG8_MMA(0, 0, At, B0); PG8_MMA(0, 1, At, B1); PG8_BAR; PG8_SCHED;
            PG8_LDA(At, 1, 1); PG8_STAGEB(PG8_SB(1, 0), b3); PG8_STAGEB(PG8_SB(1, 1), b3 + hstepB); PG8_STAGEA(PG8_SA(1, 0), a3, w00, w01);
            PG8_WAIT_V(8); PG8_WAIT_L(0); PG8_BAR; PG8_MMA(1, 0, At, B0); PG8_MMA(1, 1, At, B1); PG8_BAR; PG8_SCHED;
        }
        if constexpr (ALIGN_EPI) { if (wr == 0) PG8_BAR; }
        E(acc, cur, wr, wc, fr, fq);
        if (!has_next) break;
#pragma unroll
        for (int a = 0; a < 2; ++a)
#pragma unroll
            for (int b = 0; b < 2; ++b)
#pragma unroll
                for (int m = 0; m < 4; ++m)
#pragma unroll
                    for (int n = 0; n < 2; ++n) acc[a][b][m][n] = (f32x4){0.f, 0.f, 0.f, 0.f};
        cur = nxt; cA = nA; cB = nB; ++ui;
        if (GATHER) {
#pragma unroll
            for (int h = 0; h < 2; ++h)
#pragma unroll
                for (int i = 0; i < 2; ++i) vc[h][i] = vn[h][i];
        }
        if constexpr (ALIGN_EPI) { if (wr == 1) PG8_BAR; }
    }
    PG8_WAIT_V(0);
    if constexpr (!ALIGN_EPI) { if (wr == 0) PG8_BAR; }
    PG8_BAR;
#undef PG8_SA
#undef PG8_SB
#undef PG8_STAGE2
#undef PG8_STAGEA
#undef PG8_STAGEB
#undef PG8_LDA
#undef PG8_LDB
#undef PG8_MMA
#undef PG8_WAIT_V
#undef PG8_WAIT_L
#undef PG8_BAR
#undef PG8_SCHED
}
}
namespace att {
__device__ __forceinline__ int crow(int r, int hi) { return (r & 3) + 8 * (r >> 2) + 4 * hi; }
constexpr float THR = 6.f;
template <int DQK, int DV> struct Geo {
    static constexpr int KROW = DQK * 2 + 16, VROW = DV * 2 + 64, KT = 64 * KROW, VT = 64 * VROW;
    static constexpr int KCH = DQK / 8, VCH = DV / 8;
    static constexpr int KN = (64 * KCH + 511) / 512, VN = (64 * VCH + 511) / 512;
    static constexpr int LDS_K = 0, LDS_V = 2 * KT, LDS_END = 2 * KT + 2 * VT;
};
template <int DQK, int DV, class Src> struct Stg {
    using G = Geo<DQK, DV>;
    bf16x8 k[G::KN], v[G::VN];
    __device__ __forceinline__ void load(const Src& s, int t, int tid) {
#pragma unroll
        for (int i = 0; i < G::KN; ++i) { const int c = tid + 512 * i; if ((64 * G::KCH) % 512 == 0 || c < 64 * G::KCH) { const int row = c / G::KCH, cc = c % G::KCH; k[i] = *(const bf16x8*)s.kptr(t, row, cc); } }
#pragma unroll
        for (int i = 0; i < G::VN; ++i) { const int c = tid + 512 * i; if ((64 * G::VCH) % 512 == 0 || c < 64 * G::VCH) { const int row = c / G::VCH, cc = c % G::VCH; v[i] = *(const bf16x8*)s.vptr(t, row, cc); } }
    }
    __device__ __forceinline__ void store(LAS char* lds, int buf, int tid) const {
#pragma unroll
        for (int i = 0; i < G::KN; ++i) { const int c = tid + 512 * i; if ((64 * G::KCH) % 512 == 0 || c < 64 * G::KCH) { const int row = c / G::KCH, cc = c % G::KCH; *(LAS bf16x8*)(lds + G::LDS_K + buf * G::KT + row * G::KROW + cc * 16) = k[i]; } }
#pragma unroll
        for (int i = 0; i < G::VN; ++i) { const int c = tid + 512 * i; if ((64 * G::VCH) % 512 == 0 || c < 64 * G::VCH) { const int row = c / G::VCH, cc = c % G::VCH; *(LAS bf16x8*)(lds + G::LDS_V + buf * G::VT + row * G::VROW + cc * 16) = v[i]; } }
    }
};
template <int DQK> __device__ __forceinline__ void qk_tile(f32x16& p0, f32x16& p1, LAS const char* Kb, int r32, int hi, const bf16x8* qr) {
    constexpr int KROW = DQK * 2 + 16;
    p0 = f32x16{}; p1 = f32x16{};
    LAS const char* a = Kb + r32 * KROW + hi * 16;
#pragma unroll
    for (int d0 = 0; d0 < DQK / 16; ++d0) {
        const bf16x8 k0 = *(LAS const bf16x8*)(a + d0 * 32);
        const bf16x8 k1 = *(LAS const bf16x8*)(a + 32 * KROW + d0 * 32);
        p0 = __builtin_amdgcn_mfma_f32_32x32x16_bf16(k0, qr[d0], p0, 0, 0, 0);
        p1 = __builtin_amdgcn_mfma_f32_32x32x16_bf16(k1, qr[d0], p1, 0, 0, 0);
    }
}
template <int DV> __device__ __forceinline__ void pv_tile(f32x16* o, unsigned vaddr, bf16x8 pa0, bf16x8 pa1, bf16x8 pa2, bf16x8 pa3) {
    constexpr int VROW = DV * 2 + 64;
#define ATT_TRRD(dst, off) asm volatile("ds_read_b64_tr_b16 %0, %1 offset:%2" : "=&v"(dst) : "v"(vaddr), "i"(off) : "memory")
#pragma unroll
    for (int d0 = 0; d0 < DV / 32; ++d0) {
        s16x4 l0, l1, h0, h1;
        ATT_TRRD(l0, (0 * 16 + 0) * VROW + d0 * 64); ATT_TRRD(h0, (0 * 16 + 4) * VROW + d0 * 64);
        ATT_TRRD(l1, (1 * 16 + 0) * VROW + d0 * 64); ATT_TRRD(h1, (1 * 16 + 4) * VROW + d0 * 64);
        asm volatile("s_waitcnt lgkmcnt(0)" ::: "memory"); __builtin_amdgcn_sched_barrier(0);
        o[d0] = __builtin_amdgcn_mfma_f32_32x32x16_bf16(pa0, (bf16x8){l0[0], l0[1], l0[2], l0[3], h0[0], h0[1], h0[2], h0[3]}, o[d0], 0, 0, 0);
        o[d0] = __builtin_amdgcn_mfma_f32_32x32x16_bf16(pa1, (bf16x8){l1[0], l1[1], l1[2], l1[3], h1[0], h1[1], h1[2], h1[3]}, o[d0], 0, 0, 0);
        s16x4 l2, l3, h2, h3;
        ATT_TRRD(l2, (2 * 16 + 0) * VROW + d0 * 64); ATT_TRRD(h2, (2 * 16 + 4) * VROW + d0 * 64);
        ATT_TRRD(l3, (3 * 16 + 0) * VROW + d0 * 64); ATT_TRRD(h3, (3 * 16 + 4) * VROW + d0 * 64);
        asm volatile("s_waitcnt lgkmcnt(0)" ::: "memory"); __builtin_amdgcn_sched_barrier(0);
        o[d0] = __builtin_amdgcn_mfma_f32_32x32x16_bf16(pa2, (bf16x8){l2[0], l2[1], l2[2], l2[3], h2[0], h2[1], h2[2], h2[3]}, o[d0], 0, 0, 0);
        o[d0] = __builtin_amdgcn_mfma_f32_32x32x16_bf16(pa3, (bf16x8){l3[0], l3[1], l3[2], l3[3], h3[0], h3[1], h3[2], h3[3]}, o[d0], 0, 0, 0);
    }
#undef ATT_TRRD
}
__device__ __forceinline__ float lane_pair_max(float v) { auto rr = __builtin_amdgcn_permlane32_swap(__float_as_uint(v), __float_as_uint(v), false, false); return fmaxf(__uint_as_float(rr[0]), __uint_as_float(rr[1])); }
__device__ __forceinline__ float lane_pair_sum(float v) { auto rr = __builtin_amdgcn_permlane32_swap(__float_as_uint(v), __float_as_uint(v), false, false); return __uint_as_float(rr[0]) + __uint_as_float(rr[1]); }
__device__ __forceinline__ void pack_p(const f32x16& p0, const f32x16& p1, bf16x8& pa0, bf16x8& pa1, bf16x8& pa2, bf16x8& pa3) {
#define ATT_PK4(P, B_, OUT) do { unsigned a0 = cvt_pk_bf16(P[B_ + 0], P[B_ + 1]), a1 = cvt_pk_bf16(P[B_ + 2], P[B_ + 3]); \
        unsigned b0 = cvt_pk_bf16(P[B_ + 4], P[B_ + 5]), b1 = cvt_pk_bf16(P[B_ + 6], P[B_ + 7]); \
        auto r0 = __builtin_amdgcn_permlane32_swap(a0, b0, false, false); auto r1 = __builtin_amdgcn_permlane32_swap(a1, b1, false, false); \
        u32x4 w = {r0[0], r1[0], r0[1], r1[1]}; OUT = __builtin_bit_cast(bf16x8, w); } while (0)
    ATT_PK4(p0, 0, pa0); ATT_PK4(p0, 8, pa1); ATT_PK4(p1, 0, pa2); ATT_PK4(p1, 8, pa3);
#undef ATT_PK4
}
template <int DQK, int DV, bool DO_PV, class Src, class Msk>
__device__ __forceinline__ void run_online(LAS char* lds, LAS float* wsc, int nt, const Src& src, const Msk& msk, const bf16x8* qr, float& m_reg, float& l_reg, f32x16* o, int tid, int lane) {
    using G = Geo<DQK, DV>;
    const int r32 = lane & 31, hi = lane >> 5;
    if (nt <= 0) return;
    Stg<DQK, DV, Src> st;
    st.load(src, 0, tid); st.store(lds, 0, tid); __syncthreads();
    const unsigned vlane = (unsigned)((8 * hi + ((lane & 15) >> 2)) * G::VROW + (16 * ((lane >> 4) & 1) + 4 * (lane & 3)) * 2);
    for (int t = 0; t < nt; ++t) {
        const int buf = t & 1;
        if (t + 1 < nt) st.load(src, t + 1, tid);
        const int kind = msk.kind(t);
        if (kind) {
            f32x16 p0, p1;
            qk_tile<DQK>(p0, p1, lds + G::LDS_K + buf * G::KT, r32, hi, qr);
            if (kind >= 2) msk.apply(p0, p1, t, kind);
            float pmax = p0[0];
#pragma unroll
            for (int r = 1; r < 16; ++r) pmax = fmaxf(pmax, p0[r]);
#pragma unroll
            for (int r = 0; r < 16; ++r) pmax = fmaxf(pmax, p1[r]);
            pmax = lane_pair_max(pmax);
            float mn, alpha;
            if (__all(pmax <= m_reg + THR)) { mn = m_reg; alpha = 1.f; }
            else { mn = fmaxf(m_reg, pmax); alpha = fast_exp2(m_reg - mn); m_reg = mn; }
#pragma unroll
            for (int r = 0; r < 16; ++r) { p0[r] = fast_exp2(p0[r] - mn); p1[r] = fast_exp2(p1[r] - mn); }
            float ps = 0.f;
#pragma unroll
            for (int r = 0; r < 16; ++r) ps += p0[r] + p1[r];
            ps = lane_pair_sum(ps);
            l_reg = l_reg * alpha + ps;
            if (DO_PV) {
                if (__any(alpha < 1.f)) {
                    if (hi == 0) wsc[32 + r32] = alpha;
                    asm volatile("s_waitcnt lgkmcnt(0)" ::: "memory");
#pragma unroll
                    for (int r = 0; r < 16; ++r) { const float a = wsc[32 + crow(r, hi)];
#pragma unroll
                        for (int d = 0; d < DV / 32; ++d) o[d][r] *= a; }
                }
                bf16x8 pa0, pa1, pa2, pa3; pack_p(p0, p1, pa0, pa1, pa2, pa3);
                pv_tile<DV>(o, (unsigned)(uintptr_t)(lds + G::LDS_V + buf * G::VT) + vlane, pa0, pa1, pa2, pa3);
            }
        }
        if (t + 1 < nt) st.store(lds, buf ^ 1, tid);
        __syncthreads();
    }
}
}
namespace mla {
constexpr int DQK = 192, DV = 128;
using G = att::Geo<DQK, DV>;
struct Src {
    const bf16_t* kn; const bf16_t* kr; const bf16_t* v;
    __device__ __forceinline__ const bf16_t* kptr(int t, int row, int cc) const { const int key = 64 * t + row; return cc < 16 ? kn + (size_t)key * 128 + cc * 8 : kr + (size_t)key * 64 + (cc - 16) * 8; }
    __device__ __forceinline__ const bf16_t* vptr(int t, int row, int cc) const { return v + (size_t)(64 * t + row) * 128 + cc * 8; }
};
struct Msk {
    int qlo, qpos;
    int hi;
    __device__ __forceinline__ int kind(int t) const { const int kb = 64 * t; return kb > qlo + 31 ? 0 : (kb + 63 <= qlo ? 1 : 2); }
    __device__ __forceinline__ void apply(f32x16& p0, f32x16& p1, int t, int) const {
        const float NEG = -__builtin_inff(); const int d = qpos - 64 * t - 4 * hi;
#pragma unroll
        for (int r = 0; r < 16; ++r) { const int c = (r & 3) + 8 * (r >> 2); if (c > d) p0[r] = NEG; if (c + 32 > d) p1[r] = NEG; }
    }
};
__device__ __forceinline__ void unit(LAS char* lds, int b, int h, int qb, const bf16_t* Q, const bf16_t* KN, const bf16_t* KR, const bf16_t* V, bf16_t* O, int tid, int lane_, int wid) {
    asm volatile("" : "+v"(tid)); const int lane = tid & 63;
    const int r32 = lane & 31, hi = lane >> 5;
    LAS float* wsc = (LAS float*)(lds + G::LDS_END) + wid * 64;
    const int q0 = qb * 256 + wid * 32;
    const size_t trow = (size_t)b * SEQ + q0 + r32;
    bf16x8 qr[DQK / 16];
#pragma unroll
    for (int d0 = 0; d0 < DQK / 16; ++d0) qr[d0] = *(const bf16x8*)(Q + trow * 1536 + h * 192 + d0 * 16 + hi * 8);
    Src src{KN + (size_t)(b * MLA_H + h) * SEQ * 128, KR + (size_t)b * SEQ * 64, V + (size_t)(b * MLA_H + h) * SEQ * 128};
    Msk msk{q0, q0 + r32, hi};
    float m_reg = -1e30f, l_reg = 0.f; f32x16 o[DV / 32] = {};
    att::run_online<DQK, DV, true>(lds, wsc, 4 * (qb + 1), src, msk, qr, m_reg, l_reg, o, tid, lane);
    if (hi == 0) wsc[r32] = l_reg;
    asm volatile("s_waitcnt lgkmcnt(0)" ::: "memory");
    bf16_t* Ow = O + ((size_t)b * SEQ + q0) * 1024 + h * 128;
#pragma unroll
    for (int r = 0; r < 16; ++r) { const int orow = att::crow(r, hi); const float l = wsc[orow]; const float rl = l > 0.f ? fast_rcp(l) : 0.f;
#pragma unroll
        for (int d0 = 0; d0 < DV / 32; ++d0) { const float v = o[d0][r] * rl; const float vn = __shfl_xor(v, 1);
            if ((r32 & 1) == 0) *(unsigned*)(Ow + (size_t)orow * 1024 + d0 * 32 + r32) = cvt_pk_bf16(v, vn); } }
    asm volatile("s_waitcnt lgkmcnt(0)" ::: "memory");
}
}

namespace nsa {
constexpr int DQK = 96, DV = 64;
using G = att::Geo<DQK, DV>;
constexpr int L_WSC = G::LDS_END;
constexpr int L_TAB = L_WSC + 8 * 256;
constexpr int TABW = 132;
constexpr int L_PSUM = L_TAB + 4 * TABW * 4;
constexpr int PSW = 68;
constexpr int L_IMP = L_PSUM + 8 * 8 * PSW * 4;
constexpr int L_SELW = L_IMP + 8 * 8 * 128 * 4;
constexpr int L_END = L_SELW + 8 * 8 * 4 * 4;
struct Src {
    const bf16_t* k; const bf16_t* v; int j0;
    __device__ __forceinline__ const bf16_t* kptr(int t, int row, int cc) const { return k + (size_t)(64 * (j0 + t) + row) * 96 + cc * 8; }
    __device__ __forceinline__ const bf16_t* vptr(int t, int row, int cc) const { return v + (size_t)(64 * (j0 + t) + row) * 64 + cc * 8; }
};
struct MskCmp {
    int qlo, qpos, hi; const LAS float* tab;
    __device__ __forceinline__ int kind(int t) const {
        const int n0 = 64 * t;
        if (qlo + 7 - (16 * n0 + 31) < 0) return 0;
        return (qlo - (16 * (n0 + 63) + 31) >= 128) ? 1 : 2;
    }
    __device__ __forceinline__ void apply(f32x16& p0, f32x16& p1, int t, int) const {
        const float NEG = -__builtin_inff(); const int dq = qpos - 31 - 16 * (64 * t + 4 * hi);
#pragma unroll
        for (int r = 0; r < 16; ++r) { const int c = 16 * ((r & 3) + 8 * (r >> 2));
            { const int d = dq - c; const float bv = ((const volatile LAS float*)tab)[(unsigned)d < 128u ? d : 128]; p0[r] = d >= 0 ? p0[r] + bv : NEG; }
            { const int d = dq - c - 512; const float bv = ((const volatile LAS float*)tab)[(unsigned)d < 128u ? d : 128]; p1[r] = d >= 0 ? p1[r] + bv : NEG; } }
    }
};
struct MskSel {
    int qpos, hi, cur; const LAS float* tab; const LAS unsigned* selw;
    __device__ __forceinline__ bool mine(int j) const { return (selw[j >> 5] >> (j & 31)) & 1u; }
    __device__ __forceinline__ int kind(int j) const {
        const bool s = mine(j);
        if (!__any(s)) return 0;
        if (j >= cur - 2) return 2;
        return __all(s) ? 1 : 3;
    }
    __device__ __forceinline__ void apply(f32x16& p0, f32x16& p1, int j, int kind) const {
        const float NEG = -__builtin_inff(); const bool s = mine(j);
        if (kind == 3) {
#pragma unroll
            for (int r = 0; r < 16; ++r) { p0[r] = s ? p0[r] : NEG; p1[r] = s ? p1[r] : NEG; }
        } else { const int dq = qpos - 64 * j - 4 * hi;
#pragma unroll
            for (int r = 0; r < 16; ++r) { const int c = (r & 3) + 8 * (r >> 2);
                { const int d = dq - c; const float bv = ((const volatile LAS float*)tab)[(unsigned)d < 128u ? d : 128]; p0[r] = (s && d >= 0) ? p0[r] + bv : NEG; }
                { const int d = dq - c - 32; const float bv = ((const volatile LAS float*)tab)[(unsigned)d < 128u ? d : 128]; p1[r] = (s && d >= 0) ? p1[r] + bv : NEG; } }
        }
    }
};
struct MskWin {
    int qpos, hi, cur, j0; const LAS float* tab;
    __device__ __forceinline__ int kind(int t) const { const int j = j0 + t; return (j >= cur - 2 || j <= cur - 8) ? 2 : 1; }
    __device__ __forceinline__ void apply(f32x16& p0, f32x16& p1, int t, int) const {
        const float NEG = -__builtin_inff(); const int dq = qpos - 64 * (j0 + t) - 4 * hi;
#pragma unroll
        for (int r = 0; r < 16; ++r) { const int c = (r & 3) + 8 * (r >> 2);
            { const int d = dq - c; const float bv = ((const volatile LAS float*)tab)[(unsigned)d < 128u ? d : 128]; p0[r] = (unsigned)d < 512u ? p0[r] + bv : NEG; }
            { const int d = dq - c - 32; const float bv = ((const volatile LAS float*)tab)[(unsigned)d < 128u ? d : 128]; p1[r] = (unsigned)d < 512u ? p1[r] + bv : NEG; } }
    }
};
__device__ __forceinline__ void fold(f32x16* ofin, const f32x16* o, float f, LAS float* wsc, int r32, int hi) {
    if (hi == 0) wsc[r32] = f;
    asm volatile("s_waitcnt lgkmcnt(0)" ::: "memory");
#pragma unroll
    for (int r = 0; r < 16; ++r) { const float a = wsc[att::crow(r, hi)];
#pragma unroll
        for (int d = 0; d < DV / 32; ++d) ofin[d][r] += o[d][r] * a; }
    asm volatile("s_waitcnt lgkmcnt(0)" : "+v"(ofin[0]), "+v"(ofin[1]) :: "memory");
}
struct Tensors { const bf16_t *NQ, *KCMP, *VCMP, *KS, *VS, *KW, *VW; const float *GT, *RBT; bf16_t* O; };
#define NSA_LAUNDER() int tid = tid0; asm volatile("" : "+v"(tid)); const int lane = tid & 63, r32 = lane & 31, hi = lane >> 5, qi = r32 >> 2, hg = r32 & 3; \
    LAS float* wsc = (LAS float*)(lds + L_WSC) + wid * 64; const LAS float* tab = (LAS float*)(lds + L_TAB) + hg * TABW; const int qpos = qlo + qi;
__device__ __forceinline__ void unit(LAS char* lds, const Tensors& X, int b, int g, int qblk, int tid0, int lane0, int wid) {
    const int s0 = qblk * 64, cur = qblk, qlo = s0 + 8 * wid;
    const int bg = b * NSA_G + g;
    bf16x8 qr[DQK / 16]; float gc, gs, gw;
    f32x16 ofin[DV / 32] = {};
    LAS float* imp = (LAS float*)(lds + L_IMP) + wid * 8 * 128;
    LAS unsigned* selw = (LAS unsigned*)(lds + L_SELW) + wid * 32;
    {
    NSA_LAUNDER();
    LAS float* tabs = (LAS float*)(lds + L_TAB);
    LAS float* psum = (LAS float*)(lds + L_PSUM) + wid * 8 * PSW;
    for (int i = tid; i < 4 * TABW; i += 512) tabs[i] = X.RBT[(g * 4 + i / TABW) * TABW + i % TABW];
    for (int i = lane; i < 8 * 128; i += 64) imp[i] = 0.f;
    if (lane < 8) psum[lane * PSW] = 0.f;
    if (lane < 32) selw[lane] = 0u;
    const size_t trow = (size_t)b * SEQ + qpos;
#pragma unroll
    for (int d0 = 0; d0 < DQK / 16; ++d0) qr[d0] = *(const bf16x8*)(X.NQ + trow * 1536 + (g * 4 + hg) * 96 + d0 * 16 + hi * 8);
    gc = X.GT[trow * 48 + (g * 4 + hg) * 3 + 0]; gs = X.GT[trow * 48 + (g * 4 + hg) * 3 + 1]; gw = X.GT[trow * 48 + (g * 4 + hg) * 3 + 2];
    __syncthreads();
    }
    const int ncv = (s0 + 63 >= 31) ? ((s0 + 63 - 31) >> 4) + 1 : 0;
    const int ntc = (ncv + 63) >> 6;
#ifndef NSA_NO_CMP
    {
        NSA_LAUNDER();
        Src srcC{X.KCMP + (size_t)bg * 512 * 96, X.VCMP + (size_t)bg * 512 * 64, 0};
        MskCmp mc{qlo, qpos, hi, tab};
        LAS float* psum = (LAS float*)(lds + L_PSUM) + wid * 8 * PSW;
        float m_reg = -1e30f, l_reg = 0.f; f32x16 od[DV / 32];
        att::run_online<DQK, DV, false>(lds, wsc, ntc, srcC, mc, qr, m_reg, l_reg, od, tid, lane);
        const float inv_l = l_reg > 0.f ? fast_rcp(l_reg) : 0.f;
        f32x16 o[DV / 32] = {};
        if (ntc > 0) {
            att::Stg<DQK, DV, Src> st;
            st.load(srcC, 0, tid); st.store(lds, 0, tid); __syncthreads();
            const unsigned vlane = (unsigned)((8 * hi + ((lane & 15) >> 2)) * G::VROW + (16 * ((lane >> 4) & 1) + 4 * (lane & 3)) * 2);
            for (int t = 0; t < ntc; ++t) {
                const int buf = t & 1;
                if (t + 1 < ntc) st.load(srcC, t + 1, tid);
                const int kind = mc.kind(t);
                if (kind) {
                    f32x16 p0, p1;
                    att::qk_tile<DQK>(p0, p1, lds + G::LDS_K + buf * G::KT, r32, hi, qr);
                    if (kind >= 2) mc.apply(p0, p1, t, kind);
#pragma unroll
                    for (int r = 0; r < 16; ++r) { p0[r] = fast_exp2(p0[r] - m_reg) * inv_l; p1[r] = fast_exp2(p1[r] - m_reg) * inv_l; }
#pragma unroll
                    for (int r = 0; r < 16; ++r) {
                        float a = p0[r]; a += __shfl_xor(a, 1); a += __shfl_xor(a, 2);
                        float c = p1[r]; c += __shfl_xor(c, 1); c += __shfl_xor(c, 2);
                        if (hg == 0) { psum[qi * PSW + 1 + att::crow(r, hi)] = a; psum[qi * PSW + 33 + att::crow(r, hi)] = c; }
                    }
                    asm volatile("s_waitcnt lgkmcnt(0)" ::: "memory");
                    {
                        const int q = lane >> 3;
#pragma unroll
                        for (int e = 0; e < 2; ++e) { const int jl = (lane & 7) * 2 + e; const LAS float* ps = psum + q * PSW + 4 * jl;
                            imp[q * 128 + 16 * t + jl] = (ps[0] + ps[1]) + (ps[2] + ps[3]) + ps[4]; }
                    }
                    asm volatile("s_waitcnt lgkmcnt(0)" ::: "memory");
                    if (lane < 8) psum[lane * PSW] = psum[lane * PSW + 64];
                    asm volatile("s_waitcnt lgkmcnt(0)" ::: "memory");
                    bf16x8 pa0, pa1, pa2, pa3; att::pack_p(p0, p1, pa0, pa1, pa2, pa3);
                    att::pv_tile<DV>(o, (unsigned)(uintptr_t)(lds + G::LDS_V + buf * G::VT) + vlane, pa0, pa1, pa2, pa3);
                }
                if (t + 1 < ntc) st.store(lds, buf ^ 1, tid);
                __syncthreads();
            }
        }
        fold(ofin, o, gc, wsc, r32, hi);
    }
#endif
#ifndef NSA_NO_TOPK
    {
        NSA_LAUNDER();
        const int q = lane >> 3, jl = lane & 7;
        float v[16]; int rk[16];
#pragma unroll
        for (int i = 0; i < 16; ++i) { const int j = jl + 8 * i; const float x = imp[q * 128 + j];
            v[i] = (j == 0 || j == cur || j == cur - 1) ? 1e6f : (j > cur ? -1e6f : x); rk[i] = 0; }
        for (int jp = 0; jp <= cur; ++jp) {
            const float x = imp[q * 128 + jp]; const float w = (jp == 0 || jp == cur || jp == cur - 1) ? 1e6f : x;
#pragma unroll
            for (int i = 0; i < 16; ++i) { const int j = jl + 8 * i; rk[i] += (w > v[i] || (w == v[i] && jp < j)) ? 1 : 0; }
        }
        unsigned wd[4] = {0u, 0u, 0u, 0u};
#pragma unroll
        for (int i = 0; i < 16; ++i) { const int j = jl + 8 * i; if (j <= cur && rk[i] < 16) wd[i >> 2] |= 1u << (jl + 8 * (i & 3)); }
#pragma unroll
        for (int w = 0; w < 4; ++w) if (wd[w]) atomicOr((unsigned*)(selw + q * 4 + w), wd[w]);
        asm volatile("s_waitcnt lgkmcnt(0)" ::: "memory");
    }
#endif
#ifndef NSA_NO_SEL
    {
        NSA_LAUNDER();
        Src srcS{X.KS + (size_t)bg * SEQ * 96, X.VS + (size_t)bg * SEQ * 64, 0};
        MskSel ms{qpos, hi, cur, tab, selw + qi * 4};
        float m_reg = -1e30f, l_reg = 0.f; f32x16 o[DV / 32] = {};
        att::run_online<DQK, DV, true>(lds, wsc, cur + 1, srcS, ms, qr, m_reg, l_reg, o, tid, lane);
        fold(ofin, o, l_reg > 0.f ? gs * fast_rcp(l_reg) : 0.f, wsc, r32, hi);
    }
#endif
#ifndef NSA_NO_WIN
    {
        NSA_LAUNDER();
        const int j0 = cur >= 8 ? cur - 8 : 0;
        Src srcW{X.KW + (size_t)bg * SEQ * 96, X.VW + (size_t)bg * SEQ * 64, j0};
        MskWin mw{qpos, hi, cur, j0, tab};
        float m_reg = -1e30f, l_reg = 0.f; f32x16 o[DV / 32] = {};
        att::run_online<DQK, DV, true>(lds, wsc, cur - j0 + 1, srcW, mw, qr, m_reg, l_reg, o, tid, lane);
        fold(ofin, o, l_reg > 0.f ? gw * fast_rcp(l_reg) : 0.f, wsc, r32, hi);
    }
#endif
    NSA_LAUNDER();
    bf16_t* Ow = X.O + ((size_t)b * SEQ + qlo) * 1024 + g * 256;
#pragma unroll
    for (int r = 0; r < 16; ++r) { const int orow = att::crow(r, hi);
#pragma unroll
        for (int d0 = 0; d0 < DV / 32; ++d0) { const float v = ofin[d0][r]; const float vn = __shfl_xor(v, 1);
            if ((r32 & 1) == 0) *(unsigned*)(Ow + (size_t)(orow >> 2) * 1024 + (orow & 3) * 64 + d0 * 32 + r32) = cvt_pk_bf16(v, vn); } }
    __syncthreads();
}
}
constexpr size_t MiB = 1u << 20;
constexpr size_t WS_CTL = 0, CTL_ZERO_BYTES = 1 * MiB;
constexpr size_t WS_W_MLAIN = 1 * MiB;
constexpr size_t WS_W_QUP   = 3 * MiB;
constexpr size_t WS_W_KVUP  = WS_W_QUP + 1536 * 1024;
constexpr size_t WS_W_MLAOUT = WS_W_KVUP + 1 * MiB;
constexpr size_t WS_W_FFNGU = WS_W_MLAOUT + 2 * MiB;
constexpr size_t WS_W_FFND  = WS_W_FFNGU + 11 * MiB;
constexpr size_t WS_W_NSAIN = WS_W_FFND + 5632 * 1024;
constexpr size_t WS_W_NSAOUT = WS_W_NSAIN + 7 * MiB;
constexpr size_t WS_W_C1K = WS_W_NSAOUT + 2 * MiB;
constexpr size_t WS_W_C1V = WS_W_C1K + 256 * 3072 * 2;
constexpr size_t WS_W_C2K = WS_W_C1V + 256 * 2048 * 2;
constexpr size_t WS_W_C2V = WS_W_C2K + 256 * 128 * 2;
constexpr size_t WS_ROPE  = WS_W_C2V + 256 * 128 * 2;
constexpr size_t WS_CBIAS = WS_ROPE + 2 * MiB;
constexpr size_t WS_RBT   = WS_CBIAS + 1024;
constexpr size_t WS_ROWTOK = 38 * MiB;
constexpr size_t WS_TOKINFO = 39 * MiB;
constexpr size_t WS_TOKW = WS_TOKINFO + 256 * 1024;
static_assert(WS_RBT + 16 * 132 * 4 <= WS_ROWTOK && WS_TOKW + 256 * 1024 <= 40 * MiB, "small region");
constexpr size_t WS_XB = 40 * MiB, WS_LAT = 104 * MiB, WS_QN = 168 * MiB, WS_KVN = 200 * MiB, WS_KR = 216 * MiB, WS_Q = 220 * MiB, WS_KN = 316 * MiB, WS_V = 380 * MiB;
constexpr size_t WS_O = 40 * MiB, WS_X1 = 104 * MiB, WS_ACT = 168 * MiB, WS_X2 = 40 * MiB;
constexpr size_t WS_NQ = 104 * MiB, WS_KC = 200 * MiB, WS_VC = 224 * MiB, WS_KS = 240 * MiB, WS_VS = 264 * MiB, WS_KW = 280 * MiB, WS_VW = 304 * MiB, WS_GT = 320 * MiB;
static_assert(WS_KS - WS_KC == 40 * MiB && WS_KW - WS_KS == 40 * MiB && WS_VS - WS_VC == 40 * MiB && WS_VW - WS_VS == 40 * MiB, "FNsaIn segment stride");
constexpr size_t WS_HK = 328 * MiB, WS_HV = 330 * MiB, WS_KCMP = 332 * MiB, WS_VCMP = 334 * MiB;
constexpr size_t WS_ONSA = 348 * MiB, WS_X3 = 412 * MiB;
constexpr size_t WS_MOE_GU = 40 * MiB, WS_MOE_D = 152 * MiB, WS_DOUT = 208 * MiB;
constexpr size_t WS_END = 476 * MiB;
constexpr int CW_BAR = 4096;
constexpr int CW_ECNT = 16384;
constexpr int RING_BYTES = 131072;
constexpr int MISC_OFF = RING_BYTES + 320;
constexpr int LDS_BYTES = 147456;
constexpr int NWAVES = 8;
static_assert(nsa::L_END <= RING_BYTES && mla::G::LDS_END + 2048 <= RING_BYTES, "attention LDS");

#define RLX_AGENT __ATOMIC_RELAXED, __HIP_MEMORY_SCOPE_AGENT
#define LDS_WAIT() asm volatile("s_waitcnt lgkmcnt(0)" ::: "memory")
#define VM_WAIT() asm volatile("s_waitcnt vmcnt(0)" ::: "memory")
__device__ __forceinline__ unsigned f2bf(float f) { unsigned u = __builtin_bit_cast(unsigned, f); return (u + 0x7fffu + ((u >> 16) & 1u)) >> 16; }
__device__ __forceinline__ unsigned pk2(float lo, float hi) { return f2bf(lo) | (f2bf(hi) << 16); }

#define XB_TMO      128
#define XB_XCNT(j)  (256  + 64 * (j))
#define XB_XSUB(j)  (1280 + 64 * (j))
#define XB_XGEN(j)  (2304 + 64 * (j))
#define XB_TOP      3328
#define XB_TOPGEN   3392
#define XCD_BAR_WORDS 3456
#define XB_SPIN_CAP (1u << 20)
__device__ __forceinline__ unsigned xb_ld(unsigned* p)              { return __hip_atomic_load(p, __ATOMIC_RELAXED, __HIP_MEMORY_SCOPE_AGENT); }
__device__ __forceinline__ unsigned xb_add(unsigned* p, unsigned v) { return __hip_atomic_fetch_add(p, v, __ATOMIC_RELAXED, __HIP_MEMORY_SCOPE_AGENT); }
__device__ __forceinline__ unsigned xb_xcc_id() { return (unsigned)__builtin_amdgcn_s_getreg((3 << 11) | 20) & 0xFu; }
#define XB_SPIN(cond, bar) do { unsigned _sp = 0; while (cond) { __builtin_amdgcn_s_sleep(1); \
    if ((++_sp & 255u) == 0u) { if (xb_ld(&(bar)[XB_TMO])) break; if (_sp > XB_SPIN_CAP) { atomicAdd(&(bar)[XB_TMO], 1u); break; } } } } while (0)
struct XcdBarrier { unsigned* bar; unsigned x; volatile LAS unsigned* st; };
__device__ __forceinline__ XcdBarrier xcd_barrier_post(unsigned* bar, volatile LAS unsigned* st) {
    XcdBarrier b; b.bar = bar; b.x = xb_xcc_id(); b.st = st;
    if (threadIdx.x == 0) (void)xb_add(&bar[XB_XCNT(b.x)], 1u);
    return b;
}
__device__ __forceinline__ void xcd_barrier_complete(unsigned* bar, unsigned x, unsigned& nloc, unsigned& nx) {
    const unsigned G = gridDim.x * gridDim.y * gridDim.z;
    unsigned sum, cnt, mine, sp = 0u;
    for (;;) {
        sum = 0u; cnt = 0u; mine = 0u;
#pragma unroll
        for (unsigned j = 0; j < 16; ++j) { const unsigned c = xb_ld(&bar[XB_XCNT(j)]); sum += c; cnt += (c > 0u) ? 1u : 0u; mine = (j == x) ? c : mine; }
        if (sum == G) break;
        __builtin_amdgcn_s_sleep(1);
        if ((++sp & 255u) == 0u) { if (xb_ld(&bar[XB_TMO])) break; if (sp > XB_SPIN_CAP) { atomicAdd(&bar[XB_TMO], 1u); break; } }
    }
    nloc = mine > 0u ? mine : 1u; nx = cnt > 0u ? cnt : 1u;
}
__device__ __forceinline__ void xcd_barrier(const XcdBarrier& b) {
    asm volatile("s_waitcnt vmcnt(0)" ::: "memory");
    __syncthreads();
    if (threadIdx.x == 0) {
        unsigned* bar = b.bar;
        __builtin_amdgcn_s_waitcnt(0);
        unsigned nloc = b.st[0], nx = b.st[1];
        if (nloc == 0u) { xcd_barrier_complete(bar, b.x, nloc, nx); b.st[0] = nloc; b.st[1] = nx; }
        const unsigned old = xb_add(&bar[XB_XSUB(b.x)], 1u);
        const unsigned gen = old / nloc;
        if (old + 1u == (gen + 1u) * nloc) {
            __builtin_amdgcn_fence(__ATOMIC_RELEASE, "agent");
            asm volatile("s_waitcnt vmcnt(0)" ::: "memory");
            const unsigned og = xb_add(&bar[XB_TOP], 1u);
            const unsigned tg = og / nx;
            if (og + 1u == (tg + 1u) * nx) xb_add(&bar[XB_TOPGEN], 1u);
            else XB_SPIN(xb_ld(&bar[XB_TOPGEN]) == tg, bar);
            __builtin_amdgcn_fence(__ATOMIC_ACQUIRE, "agent");
            xb_add(&bar[XB_XGEN(b.x)], 1u);
            asm volatile("s_waitcnt vmcnt(0)" ::: "memory");
        } else {
            XB_SPIN(xb_ld(&bar[XB_XGEN(b.x)]) == gen, bar);
            __builtin_amdgcn_fence(__ATOMIC_ACQUIRE, "agent");
            asm volatile("s_waitcnt vmcnt(0)" ::: "memory");
        }
    }
    __syncthreads();
}

__device__ __forceinline__ float wave_sum(float v) {
#pragma unroll
    for (int o = 1; o < 64; o <<= 1) v += __shfl_xor(v, o);
    return v;
}
template <class RM> __device__ __forceinline__ void tr_item(const float* W, int K, int N, bf16_t* WT, int ldk, const RM& rowmap, LAS float* scr, int item, int lane) {
    const int nblk = (N + 31) / 32, kb = item / nblk, nb = item % nblk, k0 = 64 * kb, n0 = 32 * nb;
    const bool nok = n0 + (lane & 31) < N;
#pragma unroll 8
    for (int i = 0; i < 32; ++i) { const int kk = 2 * i + (lane >> 5); scr[kk * 33 + (lane & 31)] = nok ? W[(size_t)(k0 + kk) * N + n0 + (lane & 31)] : 0.f; }
    LDS_WAIT(); asm volatile("" ::: "memory");
    const int c = lane & 7;
#pragma unroll
    for (int j = 0; j < 4; ++j) { const int nl = (lane >> 3) + 8 * j; const LAS float* s = scr + (8 * c) * 33 + nl;
        u32x4 o; o.x = pk2(s[0 * 33], s[1 * 33]); o.y = pk2(s[2 * 33], s[3 * 33]); o.z = pk2(s[4 * 33], s[5 * 33]); o.w = pk2(s[6 * 33], s[7 * 33]);
        if (n0 + nl < N) *(u32x4*)(WT + (size_t)rowmap(n0 + nl) * ldk + k0 + 8 * c) = o; }
    LDS_WAIT(); asm volatile("" ::: "memory");
}
struct RmId { int off; __device__ __forceinline__ int operator()(int n) const { return off + n; } };
struct RmGU { int off; __device__ __forceinline__ int operator()(int n) const { return off + (n >> 7) * 256 + (n & 127); } };
struct RmQup { __device__ __forceinline__ int operator()(int n) const { const int h = n / 192, j = n % 192; if (j < 128) return n; const int i = j - 128, ii = i & 31; return h * 192 + 128 + 8 * (ii >> 2) + (ii & 3) + ((i >> 5) << 2); } };
template <class RM> __device__ __forceinline__ void tr_matrix(const float* W, int K, int N, bf16_t* WT, int ldk, const RM& rm, LAS float* scr, int gw, int ngw, int lane) {
    const int nitems = (K / 64) * ((N + 31) / 32);
    for (int it = gw; it < nitems; it += ngw) tr_item(W, K, N, WT, ldk, rm, scr, it, lane);
}
__device__ __forceinline__ void ln_inplace(f32x4 (&v)[4], const float* g, const float* b, int lane) {
    float s = 0.f;
#pragma unroll
    for (int j = 0; j < 4; ++j) s += (v[j].x + v[j].y) + (v[j].z + v[j].w);
    const float mean = wave_sum(s) * (1.f / D); float s2 = 0.f;
#pragma unroll
    for (int j = 0; j < 4; ++j) { v[j] = v[j] - mean; s2 += (v[j].x * v[j].x + v[j].y * v[j].y) + (v[j].z * v[j].z + v[j].w * v[j].w); }
    const float rstd = 1.f / sqrtf(wave_sum(s2) * (1.f / D) + 1e-5f);
#pragma unroll
    for (int j = 0; j < 4; ++j) { const f32x4 gg = *((const f32x4*)g + lane + 64 * j), bb = *((const f32x4*)b + lane + 64 * j); v[j] = v[j] * rstd * gg + bb; }
}
__device__ __forceinline__ void store_row_bf16(bf16_t* orow, const f32x4 (&v)[4], int lane) {
    u32x2* o8 = (u32x2*)orow + lane;
#pragma unroll
    for (int j = 0; j < 4; ++j) { u32x2 w; w.x = cvt_pk_bf16(v[j].x, v[j].y); w.y = cvt_pk_bf16(v[j].z, v[j].w); o8[64 * j] = w; }
}
__device__ __forceinline__ f32x4 bf4_to_f32(u32x2 w) { return (f32x4){bflo(w.x), bfhi(w.x), bflo(w.y), bfhi(w.y)}; }

__device__ __forceinline__ u32x4 pack8(f32x4 a, f32x4 b) { u32x4 w; w.x = cvt_pk_bf16(a[0], a[1]); w.y = cvt_pk_bf16(a[2], a[3]); w.z = cvt_pk_bf16(b[0], b[1]); w.w = cvt_pk_bf16(b[2], b[3]); return w; }
struct FBf16 { bf16_t* O; int ld; int rowoff;
    __device__ __forceinline__ void operator()(int row, int col, f32x4 a, f32x4 b) const { *(u32x4*)(O + (size_t)(rowoff + row) * ld + col) = pack8(a, b); } };
struct FQup { bf16_t* Q; const float* cs; const float* sn;
    __device__ __forceinline__ void operator()(int row, int col, f32x4 a, f32x4 b) const {
        const int j = col % 192;
        if (j >= 128) { const int i0 = ((j - 128) >> 3) * 4, s = row & (SEQ - 1);
            const f32x4 c = *(const f32x4*)(cs + s * 32 + i0), sv = *(const f32x4*)(sn + s * 32 + i0);
            const f32x4 o1 = a * c - b * sv, o2 = a * sv + b * c; a = o1; b = o2; }
        *(u32x4*)(Q + (size_t)row * 1536 + col) = pack8(a * C2_MLA, b * C2_MLA); } };
struct FKvup { bf16_t* KN; bf16_t* V;
    __device__ __forceinline__ void operator()(int row, int col, f32x4 a, f32x4 b) const {
        const int h = col >> 8, j = col & 255, bb = row >> 13, s = row & (SEQ - 1);
        bf16_t* base = (j < 128 ? KN : V) + ((size_t)(bb * MLA_H + h) * SEQ + s) * 128 + (j & 127);
        *(u32x4*)base = pack8(a, b); } };
struct FResF32 { float* P; const float* rf; const bf16_t* rb;
    __device__ __forceinline__ void operator()(int row, int col, f32x4 a, f32x4 b) const {
        const size_t o = (size_t)row * D + col; f32x4 r0, r1;
        if (rf) { r0 = *(const f32x4*)(rf + o); r1 = *(const f32x4*)(rf + o + 4); }
        else { const u32x4 w = *(const u32x4*)(rb + o); r0 = (f32x4){bflo(w.x), bfhi(w.x), bflo(w.y), bfhi(w.y)}; r1 = (f32x4){bflo(w.z), bfhi(w.z), bflo(w.w), bfhi(w.w)}; }
        *(f32x4*)(P + o) = r0 * ALPHA + a; *(f32x4*)(P + o + 4) = r1 * ALPHA + b; } };
struct FSwiglu { bf16_t* A; int ld; int rowoff;
    __device__ __forceinline__ void operator()(int row, int col, f32x4 g0, f32x4 g1, f32x4 u0, f32x4 u1) const {
        f32x4 a, b;
#pragma unroll
        for (int e = 0; e < 4; ++e) { a[e] = silu_f(g0[e]) * u0[e]; b[e] = silu_f(g1[e]) * u1[e]; }
        *(u32x4*)(A + (size_t)(rowoff + row) * ld + col) = pack8(a, b); } };
struct FNsaIn { bf16_t *NQ, *KC, *VC; float* GT;
    __device__ __forceinline__ void operator()(int row, int col, f32x4 a, f32x4 b) const {
        const int bb = row >> 13, s = row & (SEQ - 1);
        if (col < 1536) { *(u32x4*)(NQ + (size_t)row * 1536 + col) = pack8(a * C2_NSA, b * C2_NSA); return; }
        if (col >= 3504) return;
        if (col >= 3456) { float* gp = GT + (size_t)row * 48 + (col - 3456);
            f32x4 x, y;
#pragma unroll
            for (int e = 0; e < 4; ++e) { x[e] = sigmoid_f(a[e]); y[e] = sigmoid_f(b[e]); }
            *(f32x4*)gp = x; *(f32x4*)(gp + 4) = y; return; }
        int cc = col - 1536; const int seg = cc / 640; cc -= seg * 640;
        const bool isk = cc < 384; if (!isk) cc -= 384;
        bf16_t* base = (isk ? KC : VC) + (size_t)seg * (40u * 1024u * 1024u / 2u);
        const int dd = isk ? 96 : 64, g = cc / dd, d = cc - g * dd;
        *(u32x4*)(base + ((size_t)(bb * NSA_G + g) * SEQ + s) * dd + d) = pack8(a, b); } };
struct FCmp1 { bf16_t* H; const float* bias;
    __device__ __forceinline__ void operator()(int row, int col, f32x4 a, f32x4 b) const {
        if (col >= 128) return;
        const f32x4 b0 = *(const f32x4*)(bias + col), b1 = *(const f32x4*)(bias + col + 4); f32x4 x, y;
#pragma unroll
        for (int e = 0; e < 4; ++e) { x[e] = gelu_tanh_f(a[e] + b0[e]); y[e] = gelu_tanh_f(b[e] + b1[e]); }
        *(u32x4*)(H + (size_t)row * 128 + col) = pack8(x, y); } };
struct FCmp2 { bf16_t* O; int nd;
    __device__ __forceinline__ void operator()(int row, int col, f32x4 a, f32x4 b) const {
        if (col >= nd) return;
        if ((row & 511) == 511) { a = (f32x4){0.f, 0.f, 0.f, 0.f}; b = a; }
        *(u32x4*)(O + (size_t)row * nd + col) = pack8(a, b); } };

struct MoeInfo { int cnt[NE]; int ts[NE + 1];
    __device__ __forceinline__ int expert_of(int ct) const { int e = 0;
#pragma unroll
        for (int i = 1; i < NE; ++i) e += (ct >= ts[i]) ? 1 : 0; return e; } };
struct SchedMoeGU {
    pg8::StaticOrder so; MoeInfo mi; int ct0; const int* rowtok;
    __device__ __forceinline__ bool next(int i, pg8::Unit& u) const { return so.next(i, u); }
    __device__ __forceinline__ size_t a_off(const pg8::Unit&, const pg8::Gemm&) const { return 0; }
    __device__ __forceinline__ size_t b_off(const pg8::Unit& u, const pg8::Gemm& g) const { const int e = mi.expert_of(ct0 + u.pm); return ((size_t)e * (2 * FFE) + (size_t)u.pn * 256) * g.ldb * 2; }
    __device__ __forceinline__ unsigned a_row(const pg8::Unit& u, int r) const {
        const int ct = ct0 + u.pm, e = mi.expert_of(ct); int c = 0, t0 = 0;
#pragma unroll
        for (int i = 0; i < NE; ++i) { c = (i == e) ? mi.cnt[i] : c; t0 = (i == e) ? mi.ts[i] : t0; }
        const int pos = (ct - t0) * 256 + r; const int tok = pos < c ? rowtok[e * ECAP + pos] : 0;
        return (unsigned)tok * (unsigned)(D * 2); }
};
struct SchedMoeD {
    pg8::StaticOrder so; MoeInfo mi; int ct0;
    __device__ __forceinline__ bool next(int i, pg8::Unit& u) const { return so.next(i, u); }
    __device__ __forceinline__ size_t a_off(const pg8::Unit& u, const pg8::Gemm& g) const { return (size_t)u.pm * 256 * g.lda * 2; }
    __device__ __forceinline__ size_t b_off(const pg8::Unit& u, const pg8::Gemm& g) const { const int e = mi.expert_of(ct0 + u.pm); return ((size_t)e * D + (size_t)u.pn * 256) * g.ldb * 2; }
    __device__ __forceinline__ unsigned a_row(const pg8::Unit&, int) const { return 0u; }
};
#if defined(SELFTEST)
namespace st {
constexpr int TB = 2;
constexpr int CW_ERR = 32768;
template <class AF, class OF> __device__ __forceinline__ void naive_mm(int M, int N, int K, const float* W, int ldw, int n0, const AF& a, const OF& o, int gt, int ngt) {
    for (long i = gt; i < (long)M * N; i += ngt) { const int m = (int)(i / N), n = (int)(i % N); float s = 0.f; for (int k = 0; k < K; ++k) s += a(m, k) * W[(size_t)k * ldw + n0 + n]; o(m, n, s); }
}
__device__ __forceinline__ float wave_max(float v) {
#pragma unroll
    for (int o = 1; o < 64; o <<= 1) v = fmaxf(v, __shfl_xor(v, o));
    return v;
}
__device__ __forceinline__ int rel_bucket_ref(int dist) {
    const int n = dist > 0 ? dist : 0; if (n < 16) return n;
    const float nf = (float)n; int large = 16 + (int)(logf(nf / 16.f) / 2.0794415416798357f * 16.f); return large < 31 ? large : 31;
}
}
#endif
constexpr int N_PHASES = 28;
struct Args { const float* in[27]; float* out; unsigned char* ws; int ph_lo, ph_hi; };
enum { I_X = 0, I_MLA_WIN, I_MLA_QN, I_MLA_WQ, I_MLA_KVN, I_MLA_WKV, I_MLA_WO, I_NSA_WIN, I_PE_K, I_W1_K, I_W2_K, I_PE_V, I_W1_V, I_W2_V, I_NSA_WO, I_RELB,
       I_FFN_G, I_FFN_U, I_FFN_D, I_ROUTER, I_MOE_G, I_MOE_U, I_MOE_D, I_LNM_G, I_LNM_B, I_LNF_G, I_LNF_B };

__device__ __forceinline__ int rel_bucket_dev(int n) {
    if (n < 16) return n;
    int bkt = 16;
    bkt += n >= 19; bkt += n >= 21; bkt += n >= 24; bkt += n >= 27; bkt += n >= 31; bkt += n >= 35; bkt += n >= 40; bkt += n >= 46;
    bkt += n >= 52; bkt += n >= 59; bkt += n >= 67; bkt += n >= 77; bkt += n >= 87; bkt += n >= 99; bkt += n >= 113;
    return bkt;
}

__global__ void __launch_bounds__(NWAVES * 64, 2) fwd(Args args) {
    extern __shared__ __attribute__((aligned(16))) unsigned char lds_raw[];
    LAS unsigned char* lds = (LAS unsigned char*)lds_raw;
    volatile LAS unsigned* MISC = (volatile LAS unsigned*)(lds + MISC_OFF);
    const int tid_ = threadIdx.x, wave = __builtin_amdgcn_readfirstlane(tid_ >> 6);
    const int G = gridDim.x, bx = blockIdx.x;
    const int vcu = (G % 8 == 0) ? (bx % 8) * (G / 8) + bx / 8 : bx;
    const int NGW = G * NWAVES;
    unsigned char* ws = args.ws;
    unsigned* ctl = (unsigned*)(ws + WS_CTL);
    for (int u = tid_; u < (LDS_BYTES - RING_BYTES) / 4; u += NWAVES * 64) ((LAS unsigned*)(lds + RING_BYTES))[u] = 0u;
    __syncthreads();
    XcdBarrier bar = xcd_barrier_post(ctl + CW_BAR, MISC + 8);
    const int lo = args.ph_lo, hi_ph = args.ph_hi;
#ifndef PHMASK
#define PHMASK 0xFFFFFFFFu
#endif
#define IN(k) (((PHMASK >> (k)) & 1u) && lo <= (k) && (k) < hi_ph)
#define SEAM(k) do { if (IN(k) && IN((k) + 1)) xcd_barrier(bar); } while (0)
#ifndef DUP_MASK
#define DUP_MASK 0u
#endif
#define REP(k) _Pragma("nounroll") for (int rep_ = 0; rep_ < 1 + (int)((DUP_MASK >> (k)) & 1u); ++rep_, (((DUP_MASK >> (k)) & 1u) && rep_ == 1) ? xcd_barrier(bar) : (void)0)
#define W_MLAIN ((bf16_t*)(ws + WS_W_MLAIN))
#define W_QUP ((bf16_t*)(ws + WS_W_QUP))
#define W_KVUP ((bf16_t*)(ws + WS_W_KVUP))
#define W_MLAOUT ((bf16_t*)(ws + WS_W_MLAOUT))
#define W_FFNGU ((bf16_t*)(ws + WS_W_FFNGU))
#define W_FFND ((bf16_t*)(ws + WS_W_FFND))
#define W_NSAIN ((bf16_t*)(ws + WS_W_NSAIN))
#define W_NSAOUT ((bf16_t*)(ws + WS_W_NSAOUT))
#define W_C1K ((bf16_t*)(ws + WS_W_C1K))
#define W_C1V ((bf16_t*)(ws + WS_W_C1V))
#define W_C2K ((bf16_t*)(ws + WS_W_C2K))
#define W_C2V ((bf16_t*)(ws + WS_W_C2V))
#define ROPE_C ((float*)(ws + WS_ROPE))
#define CBIAS ((float*)(ws + WS_CBIAS))
#define RBT ((float*)(ws + WS_RBT))
#define ROWTOK ((int*)(ws + WS_ROWTOK))
#define TOKINFO ((unsigned*)(ws + WS_TOKINFO))
#define TOKW ((float*)(ws + WS_TOKW))
#define XB ((bf16_t*)(ws + WS_XB))
#define LAT ((bf16_t*)(ws + WS_LAT))
#define QN ((bf16_t*)(ws + WS_QN))
#define KVN ((bf16_t*)(ws + WS_KVN))
#define KR ((bf16_t*)(ws + WS_KR))
#define Q ((bf16_t*)(ws + WS_Q))
#define KN ((bf16_t*)(ws + WS_KN))
#define V ((bf16_t*)(ws + WS_V))
#define O ((bf16_t*)(ws + WS_O))
#define X1 ((bf16_t*)(ws + WS_X1))
#define ACT ((bf16_t*)(ws + WS_ACT))
#define X2 ((bf16_t*)(ws + WS_X2))
#define NQ ((bf16_t*)(ws + WS_NQ))
#define KC ((bf16_t*)(ws + WS_KC))
#define VC ((bf16_t*)(ws + WS_VC))
#define KS ((bf16_t*)(ws + WS_KS))
#define VS ((bf16_t*)(ws + WS_VS))
#define KW ((bf16_t*)(ws + WS_KW))
#define VW ((bf16_t*)(ws + WS_VW))
#define GT ((float*)(ws + WS_GT))
#define HK ((bf16_t*)(ws + WS_HK))
#define HV ((bf16_t*)(ws + WS_HV))
#define KCMP ((bf16_t*)(ws + WS_KCMP))
#define VCMP ((bf16_t*)(ws + WS_VCMP))
#define ONSA ((bf16_t*)(ws + WS_ONSA))
#define X3 ((bf16_t*)(ws + WS_X3))
#define W_MOEGU ((bf16_t*)(ws + WS_MOE_GU))
#define W_MOED ((bf16_t*)(ws + WS_MOE_D))
#define DOUT ((bf16_t*)(ws + WS_DOUT))
#define ROPE_S (ROPE_C + SEQ * 32)
#define P (args.out)
#define ACTC ((bf16_t*)args.out)
    typedef pg8::SchedPlain SP;
#define PH_LAUNDER() int tid = tid_; asm volatile("" : "+v"(tid)); const int lane = tid & 63; const int gw = vcu * NWAVES + wave; LAS float* scr = (LAS float*)(lds + wave * 8704); (void)lane; (void)gw; (void)scr;

    REP(0) if (IN(0)) {
        PH_LAUNDER();
        const float* const* in = args.in;
        tr_matrix(in[I_MLA_WIN], D, MLA_IN, W_MLAIN, D, RmId{0}, scr, gw, NGW, lane);
        tr_matrix(in[I_MLA_WQ], MLA_QR, 1536, W_QUP, MLA_QR, RmQup{}, scr, gw, NGW, lane);
        tr_matrix(in[I_MLA_WKV], MLA_KVR, 2048, W_KVUP, MLA_KVR, RmId{0}, scr, gw, NGW, lane);
        tr_matrix(in[I_MLA_WO], D, D, W_MLAOUT, D, RmId{0}, scr, gw, NGW, lane);
        tr_matrix(in[I_FFN_G], D, FF, W_FFNGU, D, RmGU{0}, scr, gw, NGW, lane);
        tr_matrix(in[I_FFN_U], D, FF, W_FFNGU, D, RmGU{128}, scr, gw, NGW, lane);
        tr_matrix(in[I_FFN_D], FF, D, W_FFND, FF, RmId{0}, scr, gw, NGW, lane);
        tr_matrix(in[I_NSA_WIN], D, NSA_IN, W_NSAIN, D, RmId{0}, scr, gw, NGW, lane);
        tr_matrix(in[I_NSA_WO], D, D, W_NSAOUT, D, RmId{0}, scr, gw, NGW, lane);
        const int gt = vcu * 512 + tid, NGT = G * 512;
        for (int i = gt; i < (1024 - MLA_IN) * D / 8; i += NGT) ((u32x4*)(W_MLAIN + (size_t)MLA_IN * D))[i] = (u32x4){0u, 0u, 0u, 0u};
        for (int i = gt; i < (NSA_INP - NSA_IN) * D / 8; i += NGT) ((u32x4*)(W_NSAIN + (size_t)NSA_IN * D))[i] = (u32x4){0u, 0u, 0u, 0u};
        for (int i = gt; i < 256 * 3072; i += NGT) { const int n = i / 3072, k = i % 3072; W_C1K[i] = (bf16_t)(n < 96 ? f2bf(in[I_W1_K][(size_t)k * 96 + n]) : 0u); }
        for (int i = gt; i < 256 * 2048; i += NGT) { const int n = i / 2048, k = i % 2048; W_C1V[i] = (bf16_t)(n < 64 ? f2bf(in[I_W1_V][(size_t)k * 64 + n]) : 0u); }
        for (int i = gt; i < 256 * 128; i += NGT) { const int n = i / 128, k = i % 128;
            W_C2K[i] = (bf16_t)((n < 96 && k < 96) ? f2bf(in[I_W2_K][k * 96 + n]) : 0u); W_C2V[i] = (bf16_t)((n < 64 && k < 64) ? f2bf(in[I_W2_V][k * 64 + n]) : 0u); }
        for (int i = gw; i < 256; i += NGW) { const int isv = i >> 7, e = i & 127; const int nd = isv ? 64 : 96; float s = 0.f;
            if (e < nd) { const float* pe = in[isv ? I_PE_V : I_PE_K]; const float* w1 = in[isv ? I_W1_V : I_W1_K]; for (int k = lane; k < 32 * nd; k += 64) s += pe[k] * w1[(size_t)k * nd + e]; }
            s = wave_sum(s); if (lane == 0) CBIAS[i] = s; }
        for (int i = gt; i < SEQ * 32; i += NGT) { const int pos = i >> 5, j = i & 31; const float fr = (float)pow(10000.0, -(double)j / 32.0); const float ang = (float)pos * fr;
            ROPE_C[i] = (float)cos((double)ang); ROPE_S[i] = (float)sin((double)ang); }
        for (int i = gt; i < 16 * nsa::TABW; i += NGT) { const int h = i / nsa::TABW, d = i % nsa::TABW; const float* rb = in[I_RELB];
            RBT[i] = d < 128 ? (rb[rel_bucket_dev(d) * 16 + h] - rb[31 * 16 + h]) * LOG2E : 0.f; }
        for (int m = gw; m < T; m += NGW) { const f32x4* xr = (const f32x4*)(in[I_X] + (size_t)m * D) + lane; f32x4 v[4];
#pragma unroll
            for (int j = 0; j < 4; ++j) v[j] = xr[64 * j];
            store_row_bf16(XB + (size_t)m * D, v, lane); }
    }
    SEAM(0);
    REP(1) if (IN(1)) { pg8::Gemm g{XB, W_MLAIN, D, D, D}; SP S; S.init(T / 256, 4, G, bx);
        pg8::EpiRow8<FBf16> E{FBf16{LAT, 1024, 0}}; pg8::gemm_phase<pg8::EpiRow8<FBf16>, SP, true, false>(lds, g, S, E); }
    SEAM(1);
    REP(2) if (IN(2)) {
        PH_LAUNDER();
        const float* qg = args.in[I_MLA_QN]; const float* kg = args.in[I_MLA_KVN];
        for (int m = gw; m < T; m += NGW) {
            const bf16_t* row = LAT + (size_t)m * 1024;
            const u32x4 wq = *((const u32x4*)row + lane);
            const u32x2 wk = *((const u32x2*)(row + 512) + lane);
            float q[8] = {bflo(wq.x), bfhi(wq.x), bflo(wq.y), bfhi(wq.y), bflo(wq.z), bfhi(wq.z), bflo(wq.w), bfhi(wq.w)};
            float k[4] = {bflo(wk.x), bfhi(wk.x), bflo(wk.y), bfhi(wk.y)};
            float sq = 0.f, sk = 0.f;
#pragma unroll
            for (int e = 0; e < 8; ++e) sq += q[e] * q[e];
#pragma unroll
            for (int e = 0; e < 4; ++e) sk += k[e] * k[e];
            const float rq = 1.f / sqrtf(wave_sum(sq) * (1.f / 512.f) + 1e-6f), rk = 1.f / sqrtf(wave_sum(sk) * (1.f / 256.f) + 1e-6f);
            const f32x4 g0 = *((const f32x4*)qg + 2 * lane), g1 = *((const f32x4*)qg + 2 * lane + 1), g2 = *((const f32x4*)kg + lane);
            u32x4 oq; oq.x = cvt_pk_bf16(q[0] * rq * g0[0], q[1] * rq * g0[1]); oq.y = cvt_pk_bf16(q[2] * rq * g0[2], q[3] * rq * g0[3]);
            oq.z = cvt_pk_bf16(q[4] * rq * g1[0], q[5] * rq * g1[1]); oq.w = cvt_pk_bf16(q[6] * rq * g1[2], q[7] * rq * g1[3]);
            *((u32x4*)(QN + (size_t)m * 512) + lane) = oq;
            u32x2 ok; ok.x = cvt_pk_bf16(k[0] * rk * g2[0], k[1] * rk * g2[1]); ok.y = cvt_pk_bf16(k[2] * rk * g2[2], k[3] * rk * g2[3]);
            *((u32x2*)(KVN + (size_t)m * 256) + lane) = ok;
            if (lane < 32) { const float x1 = bf2f(row[768 + lane]), x2 = bf2f(row[800 + lane]); const int s = m & (SEQ - 1);
                const float c = ROPE_C[s * 32 + lane], sn = ROPE_S[s * 32 + lane]; const int p = 8 * (lane >> 2) + (lane & 3);
                bf16_t* kr = KR + (size_t)m * 64; kr[p] = (bf16_t)f2bf(x1 * c - x2 * sn); kr[p + 4] = (bf16_t)f2bf(x1 * sn + x2 * c); }
        }
    }
    SEAM(2);
    REP(3) if (IN(3)) { pg8::Gemm g{QN, W_QUP, MLA_QR, MLA_QR, MLA_QR}; SP S; S.init(T / 256, 6, G, bx);
        pg8::EpiRow8<FQup> E{FQup{Q, ROPE_C, ROPE_S}}; pg8::gemm_phase<pg8::EpiRow8<FQup>, SP, true, false>(lds, g, S, E); }
    SEAM(3);
    REP(4) if (IN(4)) { pg8::Gemm g{KVN, W_KVUP, MLA_KVR, MLA_KVR, MLA_KVR}; SP S; S.init(T / 256, 8, G, bx);
        pg8::EpiRow8<FKvup> E{FKvup{KN, V}}; pg8::gemm_phase<pg8::EpiRow8<FKvup>, SP, true, false>(lds, g, S, E); }
    SEAM(4);
    REP(5) if (IN(5)) {
        PH_LAUNDER();
        for (int it2 = 2 * bx; it2 < 2 * NB * MLA_H * 16; it2 += (it2 & 1) ? 2 * G - 1 : 1) { const int it = it2 >> 1, bh = it & 31, x = it >> 5;
            mla::unit((LAS char*)lds, bh >> 3, bh & 7, (it2 & 1) ? x : 31 - x, Q, KN, KR, V, O, tid, lane, wave); }
    }
    SEAM(5);

#if defined(SELFTEST) && SELFTEST == 1
    {
        PH_LAUNDER();
        const float* const* in = args.in; const int gt = vcu * 512 + tid, NGT = G * 512;
        float* TKV = (float*)(ws + 104 * MiB); float* TLAT = (float*)(ws + 168 * MiB); float* TQ = (float*)(ws + 200 * MiB);
        float* TKR = (float*)(ws + 250 * MiB); float* TKVN = (float*)(ws + 256 * MiB); float* TQN = (float*)(ws + 264 * MiB);
        const float* xb = in[I_X] + (size_t)st::TB * SEQ * D;
        st::naive_mm(SEQ, 832, 1024, in[I_MLA_WIN], 832, 0, [&](int m, int k) { return xb[(size_t)m * D + k]; }, [&](int m, int n, float v) { TLAT[(size_t)m * 832 + n] = v; }, gt, NGT);
        xcd_barrier(bar);
        for (int m = gw; m < SEQ; m += NGW) { const float* r = TLAT + (size_t)m * 832; float sq = 0.f, sk = 0.f;
            for (int k = lane; k < 512; k += 64) sq += r[k] * r[k];
            for (int k = lane; k < 256; k += 64) sk += r[512 + k] * r[512 + k];
            sq = wave_sum(sq); sk = wave_sum(sk);
            const float rq = 1.f / sqrtf(sq / 512.f + 1e-6f), rk = 1.f / sqrtf(sk / 256.f + 1e-6f);
            for (int k = lane; k < 512; k += 64) TQN[(size_t)m * 512 + k] = r[k] * rq * in[I_MLA_QN][k];
            for (int k = lane; k < 256; k += 64) TKVN[(size_t)m * 256 + k] = r[512 + k] * rk * in[I_MLA_KVN][k];
            if (lane < 32) { const float fr = powf(10000.f, -(float)lane / 32.f), ang = (float)m * fr, c = cosf(ang), sn = sinf(ang), x1 = r[768 + lane], x2 = r[800 + lane];
                TKR[(size_t)m * 64 + lane] = x1 * c - x2 * sn; TKR[(size_t)m * 64 + 32 + lane] = x1 * sn + x2 * c; } }
        xcd_barrier(bar);
        st::naive_mm(SEQ, 1536, 512, in[I_MLA_WQ], 1536, 0, [&](int m, int k) { return TQN[(size_t)m * 512 + k]; }, [&](int m, int n, float v) { TQ[(size_t)m * 1536 + n] = v; }, gt, NGT);
        st::naive_mm(SEQ, 2048, 256, in[I_MLA_WKV], 2048, 0, [&](int m, int k) { return TKVN[(size_t)m * 256 + k]; }, [&](int m, int n, float v) { TKV[(size_t)m * 2048 + n] = v; }, gt, NGT);
        xcd_barrier(bar);
        for (int m = gw; m < SEQ; m += NGW) for (int e = lane; e < 256; e += 64) { const int h = e >> 5, i = e & 31; float* q = TQ + (size_t)m * 1536 + h * 192 + 128;
            const float fr = powf(10000.f, -(float)i / 32.f), ang = (float)m * fr, c = cosf(ang), sn = sinf(ang), x1 = q[i], x2 = q[32 + i]; q[i] = x1 * c - x2 * sn; q[32 + i] = x1 * sn + x2 * c; }
        xcd_barrier(bar);
        float err = 0.f, ref2 = 0.f;
        for (int row = gw; row < MLA_H * SEQ; row += NGW) { const int h = row & 7, q = row >> 3;
            const float* qv = TQ + (size_t)q * 1536 + h * 192; const float q0 = qv[lane], q1 = qv[64 + lane], q2 = qv[128 + lane];
            float mm = -__builtin_inff(), l = 0.f, a0 = 0.f, a1 = 0.f;
            for (int k = 0; k <= q; ++k) { const float* kn = TKV + (size_t)k * 2048 + h * 256; const float* kr = TKR + (size_t)k * 64;
                const float sc = wave_sum(q0 * kn[lane] + q1 * kn[64 + lane] + q2 * kr[lane]) * 0.07216878364870323f;
                const float mn = fmaxf(mm, sc), al = __expf(mm - mn), p = __expf(sc - mn);
                l = l * al + p; a0 = a0 * al + p * kn[128 + lane]; a1 = a1 * al + p * kn[192 + lane]; mm = mn; }
            const float o0 = a0 / l, o1 = a1 / l; const bf16_t* fo = O + ((size_t)st::TB * SEQ + q) * 1024 + h * 128;
            const float f0 = bf2f(fo[lane]), f1 = bf2f(fo[64 + lane]);
            err += (f0 - o0) * (f0 - o0) + (f1 - o1) * (f1 - o1); ref2 += o0 * o0 + o1 * o1; }
        err = wave_sum(err); ref2 = wave_sum(ref2);
        if (lane == 0) { atomicAdd((float*)(ctl + st::CW_ERR), err); atomicAdd((float*)(ctl + st::CW_ERR + 1), ref2); }
        xcd_barrier(bar);
    }
#endif
    REP(6) if (IN(6)) { pg8::Gemm g{O, W_MLAOUT, D, D, D}; SP S; S.init(T / 256, 4, G, bx);
        pg8::EpiRow8<FResF32> E{FResF32{P, args.in[I_X], nullptr}}; pg8::gemm_phase<pg8::EpiRow8<FResF32>, SP, true, false>(lds, g, S, E); }
    SEAM(6);
    REP(7) if (IN(7)) {
        PH_LAUNDER();
        for (int m = gw; m < T; m += NGW) { const f32x4* pr = (const f32x4*)(P + (size_t)m * D) + lane; f32x4 v[4];
#pragma unroll
            for (int j = 0; j < 4; ++j) v[j] = pr[64 * j];
            ln_inplace(v, args.in[I_LNM_G], args.in[I_LNM_B], lane); store_row_bf16(X1 + (size_t)m * D, v, lane); }
    }
    SEAM(7);
    REP(8) if (IN(8)) { pg8::Gemm g{X1, W_FFNGU, D, D, D}; SP S; S.init(T / 256, 22, G, bx);
        pg8::EpiGateUp<FSwiglu> E{FSwiglu{ACT, FF, 0}}; pg8::gemm_phase<pg8::EpiGateUp<FSwiglu>, SP, true, false>(lds, g, S, E); }
    SEAM(8);
    REP(9) if (IN(9)) { pg8::Gemm g{ACT, W_FFND, FF, FF, FF}; SP S; S.init(T / 256, 4, G, bx);
        pg8::EpiRow8<FResF32> E{FResF32{P, nullptr, X1}}; pg8::gemm_phase<pg8::EpiRow8<FResF32>, SP, true, false>(lds, g, S, E); }
    SEAM(9);
    REP(10) if (IN(10)) {
        PH_LAUNDER();
        for (int m = gw; m < T; m += NGW) { const f32x4* pr = (const f32x4*)(P + (size_t)m * D) + lane; f32x4 v[4];
#pragma unroll
            for (int j = 0; j < 4; ++j) v[j] = pr[64 * j];
            ln_inplace(v, args.in[I_LNF_G], args.in[I_LNF_B], lane); store_row_bf16(X2 + (size_t)m * D, v, lane); }
    }
    SEAM(10);
    REP(11) if (IN(11)) { pg8::Gemm g{X2, W_NSAIN, D, D, D}; SP S; S.init(T / 256, NSA_INP / 256, G, bx);
        pg8::EpiRow8<FNsaIn> E{FNsaIn{NQ, KC, VC, GT}}; pg8::gemm_phase<pg8::EpiRow8<FNsaIn>, SP, true, false>(lds, g, S, E); }
    SEAM(11);
    REP(12) if (IN(12)) {
        { pg8::Gemm g{KC, W_C1K, 16 * 96, 3072, 3072}; SP S; S.init(32, 1, G, bx);
          pg8::EpiRow8<FCmp1> E{FCmp1{HK, CBIAS}}; pg8::gemm_phase<pg8::EpiRow8<FCmp1>, SP, false, false>(lds, g, S, E); }
        { pg8::Gemm g{VC, W_C1V, 16 * 64, 2048, 2048}; SP S; S.init(32, 1, G, (bx + G / 2) % G);
          pg8::EpiRow8<FCmp1> E{FCmp1{HV, CBIAS + 128}}; pg8::gemm_phase<pg8::EpiRow8<FCmp1>, SP, false, false>(lds, g, S, E); }
    }
    SEAM(12);
    REP(13) if (IN(13)) {
        { pg8::Gemm g{HK, W_C2K, 128, 128, 128}; SP S; S.init(32, 1, G, bx);
          pg8::EpiRow8<FCmp2> E{FCmp2{KCMP, 96}}; pg8::gemm_phase<pg8::EpiRow8<FCmp2>, SP, false, false>(lds, g, S, E); }
        { pg8::Gemm g{HV, W_C2V, 128, 128, 128}; SP S; S.init(32, 1, G, (bx + G / 2) % G);
          pg8::EpiRow8<FCmp2> E{FCmp2{VCMP, 64}}; pg8::gemm_phase<pg8::EpiRow8<FCmp2>, SP, false, false>(lds, g, S, E); }
    }
    SEAM(13);

#if defined(SELFTEST) && SELFTEST == 3
    {
        PH_LAUNDER();
        const float* const* in = args.in; const int gt = vcu * 512 + tid, NGT = G * 512;
        float* TPROJ = (float*)(ws + 348 * MiB);
        float* THK = (float*)(ws + 460 * MiB); float* THV = (float*)(ws + 461 * MiB); float* TKC = (float*)(ws + 462 * MiB); float* TVC = (float*)(ws + 463 * MiB);
        const bf16_t* xb = X2 + (size_t)st::TB * SEQ * D;
        st::naive_mm(SEQ, 3504, 1024, in[I_NSA_WIN], 3504, 0, [&](int m, int k) { return bf2f(xb[(size_t)m * D + k]); }, [&](int m, int n, float v) { TPROJ[(size_t)m * 3504 + n] = v; }, gt, NGT);
        xcd_barrier(bar);
        for (int i = gt; i < 4 * 511 * 96; i += NGT) { const int e = i % 96, n = (i / 96) % 511, g = i / (96 * 511); float s = 0.f;
            for (int l = 0; l < 32; ++l) for (int d = 0; d < 96; ++d) s += (TPROJ[(size_t)(16 * n + l) * 3504 + 1536 + g * 96 + d] + in[I_PE_K][l * 96 + d]) * in[I_W1_K][(size_t)(l * 96 + d) * 96 + e];
            THK[(g * 512 + n) * 96 + e] = 0.5f * s * (1.f + tanhf(0.7978845608028654f * (s + 0.044715f * s * s * s))); }
        for (int i = gt; i < 4 * 511 * 64; i += NGT) { const int e = i % 64, n = (i / 64) % 511, g = i / (64 * 511); float s = 0.f;
            for (int l = 0; l < 32; ++l) for (int d = 0; d < 64; ++d) s += (TPROJ[(size_t)(16 * n + l) * 3504 + 1920 + g * 64 + d] + in[I_PE_V][l * 64 + d]) * in[I_W1_V][(size_t)(l * 64 + d) * 64 + e];
            THV[(g * 512 + n) * 64 + e] = 0.5f * s * (1.f + tanhf(0.7978845608028654f * (s + 0.044715f * s * s * s))); }
        xcd_barrier(bar);
        float err = 0.f, ref2 = 0.f;
        for (int i = gt; i < 4 * 511 * 96; i += NGT) { const int e = i % 96, n = (i / 96) % 511, g = i / (96 * 511); float s = 0.f; for (int d = 0; d < 96; ++d) s += THK[(g * 512 + n) * 96 + d] * in[I_W2_K][d * 96 + e];
            const float f = bf2f(KCMP[((size_t)(st::TB * 4 + g) * 512 + n) * 96 + e]); err += (f - s) * (f - s); ref2 += s * s; }
        for (int i = gt; i < 4 * 511 * 64; i += NGT) { const int e = i % 64, n = (i / 64) % 511, g = i / (64 * 511); float s = 0.f; for (int d = 0; d < 64; ++d) s += THV[(g * 512 + n) * 64 + d] * in[I_W2_V][d * 64 + e];
            const float f = bf2f(VCMP[((size_t)(st::TB * 4 + g) * 512 + n) * 64 + e]); err += (f - s) * (f - s); ref2 += s * s; }
        for (long i = gt; i < (long)SEQ * 3504; i += NGT) { const int m = (int)(i / 3504), c = (int)(i % 3504); const float r = TPROJ[i]; const size_t trow = (size_t)st::TB * SEQ + m; float f, rr = r;
            if (c < 1536) { f = bf2f(NQ[trow * 1536 + c]); rr = r * C2_NSA; }
            else if (c >= 3456) { f = GT[trow * 48 + (c - 3456)]; rr = 1.f / (1.f + __expf(-r)); }
            else { int cc = c - 1536; const bf16_t* base; int dd;
                if (cc < 384) { base = KC; dd = 96; } else if (cc < 640) { base = VC; dd = 64; cc -= 384; } else if (cc < 1024) { base = KS; dd = 96; cc -= 640; } else if (cc < 1280) { base = VS; dd = 64; cc -= 1024; }
                else if (cc < 1664) { base = KW; dd = 96; cc -= 1280; } else { base = VW; dd = 64; cc -= 1664; }
                const int g = cc / dd, d = cc % dd; f = bf2f(base[((size_t)(st::TB * 4 + g) * SEQ + m) * dd + d]); }
            err += (f - rr) * (f - rr); ref2 += rr * rr; }
        err = wave_sum(err); ref2 = wave_sum(ref2);
        if (lane == 0) { atomicAdd((float*)(ctl + st::CW_ERR), err); atomicAdd((float*)(ctl + st::CW_ERR + 1), ref2); }
        xcd_barrier(bar);
    }
#endif
    REP(14) if (IN(14)) {
        PH_LAUNDER();
        const nsa::Tensors X{NQ, KCMP, VCMP, KS, VS, KW, VW, GT, RBT, ONSA};
        for (int it2 = 2 * bx; it2 < 2 * NB * NSA_G * 64; it2 += (it2 & 1) ? 2 * G - 1 : 1) { const int it = it2 >> 1, bg = it & 15, x = it >> 4;
            nsa::unit((LAS char*)lds, X, bg >> 2, bg & 3, (it2 & 1) ? x : 127 - x, tid, lane, wave); }
    }
    SEAM(14);

#if defined(SELFTEST) && SELFTEST == 2
    {
        PH_LAUNDER();
        const float* rb = args.in[I_RELB];
        LAS float* buf = (LAS float*)(lds + wave * 6144); LAS float* imp = buf + 1024; LAS int* sel = (LAS int*)(imp + 128);
        const float scale_q = 1.f / LOG2E;
        float err = 0.f, ref2 = 0.f;
        for (int item = gw; item < NSA_G * SEQ; item += NGW) { const int g = item & 3, q = item >> 2, qpos = q, cur = q >> 6; const size_t trow = (size_t)st::TB * SEQ + q; const int bg = st::TB * NSA_G + g;
            float oacc[4] = {0.f, 0.f, 0.f, 0.f};
            imp[lane] = 0.f; imp[64 + lane] = 0.f;
            int nvalid = qpos >= 31 ? ((qpos - 31) >> 4) + 1 : 0; if (nvalid > 511) nvalid = 511;
            const bf16_t* kc = KCMP + (size_t)bg * 512 * 96; const bf16_t* vc = VCMP + (size_t)bg * 512 * 64;
            const bf16_t* ks = KS + (size_t)bg * SEQ * 96; const bf16_t* vs = VS + (size_t)bg * SEQ * 64; const bf16_t* kw = KW + (size_t)bg * SEQ * 96; const bf16_t* vw = VW + (size_t)bg * SEQ * 64;
            for (int h = 0; h < 4; ++h) { const int head = g * 4 + h; const bf16_t* qv = NQ + trow * 1536 + head * 96;
                float mx = -__builtin_inff();
                for (int n = lane; n < nvalid; n += 64) { float s = 0.f; for (int d = 0; d < 96; ++d) s += bf2f(qv[d]) * bf2f(kc[(size_t)n * 96 + d]);
                    s = s * scale_q + rb[st::rel_bucket_ref(qpos - 16 * n - 31) * 16 + head]; buf[n] = s; mx = fmaxf(mx, s); }
                mx = st::wave_max(mx); if (!(mx > -1e38f)) mx = 0.f;
                float sum = 0.f; LDS_WAIT();
                for (int n = lane; n < nvalid; n += 64) { const float p = __expf(buf[n] - mx); buf[n] = p; sum += p; }
                sum = wave_sum(sum); const float inv = 1.f / fmaxf(sum, 1e-30f);
                for (int n = lane; n < nvalid; n += 64) buf[n] *= inv;
                LDS_WAIT();
                float oc = 0.f; for (int n = 0; n < nvalid; ++n) oc += buf[n] * bf2f(vc[(size_t)n * 64 + lane]);
                oacc[h] += GT[trow * 48 + head * 3 + 0] * oc;
                for (int j = lane; j < 128; j += 64) { float a = 0.f; for (int n = 4 * j - 1; n <= 4 * j + 3; ++n) if (n >= 0 && n < nvalid) a += buf[n]; imp[j] += a; }
                LDS_WAIT();
            }
            float v0, v1; { const int j0 = lane, j1 = lane + 64;
                v0 = j0 > cur ? -1e6f : ((j0 == 0 || j0 == cur || j0 == cur - 1) ? 1e6f : imp[j0]); v1 = j1 > cur ? -1e6f : ((j1 == 0 || j1 == cur || j1 == cur - 1) ? 1e6f : imp[j1]); }
            for (int it = 0; it < 16; ++it) { float bv = v0; int bi = lane; if (v1 > v0) { bv = v1; bi = lane + 64; }
#pragma unroll
                for (int o = 1; o < 64; o <<= 1) { const float ov = __shfl_xor(bv, o); const int oi = __shfl_xor(bi, o); if (ov > bv || (ov == bv && oi < bi)) { bv = ov; bi = oi; } }
                if (lane == 0) sel[it] = bi;
                if (bi == lane) v0 = -__builtin_inff(); if (bi == lane + 64) v1 = -__builtin_inff(); }
            LDS_WAIT();
            for (int h = 0; h < 4; ++h) { const int head = g * 4 + h; const bf16_t* qv = NQ + trow * 1536 + head * 96;
                float mx = -__builtin_inff();
                for (int it = 0; it < 16; ++it) { const int kpos = sel[it] * 64 + lane, dist = qpos - kpos; float s = -__builtin_inff();
                    if (dist >= 0) { s = 0.f; for (int d = 0; d < 96; ++d) s += bf2f(qv[d]) * bf2f(ks[(size_t)kpos * 96 + d]); s = s * scale_q + rb[st::rel_bucket_ref(dist) * 16 + head]; }
                    buf[it * 64 + lane] = s; mx = fmaxf(mx, s); }
                mx = st::wave_max(mx); if (!(mx > -1e38f)) mx = 0.f;
                float sum = 0.f;
                for (int it = 0; it < 16; ++it) { const float p = __expf(buf[it * 64 + lane] - mx); buf[it * 64 + lane] = p; sum += p; }
                sum = wave_sum(sum); float inv = 1.f / fmaxf(sum, 1e-30f);
                LDS_WAIT();
                float os = 0.f; for (int i = 0; i < 1024; ++i) { const int kpos = sel[i >> 6] * 64 + (i & 63); os += buf[i] * bf2f(vs[(size_t)kpos * 64 + lane]); }
                oacc[h] += GT[trow * 48 + head * 3 + 1] * os * inv;
                LDS_WAIT();
                mx = -__builtin_inff();
                for (int i = lane; i < 512; i += 64) { const int kpos = qpos - i; float s = -__builtin_inff();
                    if (kpos >= 0) { s = 0.f; for (int d = 0; d < 96; ++d) s += bf2f(qv[d]) * bf2f(kw[(size_t)kpos * 96 + d]); s = s * scale_q + rb[st::rel_bucket_ref(i) * 16 + head]; }
                    buf[i] = s; mx = fmaxf(mx, s); }
                mx = st::wave_max(mx); if (!(mx > -1e38f)) mx = 0.f;
                sum = 0.f;
                for (int i = lane; i < 512; i += 64) { const float p = __expf(buf[i] - mx); buf[i] = p; sum += p; }
                sum = wave_sum(sum); inv = 1.f / fmaxf(sum, 1e-30f);
                LDS_WAIT();
                float ow = 0.f; for (int i = 0; i < 512; ++i) { const int kpos = qpos - i; if (kpos >= 0) ow += buf[i] * bf2f(vw[(size_t)kpos * 64 + lane]); }
                oacc[h] += GT[trow * 48 + head * 3 + 2] * ow * inv;
                LDS_WAIT();
                const float f = bf2f(ONSA[trow * 1024 + head * 64 + lane]);
                err += (f - oacc[h]) * (f - oacc[h]); ref2 += oacc[h] * oacc[h];
            }
        }
        err = wave_sum(err); ref2 = wave_sum(ref2);
        if (lane == 0) { atomicAdd((float*)(ctl + st::CW_ERR), err); atomicAdd((float*)(ctl + st::CW_ERR + 1), ref2); }
        xcd_barrier(bar);
    }
#endif
    REP(15) if (IN(15)) { pg8::Gemm g{ONSA, W_NSAOUT, D, D, D}; SP S; S.init(T / 256, 4, G, bx);
        pg8::EpiRow8<FResF32> E{FResF32{P, nullptr, X2}}; pg8::gemm_phase<pg8::EpiRow8<FResF32>, SP, true, false>(lds, g, S, E); }
    SEAM(15);
    if (IN(16)) {
        PH_LAUNDER();
        LAS float* wr = (LAS float*)(lds + 69632);
        LAS unsigned* lcnt = (LAS unsigned*)(lds + 69632 + 32768);
        LAS unsigned* lrec = lcnt + 16;
        for (int i = tid; i < D * NE; i += 512) wr[i] = args.in[I_ROUTER][i];
        if (tid < 16) lcnt[tid] = 0u;
        __syncthreads();
        int nrec = 0;
        for (int m = gw; m < T; m += NGW, ++nrec) { const f32x4* pr = (const f32x4*)(P + (size_t)m * D) + lane; f32x4 v[4];
#pragma unroll
            for (int j = 0; j < 4; ++j) v[j] = pr[64 * j];
            ln_inplace(v, args.in[I_LNM_G] + D, args.in[I_LNM_B] + D, lane); store_row_bf16(X3 + (size_t)m * D, v, lane);
            float lg[NE];
#pragma unroll
            for (int e = 0; e < NE; ++e) lg[e] = 0.f;
#pragma unroll
            for (int j = 0; j < 4; ++j)
#pragma unroll
                for (int c = 0; c < 4; ++c) { const int k = 4 * lane + 256 * j + c; const f32x4 w0 = *(const LAS f32x4*)(wr + k * 8), w1 = *(const LAS f32x4*)(wr + k * 8 + 4); const float xv = v[j][c];
                    lg[0] += xv * w0[0]; lg[1] += xv * w0[1]; lg[2] += xv * w0[2]; lg[3] += xv * w0[3]; lg[4] += xv * w1[0]; lg[5] += xv * w1[1]; lg[6] += xv * w1[2]; lg[7] += xv * w1[3]; }
#pragma unroll
            for (int e = 0; e < NE; ++e) lg[e] = wave_sum(lg[e]);
            int e0 = 0; float v0 = lg[0];
#pragma unroll
            for (int e = 1; e < NE; ++e) if (lg[e] > v0) { v0 = lg[e]; e0 = e; }
            int e1 = -1; float v1 = -__builtin_inff();
#pragma unroll
            for (int e = 0; e < NE; ++e) if (e != e0 && lg[e] > v1) { v1 = lg[e]; e1 = e; }
            const float w1s = fast_rcp(1.f + __expf(v0 - v1)), w0s = 1.f - w1s;
            if (lane == 0) { const unsigned p0 = atomicAdd((unsigned*)(lcnt + e0), 1u), p1 = atomicAdd((unsigned*)(lcnt + e1), 1u);
                LAS unsigned* r = lrec + (wave * 32 + nrec) * 4; r[0] = (unsigned)m; r[1] = (unsigned)e0 | (p0 << 8); r[2] = (unsigned)e1 | (p1 << 8);
                TOKW[2 * m] = w0s; TOKW[2 * m + 1] = w1s; }
        }
        __syncthreads();
        if (tid < NE) lcnt[8 + tid] = __hip_atomic_fetch_add(ctl + CW_ECNT + 64 * tid, lcnt[tid], RLX_AGENT);
        __syncthreads();
        if (lane == 0) for (int i = 0; i < nrec; ++i) { const LAS unsigned* r = lrec + (wave * 32 + i) * 4; const unsigned m = r[0];
#pragma unroll
            for (int k = 0; k < 2; ++k) { const unsigned e = r[1 + k] & 255u, pos = lcnt[8 + e] + (r[1 + k] >> 8); ROWTOK[e * ECAP + pos] = (int)m; TOKINFO[2 * m + k] = (e << 16) | pos; } }
        for (int e = 0; e < NE; ++e) {
            tr_matrix(args.in[I_MOE_G] + (size_t)e * D * FFE, D, FFE, W_MOEGU + (size_t)e * 2 * FFE * D, D, RmGU{0}, scr, gw, NGW, lane);
            tr_matrix(args.in[I_MOE_U] + (size_t)e * D * FFE, D, FFE, W_MOEGU + (size_t)e * 2 * FFE * D, D, RmGU{128}, scr, gw, NGW, lane);
            tr_matrix(args.in[I_MOE_D] + (size_t)e * FFE * D, FFE, D, W_MOED + (size_t)e * D * FFE, FFE, RmId{0}, scr, gw, NGW, lane);
        }
    }
    SEAM(16);
    REP(17) if (hi_ph > 17 && lo < 27) {
        MoeInfo mi; int acc_t = 0;
#pragma unroll
        for (int e = 0; e < NE; ++e) { const int c = (int)__builtin_amdgcn_readfirstlane(__hip_atomic_load(ctl + CW_ECNT + 64 * e, RLX_AGENT)); mi.cnt[e] = c; mi.ts[e] = acc_t; acc_t += (c + 255) >> 8; }
        mi.ts[NE] = acc_t;
        for (int c = 0; c < 5; ++c) {
            const int ct0 = 64 * c; int nM = acc_t - ct0; nM = nM < 0 ? 0 : (nM > 64 ? 64 : nM);
            if (IN(17 + 2 * c) && nM > 0) { pg8::Gemm g{X3, W_MOEGU, D, D, D}; SchedMoeGU S; S.so.init(nM, 2 * FFE / 256, G, bx); S.mi = mi; S.ct0 = ct0; S.rowtok = ROWTOK;
                pg8::EpiGateUp<FSwiglu> E{FSwiglu{ACTC, FFE, 0}}; pg8::gemm_phase<pg8::EpiGateUp<FSwiglu>, SchedMoeGU, true, true>(lds, g, S, E); }
            SEAM(17 + 2 * c);
            if (IN(18 + 2 * c) && nM > 0) { pg8::Gemm g{ACTC, W_MOED, FFE, FFE, FFE}; SchedMoeD S; S.so.init(nM, 4, G, bx); S.mi = mi; S.ct0 = ct0;
                pg8::EpiRow8<FBf16> E{FBf16{DOUT, D, ct0 * 256}}; pg8::gemm_phase<pg8::EpiRow8<FBf16>, SchedMoeD, true, false>(lds, g, S, E); }
            SEAM(18 + 2 * c);
        }
    }
    REP(27) if (IN(27)) {
        PH_LAUNDER();
        int ts[NE]; { int acc_t = 0;
#pragma unroll
            for (int e = 0; e < NE; ++e) { const int c = (int)__builtin_amdgcn_readfirstlane(__hip_atomic_load(ctl + CW_ECNT + 64 * e, RLX_AGENT)); ts[e] = acc_t; acc_t += (c + 255) >> 8; } }
        for (int m = gw; m < T; m += NGW) {
            const unsigned i0 = TOKINFO[2 * m], i1 = TOKINFO[2 * m + 1]; const float w0 = TOKW[2 * m], w1 = TOKW[2 * m + 1];
            int t0 = 0, t1 = 0;
#pragma unroll
            for (int e = 0; e < NE; ++e) { t0 = ((int)(i0 >> 16) == e) ? ts[e] : t0; t1 = ((int)(i1 >> 16) == e) ? ts[e] : t1; }
            const size_t r0 = (size_t)t0 * 256 + (i0 & 0xffffu), r1 = (size_t)t1 * 256 + (i1 & 0xffffu);
            const u32x2* xr = (const u32x2*)(X3 + (size_t)m * D) + lane; const u32x2* d0 = (const u32x2*)(DOUT + r0 * D) + lane; const u32x2* d1 = (const u32x2*)(DOUT + r1 * D) + lane;
            f32x4 v[4];
#pragma unroll
            for (int j = 0; j < 4; ++j) v[j] = bf4_to_f32(xr[64 * j]) * ALPHA + (bf4_to_f32(d0[64 * j]) * w0 + bf4_to_f32(d1[64 * j]) * w1);
            ln_inplace(v, args.in[I_LNF_G] + D, args.in[I_LNF_B] + D, lane);
            f32x4* orow = (f32x4*)(args.out + (size_t)m * D) + lane;
#pragma unroll
            for (int j = 0; j < 4; ++j) orow[64 * j] = v[j];
        }
    }

#if defined(SELFTEST)
    {
        xcd_barrier(bar);
        const float e2 = __hip_atomic_load((float*)(ctl + st::CW_ERR), RLX_AGENT), r2 = __hip_atomic_load((float*)(ctl + st::CW_ERR + 1), RLX_AGENT);
        const float E = e2 / r2; float code = -log10f(E); code = code < 0.f ? 0.f : (code > 9.9f ? 9.9f : code);
        const float A = (E == E && r2 > 0.f) ? sqrtf(100.f * code) : 40.f;
        for (long i = (long)vcu * 512 + tid_; i < (long)T * D / 4; i += (long)G * 512) ((f32x4*)args.out)[i] = (f32x4){A, A, A, A};
    }
#endif
#undef IN
#undef SEAM
#undef REP
#undef W_MLAIN
#undef W_QUP
#undef W_KVUP
#undef W_MLAOUT
#undef W_FFNGU
#undef W_FFND
#undef W_NSAIN
#undef W_NSAOUT
#undef W_C1K
#undef W_C1V
#undef W_C2K
#undef W_C2V
#undef ROPE_C
#undef CBIAS
#undef RBT
#undef ROWTOK
#undef TOKINFO
#undef TOKW
#undef XB
#undef LAT
#undef QN
#undef KVN
#undef KR
#undef Q
#undef KN
#undef V
#undef O
#undef X1
#undef ACT
#undef X2
#undef NQ
#undef KC
#undef VC
#undef KS
#undef VS
#undef KW
#undef VW
#undef GT
#undef HK
#undef HV
#undef KCMP
#undef VCMP
#undef ONSA
#undef X3
#undef W_MOEGU
#undef W_MOED
#undef DOUT
#undef ROPE_S
#undef P
#undef ACTC
#undef PH_LAUNDER
}

#ifndef MK_PER_PHASE
#define MK_PER_PHASE 0
#endif
extern "C" void kernel_launch(void* const* d_in, const int* in_sizes, int n_in, void* d_out, int out_size, void* d_ws, size_t ws_size, hipStream_t stream) {
    static int grid = 0;
    if (grid == 0) {
        if (n_in != 27 || out_size != T * D || ws_size < WS_END) { fprintf(stderr, "kernel_launch: unexpected shapes (n_in %d out %d ws %zu)\n", n_in, out_size, ws_size); grid = -1; return; }
        int dev = 0, cus = 0, per_cu = 0;
        if (hipGetDevice(&dev) != hipSuccess || hipDeviceGetAttribute(&cus, hipDeviceAttributeMultiprocessorCount, dev) != hipSuccess) { grid = -1; return; }
        if (hipFuncSetAttribute((const void*)fwd, hipFuncAttributeMaxDynamicSharedMemorySize, LDS_BYTES) != hipSuccess) { fprintf(stderr, "kernel_launch: hipFuncSetAttribute failed\n"); grid = -1; return; }
        if (hipOccupancyMaxActiveBlocksPerMultiprocessor(&per_cu, (const void*)fwd, NWAVES * 64, LDS_BYTES) != hipSuccess || per_cu < 1) { fprintf(stderr, "kernel_launch: occupancy query reports %d\n", per_cu); }
        (void)hipGetLastError();
        grid = cus;
    }
    if (grid < 0) return;
    if (hipMemsetAsync((char*)d_ws + WS_CTL, 0, CTL_ZERO_BYTES, stream) != hipSuccess) return;
    Args a{};
    for (int i = 0; i < 27; ++i) a.in[i] = (const float*)d_in[i];
    a.out = (float*)d_out; a.ws = (unsigned char*)d_ws;
#if MK_PER_PHASE
    for (int p = 0; p < N_PHASES; ++p) { a.ph_lo = p; a.ph_hi = p + 1; hipLaunchKernelGGL(fwd, dim3(grid), dim3(NWAVES * 64), LDS_BYTES, stream, a); }
#else
    a.ph_lo = 0; a.ph_hi = N_PHASES;
    hipLaunchKernelGGL(fwd, dim3(grid), dim3(NWAVES * 64), LDS_BYTES, stream, a);
#endif
}
```

```cpp
#include <hip/hip_runtime.h>
#include <cstdio>
#include <cstdint>

#define LAS __attribute__((address_space(3)))
#define GAS __attribute__((address_space(1)))
typedef unsigned short bf16_t;
typedef short bf16x8 __attribute__((ext_vector_type(8)));
typedef short s16x4 __attribute__((ext_vector_type(4)));
typedef float f32x4 __attribute__((ext_vector_type(4)));
typedef float f32x2 __attribute__((ext_vector_type(2)));
typedef float f32x16 __attribute__((ext_vector_type(16)));
typedef unsigned u32x4 __attribute__((ext_vector_type(4)));
typedef unsigned u32x2 __attribute__((ext_vector_type(2)));

#ifndef MOE_FP8
#define MOE_FP8 1
#endif
constexpr int NB = 4, SEQ = 8192, T = NB * SEQ, D = 1024;
constexpr int MLA_H = 8, MLA_QR = 512, MLA_KVR = 256, MLA_DQK = 192, MLA_DV = 128, MLA_IN = 832;
constexpr int NSA_G = 4, NSA_DK = 96, NSA_DV = 64, NSA_IN = 3504, NSA_INP = 3584;
constexpr int FF = 2816, NE = 8, FFE = 3584, ECAP = 32768;
constexpr float ALPHA = 1.41421356237309515f;
constexpr float LOG2E = 1.4426950408889634f;
constexpr float C2_MLA = 0.07216878364870323f * LOG2E;
constexpr float C2_NSA = 0.10206207261596577f * LOG2E;

__device__ __forceinline__ unsigned cvt_pk_bf16(float lo, float hi) { unsigned r; asm volatile("v_cvt_pk_bf16_f32 %0, %1, %2" : "=v"(r) : "v"(lo), "v"(hi)); return r; }
__device__ __forceinline__ float bf2f(unsigned short h) { return __uint_as_float(((unsigned)h) << 16); }
__device__ __forceinline__ float bflo(unsigned w) { return __uint_as_float(w << 16); }
__device__ __forceinline__ float bfhi(unsigned w) { return __uint_as_float(w & 0xffff0000u); }
__device__ __forceinline__ float fast_exp2(float x) { return __builtin_amdgcn_exp2f(x); }
__device__ __forceinline__ float fast_rcp(float x) { return __builtin_amdgcn_rcpf(x); }
__device__ __forceinline__ float silu_f(float x) { return x * fast_rcp(1.f + fast_exp2(-x * LOG2E)); }
__device__ __forceinline__ float sigmoid_f(float x) { return fast_rcp(1.f + fast_exp2(-x * LOG2E)); }
__device__ __forceinline__ float gelu_tanh_f(float x) {
    const float z = 0.7978845608028654f * (x + 0.044715f * x * x * x);
    return x * fast_rcp(1.f + fast_exp2(-2.f * LOG2E * z));
}

namespace pg8 {
constexpr int BM = 256, BK = 64, HALF = 128, HTB = HALF * BK * 2, STAGE_BYTES = 8 * HTB, NXCD = 8, WGM = 8;
__host__ __device__ __forceinline__ int lds_byte(int r, int c) { const int st = (r >> 4) * 2 + (c >> 5), rr = r & 15, cc = c & 31, ob = rr * 64 + cc * 2; return st * 1024 + (ob ^ (((ob >> 9) & 1) << 5)); }
__host__ __device__ __forceinline__ void stage_rc(int b, int& R, int& C) { const int st = b / 1024, sb = b % 1024, swz = sb ^ (((sb >> 9) & 1) << 5); R = (st >> 1) * 16 + swz / 64; C = (st & 1) * 32 + (swz % 64) / 2; }
__host__ __device__ __forceinline__ int perm32(int rho) { const int n = rho >> 4, i = rho & 15; return 8 * (i >> 2) + 4 * n + (i & 3); }

typedef int v8i32 __attribute__((ext_vector_type(8)));
__device__ __forceinline__ v8i32 cat8(bf16x8 a, bf16x8 b) { const u32x4 x = __builtin_bit_cast(u32x4, a), y = __builtin_bit_cast(u32x4, b); return (v8i32){(int)x[0], (int)x[1], (int)x[2], (int)x[3], (int)y[0], (int)y[1], (int)y[2], (int)y[3]}; }
struct Unit { int pm, pn; };
struct Gemm { const void* A; const void* Bt; int lda, ldb, K; };

struct StaticOrder {
    int nM, nN, nwg, G, c;
    __device__ void init(int nM_, int nN_, int G_, int c_) { nM = nM_; nN = nN_; nwg = nM * nN; G = G_; c = c_; }
    __device__ bool next(int i, Unit& u) const {
        const long L = (long)i * G + c; if (L >= nwg) return false;
        int wgid = (int)L; { const int q = nwg / NXCD, r = nwg % NXCD, xcd = wgid % NXCD, off = wgid / NXCD; wgid = (xcd < r ? xcd * (q + 1) : r * (q + 1) + (xcd - r) * q) + off; }
        const int nig = WGM * nN, gid = wgid / nig, fm = gid * WGM, gsz = (nM - fm) < WGM ? (nM - fm) : WGM;
        u.pm = fm + ((wgid % nig) % gsz); u.pn = (wgid % nig) / gsz; return true;
    }
};
struct SchedPlain {
    StaticOrder so;
    __device__ void init(int nM, int nN, int G, int c) { so.init(nM, nN, G, c); }
    __device__ __forceinline__ bool next(int i, Unit& u) const { return so.next(i, u); }
    __device__ __forceinline__ size_t a_off(const Unit& u, const Gemm& g) const { return (size_t)u.pm * 256 * g.lda; }
    __device__ __forceinline__ size_t b_off(const Unit& u, const Gemm& g) const { return (size_t)u.pn * 256 * g.ldb; }
    __device__ __forceinline__ unsigned a_row(const Unit&, int) const { return 0u; }
};

template <class F> struct EpiRow8 {
    static constexpr bool PERM = true;
    F f;
    __device__ __forceinline__ void operator()(const f32x4 (&acc)[2][2][4][2], const Unit& u, int wr, int wc, int fr, int fq) const {
#pragma unroll
        for (int ai = 0; ai < 2; ++ai)
#pragma unroll
            for (int m = 0; m < 4; ++m) { const int row = u.pm * BM + ai * HALF + wr * 64 + m * 16 + fr;
#pragma unroll
                for (int bj = 0; bj < 2; ++bj) f(row, u.pn * BM + bj * HALF + wc * 32 + 8 * fq, acc[ai][bj][m][0], acc[ai][bj][m][1]); }
    }
};
template <class F> struct EpiGateUp {
    static constexpr bool PERM = true;
    F f;
    __device__ __forceinline__ void operator()(const f32x4 (&acc)[2][2][4][2], const Unit& u, int wr, int wc, int fr, int fq) const {
#pragma unroll
        for (int ai = 0; ai < 2; ++ai)
#pragma unroll
            for (int m = 0; m < 4; ++m) { const int row = u.pm * BM + ai * HALF + wr * 64 + m * 16 + fr;
                f(row, u.pn * HALF + wc * 32 + 8 * fq, acc[ai][0][m][0], acc[ai][0][m][1], acc[ai][1][m][0], acc[ai][1][m][1]); }
    }
};

template <class Epi, class Sched, bool ALIGN_EPI, bool GATHER, bool FP8 = false>
__device__ __forceinline__ void gemm_phase(LAS unsigned char* lds, const Gemm g, const Sched& S, const Epi& E) {
    int tid = threadIdx.x; asm volatile("" : "+v"(tid));
    const int wid = __builtin_amdgcn_readfirstlane(tid >> 6), lane = tid & 63, wr = wid >> 2, wc = wid & 3, fr = lane & 15, fq = lane >> 4;
    const int nt = g.K / (BK * 2);
    int sR[2], sC[2]; unsigned voffB[2];
#pragma unroll
    for (int i = 0; i < 2; ++i) { int R, C; stage_rc(tid * 16 + i * 8192, R, C); sR[i] = R; sC[i] = C; const int Rb = Epi::PERM ? ((R & ~31) + perm32(R & 31)) : R; voffB[i] = (unsigned)(Rb * g.ldb + C * 2); }
    const int kstep = BK * 2;
    const int hstepB = HALF * g.ldb;
    const auto rsA = __builtin_amdgcn_make_buffer_rsrc((void*)g.A, 0, 0x7fffffff, 0x00020000);
    const auto rsB = __builtin_amdgcn_make_buffer_rsrc((void*)g.Bt, 0, 0x7fffffff, 0x00020000);
    const unsigned ldsw = (unsigned)wid * 1024u;
    const int aoff = lds_byte(wr * 64 + fr, fq * 8), boff = lds_byte(wc * 32 + fr, fq * 8);
#define PG8_SA(b, h) (((b) * 2 + (h)) * HTB)
#define PG8_SB(b, h) ((4 + (b) * 2 + (h)) * HTB)
#define PG8_STAGE2(bufoff, rsrc, soff, o0, o1) do { \
        __builtin_amdgcn_raw_ptr_buffer_load_lds(rsrc, (LAS unsigned*)(lds + (bufoff) + ldsw), 16, (int)(o0), (int)(soff), 0, 0); \
        __builtin_amdgcn_raw_ptr_buffer_load_lds(rsrc, (LAS unsigned*)(lds + (bufoff) + ldsw + 8192), 16, (int)(o1), (int)(soff), 0, 0); } while (0)
#define PG8_STAGEA(bufoff, soff, o0, o1) PG8_STAGE2(bufoff, rsA, soff, o0, o1)
#define PG8_STAGEB(bufoff, soff) PG8_STAGE2(bufoff, rsB, soff, voffB[0], voffB[1])
#define PG8_LDA(dst, b, h) do { _Pragma("unroll") for (int m = 0; m < 4; ++m) _Pragma("unroll") for (int k = 0; k < 2; ++k) dst[m][k] = *(const LAS bf16x8*)(lds + PG8_SA(b, h) + aoff + m * 2048 + k * 1024); } while (0)
#define PG8_LDB(dst, b, h) do { _Pragma("unroll") for (int n = 0; n < 2; ++n) _Pragma("unroll") for (int k = 0; k < 2; ++k) dst[n][k] = *(const LAS bf16x8*)(lds + PG8_SB(b, h) + boff + n * 2048 + k * 1024); } while (0)
#define PG8_MMA(ai, bj, At, Bt) do { __builtin_amdgcn_s_setprio(1); \
        if constexpr (FP8) { _Pragma("unroll") for (int m = 0; m < 4; ++m) _Pragma("unroll") for (int n = 0; n < 2; ++n) \
            acc[ai][bj][m][n] = __builtin_amdgcn_mfma_scale_f32_16x16x128_f8f6f4(cat8(Bt[n][0], Bt[n][1]), cat8(At[m][0], At[m][1]), acc[ai][bj][m][n], 0, 0, 0, 127, 0, 127); } \
        else { _Pragma("unroll") for (int m = 0; m < 4; ++m) _Pragma("unroll") for (int n = 0; n < 2; ++n) _Pragma("unroll") for (int k = 0; k < 2; ++k) \
            acc[ai][bj][m][n] = __builtin_amdgcn_mfma_f32_16x16x32_bf16(Bt[n][k], At[m][k], acc[ai][bj][m][n], 0, 0, 0); } \
        __builtin_amdgcn_s_setprio(0); } while (0)
#define PG8_WAIT_V(n) asm volatile("s_waitcnt vmcnt(" #n ")" ::: "memory")
#define PG8_WAIT_L(n) asm volatile("s_waitcnt lgkmcnt(" #n ")" ::: "memory")
#define PG8_BAR __builtin_amdgcn_s_barrier()
#define PG8_SCHED __builtin_amdgcn_sched_barrier(0)
    Unit cur, nxt; int ui = 0;
    if (!S.next(0, cur)) return;
    f32x4 acc[2][2][4][2];
#pragma unroll
    for (int a = 0; a < 2; ++a)
#pragma unroll
        for (int b = 0; b < 2; ++b)
#pragma unroll
            for (int m = 0; m < 4; ++m)
#pragma unroll
                for (int n = 0; n < 2; ++n) acc[a][b][m][n] = (f32x4){0.f, 0.f, 0.f, 0.f};
    bf16x8 At[4][2], B0[2][2], B1[2][2];
    unsigned vc[2][2], vn[2][2];
#pragma unroll
    for (int h = 0; h < 2; ++h)
#pragma unroll
        for (int i = 0; i < 2; ++i) { vc[h][i] = GATHER ? S.a_row(cur, h * HALF + sR[i]) + (unsigned)sC[i] * 2u : (unsigned)((h * HALF + sR[i]) * g.lda + sC[i] * 2); vn[h][i] = vc[h][i]; }
    int cA = (int)S.a_off(cur, g), cB = (int)S.b_off(cur, g);
    PG8_STAGEB(PG8_SB(0, 0), cB); PG8_STAGEB(PG8_SB(0, 1), cB + hstepB); PG8_STAGEA(PG8_SA(0, 0), cA, vc[0][0], vc[0][1]); PG8_STAGEA(PG8_SA(0, 1), cA, vc[1][0], vc[1][1]);
    if (wr == 1) PG8_BAR;
    PG8_WAIT_V(2); PG8_BAR;
    PG8_STAGEB(PG8_SB(1, 0), cB + kstep); PG8_STAGEA(PG8_SA(1, 0), cA + kstep, vc[0][0], vc[0][1]); PG8_STAGEB(PG8_SB(1, 1), cB + hstepB + kstep);
    PG8_WAIT_V(6); PG8_BAR;
    for (;;) {
        const bool has_next = S.next(ui + 1, nxt);
        const int nA = has_next ? (int)S.a_off(nxt, g) : cA, nB = has_next ? (int)S.b_off(nxt, g) : cB;
        if (GATHER) {
#pragma unroll
            for (int h = 0; h < 2; ++h)
#pragma unroll
                for (int i = 0; i < 2; ++i) vn[h][i] = has_next ? S.a_row(nxt, h * HALF + sR[i]) + (unsigned)sC[i] * 2u : vc[h][i];
        }
#pragma clang loop unroll(disable)
        for (int t = 0; t < nt; t += 2) {
            const bool last = (t == nt - 2);
            const int a1 = cA + (t + 1) * kstep;
            const int a2 = last ? nA : cA + (t + 2) * kstep, b2 = last ? nB : cB + (t + 2) * kstep;
            const int a3 = a2 + kstep, b3 = b2 + kstep;
            unsigned w00, w01, w10, w11;
            if (GATHER) { w00 = last ? vn[0][0] : vc[0][0]; w01 = last ? vn[0][1] : vc[0][1]; w10 = last ? vn[1][0] : vc[1][0]; w11 = last ? vn[1][1] : vc[1][1]; }
            else { w00 = vc[0][0]; w01 = vc[0][1]; w10 = vc[1][0]; w11 = vc[1][1]; }
            PG8_LDB(B0, 0, 0); PG8_LDB(B1, 0, 1); PG8_SCHED; PG8_LDA(At, 0, 0); PG8_STAGEA(PG8_SA(1, 1), a1, vc[1][0], vc[1][1]);
            PG8_WAIT_V(8); PG8_WAIT_L(0); PG8_BAR; PG8_MMA(0, 0, At, B0); PG8_MMA(0, 1, At, B1); PG8_BAR; PG8_SCHED;
            PG8_LDA(At, 0, 1); PG8_STAGEB(PG8_SB(0, 0), b2); PG8_STAGEB(PG8_SB(0, 1), b2 + hstepB); PG8_STAGEA(PG8_SA(0, 0), a2, w00, w01);
            PG8_WAIT_V(8); PG8_WAIT_L(0); PG8_BAR; PG8_MMA(1, 0, At, B0); PG8_MMA(1, 1, At, B1); PG8_BAR; PG8_SCHED;
            PG8_LDB(B0, 1, 0); PG8_LDB(B1, 1, 1); PG8_SCHED; PG8_LDA(At, 1, 0); PG8_STAGEA(PG8_SA(0, 1), a2, w10, w11);
            PG8_WAIT_V(8); PG8_WAIT_L(0); PG8_BAR; PG8_MMA(0, 0, At, B0); PG8_MMA(0, 1, At, B1); PG8_BAR; PG8_SCHED;
            PG8_LDA(At, 1, 1); PG8_STAGEB(PG8_SB(1, 0), b3); PG8_STAGEB(PG8_SB(1, 1), b3 + hstepB); PG8_STAGEA(PG8_SA(1, 0), a3, w00, w01);
            PG8_WAIT_V(8); PG8_WAIT_L(0); PG8_BAR; PG8_MMA(1, 0, At, B0); PG8_MMA(1, 1, At, B1); PG8_BAR; PG8_SCHED;
        }
        if constexpr (ALIGN_EPI) { if (wr == 0) PG8_BAR; }
        E(acc, cur, wr, wc, fr, fq);
        if (!has_next) break;
#pragma unroll
        for (int a = 0; a < 2; ++a)
#pragma unroll
            for (int b = 0; b < 2; ++b)
#pragma unroll
                for (int m = 0; m < 4; ++m)
#pragma unroll
                    for (int n = 0; n < 2; ++n) acc[a][b][m][n] = (f32x4){0.f, 0.f, 0.f, 0.f};
        cur = nxt; cA = nA; cB = nB; ++ui;
        if (GATHER) {
#pragma unroll
            for (int h = 0; h < 2; ++h)
#pragma unroll
                for (int i = 0; i < 2; ++i) vc[h][i] = vn[h][i];
        }
        if constexpr (ALIGN_EPI) { if (wr == 1) PG8_BAR; }
    }
    PG8_WAIT_V(0);
    if constexpr (!ALIGN_EPI) { if (wr == 0) PG8_BAR; }
    PG8_BAR;
#undef PG8_SA
#undef PG8_SB
#undef PG8_STAGE2
#undef PG8_STAGEA
#undef PG8_STAGEB
#undef PG8_LDA
#undef PG8_LDB
#undef PG8_MMA
#undef PG8_WAIT_V
#undef PG8_WAIT_L
#undef PG8_BAR
#undef PG8_SCHED
}
}
#if defined(__HIP_DEVICE_COMPILE__)
namespace att {
__device__ __forceinline__ int crow(int r, int hi) { return (r & 3) + 8 * (r >> 2) + 4 * hi; }
constexpr float THR = 6.f;
constexpr int NBUF = 3;
struct MlaRing { static constexpr int NS = 3, NI = 46, NPW = 6, BUF = 47104;
    static __device__ __forceinline__ constexpr int OFF(int s) { return s == 0 ? 0 : (s == 1 ? 17408 : 26624); }
    static __device__ __forceinline__ constexpr int NK(int s) { return s == 0 ? 17 : (s == 1 ? 9 : 20); }
    static __device__ __forceinline__ constexpr int GS(int s) { return s == 1 ? 128 : 256; }
    static __device__ __forceinline__ constexpr int CH(int s) { return s == 1 ? 8 : 16; }
    static __device__ __forceinline__ constexpr int ROW(int s) { return s == 0 ? 272 : (s == 1 ? 144 : 320); } };
struct NsaRing { static constexpr int NS = 2, NI = 25, NPW = 4, BUF = 25600;
    static __device__ __forceinline__ constexpr int OFF(int s) { return s == 0 ? 0 : 13312; }
    static __device__ __forceinline__ constexpr int NK(int s) { return s == 0 ? 13 : 12; }
    static __device__ __forceinline__ constexpr int GS(int s) { return s == 0 ? 192 : 128; }
    static __device__ __forceinline__ constexpr int CH(int s) { return s == 0 ? 12 : 8; }
    static __device__ __forceinline__ constexpr int ROW(int s) { return s == 0 ? 208 : 192; } };
typedef __amdgpu_buffer_rsrc_t rsrc_t;
__device__ __forceinline__ rsrc_t make_rsrc(const void* p) { return __builtin_amdgcn_make_buffer_rsrc((void*)p, 0, 0x7fffffff, 0x00020000); }
template <class R> struct Plan {
    int ldsd[R::NPW]; int strm[R::NPW]; int jj[R::NPW]; int lane16;
    __device__ __forceinline__ void init(int wid, int lane) {
        lane16 = 16 * lane;
#pragma unroll
        for (int k = 0; k < R::NPW; ++k) { int j = wid + 8 * k; if (j >= R::NI) j -= R::NI;
            int s = 0, q_ = j;
#pragma unroll
            for (int q = 0; q + 1 < R::NS; ++q) if (q_ >= R::NK(q) && s == q) { q_ -= R::NK(q); s = q + 1; }
            strm[k] = s; jj[k] = q_; ldsd[k] = (s == 0 ? R::OFF(0) : (s == 1 ? R::OFF(1) : R::OFF(R::NS - 1))) + 1024 * q_; }
    }
    template <int S> __device__ __forceinline__ int voff(int k) const { const int x = 1024 * jj[k] + lane16, r = x / R::ROW(S), cc = (x - r * R::ROW(S)) >> 4; return r * R::GS(S) + (cc < R::CH(S) ? cc : 0) * 16; }
};
template <class R> struct Src { rsrc_t rs0, rs1, rs2; int t0; };
template <class R> __device__ __forceinline__ void issue_tile(const Plan<R>& p, const Src<R>& src, int t, LAS char* buf) {
#pragma unroll
    for (int k = 0; k < R::NPW; ++k) { const int s = p.strm[k];
        if (s == 0) __builtin_amdgcn_raw_ptr_buffer_load_lds(src.rs0, (LAS unsigned*)(buf + p.ldsd[k]), 16, p.template voff<0>(k), (src.t0 + t) * 64 * R::GS(0), 0, 0);
        else if (s == 1 || R::NS == 2) __builtin_amdgcn_raw_ptr_buffer_load_lds(src.rs1, (LAS unsigned*)(buf + p.ldsd[k]), 16, p.template voff<1>(k), (src.t0 + t) * 64 * R::GS(1), 0, 0);
        else __builtin_amdgcn_raw_ptr_buffer_load_lds(src.rs2, (LAS unsigned*)(buf + p.ldsd[k]), 16, p.template voff<R::NS - 1>(k), (src.t0 + t) * 64 * R::GS(R::NS - 1), 0, 0); }
}
#define ATT_WAIT_V(n) asm volatile("s_waitcnt vmcnt(%0)" :: "i"(n) : "memory")
template <class R, int DQK> __device__ __forceinline__ void qk_tile(f32x16& p0, f32x16& p1, LAS const char* Kb, int r32, int hi, const bf16x8* qr, const f32x16& cinit) {
    p0 = cinit; p1 = cinit;
    if constexpr (R::NS == 3) {
        LAS const char* a = Kb + r32 * R::ROW(0) + hi * 16; LAS const char* b = Kb + R::OFF(1) + r32 * R::ROW(1) + hi * 16;
#pragma unroll
        for (int d0 = 0; d0 < 8; ++d0) { const bf16x8 k0 = *(LAS const bf16x8*)(a + d0 * 32); const bf16x8 k1 = *(LAS const bf16x8*)(a + 32 * R::ROW(0) + d0 * 32);
            p0 = __builtin_amdgcn_mfma_f32_32x32x16_bf16(k0, qr[d0], p0, 0, 0, 0); p1 = __builtin_amdgcn_mfma_f32_32x32x16_bf16(k1, qr[d0], p1, 0, 0, 0); }
#pragma unroll
        for (int d0 = 0; d0 < 4; ++d0) { const bf16x8 k0 = *(LAS const bf16x8*)(b + d0 * 32); const bf16x8 k1 = *(LAS const bf16x8*)(b + 32 * R::ROW(1) + d0 * 32);
            p0 = __builtin_amdgcn_mfma_f32_32x32x16_bf16(k0, qr[8 + d0], p0, 0, 0, 0); p1 = __builtin_amdgcn_mfma_f32_32x32x16_bf16(k1, qr[8 + d0], p1, 0, 0, 0); }
    } else {
        LAS const char* a = Kb + r32 * R::ROW(0) + hi * 16;
#pragma unroll
        for (int d0 = 0; d0 < DQK / 16; ++d0) { const bf16x8 k0 = *(LAS const bf16x8*)(a + d0 * 32); const bf16x8 k1 = *(LAS const bf16x8*)(a + 32 * R::ROW(0) + d0 * 32);
            p0 = __builtin_amdgcn_mfma_f32_32x32x16_bf16(k0, qr[d0], p0, 0, 0, 0); p1 = __builtin_amdgcn_mfma_f32_32x32x16_bf16(k1, qr[d0], p1, 0, 0, 0); }
    }
}
template <int DV, int VROW> __device__ __forceinline__ void pv_tile(f32x16* o, unsigned vaddr, bf16x8 pa0, bf16x8 pa1, bf16x8 pa2, bf16x8 pa3) {
#define ATT_TRRD(dst, off) asm volatile("ds_read_b64_tr_b16 %0, %1 offset:%2" : "=&v"(dst) : "v"(vaddr), "i"(off) : "memory")
#pragma unroll
    for (int d0 = 0; d0 < DV / 32; ++d0) {
        { s16x4 l0, l1, h0, h1;
        ATT_TRRD(l0, (0 * 16 + 0) * VROW + d0 * 64); ATT_TRRD(h0, (0 * 16 + 4) * VROW + d0 * 64);
        ATT_TRRD(l1, (1 * 16 + 0) * VROW + d0 * 64); ATT_TRRD(h1, (1 * 16 + 4) * VROW + d0 * 64);
        asm volatile("s_waitcnt lgkmcnt(0)" ::: "memory"); __builtin_amdgcn_sched_barrier(0);
        o[d0] = __builtin_amdgcn_mfma_f32_32x32x16_bf16(pa0, (bf16x8){l0[0], l0[1], l0[2], l0[3], h0[0], h0[1], h0[2], h0[3]}, o[d0], 0, 0, 0);
        o[d0] = __builtin_amdgcn_mfma_f32_32x32x16_bf16(pa1, (bf16x8){l1[0], l1[1], l1[2], l1[3], h1[0], h1[1], h1[2], h1[3]}, o[d0], 0, 0, 0); }
        { s16x4 l2, l3, h2, h3;
        ATT_TRRD(l2, (2 * 16 + 0) * VROW + d0 * 64); ATT_TRRD(h2, (2 * 16 + 4) * VROW + d0 * 64);
        ATT_TRRD(l3, (3 * 16 + 0) * VROW + d0 * 64); ATT_TRRD(h3, (3 * 16 + 4) * VROW + d0 * 64);
        asm volatile("s_waitcnt lgkmcnt(0)" ::: "memory"); __builtin_amdgcn_sched_barrier(0);
        o[d0] = __builtin_amdgcn_mfma_f32_32x32x16_bf16(pa2, (bf16x8){l2[0], l2[1], l2[2], l2[3], h2[0], h2[1], h2[2], h2[3]}, o[d0], 0, 0, 0);
        o[d0] = __builtin_amdgcn_mfma_f32_32x32x16_bf16(pa3, (bf16x8){l3[0], l3[1], l3[2], l3[3], h3[0], h3[1], h3[2], h3[3]}, o[d0], 0, 0, 0); }
    }
#undef ATT_TRRD
}
__device__ __forceinline__ float lane_pair_max(float v) { auto rr = __builtin_amdgcn_permlane32_swap(__float_as_uint(v), __float_as_uint(v), false, false); return fmaxf(__uint_as_float(rr[0]), __uint_as_float(rr[1])); }
__device__ __forceinline__ float lane_pair_sum(float v) { auto rr = __builtin_amdgcn_permlane32_swap(__float_as_uint(v), __float_as_uint(v), false, false); return __uint_as_float(rr[0]) + __uint_as_float(rr[1]); }
__device__ __forceinline__ void pack_p(const f32x16& p0, const f32x16& p1, bf16x8& pa0, bf16x8& pa1, bf16x8& pa2, bf16x8& pa3) {
#define ATT_PK4(P, B_, OUT) do { unsigned a0 = cvt_pk_bf16(P[B_ + 0], P[B_ + 1]), a1 = cvt_pk_bf16(P[B_ + 2], P[B_ + 3]); \
        unsigned b0 = cvt_pk_bf16(P[B_ + 4], P[B_ + 5]), b1 = cvt_pk_bf16(P[B_ + 6], P[B_ + 7]); \
        auto r0 = __builtin_amdgcn_permlane32_swap(a0, b0, false, false); auto r1 = __builtin_amdgcn_permlane32_swap(a1, b1, false, false); \
        u32x4 w = {r0[0], r1[0], r0[1], r1[1]}; OUT = __builtin_bit_cast(bf16x8, w); } while (0)
    ATT_PK4(p0, 0, pa0); ATT_PK4(p0, 8, pa1); ATT_PK4(p1, 0, pa2); ATT_PK4(p1, 8, pa3);
#undef ATT_PK4
}
template <class R, class Body> __device__ __forceinline__ void ring_loop(LAS char* lds, const Plan<R>& plan, const Src<R>& src, int nt, Body&& body) {
    issue_tile<R>(plan, src, 0, lds); if (nt > 1) issue_tile<R>(plan, src, 1, lds + R::BUF);
    if (nt > 1) ATT_WAIT_V(R::NPW); else ATT_WAIT_V(0);
    __builtin_amdgcn_s_barrier();
    int bi = 0;
    for (int t = 0; t < nt; ++t) {
        if (t + 2 < nt) { const int b2 = bi == 0 ? 2 : bi - 1; issue_tile<R>(plan, src, t + 2, lds + b2 * R::BUF); }
        body(t, lds + bi * R::BUF);
        if (t + 2 < nt) ATT_WAIT_V(R::NPW); else ATT_WAIT_V(0);
        __builtin_amdgcn_s_barrier(); bi = bi == 2 ? 0 : bi + 1;
    }
}
template <class R, class Body> __device__ __forceinline__ void ring_loop1(LAS char* lds, const Plan<R>& plan, const Src<R>& src, int nt, Body&& body) {
    issue_tile<R>(plan, src, 0, lds); ATT_WAIT_V(0);
    __builtin_amdgcn_s_barrier();
    int bi = 0;
    for (int t = 0; t < nt; ++t) {
        const int bn = bi == 2 ? 0 : bi + 1;
        if (t + 1 < nt) issue_tile<R>(plan, src, t + 1, lds + bn * R::BUF);
        body(t, lds + bi * R::BUF);
        ATT_WAIT_V(0);
        __builtin_amdgcn_s_barrier(); bi = bn;
    }
}
template <class R, int DQK, int DV, bool DO_PV, class Msk, int DBG = 0, bool NEGM = true>
__device__ __forceinline__ void run_online(LAS char* lds, LAS float* wsc, int nt, const Plan<R>& plan, const Src<R>& src, const Msk& msk, const bf16x8* qr, float& m_reg, float& l_reg, f32x16* o, int lane, int wid) {
    const int r32 = lane & 31, hi = lane >> 5;
    if (nt <= 0) return;
    constexpr int VROW = R::ROW(R::NS - 1), VOFF = R::OFF(R::NS - 1);
    const unsigned vlane = (unsigned)((8 * hi + ((lane & 15) >> 2)) * VROW + (16 * ((lane >> 4) & 1) + 4 * (lane & 3)) * 2);
    f32x16 negm;
#pragma unroll
    for (int r = 0; r < 16; ++r) negm[r] = NEGM ? -m_reg : 0.f;
    ring_loop<R>(lds, plan, src, nt, [&](int t, LAS char* Kb) {
        const int kind = DBG == 1 ? 0 : msk.kind(t);
        if (kind) {
            f32x16 p0, p1;
            if (kind == 3) {
                const bool live = msk.live(t); f32x16 ci;
#pragma unroll
                for (int r = 0; r < 16; ++r) ci[r] = live ? negm[r] : -__builtin_inff();
                qk_tile<R, DQK>(p0, p1, Kb, r32, hi, qr, ci);
            } else {
                if (NEGM) qk_tile<R, DQK>(p0, p1, Kb, r32, hi, qr, negm); else qk_tile<R, DQK>(p0, p1, Kb, r32, hi, qr, f32x16{});
                if (kind == 2) msk.apply(p0, p1, t, kind);
            }
            if (DBG == 2) { asm volatile("" :: "v"(p0), "v"(p1)); return; }
            float pmax = fmaxf(p0[0], p1[0]);
#pragma unroll
            for (int r = 1; r < 16; ++r) pmax = fmaxf(pmax, fmaxf(p0[r], p1[r]));
            pmax = lane_pair_max(pmax);
            if (!NEGM) pmax -= m_reg;
            const bool upd = pmax > THR || (l_reg == 0.f && pmax < -THR && pmax > -__builtin_inff());
            float alpha = 1.f;
            if (__any(upd)) {
                const float delta = upd ? pmax : 0.f;
                alpha = l_reg == 0.f ? 1.f : fast_exp2(-delta); m_reg += delta;
                if (NEGM) {
#pragma unroll
                    for (int r = 0; r < 16; ++r) { p0[r] -= delta; p1[r] -= delta; negm[r] = -m_reg; } }
            }
            if (NEGM) {
#pragma unroll
                for (int r = 0; r < 16; ++r) { p0[r] = fast_exp2(p0[r]); p1[r] = fast_exp2(p1[r]); }
            } else {
#pragma unroll
                for (int r = 0; r < 16; ++r) { p0[r] = fast_exp2(p0[r] - m_reg); p1[r] = fast_exp2(p1[r] - m_reg); }
            }
            float ps = 0.f;
#pragma unroll
            for (int r = 0; r < 16; ++r) ps += p0[r] + p1[r];
            ps = lane_pair_sum(ps);
            l_reg = l_reg * alpha + ps;
            if (DO_PV && DBG != 3) {
                if (__any(alpha != 1.f)) {
                    if (hi == 0) wsc[32 + r32] = alpha;
                    asm volatile("s_waitcnt lgkmcnt(0)" ::: "memory");
#pragma unroll
                    for (int r = 0; r < 16; ++r) { const float a = wsc[32 + crow(r, hi)];
#pragma unroll
                        for (int d = 0; d < DV / 32; ++d) o[d][r] *= a; }
                }
                bf16x8 pa0, pa1, pa2, pa3; pack_p(p0, p1, pa0, pa1, pa2, pa3);
                pv_tile<DV, VROW>(o, (unsigned)(uintptr_t)(Kb + VOFF) + vlane, pa0, pa1, pa2, pa3);
            }
        }
    });
}
}
namespace mla {
constexpr int DQK = 192, DV = 128;
using R = att::MlaRing;
constexpr int L_WSC = att::NBUF * R::BUF, L_END = L_WSC + 8 * 256;
struct Msk {
    int qlo, qpos;
    int hi;
    __device__ __forceinline__ int kind(int t) const { const int kb = 64 * t; return kb > qlo + 31 ? 0 : (kb + 63 <= qlo ? 1 : 2); }
    __device__ __forceinline__ bool live(int) const { return true; }
    __device__ __forceinline__ void apply(f32x16& p0, f32x16& p1, int t, int) const {
        const float NEG = -__builtin_inff(); const int d = qpos - 64 * t - 4 * hi;
#pragma unroll
        for (int r = 0; r < 16; ++r) { const int c = (r & 3) + 8 * (r >> 2); if (c > d) p0[r] = NEG; if (c + 32 > d) p1[r] = NEG; }
    }
};
__device__ __forceinline__ void unit(LAS char* lds, const att::Plan<R>& plan, int b, int h, int qb, const bf16_t* Q, const bf16_t* KN, const bf16_t* KR, const bf16_t* V, bf16_t* O, int tid, int wid) {
    asm volatile("" : "+v"(tid)); const int lane = tid & 63;
    const int r32 = lane & 31, hi = lane >> 5;
    LAS float* wsc = (LAS float*)(lds + L_WSC) + wid * 64;
    const int q0 = qb * 256 + wid * 32;
    const size_t trow = (size_t)b * SEQ + q0 + r32;
    bf16x8 qr[DQK / 16];
#pragma unroll
    for (int d0 = 0; d0 < DQK / 16; ++d0) qr[d0] = *(const bf16x8*)(Q + trow * 1536 + h * 192 + d0 * 16 + hi * 8);
    att::Src<R> src{att::make_rsrc(KN + (size_t)(b * MLA_H + h) * SEQ * 128), att::make_rsrc(KR + (size_t)b * SEQ * 64), att::make_rsrc(V + (size_t)(b * MLA_H + h) * SEQ * 128), 0};
    Msk msk{q0, q0 + r32, hi};
    float m_reg = 0.f, l_reg = 0.f; f32x16 o[DV / 32] = {};
    att::run_online<R, DQK, DV, true, Msk, 0, false>(lds, wsc, 4 * (qb + 1), plan, src, msk, qr, m_reg, l_reg, o, lane, wid);
    if (hi == 0) wsc[r32] = l_reg;
    asm volatile("s_waitcnt lgkmcnt(0)" ::: "memory");
    bf16_t* Ow = O + ((size_t)b * SEQ + q0) * 1024 + h * 128;
#pragma unroll
    for (int r = 0; r < 16; ++r) { const int orow = att::crow(r, hi); const float l = wsc[orow]; const float rl = l > 0.f ? fast_rcp(l) : 0.f;
#pragma unroll
        for (int d0 = 0; d0 < DV / 32; ++d0) { const float v = o[d0][r] * rl; const float vn = __shfl_xor(v, 1);
            if ((r32 & 1) == 0) *(unsigned*)(Ow + (size_t)orow * 1024 + d0 * 32 + r32) = cvt_pk_bf16(v, vn); } }
    asm volatile("s_waitcnt lgkmcnt(0)" ::: "memory");
}
}

namespace nsa {
constexpr int DQK = 96, DV = 64;
using R = att::NsaRing;
constexpr int L_WSC = att::NBUF * R::BUF;
constexpr int L_TAB = L_WSC + 8 * 256;
constexpr int TABW = 132;
constexpr int L_PSUM = L_TAB + 4 * TABW * 4;
constexpr int PSW = 68;
constexpr int L_IMP = L_PSUM + 8 * 8 * PSW * 4;
constexpr int L_SELW = L_IMP + 8 * 8 * 128 * 4;
constexpr int L_END = L_SELW + 8 * 8 * 4 * 4;
__device__ __forceinline__ float lds_ld(const LAS float* base, int idx) { float v; asm volatile("ds_read_b32 %0, %1" : "=&v"(v) : "v"((unsigned)(uintptr_t)(base + idx)) : "memory"); return v; }
__device__ __forceinline__ void lds_ld_wait(float (&a)[16], float (&b)[16]) {
    asm volatile("s_waitcnt lgkmcnt(0)" : "+v"(a[0]), "+v"(a[1]), "+v"(a[2]), "+v"(a[3]), "+v"(a[4]), "+v"(a[5]), "+v"(a[6]), "+v"(a[7]), "+v"(a[8]), "+v"(a[9]), "+v"(a[10]), "+v"(a[11]), "+v"(a[12]), "+v"(a[13]), "+v"(a[14]), "+v"(a[15]) :: "memory");
    asm volatile("" : "+v"(b[0]), "+v"(b[1]), "+v"(b[2]), "+v"(b[3]), "+v"(b[4]), "+v"(b[5]), "+v"(b[6]), "+v"(b[7]), "+v"(b[8]), "+v"(b[9]), "+v"(b[10]), "+v"(b[11]), "+v"(b[12]), "+v"(b[13]), "+v"(b[14]), "+v"(b[15]) :: "memory");
}
struct MskCmp {
    int qlo, qpos, hi; const LAS float* tab;
    __device__ __forceinline__ int kind(int t) const {
        const int n0 = 64 * t;
        if (qlo + 7 - (16 * n0 + 31) < 0) return 0;
        return (qlo - (16 * (n0 + 63) + 31) >= 128) ? 1 : 2;
    }
    __device__ __forceinline__ bool live(int) const { return true; }
    __device__ __forceinline__ void apply(f32x16& p0, f32x16& p1, int t, int) const {
        const float NEG = -__builtin_inff(); const int dq = qpos - 31 - 16 * (64 * t + 4 * hi);
        float bv0[16], bv1[16];
#pragma unroll
        for (int r = 0; r < 16; ++r) { const int c = 16 * ((r & 3) + 8 * (r >> 2)); const int d0 = dq - c, d1 = dq - c - 512;
            bv0[r] = lds_ld(tab, (unsigned)d0 < 128u ? d0 : 128); bv1[r] = lds_ld(tab, (unsigned)d1 < 128u ? d1 : 128); }
        lds_ld_wait(bv0, bv1);
#pragma unroll
        for (int r = 0; r < 16; ++r) { const int c = 16 * ((r & 3) + 8 * (r >> 2));
            p0[r] = dq - c >= 0 ? p0[r] + bv0[r] : NEG; p1[r] = dq - c - 512 >= 0 ? p1[r] + bv1[r] : NEG; }
    }
};
struct MskSel {
    int qpos, hi, cur; const LAS float* tab; const LAS unsigned* selw;
    __device__ __forceinline__ bool mine(int j) const { return (selw[j >> 5] >> (j & 31)) & 1u; }
    __device__ __forceinline__ int kind(int j) const {
        const bool s = mine(j);
        if (!__any(s)) return 0;
        if (j >= cur - 2) return 2;
        return __all(s) ? 1 : 3;
    }
    __device__ __forceinline__ bool live(int j) const { return mine(j); }
    __device__ __forceinline__ void apply(f32x16& p0, f32x16& p1, int j, int) const {
        const float NEG = -__builtin_inff(); const bool s = mine(j); const int dq = qpos - 64 * j - 4 * hi;
        float bv0[16], bv1[16];
#pragma unroll
        for (int r = 0; r < 16; ++r) { const int c = (r & 3) + 8 * (r >> 2); const int d0 = dq - c, d1 = dq - c - 32;
            bv0[r] = lds_ld(tab, (unsigned)d0 < 128u ? d0 : 128); bv1[r] = lds_ld(tab, (unsigned)d1 < 128u ? d1 : 128); }
        lds_ld_wait(bv0, bv1);
#pragma unroll
        for (int r = 0; r < 16; ++r) { const int c = (r & 3) + 8 * (r >> 2);
            p0[r] = (s && dq - c >= 0) ? p0[r] + bv0[r] : NEG; p1[r] = (s && dq - c - 32 >= 0) ? p1[r] + bv1[r] : NEG; }
    }
};
struct MskWin {
    int qpos, hi, cur, j0; const LAS float* tab;
    __device__ __forceinline__ int kind(int t) const { const int j = j0 + t; return (j >= cur - 2 || j <= cur - 8) ? 2 : 1; }
    __device__ __forceinline__ bool live(int) const { return true; }
    __device__ __forceinline__ void apply(f32x16& p0, f32x16& p1, int t, int) const {
        const float NEG = -__builtin_inff(); const int dq = qpos - 64 * (j0 + t) - 4 * hi;
        float bv0[16], bv1[16];
#pragma unroll
        for (int r = 0; r < 16; ++r) { const int c = (r & 3) + 8 * (r >> 2); const int d0 = dq - c, d1 = dq - c - 32;
            bv0[r] = lds_ld(tab, (unsigned)d0 < 128u ? d0 : 128); bv1[r] = lds_ld(tab, (unsigned)d1 < 128u ? d1 : 128); }
        lds_ld_wait(bv0, bv1);
#pragma unroll
        for (int r = 0; r < 16; ++r) { const int c = (r & 3) + 8 * (r >> 2);
            p0[r] = (unsigned)(dq - c) < 512u ? p0[r] + bv0[r] : NEG; p1[r] = (unsigned)(dq - c - 32) < 512u ? p1[r] + bv1[r] : NEG; }
    }
};
__device__ __forceinline__ void fold(f32x16* ofin, const f32x16* o, float f, LAS float* wsc, int r32, int hi) {
    if (hi == 0) wsc[r32] = f;
    asm volatile("s_waitcnt lgkmcnt(0)" ::: "memory");
#pragma unroll
    for (int r = 0; r < 16; ++r) { const float a = wsc[att::crow(r, hi)];
#pragma unroll
        for (int d = 0; d < DV / 32; ++d) ofin[d][r] += o[d][r] * a; }
    asm volatile("s_waitcnt lgkmcnt(0)" : "+v"(ofin[0]), "+v"(ofin[1]) :: "memory");
}
struct Tensors { const bf16_t *NQ, *KCMP, *VCMP, *KS, *VS, *KW, *VW; const float *GT, *RBT; bf16_t* O; };
#define NSA_LAUNDER() int tid = tid0; asm volatile("" : "+v"(tid)); const int lane = tid & 63, r32 = lane & 31, hi = lane >> 5, qi = r32 >> 2, hg = r32 & 3; \
    LAS float* wsc = (LAS float*)(lds + L_WSC) + wid * 64; const LAS float* tab = (LAS float*)(lds + L_TAB) + hg * TABW; const int qpos = qlo + qi;
template <int DBG = 0> __device__ __forceinline__ void unit(LAS char* lds, const att::Plan<R>& plan, const Tensors& X, int b, int g, int qblk, int tid0, int wid) {
    const int s0 = qblk * 64, cur = qblk, qlo = s0 + 8 * wid;
    const int bg = b * NSA_G + g;
    bf16x8 qr[DQK / 16]; float gc, gs, gw;
    f32x16 ofin[DV / 32] = {};
    LAS float* imp = (LAS float*)(lds + L_IMP) + wid * 8 * 128;
    LAS unsigned* selw = (LAS unsigned*)(lds + L_SELW) + wid * 32;
    {
    NSA_LAUNDER();
    LAS float* tabs = (LAS float*)(lds + L_TAB);
    LAS float* psum = (LAS float*)(lds + L_PSUM) + wid * 8 * PSW;
    for (int i = tid; i < 4 * TABW; i += 512) tabs[i] = X.RBT[(g * 4 + i / TABW) * TABW + i % TABW];
    for (int i = lane; i < 8 * 128; i += 64) imp[i] = 0.f;
    if (lane < 8) psum[lane * PSW] = 0.f;
    if (lane < 32) selw[lane] = 0u;
    const size_t trow = (size_t)b * SEQ + qpos;
#pragma unroll
    for (int d0 = 0; d0 < DQK / 16; ++d0) qr[d0] = *(const bf16x8*)(X.NQ + trow * 1536 + (g * 4 + hg) * 96 + d0 * 16 + hi * 8);
    gc = X.GT[trow * 48 + (g * 4 + hg) * 3 + 0]; gs = X.GT[trow * 48 + (g * 4 + hg) * 3 + 1]; gw = X.GT[trow * 48 + (g * 4 + hg) * 3 + 2];
    __syncthreads();
    }
    const int ncv = (s0 + 63 >= 31) ? ((s0 + 63 - 31) >> 4) + 1 : 0;
    const int ntc = (ncv + 63) >> 6;
#ifndef NSA_NO_CMP
    {
        NSA_LAUNDER();
        att::Src<R> srcC{att::make_rsrc(X.KCMP + (size_t)bg * 512 * 96), att::make_rsrc(X.VCMP + (size_t)bg * 512 * 64), att::make_rsrc(X.VCMP), 0};
        MskCmp mc{qlo, qpos, hi, tab};
        LAS float* psum = (LAS float*)(lds + L_PSUM) + wid * 8 * PSW;
        float m_reg = 0.f, l_reg = 0.f; f32x16 od[DV / 32];
        att::run_online<R, DQK, DV, false>(lds, wsc, ntc, plan, srcC, mc, qr, m_reg, l_reg, od, lane, wid);
        f32x16 cin2; { const float c2 = l_reg > 0.f ? -(m_reg + __builtin_amdgcn_logf(l_reg)) : -__builtin_inff();
#pragma unroll
            for (int r = 0; r < 16; ++r) cin2[r] = c2; }
        f32x16 o[DV / 32] = {};
        if (ntc > 0) {
            constexpr int VROW = R::ROW(1), VOFF = R::OFF(1);
            const unsigned vlane = (unsigned)((8 * hi + ((lane & 15) >> 2)) * VROW + (16 * ((lane >> 4) & 1) + 4 * (lane & 3)) * 2);
            att::ring_loop<R>(lds, plan, srcC, ntc, [&](int t, LAS char* Kb) {
                const int kind = mc.kind(t);
                if (kind) {
                    f32x16 p0, p1;
                    att::qk_tile<R, DQK>(p0, p1, Kb, r32, hi, qr, cin2);
                    if (kind >= 2) mc.apply(p0, p1, t, kind);
#pragma unroll
                    for (int r = 0; r < 16; ++r) { p0[r] = fast_exp2(p0[r]); p1[r] = fast_exp2(p1[r]); }
#pragma unroll
                    for (int r = 0; r < 16; ++r) {
                        float a = p0[r]; a += __shfl_xor(a, 1); a += __shfl_xor(a, 2);
                        float c = p1[r]; c += __shfl_xor(c, 1); c += __shfl_xor(c, 2);
                        if (hg == 0) { psum[qi * PSW + 1 + att::crow(r, hi)] = a; psum[qi * PSW + 33 + att::crow(r, hi)] = c; }
                    }
                    asm volatile("s_waitcnt lgkmcnt(0)" ::: "memory");
                    {
                        const int q = lane >> 3;
#pragma unroll
                        for (int e = 0; e < 2; ++e) { const int jl = (lane & 7) * 2 + e; const LAS float* ps = psum + q * PSW + 4 * jl;
                            imp[q * 128 + 16 * t + jl] = (ps[0] + ps[1]) + (ps[2] + ps[3]) + ps[4]; }
                    }
                    asm volatile("s_waitcnt lgkmcnt(0)" ::: "memory");
                    if (lane < 8) psum[lane * PSW] = psum[lane * PSW + 64];
                    asm volatile("s_waitcnt lgkmcnt(0)" ::: "memory");
                    bf16x8 pa0, pa1, pa2, pa3; att::pack_p(p0, p1, pa0, pa1, pa2, pa3);
                    att::pv_tile<DV, VROW>(o, (unsigned)(uintptr_t)(Kb + VOFF) + vlane, pa0, pa1, pa2, pa3);
                }
            });
        }
        fold(ofin, o, gc, wsc, r32, hi);
    }
#endif
#ifndef NSA_NO_TOPK
    {
        NSA_LAUNDER();
        const int q = lane >> 3, jl = lane & 7;
        float v[16]; int rk[16];
#pragma unroll
        for (int i = 0; i < 16; ++i) { const int j = jl + 8 * i; const float x = imp[q * 128 + j];
            v[i] = (j == 0 || j == cur || j == cur - 1) ? 1e6f : (j > cur ? -1e6f : x); rk[i] = 0; }
        for (int jp = 0; jp <= cur; ++jp) {
            const float x = imp[q * 128 + jp]; const float w = (jp == 0 || jp == cur || jp == cur - 1) ? 1e6f : x;
#pragma unroll
            for (int i = 0; i < 16; ++i) { const int j = jl + 8 * i; rk[i] += (w > v[i] || (w == v[i] && jp < j)) ? 1 : 0; }
        }
        unsigned wd[4] = {0u, 0u, 0u, 0u};
#pragma unroll
        for (int i = 0; i < 16; ++i) { const int j = jl + 8 * i; if (j <= cur && rk[i] < 16) wd[i >> 2] |= 1u << (jl + 8 * (i & 3)); }
#pragma unroll
        for (int w = 0; w < 4; ++w) if (wd[w]) atomicOr((unsigned*)(selw + q * 4 + w), wd[w]);
        asm volatile("s_waitcnt lgkmcnt(0)" ::: "memory");
    }
#endif
#ifndef NSA_NO_SEL
    {
        NSA_LAUNDER();
        att::Src<R> srcS{att::make_rsrc(X.KS + (size_t)bg * SEQ * 96), att::make_rsrc(X.VS + (size_t)bg * SEQ * 64), att::make_rsrc(X.VS), 0};
        MskSel ms{qpos, hi, cur, tab, selw + qi * 4};
        float m_reg = 0.f, l_reg = 0.f; f32x16 o[DV / 32] = {};
        att::run_online<R, DQK, DV, true, MskSel, DBG>(lds, wsc, cur + 1, plan, srcS, ms, qr, m_reg, l_reg, o, lane, wid);
        fold(ofin, o, l_reg > 0.f ? gs * fast_rcp(l_reg) : 0.f, wsc, r32, hi);
    }
#endif
#ifndef NSA_NO_WIN
    {
        NSA_LAUNDER();
        const int j0 = cur >= 8 ? cur - 8 : 0;
        att::Src<R> srcW{att::make_rsrc(X.KW + (size_t)bg * SEQ * 96), att::make_rsrc(X.VW + (size_t)bg * SEQ * 64), att::make_rsrc(X.VW), j0};
        MskWin mw{qpos, hi, cur, j0, tab};
        float m_reg = 0.f, l_reg = 0.f; f32x16 o[DV / 32] = {};
        att::run_online<R, DQK, DV, true, MskWin, DBG>(lds, wsc, cur - j0 + 1, plan, srcW, mw, qr, m_reg, l_reg, o, lane, wid);
        fold(ofin, o, l_reg > 0.f ? gw * fast_rcp(l_reg) : 0.f, wsc, r32, hi);
    }
#endif
    NSA_LAUNDER();
    bf16_t* Ow = X.O + ((size_t)b * SEQ + qlo) * 1024 + g * 256;
#pragma unroll
    for (int r = 0; r < 16; ++r) { const int orow = att::crow(r, hi);
#pragma unroll
        for (int d0 = 0; d0 < DV / 32; ++d0) { const float v = ofin[d0][r]; const float vn = __shfl_xor(v, 1);
            if ((r32 & 1) == 0) *(unsigned*)(Ow + (size_t)(orow >> 2) * 1024 + (orow & 3) * 64 + d0 * 32 + r32) = cvt_pk_bf16(v, vn); } }
    __syncthreads();
}
}
#endif
#if !defined(__HIP_DEVICE_COMPILE__)
namespace nsa { constexpr int L_END = 0, TABW = 132; } namespace mla { constexpr int L_END = 0; }
#endif
constexpr size_t MiB = 1u << 20;
constexpr size_t WS_CTL = 0, CTL_ZERO_BYTES = 1 * MiB;
constexpr size_t WS_W_MLAIN = 1 * MiB;
constexpr size_t WS_W_QUP   = 3 * MiB;
constexpr size_t WS_W_KVUP  = WS_W_QUP + 1536 * 1024;
constexpr size_t WS_W_MLAOUT = WS_W_KVUP + 1 * MiB;
constexpr size_t WS_W_FFNGU = WS_W_MLAOUT + 2 * MiB;
constexpr size_t WS_W_FFND  = WS_W_FFNGU + 11 * MiB;
constexpr size_t WS_W_NSAIN = WS_W_FFND + 5632 * 1024;
constexpr size_t WS_W_NSAOUT = WS_W_NSAIN + 7 * MiB;
constexpr size_t WS_W_C1K = WS_W_NSAOUT + 2 * MiB;
constexpr size_t WS_W_C1V = WS_W_C1K + 256 * 3072 * 2;
constexpr size_t WS_W_C2K = WS_W_C1V + 256 * 2048 * 2;
constexpr size_t WS_W_C2V = WS_W_C2K + 256 * 128 * 2;
constexpr size_t WS_ROPE  = WS_W_C2V + 256 * 128 * 2;
constexpr size_t WS_CBIAS = WS_ROPE + 2 * MiB;
constexpr size_t WS_RBT   = WS_CBIAS + 1024;
constexpr size_t WS_ROWTOK = 38 * MiB;
constexpr size_t WS_TOKINFO = 39 * MiB;
constexpr size_t WS_TOKW = WS_TOKINFO + 256 * 1024;
static_assert(WS_RBT + 16 * 132 * 4 <= WS_ROWTOK && WS_TOKW + 256 * 1024 <= 40 * MiB, "small region");
constexpr size_t WS_XB = 40 * MiB, WS_LAT = 104 * MiB, WS_QN = 168 * MiB, WS_KVN = 200 * MiB, WS_KR = 216 * MiB, WS_Q = 220 * MiB, WS_KN = 316 * MiB, WS_V = 380 * MiB;
constexpr size_t WS_O = 40 * MiB, WS_X1 = 104 * MiB, WS_ACT = 168 * MiB, WS_X2 = 40 * MiB;
constexpr size_t WS_NQ = 104 * MiB, WS_KC = 200 * MiB, WS_VC = 224 * MiB, WS_KS = 240 * MiB, WS_VS = 264 * MiB, WS_KW = 280 * MiB, WS_VW = 304 * MiB, WS_GT = 320 * MiB;
static_assert(WS_KS - WS_KC == 40 * MiB && WS_KW - WS_KS == 40 * MiB && WS_VS - WS_VC == 40 * MiB && WS_VW - WS_VS == 40 * MiB, "FNsaIn segment stride");
constexpr size_t WS_HK = 328 * MiB, WS_HV = 330 * MiB, WS_KCMP = 332 * MiB, WS_VCMP = 334 * MiB;
constexpr size_t WS_ONSA = 348 * MiB, WS_X3 = 412 * MiB;
constexpr size_t WS_MOE_GU = 40 * MiB, WS_MOE_D = 152 * MiB, WS_DOUT = 208 * MiB;
constexpr size_t WS_MOE_GU8 = 40 * MiB, WS_MOE_D8 = 96 * MiB, WS_X3F8 = 124 * MiB;
constexpr float MOE_GU_WS = 32.f, MOE_D_WS = 128.f, MOE_H_S = 4.f;
constexpr size_t WS_END = 476 * MiB;
constexpr int CW_BAR = 4096;
constexpr int CW_ECNT = 16384;
constexpr int RING_BYTES = 161792;
constexpr int MISC_OFF = RING_BYTES + 320;
constexpr int LDS_BYTES = 163840;
constexpr int NWAVES = 8;
static_assert(nsa::L_END <= RING_BYTES && mla::L_END <= RING_BYTES, "attention LDS");

#define RLX_AGENT __ATOMIC_RELAXED, __HIP_MEMORY_SCOPE_AGENT
#define LDS_WAIT() asm volatile("s_waitcnt lgkmcnt(0)" ::: "memory")
#define VM_WAIT() asm volatile("s_waitcnt vmcnt(0)" ::: "memory")
__device__ __forceinline__ unsigned f2bf(float f) { unsigned u = __builtin_bit_cast(unsigned, f); return (u + 0x7fffu + ((u >> 16) & 1u)) >> 16; }
__device__ __forceinline__ unsigned pk2(float lo, float hi) { return f2bf(lo) | (f2bf(hi) << 16); }

#define XB_TMO      128
#define XB_XCNT(j)  (256  + 64 * (j))
#define XB_XSUB(j)  (1280 + 64 * (j))
#define XB_XGEN(j)  (2304 + 64 * (j))
#define XB_TOP      3328
#define XB_TOPGEN   3392
#define XCD_BAR_WORDS 3456
#define XB_SPIN_CAP (1u << 20)
__device__ __forceinline__ unsigned xb_ld(unsigned* p)              { return __hip_atomic_load(p, __ATOMIC_RELAXED, __HIP_MEMORY_SCOPE_AGENT); }
__device__ __forceinline__ unsigned xb_add(unsigned* p, unsigned v) { return __hip_atomic_fetch_add(p, v, __ATOMIC_RELAXED, __HIP_MEMORY_SCOPE_AGENT); }
__device__ __forceinline__ unsigned xb_xcc_id() { return (unsigned)__builtin_amdgcn_s_getreg((3 << 11) | 20) & 0xFu; }
#define XB_SPIN(cond, bar) do { unsigned _sp = 0; while (cond) { __builtin_amdgcn_s_sleep(1); \
    if ((++_sp & 255u) == 0u) { if (xb_ld(&(bar)[XB_TMO])) break; if (_sp > XB_SPIN_CAP) { atomicAdd(&(bar)[XB_TMO], 1u); break; } } } } while (0)
struct XcdBarrier { unsigned* bar; unsigned x; volatile LAS unsigned* st; };
__device__ __forceinline__ XcdBarrier xcd_barrier_post(unsigned* bar, volatile LAS unsigned* st) {
    XcdBarrier b; b.bar = bar; b.x = xb_xcc_id(); b.st = st;
    if (threadIdx.x == 0) (void)xb_add(&bar[XB_XCNT(b.x)], 1u);
    return b;
}
__device__ __forceinline__ void xcd_barrier_complete(unsigned* bar, unsigned x, unsigned& nloc, unsigned& nx) {
    const unsigned G = gridDim.x * gridDim.y * gridDim.z;
    unsigned sum, cnt, mine, sp = 0u;
    for (;;) {
        sum = 0u; cnt = 0u; mine = 0u;
#pragma unroll
        for (unsigned j = 0; j < 16; ++j) { const unsigned c = xb_ld(&bar[XB_XCNT(j)]); sum += c; cnt += (c > 0u) ? 1u : 0u; mine = (j == x) ? c : mine; }
        if (sum == G) break;
        __builtin_amdgcn_s_sleep(1);
        if ((++sp & 255u) == 0u) { if (xb_ld(&bar[XB_TMO])) break; if (sp > XB_SPIN_CAP) { atomicAdd(&bar[XB_TMO], 1u); break; } }
    }
    nloc = mine > 0u ? mine : 1u; nx = cnt > 0u ? cnt : 1u;
}
__device__ __forceinline__ void xcd_barrier(const XcdBarrier& b) {
    asm volatile("s_waitcnt vmcnt(0)" ::: "memory");
    __syncthreads();
    if (threadIdx.x == 0) {
        unsigned* bar = b.bar;
        __builtin_amdgcn_s_waitcnt(0);
        unsigned nloc = b.st[0], nx = b.st[1];
        if (nloc == 0u) { xcd_barrier_complete(bar, b.x, nloc, nx); b.st[0] = nloc; b.st[1] = nx; }
        const unsigned old = xb_add(&bar[XB_XSUB(b.x)], 1u);
        const unsigned gen = old / nloc;
        if (old + 1u == (gen + 1u) * nloc) {
            __builtin_amdgcn_fence(__ATOMIC_RELEASE, "agent");
            asm volatile("s_waitcnt vmcnt(0)" ::: "memory");
            const unsigned og = xb_add(&bar[XB_TOP], 1u);
            const unsigned tg = og / nx;
            if (og + 1u == (tg + 1u) * nx) xb_add(&bar[XB_TOPGEN], 1u);
            else XB_SPIN(xb_ld(&bar[XB_TOPGEN]) == tg, bar);
            __builtin_amdgcn_fence(__ATOMIC_ACQUIRE, "agent");
            xb_add(&bar[XB_XGEN(b.x)], 1u);
            asm volatile("s_waitcnt vmcnt(0)" ::: "memory");
        } else {
            XB_SPIN(xb_ld(&bar[XB_XGEN(b.x)]) == gen, bar);
            __builtin_amdgcn_fence(__ATOMIC_ACQUIRE, "agent");
            asm volatile("s_waitcnt vmcnt(0)" ::: "memory");
        }
    }
    __syncthreads();
}

__device__ __forceinline__ float wave_sum(float v) {
#pragma unroll
    for (int o = 1; o < 64; o <<= 1) v += __shfl_xor(v, o);
    return v;
}
template <class RM> __device__ __forceinline__ void tr_item(const float* W, int K, int N, bf16_t* WT, int ldk, const RM& rowmap, LAS float* scr, int item, int lane) {
    const int nblk = (N + 31) / 32, kb = item / nblk, nb = item % nblk, k0 = 64 * kb, n0 = 32 * nb;
    const bool nok = n0 + (lane & 31) < N;
#pragma unroll 8
    for (int i = 0; i < 32; ++i) { const int kk = 2 * i + (lane >> 5); scr[kk * 33 + (lane & 31)] = nok ? W[(size_t)(k0 + kk) * N + n0 + (lane & 31)] : 0.f; }
    LDS_WAIT(); asm volatile("" ::: "memory");
    const int c = lane & 7;
#pragma unroll
    for (int j = 0; j < 4; ++j) { const int nl = (lane >> 3) + 8 * j; const LAS float* s = scr + (8 * c) * 33 + nl;
        u32x4 o; o.x = pk2(s[0 * 33], s[1 * 33]); o.y = pk2(s[2 * 33], s[3 * 33]); o.z = pk2(s[4 * 33], s[5 * 33]); o.w = pk2(s[6 * 33], s[7 * 33]);
        if (n0 + nl < N) *(u32x4*)(WT + (size_t)rowmap(n0 + nl) * ldk + k0 + 8 * c) = o; }
    LDS_WAIT(); asm volatile("" ::: "memory");
}
struct RmId { int off; __device__ __forceinline__ int operator()(int n) const { return off + n; } };
struct RmGU { int off; __device__ __forceinline__ int operator()(int n) const { return off + (n >> 7) * 256 + (n & 127); } };
struct RmQup { __device__ __forceinline__ int operator()(int n) const { const int h = n / 192, j = n % 192; if (j < 128) return n; const int i = j - 128, ii = i & 31; return h * 192 + 128 + 8 * (ii >> 2) + (ii & 3) + ((i >> 5) << 2); } };
template <class RM> __device__ __forceinline__ void tr_matrix(const float* W, int K, int N, bf16_t* WT, int ldk, const RM& rm, LAS float* scr, int gw, int ngw, int lane) {
    const int nitems = (K / 64) * ((N + 31) / 32);
    for (int it = gw; it < nitems; it += ngw) tr_item(W, K, N, WT, ldk, rm, scr, it, lane);
}

__device__ __forceinline__ float clamp448(float v) { return fminf(fmaxf(v, -448.f), 448.f); }
__device__ __forceinline__ unsigned pk4_fp8(float a, float b, float c, float d) { int w = 0; w = __builtin_amdgcn_cvt_pk_fp8_f32(clamp448(a), clamp448(b), w, false); w = __builtin_amdgcn_cvt_pk_fp8_f32(clamp448(c), clamp448(d), w, true); return (unsigned)w; }
template <class RM> __device__ __forceinline__ void tr_item_f8(const float* W, int K, int N, unsigned char* WT, int ldk, float scale, const RM& rowmap, LAS float* scr, int item, int lane) {
    const int nblk = (N + 31) / 32, kb = item / nblk, nb = item % nblk, k0 = 64 * kb, n0 = 32 * nb;
    const bool nok = n0 + (lane & 31) < N;
#pragma unroll 8
    for (int i = 0; i < 32; ++i) { const int kk = 2 * i + (lane >> 5); scr[kk * 33 + (lane & 31)] = nok ? W[(size_t)(k0 + kk) * N + n0 + (lane & 31)] * scale : 0.f; }
    LDS_WAIT(); asm volatile("" ::: "memory");
    const int c = lane & 3;
#pragma unroll
    for (int j = 0; j < 2; ++j) { const int nl = (lane >> 2) + 16 * j; const LAS float* s = scr + (16 * c) * 33 + nl;
        u32x4 o; o.x = pk4_fp8(s[0 * 33], s[1 * 33], s[2 * 33], s[3 * 33]); o.y = pk4_fp8(s[4 * 33], s[5 * 33], s[6 * 33], s[7 * 33]);
        o.z = pk4_fp8(s[8 * 33], s[9 * 33], s[10 * 33], s[11 * 33]); o.w = pk4_fp8(s[12 * 33], s[13 * 33], s[14 * 33], s[15 * 33]);
        if (n0 + nl < N) *(u32x4*)(WT + (size_t)rowmap(n0 + nl) * ldk + k0 + 16 * c) = o; }
    LDS_WAIT(); asm volatile("" ::: "memory");
}
template <class RM> __device__ __forceinline__ void tr_matrix_f8(const float* W, int K, int N, unsigned char* WT, int ldk, float scale, const RM& rm, LAS float* scr, int gw, int ngw, int lane) {
    const int nitems = (K / 64) * ((N + 31) / 32);
    for (int it = gw; it < nitems; it += ngw) tr_item_f8(W, K, N, WT, ldk, scale, rm, scr, it, lane);
}
__device__ __forceinline__ void ln_inplace(f32x4 (&v)[4], const float* g, const float* b, int lane) {
    float s = 0.f;
#pragma unroll
    for (int j = 0; j < 4; ++j) s += (v[j].x + v[j].y) + (v[j].z + v[j].w);
    const float mean = wave_sum(s) * (1.f / D); float s2 = 0.f;
#pragma unroll
    for (int j = 0; j < 4; ++j) { v[j] = v[j] - mean; s2 += (v[j].x * v[j].x + v[j].y * v[j].y) + (v[j].z * v[j].z + v[j].w * v[j].w); }
    const float rstd = 1.f / sqrtf(wave_sum(s2) * (1.f / D) + 1e-5f);
#pragma unroll
    for (int j = 0; j < 4; ++j) { const f32x4 gg = *((const f32x4*)g + lane + 64 * j), bb = *((const f32x4*)b + lane + 64 * j); v[j] = v[j] * rstd * gg + bb; }
}
__device__ __forceinline__ void store_row_bf16(bf16_t* orow, const f32x4 (&v)[4], int lane) {
    u32x2* o8 = (u32x2*)orow + lane;
#pragma unroll
    for (int j = 0; j < 4; ++j) { u32x2 w; w.x = cvt_pk_bf16(v[j].x, v[j].y); w.y = cvt_pk_bf16(v[j].z, v[j].w); o8[64 * j] = w; }
}
__device__ __forceinline__ f32x4 bf4_to_f32(u32x2 w) { return (f32x4){bflo(w.x), bfhi(w.x), bflo(w.y), bfhi(w.y)}; }

__device__ __forceinline__ u32x4 pack8(f32x4 a, f32x4 b) { u32x4 w; w.x = cvt_pk_bf16(a[0], a[1]); w.y = cvt_pk_bf16(a[2], a[3]); w.z = cvt_pk_bf16(b[0], b[1]); w.w = cvt_pk_bf16(b[2], b[3]); return w; }
struct FBf16 { bf16_t* O; int ld; int rowoff;
    __device__ __forceinline__ void operator()(int row, int col, f32x4 a, f32x4 b) const { *(u32x4*)(O + (size_t)(rowoff + row) * ld + col) = pack8(a, b); } };
struct FBf16S { bf16_t* O; int ld; int rowoff; float sc;
    __device__ __forceinline__ void operator()(int row, int col, f32x4 a, f32x4 b) const { *(u32x4*)(O + (size_t)(rowoff + row) * ld + col) = pack8(a * sc, b * sc); } };
struct FSwigluF8 { unsigned char* A; int ld; float isc, osc;
    __device__ __forceinline__ void operator()(int row, int col, f32x4 g0, f32x4 g1, f32x4 u0, f32x4 u1) const {
        f32x4 a, b;
#pragma unroll
        for (int e = 0; e < 4; ++e) { a[e] = silu_f(g0[e] * isc) * (u0[e] * (isc * osc)); b[e] = silu_f(g1[e] * isc) * (u1[e] * (isc * osc)); }
        u32x2 w; w.x = pk4_fp8(a[0], a[1], a[2], a[3]); w.y = pk4_fp8(b[0], b[1], b[2], b[3]);
        *(u32x2*)(A + (size_t)row * ld + col) = w; } };
struct FQup { bf16_t* Q; const float* cs; const float* sn;
    __device__ __forceinline__ void operator()(int row, int col, f32x4 a, f32x4 b) const {
        const int j = col % 192;
        if (j >= 128) { const int i0 = ((j - 128) >> 3) * 4, s = row & (SEQ - 1);
            const f32x4 c = *(const f32x4*)(cs + s * 32 + i0), sv = *(const f32x4*)(sn + s * 32 + i0);
            const f32x4 o1 = a * c - b * sv, o2 = a * sv + b * c; a = o1; b = o2; }
        *(u32x4*)(Q + (size_t)row * 1536 + col) = pack8(a * C2_MLA, b * C2_MLA); } };
struct FKvup { bf16_t* KN; bf16_t* V;
    __device__ __forceinline__ void operator()(int row, int col, f32x4 a, f32x4 b) const {
        const int h = col >> 8, j = col & 255, bb = row >> 13, s = row & (SEQ - 1);
        bf16_t* base = (j < 128 ? KN : V) + ((size_t)(bb * MLA_H + h) * SEQ + s) * 128 + (j & 127);
        *(u32x4*)base = pack8(a, b); } };
struct FResF32 { float* P; const float* rf; const bf16_t* rb;
    __device__ __forceinline__ void operator()(int row, int col, f32x4 a, f32x4 b) const {
        const size_t o = (size_t)row * D + col; f32x4 r0, r1;
        if (rf) { r0 = *(const f32x4*)(rf + o); r1 = *(const f32x4*)(rf + o + 4); }
        else { const u32x4 w = *(const u32x4*)(rb + o); r0 = (f32x4){bflo(w.x), bfhi(w.x), bflo(w.y), bfhi(w.y)}; r1 = (f32x4){bflo(w.z), bfhi(w.z), bflo(w.w), bfhi(w.w)}; }
        *(f32x4*)(P + o) = r0 * ALPHA + a; *(f32x4*)(P + o + 4) = r1 * ALPHA + b; } };
struct FSwiglu { bf16_t* A; int ld; int rowoff;
    __device__ __forceinline__ void operator()(int row, int col, f32x4 g0, f32x4 g1, f32x4 u0, f32x4 u1) const {
        f32x4 a, b;
#pragma unroll
        for (int e = 0; e < 4; ++e) { a[e] = silu_f(g0[e]) * u0[e]; b[e] = silu_f(g1[e]) * u1[e]; }
        *(u32x4*)(A + (size_t)(rowoff + row) * ld + col) = pack8(a, b); } };
struct FNsaIn { bf16_t *NQ, *KC, *VC; float* GT;
    __device__ __forceinline__ void operator()(int row, int col, f32x4 a, f32x4 b) const {
        const int bb = row >> 13, s = row & (SEQ - 1);
        if (col < 1536) { *(u32x4*)(NQ + (size_t)row * 1536 + col) = pack8(a * C2_NSA, b * C2_NSA); return; }
        if (col >= 3504) return;
        if (col >= 3456) { float* gp = GT + (size_t)row * 48 + (col - 3456);
            f32x4 x, y;
#pragma unroll
            for (int e = 0; e < 4; ++e) { x[e] = sigmoid_f(a[e]); y[e] = sigmoid_f(b[e]); }
            *(f32x4*)gp = x; *(f32x4*)(gp + 4) = y; return; }
        int cc = col - 1536; const int seg = cc / 640; cc -= seg * 640;
        const bool isk = cc < 384; if (!isk) cc -= 384;
        bf16_t* base = (isk ? KC : VC) + (size_t)seg * (40u * 1024u * 1024u / 2u);
        const int dd = isk ? 96 : 64, g = cc / dd, d = cc - g * dd;
        *(u32x4*)(base + ((size_t)(bb * NSA_G + g) * SEQ + s) * dd + d) = pack8(a, b); } };
struct FCmp1 { bf16_t* H; const float* bias;
    __device__ __forceinline__ void operator()(int row, int col, f32x4 a, f32x4 b) const {
        if (col >= 128) return;
        const f32x4 b0 = *(const f32x4*)(bias + col), b1 = *(const f32x4*)(bias + col + 4); f32x4 x, y;
#pragma unroll
        for (int e = 0; e < 4; ++e) { x[e] = gelu_tanh_f(a[e] + b0[e]); y[e] = gelu_tanh_f(b[e] + b1[e]); }
        *(u32x4*)(H + (size_t)row * 128 + col) = pack8(x, y); } };
struct FCmp2 { bf16_t* O; int nd;
    __device__ __forceinline__ void operator()(int row, int col, f32x4 a, f32x4 b) const {
        if (col >= nd) return;
        if ((row & 511) == 511) { a = (f32x4){0.f, 0.f, 0.f, 0.f}; b = a; }
        *(u32x4*)(O + (size_t)row * nd + col) = pack8(a, b); } };

struct MoeInfo { int cnt[NE]; int ts[NE + 1];
    __device__ __forceinline__ int expert_of(int ct) const { int e = 0;
#pragma unroll
        for (int i = 1; i < NE; ++i) e += (ct >= ts[i]) ? 1 : 0; return e; } };
struct SchedMoeGU {
    pg8::StaticOrder so; MoeInfo mi; int ct0; const int* rowtok; int rowbytes;
    __device__ __forceinline__ bool next(int i, pg8::Unit& u) const { return so.next(i, u); }
    __device__ __forceinline__ size_t a_off(const pg8::Unit&, const pg8::Gemm&) const { return 0; }
    __device__ __forceinline__ size_t b_off(const pg8::Unit& u, const pg8::Gemm& g) const { const int e = mi.expert_of(ct0 + u.pm); return ((size_t)e * (2 * FFE) + (size_t)u.pn * 256) * g.ldb; }
    __device__ __forceinline__ unsigned a_row(const pg8::Unit& u, int r) const {
        const int ct = ct0 + u.pm, e = mi.expert_of(ct); int c = 0, t0 = 0;
#pragma unroll
        for (int i = 0; i < NE; ++i) { c = (i == e) ? mi.cnt[i] : c; t0 = (i == e) ? mi.ts[i] : t0; }
        const int pos = (ct - t0) * 256 + r; const int tok = pos < c ? rowtok[e * ECAP + pos] : 0;
        return (unsigned)tok * (unsigned)rowbytes; }
};
struct SchedMoeD {
    pg8::StaticOrder so; MoeInfo mi; int ct0;
    __device__ __forceinline__ bool next(int i, pg8::Unit& u) const { return so.next(i, u); }
    __device__ __forceinline__ size_t a_off(const pg8::Unit& u, const pg8::Gemm& g) const { return (size_t)u.pm * 256 * g.lda; }
    __device__ __forceinline__ size_t b_off(const pg8::Unit& u, const pg8::Gemm& g) const { const int e = mi.expert_of(ct0 + u.pm); return ((size_t)e * D + (size_t)u.pn * 256) * g.ldb; }
    __device__ __forceinline__ unsigned a_row(const pg8::Unit&, int) const { return 0u; }
};
#if defined(SELFTEST)
namespace st {
constexpr int TB = 2;
constexpr int CW_ERR = 32768;
template <class AF, class OF> __device__ __forceinline__ void naive_mm(int M, int N, int K, const float* W, int ldw, int n0, const AF& a, const OF& o, int gt, int ngt) {
    for (long i = gt; i < (long)M * N; i += ngt) { const int m = (int)(i / N), n = (int)(i % N); float s = 0.f; for (int k = 0; k < K; ++k) s += a(m, k) * W[(size_t)k * ldw + n0 + n]; o(m, n, s); }
}
__device__ __forceinline__ float wave_max(float v) {
#pragma unroll
    for (int o = 1; o < 64; o <<= 1) v = fmaxf(v, __shfl_xor(v, o));
    return v;
}
__device__ __forceinline__ int rel_bucket_ref(int dist) {
    const int n = dist > 0 ? dist : 0; if (n < 16) return n;
    const float nf = (float)n; int large = 16 + (int)(logf(nf / 16.f) / 2.0794415416798357f * 16.f); return large < 31 ? large : 31;
}
}
#endif
constexpr int N_PHASES = 28;
struct Args { const float* in[27]; float* out; unsigned char* ws; int ph_lo, ph_hi; };
enum { I_X = 0, I_MLA_WIN, I_MLA_QN, I_MLA_WQ, I_MLA_KVN, I_MLA_WKV, I_MLA_WO, I_NSA_WIN, I_PE_K, I_W1_K, I_W2_K, I_PE_V, I_W1_V, I_W2_V, I_NSA_WO, I_RELB,
       I_FFN_G, I_FFN_U, I_FFN_D, I_ROUTER, I_MOE_G, I_MOE_U, I_MOE_D, I_LNM_G, I_LNM_B, I_LNF_G, I_LNF_B };

__device__ __forceinline__ int rel_bucket_dev(int n) {
    if (n < 16) return n;
    int bkt = 16;
    bkt += n >= 19; bkt += n >= 21; bkt += n >= 24; bkt += n >= 27; bkt += n >= 31; bkt += n >= 35; bkt += n >= 40; bkt += n >= 46;
    bkt += n >= 52; bkt += n >= 59; bkt += n >= 67; bkt += n >= 77; bkt += n >= 87; bkt += n >= 99; bkt += n >= 113;
    return bkt;
}

__global__ void __launch_bounds__(NWAVES * 64, 2) fwd(Args args) {
#if defined(__HIP_DEVICE_COMPILE__)
    extern __shared__ __attribute__((aligned(16))) unsigned char lds_raw[];
    LAS unsigned char* lds = (LAS unsigned char*)lds_raw;
    volatile LAS unsigned* MISC = (volatile LAS unsigned*)(lds + MISC_OFF);
    const int tid_ = threadIdx.x, wave = __builtin_amdgcn_readfirstlane(tid_ >> 6);
    const int G = gridDim.x, bx = blockIdx.x;
    const int vcu = (G % 8 == 0) ? (bx % 8) * (G / 8) + bx / 8 : bx;
    const int NGW = G * NWAVES;
    unsigned char* ws = args.ws;
    unsigned* ctl = (unsigned*)(ws + WS_CTL);
    for (int u = tid_; u < (LDS_BYTES - RING_BYTES) / 4; u += NWAVES * 64) ((LAS unsigned*)(lds + RING_BYTES))[u] = 0u;
    __syncthreads();
    XcdBarrier bar = xcd_barrier_post(ctl + CW_BAR, MISC + 8);
    const int lo = args.ph_lo, hi_ph = args.ph_hi;
#ifndef PHMASK
#define PHMASK 0xFFFFFFFFu
#endif
#define IN(k) (((PHMASK >> (k)) & 1u) && lo <= (k) && (k) < hi_ph)
#define SEAM(k) do { if (IN(k) && IN((k) + 1)) xcd_barrier(bar); } while (0)
#ifndef DUP_MASK
#define DUP_MASK 0u
#endif
#define REP(k) _Pragma("nounroll") for (int rep_ = 0; rep_ < 1 + (int)((DUP_MASK >> (k)) & 1u); ++rep_, (((DUP_MASK >> (k)) & 1u) && rep_ == 1) ? xcd_barrier(bar) : (void)0)
#define W_MLAIN ((bf16_t*)(ws + WS_W_MLAIN))
#define W_QUP ((bf16_t*)(ws + WS_W_QUP))
#define W_KVUP ((bf16_t*)(ws + WS_W_KVUP))
#define W_MLAOUT ((bf16_t*)(ws + WS_W_MLAOUT))
#define W_FFNGU ((bf16_t*)(ws + WS_W_FFNGU))
#define W_FFND ((bf16_t*)(ws + WS_W_FFND))
#define W_NSAIN ((bf16_t*)(ws + WS_W_NSAIN))
#define W_NSAOUT ((bf16_t*)(ws + WS_W_NSAOUT))
#define W_C1K ((bf16_t*)(ws + WS_W_C1K))
#define W_C1V ((bf16_t*)(ws + WS_W_C1V))
#define W_C2K ((bf16_t*)(ws + WS_W_C2K))
#define W_C2V ((bf16_t*)(ws + WS_W_C2V))
#define ROPE_C ((float*)(ws + WS_ROPE))
#define CBIAS ((float*)(ws + WS_CBIAS))
#define RBT ((float*)(ws + WS_RBT))
#define ROWTOK ((int*)(ws + WS_ROWTOK))
#define TOKINFO ((unsigned*)(ws + WS_TOKINFO))
#define TOKW ((float*)(ws + WS_TOKW))
#define XB ((bf16_t*)(ws + WS_XB))
#define LAT ((bf16_t*)(ws + WS_LAT))
#define QN ((bf16_t*)(ws + WS_QN))
#define KVN ((bf16_t*)(ws + WS_KVN))
#define KR ((bf16_t*)(ws + WS_KR))
#define Q ((bf16_t*)(ws + WS_Q))
#define KN ((bf16_t*)(ws + WS_KN))
#define V ((bf16_t*)(ws + WS_V))
#define O ((bf16_t*)(ws + WS_O))
#define X1 ((bf16_t*)(ws + WS_X1))
#define ACT ((bf16_t*)(ws + WS_ACT))
#define X2 ((bf16_t*)(ws + WS_X2))
#define NQ ((bf16_t*)(ws + WS_NQ))
#define KC ((bf16_t*)(ws + WS_KC))
#define VC ((bf16_t*)(ws + WS_VC))
#define KS ((bf16_t*)(ws + WS_KS))
#define VS ((bf16_t*)(ws + WS_VS))
#define KW ((bf16_t*)(ws + WS_KW))
#define VW ((bf16_t*)(ws + WS_VW))
#define GT ((float*)(ws + WS_GT))
#define HK ((bf16_t*)(ws + WS_HK))
#define HV ((bf16_t*)(ws + WS_HV))
#define KCMP ((bf16_t*)(ws + WS_KCMP))
#define VCMP ((bf16_t*)(ws + WS_VCMP))
#define ONSA ((bf16_t*)(ws + WS_ONSA))
#define X3 ((bf16_t*)(ws + WS_X3))
#define W_MOEGU ((bf16_t*)(ws + WS_MOE_GU))
#define W_MOED ((bf16_t*)(ws + WS_MOE_D))
#define DOUT ((bf16_t*)(ws + WS_DOUT))
#define W_MOEGU8 ((unsigned char*)(ws + WS_MOE_GU8))
#define W_MOED8 ((unsigned char*)(ws + WS_MOE_D8))
#define X3F8 ((unsigned char*)(ws + WS_X3F8))
#define ROPE_S (ROPE_C + SEQ * 32)
#define P (args.out)
#define ACTC ((bf16_t*)args.out)
    typedef pg8::SchedPlain SP;
#define PH_LAUNDER() int tid = tid_; asm volatile("" : "+v"(tid)); const int lane = tid & 63; const int gw = vcu * NWAVES + wave; LAS float* scr = (LAS float*)(lds + wave * 8704); (void)lane; (void)gw; (void)scr;

    REP(0) if (IN(0)) {
        PH_LAUNDER();
        const float* const* in = args.in;
        tr_matrix(in[I_MLA_WIN], D, MLA_IN, W_MLAIN, D, RmId{0}, scr, gw, NGW, lane);
        tr_matrix(in[I_MLA_WQ], MLA_QR, 1536, W_QUP, MLA_QR, RmQup{}, scr, gw, NGW, lane);
        tr_matrix(in[I_MLA_WKV], MLA_KVR, 2048, W_KVUP, MLA_KVR, RmId{0}, scr, gw, NGW, lane);
        tr_matrix(in[I_MLA_WO], D, D, W_MLAOUT, D, RmId{0}, scr, gw, NGW, lane);
        tr_matrix(in[I_FFN_G], D, FF, W_FFNGU, D, RmGU{0}, scr, gw, NGW, lane);
        tr_matrix(in[I_FFN_U], D, FF, W_FFNGU, D, RmGU{128}, scr, gw, NGW, lane);
        tr_matrix(in[I_FFN_D], FF, D, W_FFND, FF, RmId{0}, scr, gw, NGW, lane);
        tr_matrix(in[I_NSA_WIN], D, NSA_IN, W_NSAIN, D, RmId{0}, scr, gw, NGW, lane);
        tr_matrix(in[I_NSA_WO], D, D, W_NSAOUT, D, RmId{0}, scr, gw, NGW, lane);
        const int gt = vcu * 512 + tid, NGT = G * 512;
        for (int i = gt; i < (1024 - MLA_IN) * D / 8; i += NGT) ((u32x4*)(W_MLAIN + (size_t)MLA_IN * D))[i] = (u32x4){0u, 0u, 0u, 0u};
        for (int i = gt; i < (NSA_INP - NSA_IN) * D / 8; i += NGT) ((u32x4*)(W_NSAIN + (size_t)NSA_IN * D))[i] = (u32x4){0u, 0u, 0u, 0u};
        for (int i = gt; i < 256 * 3072; i += NGT) { const int n = i / 3072, k = i % 3072; W_C1K[i] = (bf16_t)(n < 96 ? f2bf(in[I_W1_K][(size_t)k * 96 + n]) : 0u); }
        for (int i = gt; i < 256 * 2048; i += NGT) { const int n = i / 2048, k = i % 2048; W_C1V[i] = (bf16_t)(n < 64 ? f2bf(in[I_W1_V][(size_t)k * 64 + n]) : 0u); }
        for (int i = gt; i < 256 * 128; i += NGT) { const int n = i / 128, k = i % 128;
            W_C2K[i] = (bf16_t)((n < 96 && k < 96) ? f2bf(in[I_W2_K][k * 96 + n]) : 0u); W_C2V[i] = (bf16_t)((n < 64 && k < 64) ? f2bf(in[I_W2_V][k * 64 + n]) : 0u); }
        for (int i = gw; i < 256; i += NGW) { const int isv = i >> 7, e = i & 127; const int nd = isv ? 64 : 96; float s = 0.f;
            if (e < nd) { const float* pe = in[isv ? I_PE_V : I_PE_K]; const float* w1 = in[isv ? I_W1_V : I_W1_K]; for (int k = lane; k < 32 * nd; k += 64) s += pe[k] * w1[(size_t)k * nd + e]; }
            s = wave_sum(s); if (lane == 0) CBIAS[i] = s; }
        for (int i = gt; i < SEQ * 32; i += NGT) { const int pos = i >> 5, j = i & 31; const float fr = (float)pow(10000.0, -(double)j / 32.0); const float ang = (float)pos * fr;
            ROPE_C[i] = (float)cos((double)ang); ROPE_S[i] = (float)sin((double)ang); }
        for (int i = gt; i < 16 * nsa::TABW; i += NGT) { const int h = i / nsa::TABW, d = i % nsa::TABW; const float* rb = in[I_RELB];
            RBT[i] = d < 128 ? (rb[rel_bucket_dev(d) * 16 + h] - rb[31 * 16 + h]) * LOG2E : 0.f; }
        for (int m = gw; m < T; m += NGW) { const f32x4* xr = (const f32x4*)(in[I_X] + (size_t)m * D) + lane; f32x4 v[4];
#pragma unroll
            for (int j = 0; j < 4; ++j) v[j] = xr[64 * j];
            store_row_bf16(XB + (size_t)m * D, v, lane); }
    }
    SEAM(0);
    REP(1) if (IN(1)) { pg8::Gemm g{XB, W_MLAIN, (D) * 2, (D) * 2, (D) * 2}; SP S; S.init(T / 256, 4, G, bx);
        pg8::EpiRow8<FBf16> E{FBf16{LAT, 1024, 0}}; pg8::gemm_phase<pg8::EpiRow8<FBf16>, SP, true, false>(lds, g, S, E); }
    SEAM(1);
    REP(2) if (IN(2)) {
        PH_LAUNDER();
        const float* qg = args.in[I_MLA_QN]; const float* kg = args.in[I_MLA_KVN];
        for (int m = gw; m < T; m += NGW) {
            const bf16_t* row = LAT + (size_t)m * 1024;
            const u32x4 wq = *((const u32x4*)row + lane);
            const u32x2 wk = *((const u32x2*)(row + 512) + lane);
            float q[8] = {bflo(wq.x), bfhi(wq.x), bflo(wq.y), bfhi(wq.y), bflo(wq.z), bfhi(wq.z), bflo(wq.w), bfhi(wq.w)};
            float k[4] = {bflo(wk.x), bfhi(wk.x), bflo(wk.y), bfhi(wk.y)};
            float sq = 0.f, sk = 0.f;
#pragma unroll
            for (int e = 0; e < 8; ++e) sq += q[e] * q[e];
#pragma unroll
            for (int e = 0; e < 4; ++e) sk += k[e] * k[e];
            const float rq = 1.f / sqrtf(wave_sum(sq) * (1.f / 512.f) + 1e-6f), rk = 1.f / sqrtf(wave_sum(sk) * (1.f / 256.f) + 1e-6f);
            const f32x4 g0 = *((const f32x4*)qg + 2 * lane), g1 = *((const f32x4*)qg + 2 * lane + 1), g2 = *((const f32x4*)kg + lane);
            u32x4 oq; oq.x = cvt_pk_bf16(q[0] * rq * g0[0], q[1] * rq * g0[1]); oq.y = cvt_pk_bf16(q[2] * rq * g0[2], q[3] * rq * g0[3]);
            oq.z = cvt_pk_bf16(q[4] * rq * g1[0], q[5] * rq * g1[1]); oq.w = cvt_pk_bf16(q[6] * rq * g1[2], q[7] * rq * g1[3]);
            *((u32x4*)(QN + (size_t)m * 512) + lane) = oq;
            u32x2 ok; ok.x = cvt_pk_bf16(k[0] * rk * g2[0], k[1] * rk * g2[1]); ok.y = cvt_pk_bf16(k[2] * rk * g2[2], k[3] * rk * g2[3]);
            *((u32x2*)(KVN + (size_t)m * 256) + lane) = ok;
            if (lane < 32) { const float x1 = bf2f(row[768 + lane]), x2 = bf2f(row[800 + lane]); const int s = m & (SEQ - 1);
                const float c = ROPE_C[s * 32 + lane], sn = ROPE_S[s * 32 + lane]; const int p = 8 * (lane >> 2) + (lane & 3);
                bf16_t* kr = KR + (size_t)m * 64; kr[p] = (bf16_t)f2bf(x1 * c - x2 * sn); kr[p + 4] = (bf16_t)f2bf(x1 * sn + x2 * c); }
        }
    }
    SEAM(2);
    REP(3) if (IN(3)) { pg8::Gemm g{QN, W_QUP, (MLA_QR) * 2, (MLA_QR) * 2, (MLA_QR) * 2}; SP S; S.init(T / 256, 6, G, bx);
        pg8::EpiRow8<FQup> E{FQup{Q, ROPE_C, ROPE_S}}; pg8::gemm_phase<pg8::EpiRow8<FQup>, SP, true, false>(lds, g, S, E); }
    SEAM(3);
    REP(4) if (IN(4)) { pg8::Gemm g{KVN, W_KVUP, (MLA_KVR) * 2, (MLA_KVR) * 2, (MLA_KVR) * 2}; SP S; S.init(T / 256, 8, G, bx);
        pg8::EpiRow8<FKvup> E{FKvup{KN, V}}; pg8::gemm_phase<pg8::EpiRow8<FKvup>, SP, true, false>(lds, g, S, E); }
    SEAM(4);
    REP(5) if (IN(5)) {
        PH_LAUNDER();
        att::Plan<mla::R> plan; plan.init(wave, lane);
        for (int it2 = 2 * bx; it2 < 2 * NB * MLA_H * 16; it2 += (it2 & 1) ? 2 * G - 1 : 1) { const int it = it2 >> 1, bh = it & 31, x = it >> 5;
            mla::unit((LAS char*)lds, plan, bh >> 3, bh & 7, (it2 & 1) ? x : 31 - x, Q, KN, KR, V, O, tid, wave); }
    }
    SEAM(5);

#if defined(SELFTEST) && SELFTEST == 1
    {
        PH_LAUNDER();
        const float* const* in = args.in; const int gt = vcu * 512 + tid, NGT = G * 512;
        float* TKV = (float*)(ws + 104 * MiB); float* TLAT = (float*)(ws + 168 * MiB); float* TQ = (float*)(ws + 200 * MiB);
        float* TKR = (float*)(ws + 250 * MiB); float* TKVN = (float*)(ws + 256 * MiB); float* TQN = (float*)(ws + 264 * MiB);
        const float* xb = in[I_X] + (size_t)st::TB * SEQ * D;
        st::naive_mm(SEQ, 832, 1024, in[I_MLA_WIN], 832, 0, [&](int m, int k) { return xb[(size_t)m * D + k]; }, [&](int m, int n, float v) { TLAT[(size_t)m * 832 + n] = v; }, gt, NGT);
        xcd_barrier(bar);
        for (int m = gw; m < SEQ; m += NGW) { const float* r = TLAT + (size_t)m * 832; float sq = 0.f, sk = 0.f;
            for (int k = lane; k < 512; k += 64) sq += r[k] * r[k];
            for (int k = lane; k < 256; k += 64) sk += r[512 + k] * r[512 + k];
            sq = wave_sum(sq); sk = wave_sum(sk);
            const float rq = 1.f / sqrtf(sq / 512.f + 1e-6f), rk = 1.f / sqrtf(sk / 256.f + 1e-6f);
            for (int k = lane; k < 512; k += 64) TQN[(size_t)m * 512 + k] = r[k] * rq * in[I_MLA_QN][k];
            for (int k = lane; k < 256; k += 64) TKVN[(size_t)m * 256 + k] = r[512 + k] * rk * in[I_MLA_KVN][k];
            if (lane < 32) { const float fr = powf(10000.f, -(float)lane / 32.f), ang = (float)m * fr, c = cosf(ang), sn = sinf(ang), x1 = r[768 + lane], x2 = r[800 + lane];
                TKR[(size_t)m * 64 + lane] = x1 * c - x2 * sn; TKR[(size_t)m * 64 + 32 + lane] = x1 * sn + x2 * c; } }
        xcd_barrier(bar);
        st::naive_mm(SEQ, 1536, 512, in[I_MLA_WQ], 1536, 0, [&](int m, int k) { return TQN[(size_t)m * 512 + k]; }, [&](int m, int n, float v) { TQ[(size_t)m * 1536 + n] = v; }, gt, NGT);
        st::naive_mm(SEQ, 2048, 256, in[I_MLA_WKV], 2048, 0, [&](int m, int k) { return TKVN[(size_t)m * 256 + k]; }, [&](int m, int n, float v) { TKV[(size_t)m * 2048 + n] = v; }, gt, NGT);
        xcd_barrier(bar);
        for (int m = gw; m < SEQ; m += NGW) for (int e = lane; e < 256; e += 64) { const int h = e >> 5, i = e & 31; float* q = TQ + (size_t)m * 1536 + h * 192 + 128;
            const float fr = powf(10000.f, -(float)i / 32.f), ang = (float)m * fr, c = cosf(ang), sn = sinf(ang), x1 = q[i], x2 = q[32 + i]; q[i] = x1 * c - x2 * sn; q[32 + i] = x1 * sn + x2 * c; }
        xcd_barrier(bar);
        float err = 0.f, ref2 = 0.f;
        for (int row = gw; row < MLA_H * SEQ; row += NGW) { const int h = row & 7, q = row >> 3;
            const float* qv = TQ + (size_t)q * 1536 + h * 192; const float q0 = qv[lane], q1 = qv[64 + lane], q2 = qv[128 + lane];
            float mm = -__builtin_inff(), l = 0.f, a0 = 0.f, a1 = 0.f;
            for (int k = 0; k <= q; ++k) { const float* kn = TKV + (size_t)k * 2048 + h * 256; const float* kr = TKR + (size_t)k * 64;
                const float sc = wave_sum(q0 * kn[lane] + q1 * kn[64 + lane] + q2 * kr[lane]) * 0.07216878364870323f;
                const float mn = fmaxf(mm, sc), al = __expf(mm - mn), p = __expf(sc - mn);
                l = l * al + p; a0 = a0 * al + p * kn[128 + lane]; a1 = a1 * al + p * kn[192 + lane]; mm = mn; }
            const float o0 = a0 / l, o1 = a1 / l; const bf16_t* fo = O + ((size_t)st::TB * SEQ + q) * 1024 + h * 128;
            const float f0 = bf2f(fo[lane]), f1 = bf2f(fo[64 + lane]);
            err += (f0 - o0) * (f0 - o0) + (f1 - o1) * (f1 - o1); ref2 += o0 * o0 + o1 * o1; }
        err = wave_sum(err); ref2 = wave_sum(ref2);
        if (lane == 0) { atomicAdd((float*)(ctl + st::CW_ERR), err); atomicAdd((float*)(ctl + st::CW_ERR + 1), ref2); }
        xcd_barrier(bar);
    }
#endif
    REP(6) if (IN(6)) { pg8::Gemm g{O, W_MLAOUT, (D) * 2, (D) * 2, (D) * 2}; SP S; S.init(T / 256, 4, G, bx);
        pg8::EpiRow8<FResF32> E{FResF32{P, args.in[I_X], nullptr}}; pg8::gemm_phase<pg8::EpiRow8<FResF32>, SP, true, false>(lds, g, S, E); }
    SEAM(6);
    REP(7) if (IN(7)) {
        PH_LAUNDER();
        for (int m = gw; m < T; m += NGW) { const f32x4* pr = (const f32x4*)(P + (size_t)m * D) + lane; f32x4 v[4];
#pragma unroll
            for (int j = 0; j < 4; ++j) v[j] = pr[64 * j];
            ln_inplace(v, args.in[I_LNM_G], args.in[I_LNM_B], lane); store_row_bf16(X1 + (size_t)m * D, v, lane); }
    }
    SEAM(7);
    REP(8) if (IN(8)) { pg8::Gemm g{X1, W_FFNGU, (D) * 2, (D) * 2, (D) * 2}; SP S; S.init(T / 256, 22, G, bx);
        pg8::EpiGateUp<FSwiglu> E{FSwiglu{ACT, FF, 0}}; pg8::gemm_phase<pg8::EpiGateUp<FSwiglu>, SP, true, false>(lds, g, S, E); }
    SEAM(8);
    REP(9) if (IN(9)) { pg8::Gemm g{ACT, W_FFND, (FF) * 2, (FF) * 2, (FF) * 2}; SP S; S.init(T / 256, 4, G, bx);
        pg8::EpiRow8<FResF32> E{FResF32{P, nullptr, X1}}; pg8::gemm_phase<pg8::EpiRow8<FResF32>, SP, true, false>(lds, g, S, E); }
    SEAM(9);
    REP(10) if (IN(10)) {
        PH_LAUNDER();
        for (int m = gw; m < T; m += NGW) { const f32x4* pr = (const f32x4*)(P + (size_t)m * D) + lane; f32x4 v[4];
#pragma unroll
            for (int j = 0; j < 4; ++j) v[j] = pr[64 * j];
            ln_inplace(v, args.in[I_LNF_G], args.in[I_LNF_B], lane); store_row_bf16(X2 + (size_t)m * D, v, lane); }
    }
    SEAM(10);
    REP(11) if (IN(11)) { pg8::Gemm g{X2, W_NSAIN, (D) * 2, (D) * 2, (D) * 2}; SP S; S.init(T / 256, NSA_INP / 256, G, bx);
        pg8::EpiRow8<FNsaIn> E{FNsaIn{NQ, KC, VC, GT}}; pg8::gemm_phase<pg8::EpiRow8<FNsaIn>, SP, true, false>(lds, g, S, E); }
    SEAM(11);
    REP(12) if (IN(12)) {
        { pg8::Gemm g{KC, W_C1K, (16 * 96) * 2, (3072) * 2, (3072) * 2}; SP S; S.init(32, 1, G, bx);
          pg8::EpiRow8<FCmp1> E{FCmp1{HK, CBIAS}}; pg8::gemm_phase<pg8::EpiRow8<FCmp1>, SP, false, false>(lds, g, S, E); }
        { pg8::Gemm g{VC, W_C1V, (16 * 64) * 2, (2048) * 2, (2048) * 2}; SP S; S.init(32, 1, G, (bx + G / 2) % G);
          pg8::EpiRow8<FCmp1> E{FCmp1{HV, CBIAS + 128}}; pg8::gemm_phase<pg8::EpiRow8<FCmp1>, SP, false, false>(lds, g, S, E); }
    }
    SEAM(12);
    REP(13) if (IN(13)) {
        { pg8::Gemm g{HK, W_C2K, (128) * 2, (128) * 2, (128) * 2}; SP S; S.init(32, 1, G, bx);
          pg8::EpiRow8<FCmp2> E{FCmp2{KCMP, 96}}; pg8::gemm_phase<pg8::EpiRow8<FCmp2>, SP, false, false>(lds, g, S, E); }
        { pg8::Gemm g{HV, W_C2V, (128) * 2, (128) * 2, (128) * 2}; SP S; S.init(32, 1, G, (bx + G / 2) % G);
          pg8::EpiRow8<FCmp2> E{FCmp2{VCMP, 64}}; pg8::gemm_phase<pg8::EpiRow8<FCmp2>, SP, false, false>(lds, g, S, E); }
    }
    SEAM(13);

#if defined(SELFTEST) && SELFTEST == 3
    {
        PH_LAUNDER();
        const float* const* in = args.in; const int gt = vcu * 512 + tid, NGT = G * 512;
        float* TPROJ = (float*)(ws + 348 * MiB);
        float* THK = (float*)(ws + 460 * MiB); float* THV = (float*)(ws + 461 * MiB); float* TKC = (float*)(ws + 462 * MiB); float* TVC = (float*)(ws + 463 * MiB);
        const bf16_t* xb = X2 + (size_t)st::TB * SEQ * D;
        st::naive_mm(SEQ, 3504, 1024, in[I_NSA_WIN], 3504, 0, [&](int m, int k) { return bf2f(xb[(size_t)m * D + k]); }, [&](int m, int n, float v) { TPROJ[(size_t)m * 3504 + n] = v; }, gt, NGT);
        xcd_barrier(bar);
        for (int i = gt; i < 4 * 511 * 96; i += NGT) { const int e = i % 96, n = (i / 96) % 511, g = i / (96 * 511); float s = 0.f;
            for (int l = 0; l < 32; ++l) for (int d = 0; d < 96; ++d) s += (TPROJ[(size_t)(16 * n + l) * 3504 + 1536 + g * 96 + d] + in[I_PE_K][l * 96 + d]) * in[I_W1_K][(size_t)(l * 96 + d) * 96 + e];
            THK[(g * 512 + n) * 96 + e] = 0.5f * s * (1.f + tanhf(0.7978845608028654f * (s + 0.044715f * s * s * s))); }
        for (int i = gt; i < 4 * 511 * 64; i += NGT) { const int e = i % 64, n = (i / 64) % 511, g = i / (64 * 511); float s = 0.f;
            for (int l = 0; l < 32; ++l) for (int d = 0; d < 64; ++d) s += (TPROJ[(size_t)(16 * n + l) * 3504 + 1920 + g * 64 + d] + in[I_PE_V][l * 64 + d]) * in[I_W1_V][(size_t)(l * 64 + d) * 64 + e];
            THV[(g * 512 + n) * 64 + e] = 0.5f * s * (1.f + tanhf(0.7978845608028654f * (s + 0.044715f * s * s * s))); }
        xcd_barrier(bar);
        float err = 0.f, ref2 = 0.f;
        for (int i = gt; i < 4 * 511 * 96; i += NGT) { const int e = i % 96, n = (i / 96) % 511, g = i / (96 * 511); float s = 0.f; for (int d = 0; d < 96; ++d) s += THK[(g * 512 + n) * 96 + d] * in[I_W2_K][d * 96 + e];
            const float f = bf2f(KCMP[((size_t)(st::TB * 4 + g) * 512 + n) * 96 + e]); err += (f - s) * (f - s); ref2 += s * s; }
        for (int i = gt; i < 4 * 511 * 64; i += NGT) { const int e = i % 64, n = (i / 64) % 511, g = i / (64 * 511); float s = 0.f; for (int d = 0; d < 64; ++d) s += THV[(g * 512 + n) * 64 + d] * in[I_W2_V][d * 64 + e];
            const float f = bf2f(VCMP[((size_t)(st::TB * 4 + g) * 512 + n) * 64 + e]); err += (f - s) * (f - s); ref2 += s * s; }
        for (long i = gt; i < (long)SEQ * 3504; i += NGT) { const int m = (int)(i / 3504), c = (int)(i % 3504); const float r = TPROJ[i]; const size_t trow = (size_t)st::TB * SEQ + m; float f, rr = r;
            if (c < 1536) { f = bf2f(NQ[trow * 1536 + c]); rr = r * C2_NSA; }
            else if (c >= 3456) { f = GT[trow * 48 + (c - 3456)]; rr = 1.f / (1.f + __expf(-r)); }
            else { int cc = c - 1536; const bf16_t* base; int dd;
                if (cc < 384) { base = KC; dd = 96; } else if (cc < 640) { base = VC; dd = 64; cc -= 384; } else if (cc < 1024) { base = KS; dd = 96; cc -= 640; } else if (cc < 1280) { base = VS; dd = 64; cc -= 1024; }
                else if (cc < 1664) { base = KW; dd = 96; cc -= 1280; } else { base = VW; dd = 64; cc -= 1664; }
                const int g = cc / dd, d = cc % dd; f = bf2f(base[((size_t)(st::TB * 4 + g) * SEQ + m) * dd + d]); }
            err += (f - rr) * (f - rr); ref2 += rr * rr; }
        err = wave_sum(err); ref2 = wave_sum(ref2);
        if (lane == 0) { atomicAdd((float*)(ctl + st::CW_ERR), err); atomicAdd((float*)(ctl + st::CW_ERR + 1), ref2); }
        xcd_barrier(bar);
    }
#endif
#if defined(XNSA)
    {
        PH_LAUNDER();
        const nsa::Tensors X{NQ, KCMP, VCMP, KS, VS, KW, VW, GT, RBT, (bf16_t*)args.out};
        att::Plan<nsa::R> plan; plan.init(wave, lane);
        for (int it2 = 2 * bx; it2 < 2 * NB * NSA_G * 64; it2 += (it2 & 1) ? 2 * G - 1 : 1) { const int it = it2 >> 1, bg = it & 15, x = it >> 4;
            nsa::unit<XNSA>((LAS char*)lds, plan, X, bg >> 2, bg & 3, (it2 & 1) ? x : 127 - x, tid, wave); }
        xcd_barrier(bar);
    }
#endif
    REP(14) if (IN(14)) {
        PH_LAUNDER();
        const nsa::Tensors X{NQ, KCMP, VCMP, KS, VS, KW, VW, GT, RBT, ONSA};
        att::Plan<nsa::R> plan; plan.init(wave, lane);
        for (int it2 = 2 * bx; it2 < 2 * NB * NSA_G * 64; it2 += (it2 & 1) ? 2 * G - 1 : 1) { const int it = it2 >> 1, bg = it & 15, x = it >> 4;
            nsa::unit((LAS char*)lds, plan, X, bg >> 2, bg & 3, (it2 & 1) ? x : 127 - x, tid, wave); }
    }
    SEAM(14);

#if defined(SELFTEST) && SELFTEST == 2
    {
        PH_LAUNDER();
        const float* rb = args.in[I_RELB];
        LAS float* buf = (LAS float*)(lds + wave * 6144); LAS float* imp = buf + 1024; LAS int* sel = (LAS int*)(imp + 128);
        const float scale_q = 1.f / LOG2E;
        float err = 0.f, ref2 = 0.f;
        for (int item = gw; item < NSA_G * SEQ; item += NGW) { const int g = item & 3, q = item >> 2, qpos = q, cur = q >> 6; const size_t trow = (size_t)st::TB * SEQ + q; const int bg = st::TB * NSA_G + g;
            float oacc[4] = {0.f, 0.f, 0.f, 0.f};
            imp[lane] = 0.f; imp[64 + lane] = 0.f;
            int nvalid = qpos >= 31 ? ((qpos - 31) >> 4) + 1 : 0; if (nvalid > 511) nvalid = 511;
            const bf16_t* kc = KCMP + (size_t)bg * 512 * 96; const bf16_t* vc = VCMP + (size_t)bg * 512 * 64;
            const bf16_t* ks = KS + (size_t)bg * SEQ * 96; const bf16_t* vs = VS + (size_t)bg * SEQ * 64; const bf16_t* kw = KW + (size_t)bg * SEQ * 96; const bf16_t* vw = VW + (size_t)bg * SEQ * 64;
            for (int h = 0; h < 4; ++h) { const int head = g * 4 + h; const bf16_t* qv = NQ + trow * 1536 + head * 96;
                float mx = -__builtin_inff();
                for (int n = lane; n < nvalid; n += 64) { float s = 0.f; for (int d = 0; d < 96; ++d) s += bf2f(qv[d]) * bf2f(kc[(size_t)n * 96 + d]);
                    s = s * scale_q + rb[st::rel_bucket_ref(qpos - 16 * n - 31) * 16 + head]; buf[n] = s; mx = fmaxf(mx, s); }
                mx = st::wave_max(mx); if (!(mx > -1e38f)) mx = 0.f;
                float sum = 0.f; LDS_WAIT();
                for (int n = lane; n < nvalid; n += 64) { const float p = __expf(buf[n] - mx); buf[n] = p; sum += p; }
                sum = wave_sum(sum); const float inv = 1.f / fmaxf(sum, 1e-30f);
                for (int n = lane; n < nvalid; n += 64) buf[n] *= inv;
                LDS_WAIT();
                float oc = 0.f; for (int n = 0; n < nvalid; ++n) oc += buf[n] * bf2f(vc[(size_t)n * 64 + lane]);
                oacc[h] += GT[trow * 48 + head * 3 + 0] * oc;
                for (int j = lane; j < 128; j += 64) { float a = 0.f; for (int n = 4 * j - 1; n <= 4 * j + 3; ++n) if (n >= 0 && n < nvalid) a += buf[n]; imp[j] += a; }
                LDS_WAIT();
            }
            float v0, v1; { const int j0 = lane, j1 = lane + 64;
                v0 = j0 > cur ? -1e6f : ((j0 == 0 || j0 == cur || j0 == cur - 1) ? 1e6f : imp[j0]); v1 = j1 > cur ? -1e6f : ((j1 == 0 || j1 == cur || j1 == cur - 1) ? 1e6f : imp[j1]); }
            for (int it = 0; it < 16; ++it) { float bv = v0; int bi = lane; if (v1 > v0) { bv = v1; bi = lane + 64; }
#pragma unroll
                for (int o = 1; o < 64; o <<= 1) { const float ov = __shfl_xor(bv, o); const int oi = __shfl_xor(bi, o); if (ov > bv || (ov == bv && oi < bi)) { bv = ov; bi = oi; } }
                if (lane == 0) sel[it] = bi;
                if (bi == lane) v0 = -__builtin_inff(); if (bi == lane + 64) v1 = -__builtin_inff(); }
            LDS_WAIT();
            for (int h = 0; h < 4; ++h) { const int head = g * 4 + h; const bf16_t* qv = NQ + trow * 1536 + head * 96;
                float mx = -__builtin_inff();
                for (int it = 0; it < 16; ++it) { const int kpos = sel[it] * 64 + lane, dist = qpos - kpos; float s = -__builtin_inff();
                    if (dist >= 0) { s = 0.f; for (int d = 0; d < 96; ++d) s += bf2f(qv[d]) * bf2f(ks[(size_t)kpos * 96 + d]); s = s * scale_q + rb[st::rel_bucket_ref(dist) * 16 + head]; }
                    buf[it * 64 + lane] = s; mx = fmaxf(mx, s); }
                mx = st::wave_max(mx); if (!(mx > -1e38f)) mx = 0.f;
                float sum = 0.f;
                for (int it = 0; it < 16; ++it) { const float p = __expf(buf[it * 64 + lane] - mx); buf[it * 64 + lane] = p; sum += p; }
                sum = wave_sum(sum); float inv = 1.f / fmaxf(sum, 1e-30f);
                LDS_WAIT();
                float os = 0.f; for (int i = 0; i < 1024; ++i) { const int kpos = sel[i >> 6] * 64 + (i & 63); os += buf[i] * bf2f(vs[(size_t)kpos * 64 + lane]); }
                oacc[h] += GT[trow * 48 + head * 3 + 1] * os * inv;
                LDS_WAIT();
                mx = -__builtin_inff();
                for (int i = lane; i < 512; i += 64) { const int kpos = qpos - i; float s = -__builtin_inff();
                    if (kpos >= 0) { s = 0.f; for (int d = 0; d < 96; ++d) s += bf2f(qv[d]) * bf2f(kw[(size_t)kpos * 96 + d]); s = s * scale_q + rb[st::rel_bucket_ref(i) * 16 + head]; }
                    buf[i] = s; mx = fmaxf(mx, s); }
                mx = st::wave_max(mx); if (!(mx > -1e38f)) mx = 0.f;
                sum = 0.f;
                for (int i = lane; i < 512; i += 64) { const float p = __expf(buf[i] - mx); buf[i] = p; sum += p; }
                sum = wave_sum(sum); inv = 1.f / fmaxf(sum, 1e-30f);
                LDS_WAIT();
                float ow = 0.f; for (int i = 0; i < 512; ++i) { const int kpos = qpos - i; if (kpos >= 0) ow += buf[i] * bf2f(vw[(size_t)kpos * 64 + lane]); }
                oacc[h] += GT[trow * 48 + head * 3 + 2] * ow * inv;
                LDS_WAIT();
                const float f = bf2f(ONSA[trow * 1024 + head * 64 + lane]);
                err += (f - oacc[h]) * (f - oacc[h]); ref2 += oacc[h] * oacc[h];
            }
        }
        err = wave_sum(err); ref2 = wave_sum(ref2);
        if (lane == 0) { atomicAdd((float*)(ctl + st::CW_ERR), err); atomicAdd((float*)(ctl + st::CW_ERR + 1), ref2); }
        xcd_barrier(bar);
    }
#endif
    REP(15) if (IN(15)) { pg8::Gemm g{ONSA, W_NSAOUT, (D) * 2, (D) * 2, (D) * 2}; SP S; S.init(T / 256, 4, G, bx);
        pg8::EpiRow8<FResF32> E{FResF32{P, nullptr, X2}}; pg8::gemm_phase<pg8::EpiRow8<FResF32>, SP, true, false>(lds, g, S, E); }
    SEAM(15);
    if (IN(16)) {
        PH_LAUNDER();
        LAS float* wr = (LAS float*)(lds + 69632);
        LAS unsigned* lcnt = (LAS unsigned*)(lds + 69632 + 32768);
        LAS unsigned* lrec = lcnt + 16;
        for (int i = tid; i < D * NE; i += 512) wr[i] = args.in[I_ROUTER][i];
        if (tid < 16) lcnt[tid] = 0u;
        __syncthreads();
        int nrec = 0;
        for (int m = gw; m < T; m += NGW, ++nrec) { const f32x4* pr = (const f32x4*)(P + (size_t)m * D) + lane; f32x4 v[4];
#pragma unroll
            for (int j = 0; j < 4; ++j) v[j] = pr[64 * j];
            ln_inplace(v, args.in[I_LNM_G] + D, args.in[I_LNM_B] + D, lane); store_row_bf16(X3 + (size_t)m * D, v, lane);
#if MOE_FP8
#pragma unroll
            for (int j = 0; j < 4; ++j) *((unsigned*)(X3F8 + (size_t)m * D) + lane + 64 * j) = pk4_fp8(v[j].x, v[j].y, v[j].z, v[j].w);
#endif
            float lg[NE];
#pragma unroll
            for (int e = 0; e < NE; ++e) lg[e] = 0.f;
#pragma unroll
            for (int j = 0; j < 4; ++j)
#pragma unroll
                for (int c = 0; c < 4; ++c) { const int k = 4 * lane + 256 * j + c; const f32x4 w0 = *(const LAS f32x4*)(wr + k * 8), w1 = *(const LAS f32x4*)(wr + k * 8 + 4); const float xv = v[j][c];
                    lg[0] += xv * w0[0]; lg[1] += xv * w0[1]; lg[2] += xv * w0[2]; lg[3] += xv * w0[3]; lg[4] += xv * w1[0]; lg[5] += xv * w1[1]; lg[6] += xv * w1[2]; lg[7] += xv * w1[3]; }
#pragma unroll
            for (int e = 0; e < NE; ++e) lg[e] = wave_sum(lg[e]);
            int e0 = 0; float v0 = lg[0];
#pragma unroll
            for (int e = 1; e < NE; ++e) if (lg[e] > v0) { v0 = lg[e]; e0 = e; }
            int e1 = -1; float v1 = -__builtin_inff();
#pragma unroll
            for (int e = 0; e < NE; ++e) if (e != e0 && lg[e] > v1) { v1 = lg[e]; e1 = e; }
            const float w1s = fast_rcp(1.f + __expf(v0 - v1)), w0s = 1.f - w1s;
            if (lane == 0) { const unsigned p0 = atomicAdd((unsigned*)(lcnt + e0), 1u), p1 = atomicAdd((unsigned*)(lcnt + e1), 1u);
                LAS unsigned* r = lrec + (wave * 32 + nrec) * 4; r[0] = (unsigned)m; r[1] = (unsigned)e0 | (p0 << 8); r[2] = (unsigned)e1 | (p1 << 8);
                TOKW[2 * m] = w0s; TOKW[2 * m + 1] = w1s; }
        }
        __syncthreads();
        if (tid < NE) lcnt[8 + tid] = __hip_atomic_fetch_add(ctl + CW_ECNT + 64 * tid, lcnt[tid], RLX_AGENT);
        __syncthreads();
        if (lane == 0) for (int i = 0; i < nrec; ++i) { const LAS unsigned* r = lrec + (wave * 32 + i) * 4; const unsigned m = r[0];
#pragma unroll
            for (int k = 0; k < 2; ++k) { const unsigned e = r[1 + k] & 255u, pos = lcnt[8 + e] + (r[1 + k] >> 8); ROWTOK[e * ECAP + pos] = (int)m; TOKINFO[2 * m + k] = (e << 16) | pos; } }
        for (int e = 0; e < NE; ++e) {
#if MOE_FP8
            tr_matrix_f8(args.in[I_MOE_G] + (size_t)e * D * FFE, D, FFE, W_MOEGU8 + (size_t)e * 2 * FFE * D, D, MOE_GU_WS, RmGU{0}, scr, gw, NGW, lane);
            tr_matrix_f8(args.in[I_MOE_U] + (size_t)e * D * FFE, D, FFE, W_MOEGU8 + (size_t)e * 2 * FFE * D, D, MOE_GU_WS, RmGU{128}, scr, gw, NGW, lane);
            tr_matrix_f8(args.in[I_MOE_D] + (size_t)e * FFE * D, FFE, D, W_MOED8 + (size_t)e * D * FFE, FFE, MOE_D_WS, RmId{0}, scr, gw, NGW, lane);
#else
            tr_matrix(args.in[I_MOE_G] + (size_t)e * D * FFE, D, FFE, W_MOEGU + (size_t)e * 2 * FFE * D, D, RmGU{0}, scr, gw, NGW, lane);
            tr_matrix(args.in[I_MOE_U] + (size_t)e * D * FFE, D, FFE, W_MOEGU + (size_t)e * 2 * FFE * D, D, RmGU{128}, scr, gw, NGW, lane);
            tr_matrix(args.in[I_MOE_D] + (size_t)e * FFE * D, FFE, D, W_MOED + (size_t)e * D * FFE, FFE, RmId{0}, scr, gw, NGW, lane);
#endif
        }
    }
    SEAM(16);
    REP(17) if (hi_ph > 17 && lo < 27) {
        MoeInfo mi; int acc_t = 0;
#pragma unroll
        for (int e = 0; e < NE; ++e) { const int c = (int)__builtin_amdgcn_readfirstlane(__hip_atomic_load(ctl + CW_ECNT + 64 * e, RLX_AGENT)); mi.cnt[e] = c; mi.ts[e] = acc_t; acc_t += (c + 255) >> 8; }
        mi.ts[NE] = acc_t;
        for (int c = 0; c < 5; ++c) {
            const int ct0 = 64 * c; int nM = acc_t - ct0; nM = nM < 0 ? 0 : (nM > 64 ? 64 : nM);
#if MOE_FP8
            if (IN(17 + 2 * c) && nM > 0) { pg8::Gemm g{X3F8, W_MOEGU8, D, D, D}; SchedMoeGU S; S.so.init(nM, 2 * FFE / 256, G, bx); S.mi = mi; S.ct0 = ct0; S.rowtok = ROWTOK; S.rowbytes = D;
                pg8::EpiGateUp<FSwigluF8> E{FSwigluF8{(unsigned char*)args.out, FFE, 1.f / MOE_GU_WS, MOE_H_S}}; pg8::gemm_phase<pg8::EpiGateUp<FSwigluF8>, SchedMoeGU, true, true, true>(lds, g, S, E); }
            SEAM(17 + 2 * c);
            if (IN(18 + 2 * c) && nM > 0) { pg8::Gemm g{(unsigned char*)args.out, W_MOED8, FFE, FFE, FFE}; SchedMoeD S; S.so.init(nM, 4, G, bx); S.mi = mi; S.ct0 = ct0;
                pg8::EpiRow8<FBf16S> E{FBf16S{DOUT, D, ct0 * 256, 1.f / (MOE_D_WS * MOE_H_S)}}; pg8::gemm_phase<pg8::EpiRow8<FBf16S>, SchedMoeD, true, false, true>(lds, g, S, E); }
#else
            if (IN(17 + 2 * c) && nM > 0) { pg8::Gemm g{X3, W_MOEGU, (D) * 2, (D) * 2, (D) * 2}; SchedMoeGU S; S.so.init(nM, 2 * FFE / 256, G, bx); S.mi = mi; S.ct0 = ct0; S.rowtok = ROWTOK; S.rowbytes = D * 2;
                pg8::EpiGateUp<FSwiglu> E{FSwiglu{ACTC, FFE, 0}}; pg8::gemm_phase<pg8::EpiGateUp<FSwiglu>, SchedMoeGU, true, true>(lds, g, S, E); }
            SEAM(17 + 2 * c);
            if (IN(18 + 2 * c) && nM > 0) { pg8::Gemm g{ACTC, W_MOED, (FFE) * 2, (FFE) * 2, (FFE) * 2}; SchedMoeD S; S.so.init(nM, 4, G, bx); S.mi = mi; S.ct0 = ct0;
                pg8::EpiRow8<FBf16> E{FBf16{DOUT, D, ct0 * 256}}; pg8::gemm_phase<pg8::EpiRow8<FBf16>, SchedMoeD, true, false>(lds, g, S, E); }
#endif
            SEAM(18 + 2 * c);
        }
    }
    REP(27) if (IN(27)) {
        PH_LAUNDER();
        int ts[NE]; { int acc_t = 0;
#pragma unroll
            for (int e = 0; e < NE; ++e) { const int c = (int)__builtin_amdgcn_readfirstlane(__hip_atomic_load(ctl + CW_ECNT + 64 * e, RLX_AGENT)); ts[e] = acc_t; acc_t += (c + 255) >> 8; } }
        for (int m = gw; m < T; m += NGW) {
            const unsigned i0 = TOKINFO[2 * m], i1 = TOKINFO[2 * m + 1]; const float w0 = TOKW[2 * m], w1 = TOKW[2 * m + 1];
            int t0 = 0, t1 = 0;
#pragma unroll
            for (int e = 0; e < NE; ++e) { t0 = ((int)(i0 >> 16) == e) ? ts[e] : t0; t1 = ((int)(i1 >> 16) == e) ? ts[e] : t1; }
            const size_t r0 = (size_t)t0 * 256 + (i0 & 0xffffu), r1 = (size_t)t1 * 256 + (i1 & 0xffffu);
            const u32x2* xr = (const u32x2*)(X3 + (size_t)m * D) + lane; const u32x2* d0 = (const u32x2*)(DOUT + r0 * D) + lane; const u32x2* d1 = (const u32x2*)(DOUT + r1 * D) + lane;
            f32x4 v[4];
#pragma unroll
            for (int j = 0; j < 4; ++j) v[j] = bf4_to_f32(xr[64 * j]) * ALPHA + (bf4_to_f32(d0[64 * j]) * w0 + bf4_to_f32(d1[64 * j]) * w1);
            ln_inplace(v, args.in[I_LNF_G] + D, args.in[I_LNF_B] + D, lane);
            f32x4* orow = (f32x4*)(args.out + (size_t)m * D) + lane;
#pragma unroll
            for (int j = 0; j < 4; ++j) orow[64 * j] = v[j];
        }
    }

#if defined(SELFTEST)
    {
        xcd_barrier(bar);
        const float e2 = __hip_atomic_load((float*)(ctl + st::CW_ERR), RLX_AGENT), r2 = __hip_atomic_load((float*)(ctl + st::CW_ERR + 1), RLX_AGENT);
        const float E = e2 / r2; float code = -log10f(E); code = code < 0.f ? 0.f : (code > 9.9f ? 9.9f : code);
        const float A = (E == E && r2 > 0.f) ? sqrtf(100.f * code) : 40.f;
        for (long i = (long)vcu * 512 + tid_; i < (long)T * D / 4; i += (long)G * 512) ((f32x4*)args.out)[i] = (f32x4){A, A, A, A};
    }
#endif
#undef IN
#undef SEAM
#undef REP
#undef W_MLAIN
#undef W_QUP
#undef W_KVUP
#undef W_MLAOUT
#undef W_FFNGU
#undef W_FFND
#undef W_NSAIN
#undef W_NSAOUT
#undef W_C1K
#undef W_C1V
#undef W_C2K
#undef W_C2V
#undef ROPE_C
#undef CBIAS
#undef RBT
#undef ROWTOK
#undef TOKINFO
#undef TOKW
#undef XB
#undef LAT
#undef QN
#undef KVN
#undef KR
#undef Q
#undef KN
#undef V
#undef O
#undef X1
#undef ACT
#undef X2
#undef NQ
#undef KC
#undef VC
#undef KS
#undef VS
#undef KW
#undef VW
#undef GT
#undef HK
#undef HV
#undef KCMP
#undef VCMP
#undef ONSA
#undef X3
#undef W_MOEGU
#undef W_MOED
#undef DOUT
#undef ROPE_S
#undef P
#undef ACTC
#undef PH_LAUNDER
#endif
}

#ifndef MK_PER_PHASE
#define MK_PER_PHASE 0
#endif
extern "C" void kernel_launch(void* const* d_in, const int* in_sizes, int n_in, void* d_out, int out_size, void* d_ws, size_t ws_size, hipStream_t stream) {
    static int grid = 0;
    if (grid == 0) {
        if (n_in != 27 || out_size != T * D || ws_size < WS_END) { fprintf(stderr, "kernel_launch: unexpected shapes (n_in %d out %d ws %zu)\n", n_in, out_size, ws_size); grid = -1; return; }
        int dev = 0, cus = 0, per_cu = 0;
        if (hipGetDevice(&dev) != hipSuccess || hipDeviceGetAttribute(&cus, hipDeviceAttributeMultiprocessorCount, dev) != hipSuccess) { grid = -1; return; }
        if (hipFuncSetAttribute((const void*)fwd, hipFuncAttributeMaxDynamicSharedMemorySize, LDS_BYTES) != hipSuccess) { fprintf(stderr, "kernel_launch: hipFuncSetAttribute failed\n"); grid = -1; return; }
        if (hipOccupancyMaxActiveBlocksPerMultiprocessor(&per_cu, (const void*)fwd, NWAVES * 64, LDS_BYTES) != hipSuccess || per_cu < 1) { fprintf(stderr, "kernel_launch: occupancy query reports %d\n", per_cu); }
        (void)hipGetLastError();
        grid = cus;
    }
    if (grid < 0) return;
    if (hipMemsetAsync((char*)d_ws + WS_CTL, 0, CTL_ZERO_BYTES, stream) != hipSuccess) return;
    Args a{};
    for (int i = 0; i < 27; ++i) a.in[i] = (const float*)d_in[i];
    a.out = (float*)d_out; a.ws = (unsigned char*)d_ws;
#if MK_PER_PHASE
    for (int p = 0; p < N_PHASES; ++p) { a.ph_lo = p; a.ph_hi = p + 1; hipLaunchKernelGGL(fwd, dim3(grid), dim3(NWAVES * 64), LDS_BYTES, stream, a); }
#else
    a.ph_lo = 0; a.ph_hi = N_PHASES;
    hipLaunchKernelGGL(fwd, dim3(grid), dim3(NWAVES * 64), LDS_BYTES, stream, a);
#endif
}
```

```cpp
#include <hip/hip_runtime.h>
#include <cstdio>
#include <cstdint>

#define LAS __attribute__((address_space(3)))
#define GAS __attribute__((address_space(1)))
typedef unsigned short bf16_t;
typedef short bf16x8 __attribute__((ext_vector_type(8)));
typedef short s16x4 __attribute__((ext_vector_type(4)));
typedef float f32x4 __attribute__((ext_vector_type(4)));
typedef float f32x2 __attribute__((ext_vector_type(2)));
typedef float f32x16 __attribute__((ext_vector_type(16)));
typedef unsigned u32x4 __attribute__((ext_vector_type(4)));
typedef unsigned u32x2 __attribute__((ext_vector_type(2)));

#ifndef FFN_FP8
#define FFN_FP8 0
#endif
#ifndef MOE_FP8
#define MOE_FP8 1
#endif
constexpr int NB = 4, SEQ = 8192, T = NB * SEQ, D = 1024;
constexpr int MLA_H = 8, MLA_QR = 512, MLA_KVR = 256, MLA_DQK = 192, MLA_DV = 128, MLA_IN = 832;
constexpr int NSA_G = 4, NSA_DK = 96, NSA_DV = 64, NSA_IN = 3504, NSA_INP = 3584;
constexpr int FF = 2816, NE = 8, FFE = 3584, ECAP = 32768;
constexpr float ALPHA = 1.41421356237309515f;
constexpr float LOG2E = 1.4426950408889634f;
constexpr float C2_MLA = 0.07216878364870323f * LOG2E;
constexpr float C2_NSA = 0.10206207261596577f * LOG2E;

__device__ __forceinline__ int fresh_lane() { int l; asm volatile("v_mbcnt_lo_u32_b32 %0, -1, 0\n\tv_mbcnt_hi_u32_b32 %0, -1, %0" : "=v"(l)); return l; }
__device__ __forceinline__ unsigned cvt_pk_bf16(float lo, float hi) { unsigned r; asm volatile("v_cvt_pk_bf16_f32 %0, %1, %2" : "=v"(r) : "v"(lo), "v"(hi)); return r; }
__device__ __forceinline__ float bf2f(unsigned short h) { return __uint_as_float(((unsigned)h) << 16); }
__device__ __forceinline__ float bflo(unsigned w) { return __uint_as_float(w << 16); }
__device__ __forceinline__ float bfhi(unsigned w) { return __uint_as_float(w & 0xffff0000u); }
__device__ __forceinline__ float fast_exp2(float x) { return __builtin_amdgcn_exp2f(x); }
__device__ __forceinline__ float fast_rcp(float x) { return __builtin_amdgcn_rcpf(x); }
__device__ __forceinline__ float silu_f(float x) { return x * fast_rcp(1.f + fast_exp2(-x * LOG2E)); }
__device__ __forceinline__ float sigmoid_f(float x) { return fast_rcp(1.f + fast_exp2(-x * LOG2E)); }
__device__ __forceinline__ float gelu_tanh_f(float x) {
    const float z = 0.7978845608028654f * (x + 0.044715f * x * x * x);
    return x * fast_rcp(1.f + fast_exp2(-2.f * LOG2E * z));
}

namespace pg8 {
constexpr int BM = 256, BK = 64, HALF = 128, HTB = HALF * BK * 2, STAGE_BYTES = 8 * HTB, NXCD = 8, WGM = 8;
__host__ __device__ __forceinline__ int lds_byte(int r, int c) { const int st = (r >> 4) * 2 + (c >> 5), rr = r & 15, cc = c & 31, ob = rr * 64 + cc * 2; return st * 1024 + (ob ^ (((ob >> 9) & 1) << 5)); }
__host__ __device__ __forceinline__ void stage_rc(int b, int& R, int& C) { const int st = b / 1024, sb = b % 1024, swz = sb ^ (((sb >> 9) & 1) << 5); R = (st >> 1) * 16 + swz / 64; C = (st & 1) * 32 + (swz % 64) / 2; }
__host__ __device__ __forceinline__ int perm32(int rho) { const int n = rho >> 4, i = rho & 15; return 8 * (i >> 2) + 4 * n + (i & 3); }

typedef int v8i32 __attribute__((ext_vector_type(8)));
__device__ __forceinline__ v8i32 cat8(bf16x8 a, bf16x8 b) { const u32x4 x = __builtin_bit_cast(u32x4, a), y = __builtin_bit_cast(u32x4, b); return (v8i32){(int)x[0], (int)x[1], (int)x[2], (int)x[3], (int)y[0], (int)y[1], (int)y[2], (int)y[3]}; }
struct Unit { int pm, pn; };
struct Gemm { const void* A; const void* Bt; int lda, ldb, K; };

struct StaticOrder {
    int nM, nN, nwg, G, c;
    __device__ void init(int nM_, int nN_, int G_, int c_) { nM = nM_; nN = nN_; nwg = nM * nN; G = G_; c = c_; }
    __device__ bool next(int i, Unit& u) const {
        const long L = (long)i * G + c; if (L >= nwg) return false;
        int wgid = (int)L; { const int q = nwg / NXCD, r = nwg % NXCD, xcd = wgid % NXCD, off = wgid / NXCD; wgid = (xcd < r ? xcd * (q + 1) : r * (q + 1) + (xcd - r) * q) + off; }
        const int nig = WGM * nN, gid = wgid / nig, fm = gid * WGM, gsz = (nM - fm) < WGM ? (nM - fm) : WGM;
        u.pm = fm + ((wgid % nig) % gsz); u.pn = (wgid % nig) / gsz; return true;
    }
};
struct SchedPlain {
    StaticOrder so;
    __device__ void init(int nM, int nN, int G, int c) { so.init(nM, nN, G, c); }
    __device__ __forceinline__ bool next(int i, Unit& u) const { return so.next(i, u); }
    __device__ __forceinline__ size_t a_off(const Unit& u, const Gemm& g) const { return (size_t)u.pm * 256 * g.lda; }
    __device__ __forceinline__ size_t b_off(const Unit& u, const Gemm& g) const { return (size_t)u.pn * 256 * g.ldb; }
    __device__ __forceinline__ unsigned a_row(const Unit&, int) const { return 0u; }
};

template <class F> struct EpiRow8 {
    static constexpr bool PERM = true;
    F f;
    __device__ __forceinline__ void operator()(const f32x4 (&acc)[2][2][4][2], const Unit& u, int wr, int wc, int fr, int fq) const {
#pragma unroll
        for (int ai = 0; ai < 2; ++ai)
#pragma unroll
            for (int m = 0; m < 4; ++m) { const int row = u.pm * BM + ai * HALF + wr * 64 + m * 16 + fr;
#pragma unroll
                for (int bj = 0; bj < 2; ++bj) f(row, u.pn * BM + bj * HALF + wc * 32 + 8 * fq, acc[ai][bj][m][0], acc[ai][bj][m][1]); }
    }
};
template <class F> struct EpiGateUp {
    static constexpr bool PERM = true;
    F f;
    __device__ __forceinline__ void operator()(const f32x4 (&acc)[2][2][4][2], const Unit& u, int wr, int wc, int fr, int fq) const {
#pragma unroll
        for (int ai = 0; ai < 2; ++ai)
#pragma unroll
            for (int m = 0; m < 4; ++m) { const int row = u.pm * BM + ai * HALF + wr * 64 + m * 16 + fr;
                f(row, u.pn * HALF + wc * 32 + 8 * fq, acc[ai][0][m][0], acc[ai][0][m][1], acc[ai][1][m][0], acc[ai][1][m][1]); }
    }
};

template <class Epi, class Sched, bool ALIGN_EPI, bool GATHER, bool FP8 = false>
__device__ __forceinline__ void gemm_phase(LAS unsigned char* lds, const int wid, const Gemm g, const Sched& S, const Epi& E) {
    const int lane = fresh_lane(), tid = wid * 64 + lane;
    const int  wr = wid >> 2, wc = wid & 3, fr = lane & 15, fq = lane >> 4;
    const int nt = g.K / (BK * 2);
    int sR[2], sC[2]; unsigned voffB[2];
#pragma unroll
    for (int i = 0; i < 2; ++i) { int R, C; stage_rc(tid * 16 + i * 8192, R, C); sR[i] = R; sC[i] = C; const int Rb = Epi::PERM ? ((R & ~31) + perm32(R & 31)) : R; voffB[i] = (unsigned)(Rb * g.ldb + C * 2); }
    const int kstep = BK * 2;
    const int hstepB = HALF * g.ldb;
    const auto rsA = __builtin_amdgcn_make_buffer_rsrc((void*)g.A, 0, 0x7fffffff, 0x00020000);
    const auto rsB = __builtin_amdgcn_make_buffer_rsrc((void*)g.Bt, 0, 0x7fffffff, 0x00020000);
    const unsigned ldsw = (unsigned)wid * 1024u;
    const int aoff = lds_byte(wr * 64 + fr, fq * 8), boff = lds_byte(wc * 32 + fr, fq * 8);
#define PG8_SA(b, h) (((b) * 2 + (h)) * HTB)
#define PG8_SB(b, h) ((4 + (b) * 2 + (h)) * HTB)
#define PG8_STAGE2(bufoff, rsrc, soff, o0, o1) do { \
        __builtin_amdgcn_raw_ptr_buffer_load_lds(rsrc, (LAS unsigned*)(lds + (bufoff) + ldsw), 16, (int)(o0), (int)(soff), 0, 0); \
        __builtin_amdgcn_raw_ptr_buffer_load_lds(rsrc, (LAS unsigned*)(lds + (bufoff) + ldsw + 8192), 16, (int)(o1), (int)(soff), 0, 0); } while (0)
#define PG8_STAGEA(bufoff, soff, o0, o1) PG8_STAGE2(bufoff, rsA, soff, o0, o1)
#define PG8_STAGEB(bufoff, soff) PG8_STAGE2(bufoff, rsB, soff, voffB[0], voffB[1])
#define PG8_LDA(dst, b, h) do { _Pragma("unroll") for (int m = 0; m < 4; ++m) _Pragma("unroll") for (int k = 0; k < 2; ++k) dst[m][k] = *(const LAS bf16x8*)(lds + PG8_SA(b, h) + aoff + m * 2048 + k * 1024); } while (0)
#define PG8_LDB(dst, b, h) do { _Pragma("unroll") for (int n = 0; n < 2; ++n) _Pragma("unroll") for (int k = 0; k < 2; ++k) dst[n][k] = *(const LAS bf16x8*)(lds + PG8_SB(b, h) + boff + n * 2048 + k * 1024); } while (0)
#define PG8_MMA(ai, bj, At, Bt) do { __builtin_amdgcn_s_setprio(1); \
        if constexpr (FP8) { _Pragma("unroll") for (int m = 0; m < 4; ++m) _Pragma("unroll") for (int n = 0; n < 2; ++n) \
            acc[ai][bj][m][n] = __builtin_amdgcn_mfma_scale_f32_16x16x128_f8f6f4(cat8(Bt[n][0], Bt[n][1]), cat8(At[m][0], At[m][1]), acc[ai][bj][m][n], 0, 0, 0, 127, 0, 127); } \
        else { _Pragma("unroll") for (int m = 0; m < 4; ++m) _Pragma("unroll") for (int n = 0; n < 2; ++n) _Pragma("unroll") for (int k = 0; k < 2; ++k) \
            acc[ai][bj][m][n] = __builtin_amdgcn_mfma_f32_16x16x32_bf16(Bt[n][k], At[m][k], acc[ai][bj][m][n], 0, 0, 0); } \
        __builtin_amdgcn_s_setprio(0); } while (0)
#define PG8_WAIT_V(n) asm volatile("s_waitcnt vmcnt(" #n ")" ::: "memory")
#define PG8_WAIT_L(n) asm volatile("s_waitcnt lgkmcnt(" #n ")" ::: "memory")
#define PG8_BAR __builtin_amdgcn_s_barrier()
#define PG8_SCHED __builtin_amdgcn_sched_barrier(0)
    Unit cur, nxt; int ui = 0;
    if (!S.next(0, cur)) return;
    f32x4 acc[2][2][4][2];
#pragma unroll
    for (int a = 0; a < 2; ++a)
#pragma unroll
        for (int b = 0; b < 2; ++b)
#pragma unroll
            for (int m = 0; m < 4; ++m)
#pragma unroll
                for (int n = 0; n < 2; ++n) acc[a][b][m][n] = (f32x4){0.f, 0.f, 0.f, 0.f};
    bf16x8 At[4][2], B0[2][2], B1[2][2];
    unsigned vc[2][2], vn[2][2];
#pragma unroll
    for (int h = 0; h < 2; ++h)
#pragma unroll
        for (int i = 0; i < 2; ++i) { vc[h][i] = GATHER ? S.a_row(cur, h * HALF + sR[i]) + (unsigned)sC[i] * 2u : (unsigned)((h * HALF + sR[i]) * g.lda + sC[i] * 2); vn[h][i] = vc[h][i]; }
    int cA = (int)S.a_off(cur, g), cB = (int)S.b_off(cur, g);
    PG8_STAGEB(PG8_SB(0, 0), cB); PG8_STAGEB(PG8_SB(0, 1), cB + hstepB); PG8_STAGEA(PG8_SA(0, 0), cA, vc[0][0], vc[0][1]); PG8_STAGEA(PG8_SA(0, 1), cA, vc[1][0], vc[1][1]);
    if (wr == 1) PG8_BAR;
    PG8_WAIT_V(2); PG8_BAR;
    PG8_STAGEB(PG8_SB(1, 0), cB + kstep); PG8_STAGEA(PG8_SA(1, 0), cA + kstep, vc[0][0], vc[0][1]); PG8_STAGEB(PG8_SB(1, 1), cB + hstepB + kstep);
    PG8_WAIT_V(6); PG8_BAR;
    for (;;) {
        const bool has_next = S.next(ui + 1, nxt);
        const int nA = has_next ? (int)S.a_off(nxt, g) : cA, nB = has_next ? (int)S.b_off(nxt, g) : cB;
        if (GATHER) {
#pragma unroll
            for (int h = 0; h < 2; ++h)
#pragma unroll
                for (int i = 0; i < 2; ++i) vn[h][i] = has_next ? S.a_row(nxt, h * HALF + sR[i]) + (unsigned)sC[i] * 2u : vc[h][i];
        }
#pragma clang loop unroll(disable)
        for (int t = 0; t < nt; t += 2) {
            const bool last = (t == nt - 2);
            const int a1 = cA + (t + 1) * kstep;
            const int a2 = last ? nA : cA + (t + 2) * kstep, b2 = last ? nB : cB + (t + 2) * kstep;
            const int a3 = a2 + kstep, b3 = b2 + kstep;
            unsigned w00, w01, w10, w11;
            if (GATHER) { w00 = last ? vn[0][0] : vc[0][0]; w01 = last ? vn[0][1] : vc[0][1]; w10 = last ? vn[1][0] : vc[1][0]; w11 = last ? vn[1][1] : vc[1][1]; }
            else { w00 = vc[0][0]; w01 = vc[0][1]; w10 = vc[1][0]; w11 = vc[1][1]; }
            PG8_LDB(B0, 0, 0); PG8_LDB(B1, 0, 1); PG8_SCHED; PG8_LDA(At, 0, 0); PG8_STAGEA(PG8_SA(1, 1), a1, vc[1][0], vc[1][1]);
            PG8_WAIT_V(8); PG8_WAIT_L(0); PG8_BAR; PG8_MMA(0, 0, At, B0); PG8_MMA(0, 1, At, B1); PG8_BAR; PG8_SCHED;
            PG8_LDA(At, 0, 1); PG8_STAGEB(PG8_SB(0, 0), b2); PG8_STAGEB(PG8_SB(0, 1), b2 + hstepB); PG8_STAGEA(PG8_SA(0, 0), a2, w00, w01);
            PG8_WAIT_V(8); PG8_WAIT_L(0); PG8_BAR; PG8_MMA(1, 0, At, B0); PG8_MMA(1, 1, At, B1); PG8_BAR; PG8_SCHED;
            PG8_LDB(B0, 1, 0); PG8_LDB(B1, 1, 1); PG8_SCHED; PG8_LDA(At, 1, 0); PG8_STAGEA(PG8_SA(0, 1), a2, w10, w11);
            PG8_WAIT_V(8); PG8_WAIT_L(0); PG8_BAR; PG8_MMA(0, 0, At, B0); PG8_MMA(0, 1, At, B1); PG8_BAR; PG8_SCHED;
            PG8_LDA(At, 1, 1); PG8_STAGEB(PG8_SB(1, 0), b3); PG8_STAGEB(PG8_SB(1, 1), b3 + hstepB); PG8_STAGEA(PG8_SA(1, 0), a3, w00, w01);
            PG8_WAIT_V(8); PG8_WAIT_L(0); PG8_BAR; PG8_MMA(1, 0, At, B0); PG8_MMA(1, 1, At, B1); PG8_BAR; PG8_SCHED;
        }
        if constexpr (ALIGN_EPI) { if (wr == 0) PG8_BAR; }
        { const int l_ = fresh_lane();
          E(acc, cur, wr, wc, l_ & 15, l_ >> 4); }
        if (!has_next) break;
#pragma unroll
        for (int a = 0; a < 2; ++a)
#pragma unroll
            for (int b = 0; b < 2; ++b)
#pragma unroll
                for (int m = 0; m < 4; ++m)
#pragma unroll
                    for (int n = 0; n < 2; ++n) acc[a][b][m][n] = (f32x4){0.f, 0.f, 0.f, 0.f};
        cur = nxt; cA = nA; cB = nB; ++ui;
        if (GATHER) {
#pragma unroll
            for (int h = 0; h < 2; ++h)
#pragma unroll
                for (int i = 0; i < 2; ++i) vc[h][i] = vn[h][i];
        }
        if constexpr (ALIGN_EPI) { if (wr == 1) PG8_BAR; }
    }
    PG8_WAIT_V(0);
    if constexpr (!ALIGN_EPI) { if (wr == 0) PG8_BAR; }
    PG8_BAR;
#undef PG8_SA
#undef PG8_SB
#undef PG8_STAGE2
#undef PG8_STAGEA
#undef PG8_STAGEB
#undef PG8_LDA
#undef PG8_LDB
#undef PG8_MMA
#undef PG8_WAIT_V
#undef PG8_WAIT_L
#undef PG8_BAR
#undef PG8_SCHED
}
}
#if defined(__HIP_DEVICE_COMPILE__)
namespace att {
__device__ __forceinline__ int crow(int r, int hi) { return (r & 3) + 8 * (r >> 2) + 4 * hi; }
constexpr float THR = 6.f;
constexpr int NBUF = 3;
struct MlaRing { static constexpr int NS = 3, NI = 46, NPW = 6, BUF = 47104;
    static __device__ __forceinline__ constexpr int OFF(int s) { return s == 0 ? 0 : (s == 1 ? 17408 : 26624); }
    static __device__ __forceinline__ constexpr int NK(int s) { return s == 0 ? 17 : (s == 1 ? 9 : 20); }
    static __device__ __forceinline__ constexpr int GS(int s) { return s == 1 ? 128 : 256; }
    static __device__ __forceinline__ constexpr int CH(int s) { return s == 1 ? 8 : 16; }
    static __device__ __forceinline__ constexpr int ROW(int s) { return s == 0 ? 272 : (s == 1 ? 144 : 320); } };
struct NsaRing { static constexpr int NS = 2, NI = 25, NPW = 4, BUF = 25600;
    static __device__ __forceinline__ constexpr int OFF(int s) { return s == 0 ? 0 : 13312; }
    static __device__ __forceinline__ constexpr int NK(int s) { return s == 0 ? 13 : 12; }
    static __device__ __forceinline__ constexpr int GS(int s) { return s == 0 ? 192 : 128; }
    static __device__ __forceinline__ constexpr int CH(int s) { return s == 0 ? 12 : 8; }
    static __device__ __forceinline__ constexpr int ROW(int s) { return s == 0 ? 208 : 192; } };
typedef __amdgpu_buffer_rsrc_t rsrc_t;
__device__ __forceinline__ rsrc_t make_rsrc(const void* p) { return __builtin_amdgcn_make_buffer_rsrc((void*)p, 0, 0x7fffffff, 0x00020000); }
template <class R> struct Plan {
    int ldsd[R::NPW]; int strm[R::NPW]; int jj[R::NPW]; int lane16;
    __device__ __forceinline__ void init(int wid, int lane) {
        lane16 = 16 * lane;
#pragma unroll
        for (int k = 0; k < R::NPW; ++k) { int j = wid + 8 * k; if (j >= R::NI) j -= R::NI;
            int s = 0, q_ = j;
#pragma unroll
            for (int q = 0; q + 1 < R::NS; ++q) if (q_ >= R::NK(q) && s == q) { q_ -= R::NK(q); s = q + 1; }
            strm[k] = s; jj[k] = q_; ldsd[k] = (s == 0 ? R::OFF(0) : (s == 1 ? R::OFF(1) : R::OFF(R::NS - 1))) + 1024 * q_; }
    }
    template <int S> __device__ __forceinline__ int voff(int k) const { const int x = 1024 * jj[k] + lane16, r = x / R::ROW(S), cc = (x - r * R::ROW(S)) >> 4; return r * R::GS(S) + (cc < R::CH(S) ? cc : 0) * 16; }
};
template <class R> struct Src { rsrc_t rs0, rs1, rs2; int t0; };
template <class R> __device__ __forceinline__ void issue_tile(const Plan<R>& p, const Src<R>& src, int t, LAS char* buf) {
#pragma unroll
    for (int k = 0; k < R::NPW; ++k) { const int s = p.strm[k];
        if (s == 0) __builtin_amdgcn_raw_ptr_buffer_load_lds(src.rs0, (LAS unsigned*)(buf + p.ldsd[k]), 16, p.template voff<0>(k), (src.t0 + t) * 64 * R::GS(0), 0, 0);
        else if (s == 1 || R::NS == 2) __builtin_amdgcn_raw_ptr_buffer_load_lds(src.rs1, (LAS unsigned*)(buf + p.ldsd[k]), 16, p.template voff<1>(k), (src.t0 + t) * 64 * R::GS(1), 0, 0);
        else __builtin_amdgcn_raw_ptr_buffer_load_lds(src.rs2, (LAS unsigned*)(buf + p.ldsd[k]), 16, p.template voff<R::NS - 1>(k), (src.t0 + t) * 64 * R::GS(R::NS - 1), 0, 0); }
}
#define ATT_WAIT_V(n) asm volatile("s_waitcnt vmcnt(%0)" :: "i"(n) : "memory")
template <class R, int DQK> __device__ __forceinline__ void qk_tile(f32x16& p0, f32x16& p1, LAS const char* Kb, int r32, int hi, const bf16x8* qr, const f32x16& cinit) {
    p0 = cinit; p1 = cinit;
    if constexpr (R::NS == 3) {
        LAS const char* a = Kb + r32 * R::ROW(0) + hi * 16; LAS const char* b = Kb + R::OFF(1) + r32 * R::ROW(1) + hi * 16;
#pragma unroll
        for (int d0 = 0; d0 < 8; ++d0) { const bf16x8 k0 = *(LAS const bf16x8*)(a + d0 * 32); const bf16x8 k1 = *(LAS const bf16x8*)(a + 32 * R::ROW(0) + d0 * 32);
            p0 = __builtin_amdgcn_mfma_f32_32x32x16_bf16(k0, qr[d0], p0, 0, 0, 0); p1 = __builtin_amdgcn_mfma_f32_32x32x16_bf16(k1, qr[d0], p1, 0, 0, 0); }
#pragma unroll
        for (int d0 = 0; d0 < 4; ++d0) { const bf16x8 k0 = *(LAS const bf16x8*)(b + d0 * 32); const bf16x8 k1 = *(LAS const bf16x8*)(b + 32 * R::ROW(1) + d0 * 32);
            p0 = __builtin_amdgcn_mfma_f32_32x32x16_bf16(k0, qr[8 + d0], p0, 0, 0, 0); p1 = __builtin_amdgcn_mfma_f32_32x32x16_bf16(k1, qr[8 + d0], p1, 0, 0, 0); }
    } else {
        LAS const char* a = Kb + r32 * R::ROW(0) + hi * 16;
#pragma unroll
        for (int d0 = 0; d0 < DQK / 16; ++d0) { const bf16x8 k0 = *(LAS const bf16x8*)(a + d0 * 32); const bf16x8 k1 = *(LAS const bf16x8*)(a + 32 * R::ROW(0) + d0 * 32);
            p0 = __builtin_amdgcn_mfma_f32_32x32x16_bf16(k0, qr[d0], p0, 0, 0, 0); p1 = __builtin_amdgcn_mfma_f32_32x32x16_bf16(k1, qr[d0], p1, 0, 0, 0); }
    }
}
template <int DV, int VROW> __device__ __forceinline__ void pv_tile(f32x16* o, unsigned vaddr, bf16x8 pa0, bf16x8 pa1, bf16x8 pa2, bf16x8 pa3) {
#define ATT_TRRD(dst, off) asm volatile("ds_read_b64_tr_b16 %0, %1 offset:%2" : "=&v"(dst) : "v"(vaddr), "i"(off) : "memory")
#pragma unroll
    for (int d0 = 0; d0 < DV / 32; ++d0) {
        { s16x4 l0, l1, h0, h1;
        ATT_TRRD(l0, (0 * 16 + 0) * VROW + d0 * 64); ATT_TRRD(h0, (0 * 16 + 4) * VROW + d0 * 64);
        ATT_TRRD(l1, (1 * 16 + 0) * VROW + d0 * 64); ATT_TRRD(h1, (1 * 16 + 4) * VROW + d0 * 64);
        asm volatile("s_waitcnt lgkmcnt(0)" ::: "memory"); __builtin_amdgcn_sched_barrier(0);
        o[d0] = __builtin_amdgcn_mfma_f32_32x32x16_bf16(pa0, (bf16x8){l0[0], l0[1], l0[2], l0[3], h0[0], h0[1], h0[2], h0[3]}, o[d0], 0, 0, 0);
        o[d0] = __builtin_amdgcn_mfma_f32_32x32x16_bf16(pa1, (bf16x8){l1[0], l1[1], l1[2], l1[3], h1[0], h1[1], h1[2], h1[3]}, o[d0], 0, 0, 0); }
        { s16x4 l2, l3, h2, h3;
        ATT_TRRD(l2, (2 * 16 + 0) * VROW + d0 * 64); ATT_TRRD(h2, (2 * 16 + 4) * VROW + d0 * 64);
        ATT_TRRD(l3, (3 * 16 + 0) * VROW + d0 * 64); ATT_TRRD(h3, (3 * 16 + 4) * VROW + d0 * 64);
        asm volatile("s_waitcnt lgkmcnt(0)" ::: "memory"); __builtin_amdgcn_sched_barrier(0);
        o[d0] = __builtin_amdgcn_mfma_f32_32x32x16_bf16(pa2, (bf16x8){l2[0], l2[1], l2[2], l2[3], h2[0], h2[1], h2[2], h2[3]}, o[d0], 0, 0, 0);
        o[d0] = __builtin_amdgcn_mfma_f32_32x32x16_bf16(pa3, (bf16x8){l3[0], l3[1], l3[2], l3[3], h3[0], h3[1], h3[2], h3[3]}, o[d0], 0, 0, 0); }
    }
#undef ATT_TRRD
}
__device__ __forceinline__ float lane_pair_max(float v) { auto rr = __builtin_amdgcn_permlane32_swap(__float_as_uint(v), __float_as_uint(v), false, false); return fmaxf(__uint_as_float(rr[0]), __uint_as_float(rr[1])); }
__device__ __forceinline__ float lane_pair_sum(float v) { auto rr = __builtin_amdgcn_permlane32_swap(__float_as_uint(v), __float_as_uint(v), false, false); return __uint_as_float(rr[0]) + __uint_as_float(rr[1]); }
__device__ __forceinline__ void pack_p(const f32x16& p0, const f32x16& p1, bf16x8& pa0, bf16x8& pa1, bf16x8& pa2, bf16x8& pa3) {
#define ATT_PK4(P, B_, OUT) do { unsigned a0 = cvt_pk_bf16(P[B_ + 0], P[B_ + 1]), a1 = cvt_pk_bf16(P[B_ + 2], P[B_ + 3]); \
        unsigned b0 = cvt_pk_bf16(P[B_ + 4], P[B_ + 5]), b1 = cvt_pk_bf16(P[B_ + 6], P[B_ + 7]); \
        auto r0 = __builtin_amdgcn_permlane32_swap(a0, b0, false, false); auto r1 = __builtin_amdgcn_permlane32_swap(a1, b1, false, false); \
        u32x4 w = {r0[0], r1[0], r0[1], r1[1]}; OUT = __builtin_bit_cast(bf16x8, w); } while (0)
    ATT_PK4(p0, 0, pa0); ATT_PK4(p0, 8, pa1); ATT_PK4(p1, 0, pa2); ATT_PK4(p1, 8, pa3);
#undef ATT_PK4
}
template <class R, class Body> __device__ __forceinline__ void ring_loop(LAS char* lds, const Plan<R>& plan, const Src<R>& src, int nt, Body&& body) {
    issue_tile<R>(plan, src, 0, lds); if (nt > 1) issue_tile<R>(plan, src, 1, lds + R::BUF);
    if (nt > 1) ATT_WAIT_V(R::NPW); else ATT_WAIT_V(0);
    __builtin_amdgcn_s_barrier();
    int bi = 0;
    for (int t = 0; t < nt; ++t) {
        if (t + 2 < nt) { const int b2 = bi == 0 ? 2 : bi - 1; issue_tile<R>(plan, src, t + 2, lds + b2 * R::BUF); }
        body(t, lds + bi * R::BUF);
        if (t + 2 < nt) ATT_WAIT_V(R::NPW); else ATT_WAIT_V(0);
        __builtin_amdgcn_s_barrier(); bi = bi == 2 ? 0 : bi + 1;
    }
}
template <class R, class Body> __device__ __forceinline__ void ring_loop1(LAS char* lds, const Plan<R>& plan, const Src<R>& src, int nt, Body&& body) {
    issue_tile<R>(plan, src, 0, lds); ATT_WAIT_V(0);
    __builtin_amdgcn_s_barrier();
    int bi = 0;
    for (int t = 0; t < nt; ++t) {
        const int bn = bi == 2 ? 0 : bi + 1;
        if (t + 1 < nt) issue_tile<R>(plan, src, t + 1, lds + bn * R::BUF);
        body(t, lds + bi * R::BUF);
        ATT_WAIT_V(0);
        __builtin_amdgcn_s_barrier(); bi = bn;
    }
}
template <class R, int DQK, int DV, bool DO_PV, class Msk, int DBG = 0, bool NEGM = true>
__device__ __forceinline__ void run_online(LAS char* lds, LAS float* wsc, int nt, const Plan<R>& plan, const Src<R>& src, const Msk& msk, const bf16x8* qr, float& m_reg, float& l_reg, f32x16* o, int lane, int wid) {
    const int r32 = lane & 31, hi = lane >> 5;
    if (nt <= 0) return;
    constexpr int VROW = R::ROW(R::NS - 1), VOFF = R::OFF(R::NS - 1);
    const unsigned vlane = (unsigned)((8 * hi + ((lane & 15) >> 2)) * VROW + (16 * ((lane >> 4) & 1) + 4 * (lane & 3)) * 2);
    f32x16 negm;
#pragma unroll
    for (int r = 0; r < 16; ++r) negm[r] = NEGM ? -m_reg : 0.f;
    ring_loop<R>(lds, plan, src, nt, [&](int t, LAS char* Kb) {
        const int kind = DBG == 1 ? 0 : msk.kind(t);
        if (kind) {
            f32x16 p0, p1;
            if (kind == 3) {
                const bool live = msk.live(t); f32x16 ci;
#pragma unroll
                for (int r = 0; r < 16; ++r) ci[r] = live ? negm[r] : -__builtin_inff();
                qk_tile<R, DQK>(p0, p1, Kb, r32, hi, qr, ci);
            } else {
                if (NEGM) qk_tile<R, DQK>(p0, p1, Kb, r32, hi, qr, negm); else qk_tile<R, DQK>(p0, p1, Kb, r32, hi, qr, f32x16{});
                if (kind == 2) msk.apply(p0, p1, t, kind);
            }
            if (DBG == 2) { asm volatile("" :: "v"(p0), "v"(p1)); return; }
            float pmax = fmaxf(p0[0], p1[0]);
#pragma unroll
            for (int r = 1; r < 16; ++r) pmax = fmaxf(pmax, fmaxf(p0[r], p1[r]));
            pmax = lane_pair_max(pmax);
            if (!NEGM) pmax -= m_reg;
            const bool upd = pmax > THR || (l_reg == 0.f && pmax < -THR && pmax > -__builtin_inff());
            float alpha = 1.f;
            if (__any(upd)) {
                const float delta = upd ? pmax : 0.f;
                alpha = l_reg == 0.f ? 1.f : fast_exp2(-delta); m_reg += delta;
                if (NEGM) {
#pragma unroll
                    for (int r = 0; r < 16; ++r) { p0[r] -= delta; p1[r] -= delta; negm[r] = -m_reg; } }
            }
            if (NEGM) {
#pragma unroll
                for (int r = 0; r < 16; ++r) { p0[r] = fast_exp2(p0[r]); p1[r] = fast_exp2(p1[r]); }
            } else {
#pragma unroll
                for (int r = 0; r < 16; ++r) { p0[r] = fast_exp2(p0[r] - m_reg); p1[r] = fast_exp2(p1[r] - m_reg); }
            }
            float ps = 0.f;
#pragma unroll
            for (int r = 0; r < 16; ++r) ps += p0[r] + p1[r];
            ps = lane_pair_sum(ps);
            l_reg = l_reg * alpha + ps;
            if (DO_PV && DBG != 3) {
                if (__any(alpha != 1.f)) {
                    if (hi == 0) wsc[32 + r32] = alpha;
                    asm volatile("s_waitcnt lgkmcnt(0)" ::: "memory");
#pragma unroll
                    for (int r = 0; r < 16; ++r) { const float a = wsc[32 + crow(r, hi)];
#pragma unroll
                        for (int d = 0; d < DV / 32; ++d) o[d][r] *= a; }
                }
                bf16x8 pa0, pa1, pa2, pa3; pack_p(p0, p1, pa0, pa1, pa2, pa3);
                pv_tile<DV, VROW>(o, (unsigned)(uintptr_t)(Kb + VOFF) + vlane, pa0, pa1, pa2, pa3);
            }
        }
    });
}
}
namespace mla {
constexpr int DQK = 192, DV = 128;
using R = att::MlaRing;
constexpr int L_WSC = att::NBUF * R::BUF, L_END = L_WSC + 8 * 256;
struct Msk {
    int qlo, qpos;
    int hi;
    __device__ __forceinline__ int kind(int t) const { const int kb = 64 * t; return kb > qlo + 31 ? 0 : (kb + 63 <= qlo ? 1 : 2); }
    __device__ __forceinline__ bool live(int) const { return true; }
    __device__ __forceinline__ void apply(f32x16& p0, f32x16& p1, int t, int) const {
        const float NEG = -__builtin_inff(); const int d = qpos - 64 * t - 4 * hi;
#pragma unroll
        for (int r = 0; r < 16; ++r) { const int c = (r & 3) + 8 * (r >> 2); if (c > d) p0[r] = NEG; if (c + 32 > d) p1[r] = NEG; }
    }
};
__device__ __forceinline__ void unit(LAS char* lds, const att::Plan<R>& plan, int b, int h, int qb, const bf16_t* Q, const bf16_t* KN, const bf16_t* KR, const bf16_t* V, bf16_t* O, int tid, int wid) {
    const int lane = fresh_lane(); (void)tid;
    const int r32 = lane & 31, hi = lane >> 5;
    LAS float* wsc = (LAS float*)(lds + L_WSC) + wid * 64;
    const int q0 = qb * 256 + wid * 32;
    const size_t trow = (size_t)b * SEQ + q0 + r32;
    bf16x8 qr[DQK / 16];
#pragma unroll
    for (int d0 = 0; d0 < DQK / 16; ++d0) qr[d0] = *(const bf16x8*)(Q + trow * 1536 + h * 192 + d0 * 16 + hi * 8);
    att::Src<R> src{att::make_rsrc(KN + (size_t)(b * MLA_H + h) * SEQ * 128), att::make_rsrc(KR + (size_t)b * SEQ * 64), att::make_rsrc(V + (size_t)(b * MLA_H + h) * SEQ * 128), 0};
    Msk msk{q0, q0 + r32, hi};
    float m_reg = 0.f, l_reg = 0.f; f32x16 o[DV / 32] = {};
    att::run_online<R, DQK, DV, true, Msk, 0, false>(lds, wsc, 4 * (qb + 1), plan, src, msk, qr, m_reg, l_reg, o, lane, wid);
    if (hi == 0) wsc[r32] = l_reg;
    asm volatile("s_waitcnt lgkmcnt(0)" ::: "memory");
    bf16_t* Ow = O + ((size_t)b * SEQ + q0) * 1024 + h * 128;
#pragma unroll
    for (int r = 0; r < 16; ++r) { const int orow = att::crow(r, hi); const float l = wsc[orow]; const float rl = l > 0.f ? fast_rcp(l) : 0.f;
#pragma unroll
        for (int d0 = 0; d0 < DV / 32; ++d0) { const float v = o[d0][r] * rl; const float vn = __shfl_xor(v, 1);
            if ((r32 & 1) == 0) *(unsigned*)(Ow + (size_t)orow * 1024 + d0 * 32 + r32) = cvt_pk_bf16(v, vn); } }
    asm volatile("s_waitcnt lgkmcnt(0)" ::: "memory");
}
}

namespace nsa {
constexpr int DQK = 96, DV = 64;
using R = att::NsaRing;
constexpr int L_WSC = att::NBUF * R::BUF;
constexpr int L_TAB = L_WSC + 8 * 256;
constexpr int TABW = 132;
constexpr int L_PSUM = L_TAB + 4 * TABW * 4;
constexpr int PSW = 68;
constexpr int L_IMP = L_PSUM + 8 * 8 * PSW * 4;
constexpr int L_SELW = L_IMP + 8 * 8 * 128 * 4;
constexpr int L_END = L_SELW + 8 * 8 * 4 * 4;
__device__ __forceinline__ float lds_ld(const LAS float* base, int idx) { float v; asm volatile("ds_read_b32 %0, %1" : "=&v"(v) : "v"((unsigned)(uintptr_t)(base + idx)) : "memory"); return v; }
__device__ __forceinline__ void lds_ld_wait(float (&a)[16], float (&b)[16]) {
    asm volatile("s_waitcnt lgkmcnt(0)" : "+v"(a[0]), "+v"(a[1]), "+v"(a[2]), "+v"(a[3]), "+v"(a[4]), "+v"(a[5]), "+v"(a[6]), "+v"(a[7]), "+v"(a[8]), "+v"(a[9]), "+v"(a[10]), "+v"(a[11]), "+v"(a[12]), "+v"(a[13]), "+v"(a[14]), "+v"(a[15]) :: "memory");
    asm volatile("" : "+v"(b[0]), "+v"(b[1]), "+v"(b[2]), "+v"(b[3]), "+v"(b[4]), "+v"(b[5]), "+v"(b[6]), "+v"(b[7]), "+v"(b[8]), "+v"(b[9]), "+v"(b[10]), "+v"(b[11]), "+v"(b[12]), "+v"(b[13]), "+v"(b[14]), "+v"(b[15]) :: "memory");
}
struct MskCmp {
    int qlo, qpos, hi; const LAS float* tab;
    __device__ __forceinline__ int kind(int t) const {
        const int n0 = 64 * t;
        if (qlo + 7 - (16 * n0 + 31) < 0) return 0;
        return (qlo - (16 * (n0 + 63) + 31) >= 128) ? 1 : 2;
    }
    __device__ __forceinline__ bool live(int) const { return true; }
    __device__ __forceinline__ void apply(f32x16& p0, f32x16& p1, int t, int) const {
        const float NEG = -__builtin_inff(); const int dq = qpos - 31 - 16 * (64 * t + 4 * hi);
        float bv0[16], bv1[16];
#pragma unroll
        for (int r = 0; r < 16; ++r) { const int c = 16 * ((r & 3) + 8 * (r >> 2)); const int d0 = dq - c, d1 = dq - c - 512;
            bv0[r] = lds_ld(tab, (unsigned)d0 < 128u ? d0 : 128); bv1[r] = lds_ld(tab, (unsigned)d1 < 128u ? d1 : 128); }
        lds_ld_wait(bv0, bv1);
#pragma unroll
        for (int r = 0; r < 16; ++r) { const int c = 16 * ((r & 3) + 8 * (r >> 2));
            p0[r] = dq - c >= 0 ? p0[r] + bv0[r] : NEG; p1[r] = dq - c - 512 >= 0 ? p1[r] + bv1[r] : NEG; }
    }
};
struct MskSel {
    int qpos, hi, cur; const LAS float* tab; const LAS unsigned* selw;
    __device__ __forceinline__ bool mine(int j) const { return (selw[j >> 5] >> (j & 31)) & 1u; }
    __device__ __forceinline__ int kind(int j) const {
        const bool s = mine(j);
        if (!__any(s)) return 0;
        if (j >= cur - 2) return 2;
        return __all(s) ? 1 : 3;
    }
    __device__ __forceinline__ bool live(int j) const { return mine(j); }
    __device__ __forceinline__ void apply(f32x16& p0, f32x16& p1, int j, int) const {
        const float NEG = -__builtin_inff(); const bool s = mine(j); const int dq = qpos - 64 * j - 4 * hi;
        float bv0[16], bv1[16];
#pragma unroll
        for (int r = 0; r < 16; ++r) { const int c = (r & 3) + 8 * (r >> 2); const int d0 = dq - c, d1 = dq - c - 32;
            bv0[r] = lds_ld(tab, (unsigned)d0 < 128u ? d0 : 128); bv1[r] = lds_ld(tab, (unsigned)d1 < 128u ? d1 : 128); }
        lds_ld_wait(bv0, bv1);
#pragma unroll
        for (int r = 0; r < 16; ++r) { const int c = (r & 3) + 8 * (r >> 2);
            p0[r] = (s && dq - c >= 0) ? p0[r] + bv0[r] : NEG; p1[r] = (s && dq - c - 32 >= 0) ? p1[r] + bv1[r] : NEG; }
    }
};
struct MskWin {
    int qpos, hi, cur, j0; const LAS float* tab;
    __device__ __forceinline__ int kind(int t) const { const int j = j0 + t; return (j >= cur - 2 || j <= cur - 8) ? 2 : 1; }
    __device__ __forceinline__ bool live(int) const { return true; }
    __device__ __forceinline__ void apply(f32x16& p0, f32x16& p1, int t, int) const {
        const float NEG = -__builtin_inff(); const int dq = qpos - 64 * (j0 + t) - 4 * hi;
        float bv0[16], bv1[16];
#pragma unroll
        for (int r = 0; r < 16; ++r) { const int c = (r & 3) + 8 * (r >> 2); const int d0 = dq - c, d1 = dq - c - 32;
            bv0[r] = lds_ld(tab, (unsigned)d0 < 128u ? d0 : 128); bv1[r] = lds_ld(tab, (unsigned)d1 < 128u ? d1 : 128); }
        lds_ld_wait(bv0, bv1);
#pragma unroll
        for (int r = 0; r < 16; ++r) { const int c = (r & 3) + 8 * (r >> 2);
            p0[r] = (unsigned)(dq - c) < 512u ? p0[r] + bv0[r] : NEG; p1[r] = (unsigned)(dq - c - 32) < 512u ? p1[r] + bv1[r] : NEG; }
    }
};
__device__ __forceinline__ void fold(f32x16* ofin, const f32x16* o, float f, LAS float* wsc, int r32, int hi) {
    if (hi == 0) wsc[r32] = f;
    asm volatile("s_waitcnt lgkmcnt(0)" ::: "memory");
#pragma unroll
    for (int r = 0; r < 16; ++r) { const float a = wsc[att::crow(r, hi)];
#pragma unroll
        for (int d = 0; d < DV / 32; ++d) ofin[d][r] += o[d][r] * a; }
    asm volatile("s_waitcnt lgkmcnt(0)" : "+v"(ofin[0]), "+v"(ofin[1]) :: "memory");
}
struct Tensors { const bf16_t *NQ, *KCMP, *VCMP, *KS, *VS, *KW, *VW; const float *GT, *RBT; bf16_t* O; };
#define NSA_LAUNDER() const int lane = fresh_lane(), tid = wid * 64 + lane, r32 = lane & 31, hi = lane >> 5, qi = r32 >> 2, hg = r32 & 3; \
    LAS float* wsc = (LAS float*)(lds + L_WSC) + wid * 64; const LAS float* tab = (LAS float*)(lds + L_TAB) + hg * TABW; const int qpos = qlo + qi;
template <int DBG = 0> __device__ __forceinline__ void unit(LAS char* lds, const att::Plan<R>& plan, const Tensors& X, int b, int g, int qblk, int tid0, int wid) {
    const int s0 = qblk * 64, cur = qblk, qlo = s0 + 8 * wid;
    const int bg = b * NSA_G + g;
    bf16x8 qr[DQK / 16]; float gc, gs, gw;
    f32x16 ofin[DV / 32] = {};
    LAS float* imp = (LAS float*)(lds + L_IMP) + wid * 8 * 128;
    LAS unsigned* selw = (LAS unsigned*)(lds + L_SELW) + wid * 32;
    {
    NSA_LAUNDER();
    LAS float* tabs = (LAS float*)(lds + L_TAB);
    LAS float* psum = (LAS float*)(lds + L_PSUM) + wid * 8 * PSW;
    for (int i = tid; i < 4 * TABW; i += 512) tabs[i] = X.RBT[(g * 4 + i / TABW) * TABW + i % TABW];
    for (int i = lane; i < 8 * 128; i += 64) imp[i] = 0.f;
    if (lane < 8) psum[lane * PSW] = 0.f;
    if (lane < 32) selw[lane] = 0u;
    const size_t trow = (size_t)b * SEQ + qpos;
#pragma unroll
    for (int d0 = 0; d0 < DQK / 16; ++d0) qr[d0] = *(const bf16x8*)(X.NQ + trow * 1536 + (g * 4 + hg) * 96 + d0 * 16 + hi * 8);
    gc = X.GT[trow * 48 + (g * 4 + hg) * 3 + 0]; gs = X.GT[trow * 48 + (g * 4 + hg) * 3 + 1]; gw = X.GT[trow * 48 + (g * 4 + hg) * 3 + 2];
    __syncthreads();
    }
    const int ncv = (s0 + 63 >= 31) ? ((s0 + 63 - 31) >> 4) + 1 : 0;
    const int ntc = (ncv + 63) >> 6;
#ifndef NSA_NO_CMP
    {
        NSA_LAUNDER();
        att::Src<R> srcC{att::make_rsrc(X.KCMP + (size_t)bg * 512 * 96), att::make_rsrc(X.VCMP + (size_t)bg * 512 * 64), att::make_rsrc(X.VCMP), 0};
        MskCmp mc{qlo, qpos, hi, tab};
        LAS float* psum = (LAS float*)(lds + L_PSUM) + wid * 8 * PSW;
        float m_reg = 0.f, l_reg = 0.f; f32x16 od[DV / 32];
        att::run_online<R, DQK, DV, false>(lds, wsc, ntc, plan, srcC, mc, qr, m_reg, l_reg, od, lane, wid);
        f32x16 cin2; { const float c2 = l_reg > 0.f ? -(m_reg + __builtin_amdgcn_logf(l_reg)) : -__builtin_inff();
#pragma unroll
            for (int r = 0; r < 16; ++r) cin2[r] = c2; }
        f32x16 o[DV / 32] = {};
        if (ntc > 0) {
            constexpr int VROW = R::ROW(1), VOFF = R::OFF(1);
            const unsigned vlane = (unsigned)((8 * hi + ((lane & 15) >> 2)) * VROW + (16 * ((lane >> 4) & 1) + 4 * (lane & 3)) * 2);
            att::ring_loop<R>(lds, plan, srcC, ntc, [&](int t, LAS char* Kb) {
                const int kind = mc.kind(t);
                if (kind) {
                    f32x16 p0, p1;
                    att::qk_tile<R, DQK>(p0, p1, Kb, r32, hi, qr, cin2);
                    if (kind >= 2) mc.apply(p0, p1, t, kind);
#pragma unroll
                    for (int r = 0; r < 16; ++r) { p0[r] = fast_exp2(p0[r]); p1[r] = fast_exp2(p1[r]); }
#pragma unroll
                    for (int r = 0; r < 16; ++r) {
                        float a = p0[r]; a += __shfl_xor(a, 1); a += __shfl_xor(a, 2);
                        float c = p1[r]; c += __shfl_xor(c, 1); c += __shfl_xor(c, 2);
                        if (hg == 0) { psum[qi * PSW + 1 + att::crow(r, hi)] = a; psum[qi * PSW + 33 + att::crow(r, hi)] = c; }
                    }
                    asm volatile("s_waitcnt lgkmcnt(0)" ::: "memory");
                    {
                        const int q = lane >> 3;
#pragma unroll
                        for (int e = 0; e < 2; ++e) { const int jl = (lane & 7) * 2 + e; const LAS float* ps = psum + q * PSW + 4 * jl;
                            imp[q * 128 + 16 * t + jl] = (ps[0] + ps[1]) + (ps[2] + ps[3]) + ps[4]; }
                    }
                    asm volatile("s_waitcnt lgkmcnt(0)" ::: "memory");
                    if (lane < 8) psum[lane * PSW] = psum[lane * PSW + 64];
                    asm volatile("s_waitcnt lgkmcnt(0)" ::: "memory");
                    bf16x8 pa0, pa1, pa2, pa3; att::pack_p(p0, p1, pa0, pa1, pa2, pa3);
                    att::pv_tile<DV, VROW>(o, (unsigned)(uintptr_t)(Kb + VOFF) + vlane, pa0, pa1, pa2, pa3);
                }
            });
        }
        fold(ofin, o, gc, wsc, r32, hi);
    }
#endif
#ifndef NSA_NO_TOPK
    {
        NSA_LAUNDER();
        const int q = lane >> 3, jl = lane & 7;
        float v[16];
#pragma unroll
        for (int i = 0; i < 16; ++i) { const int j = jl + 8 * i; const float x = imp[q * 128 + j];
            v[i] = (j == 0 || j == cur || j == cur - 1) ? 1e6f : (j > cur ? -1e6f : x); }
        unsigned wd[4] = {0u, 0u, 0u, 0u};
        const int nsel = cur + 1 < 16 ? cur + 1 : 16;
        for (int it = 0; it < nsel; ++it) {
            float bv = v[0]; int bj = jl;
#pragma unroll
            for (int i = 1; i < 16; ++i) { const bool g = v[i] > bv; bv = g ? v[i] : bv; bj = g ? jl + 8 * i : bj; }
#pragma unroll
            for (int o = 1; o < 8; o <<= 1) { const float ov = __shfl_xor(bv, o); const int oj = __shfl_xor(bj, o); const bool g = ov > bv || (ov == bv && oj < bj); bv = g ? ov : bv; bj = g ? oj : bj; }
            const bool mine = (bj & 7) == jl; const int wi = bj >> 3;
#pragma unroll
            for (int i = 0; i < 16; ++i) v[i] = (mine && i == wi) ? -__builtin_inff() : v[i];
            const unsigned bit = (mine && bj <= cur) ? 1u << (jl + 8 * (wi & 3)) : 0u;
#pragma unroll
            for (int w = 0; w < 4; ++w) wd[w] |= (w == (wi >> 2)) ? bit : 0u;
        }
#pragma unroll
        for (int w = 0; w < 4; ++w) if (wd[w]) atomicOr((unsigned*)(selw + q * 4 + w), wd[w]);
        asm volatile("s_waitcnt lgkmcnt(0)" ::: "memory");
    }
#endif
#ifndef NSA_NO_SEL
    {
        NSA_LAUNDER();
        att::Src<R> srcS{att::make_rsrc(X.KS + (size_t)bg * SEQ * 96), att::make_rsrc(X.VS + (size_t)bg * SEQ * 64), att::make_rsrc(X.VS), 0};
        MskSel ms{qpos, hi, cur, tab, selw + qi * 4};
        float m_reg = 0.f, l_reg = 0.f; f32x16 o[DV / 32] = {};
        att::run_online<R, DQK, DV, true, MskSel, DBG>(lds, wsc, cur + 1, plan, srcS, ms, qr, m_reg, l_reg, o, lane, wid);
        fold(ofin, o, l_reg > 0.f ? gs * fast_rcp(l_reg) : 0.f, wsc, r32, hi);
    }
#endif
#ifndef NSA_NO_WIN
    {
        NSA_LAUNDER();
        const int j0 = cur >= 8 ? cur - 8 : 0;
        att::Src<R> srcW{att::make_rsrc(X.KW + (size_t)bg * SEQ * 96), att::make_rsrc(X.VW + (size_t)bg * SEQ * 64), att::make_rsrc(X.VW), j0};
        MskWin mw{qpos, hi, cur, j0, tab};
        float m_reg = 0.f, l_reg = 0.f; f32x16 o[DV / 32] = {};
        att::run_online<R, DQK, DV, true, MskWin, DBG>(lds, wsc, cur - j0 + 1, plan, srcW, mw, qr, m_reg, l_reg, o, lane, wid);
        fold(ofin, o, l_reg > 0.f ? gw * fast_rcp(l_reg) : 0.f, wsc, r32, hi);
    }
#endif
    NSA_LAUNDER();
    bf16_t* Ow = X.O + ((size_t)b * SEQ + qlo) * 1024 + g * 256;
#pragma unroll
    for (int r = 0; r < 16; ++r) { const int orow = att::crow(r, hi);
#pragma unroll
        for (int d0 = 0; d0 < DV / 32; ++d0) { const float v = ofin[d0][r]; const float vn = __shfl_xor(v, 1);
            if ((r32 & 1) == 0) *(unsigned*)(Ow + (size_t)(orow >> 2) * 1024 + (orow & 3) * 64 + d0 * 32 + r32) = cvt_pk_bf16(v, vn); } }
    __syncthreads();
}
}
#endif
#if !defined(__HIP_DEVICE_COMPILE__)
namespace nsa { constexpr int L_END = 0, TABW = 132; } namespace mla { constexpr int L_END = 0; }
#endif
constexpr size_t MiB = 1u << 20;
constexpr size_t WS_CTL = 0, CTL_ZERO_BYTES = 1 * MiB;
constexpr size_t WS_W_MLAIN = 1 * MiB;
constexpr size_t WS_W_QUP   = 3 * MiB;
constexpr size_t WS_W_KVUP  = WS_W_QUP + 1536 * 1024;
constexpr size_t WS_W_MLAOUT = WS_W_KVUP + 1 * MiB;
constexpr size_t WS_W_FFNGU = WS_W_MLAOUT + 2 * MiB;
constexpr size_t WS_W_FFND  = WS_W_FFNGU + 11 * MiB;
constexpr size_t WS_W_NSAIN = WS_W_FFND + 5632 * 1024;
constexpr size_t WS_W_NSAOUT = WS_W_NSAIN + 7 * MiB;
constexpr size_t WS_W_C1K = WS_W_NSAOUT + 2 * MiB;
constexpr size_t WS_W_C1V = WS_W_C1K + 256 * 3072 * 2;
constexpr size_t WS_W_C2K = WS_W_C1V + 256 * 2048 * 2;
constexpr size_t WS_W_C2V = WS_W_C2K + 256 * 128 * 2;
constexpr size_t WS_ROPE  = WS_W_C2V + 256 * 128 * 2;
constexpr size_t WS_CBIAS = WS_ROPE + 2 * MiB;
constexpr size_t WS_RBT   = WS_CBIAS + 1024;
constexpr size_t WS_ROWTOK = 38 * MiB;
constexpr size_t WS_TOKINFO = 39 * MiB;
constexpr size_t WS_TOKW = WS_TOKINFO + 256 * 1024;
static_assert(WS_RBT + 16 * 132 * 4 <= WS_ROWTOK && WS_TOKW + 256 * 1024 <= 40 * MiB, "small region");
constexpr size_t WS_XB = 40 * MiB, WS_LAT = 104 * MiB, WS_QN = 168 * MiB, WS_KVN = 200 * MiB, WS_KR = 216 * MiB, WS_Q = 220 * MiB, WS_KN = 316 * MiB, WS_V = 380 * MiB;
constexpr size_t WS_O = 40 * MiB, WS_X1 = 104 * MiB, WS_ACT = 168 * MiB, WS_X2 = 40 * MiB;
constexpr size_t WS_NQ = 104 * MiB, WS_KC = 200 * MiB, WS_VC = 224 * MiB, WS_KS = 240 * MiB, WS_VS = 264 * MiB, WS_KW = 280 * MiB, WS_VW = 304 * MiB, WS_GT = 320 * MiB;
static_assert(WS_KS - WS_KC == 40 * MiB && WS_KW - WS_KS == 40 * MiB && WS_VS - WS_VC == 40 * MiB && WS_VW - WS_VS == 40 * MiB, "FNsaIn segment stride");
constexpr size_t WS_HK = 328 * MiB, WS_HV = 330 * MiB, WS_KCMP = 332 * MiB, WS_VCMP = 334 * MiB;
constexpr size_t WS_ONSA = 348 * MiB, WS_X3 = 412 * MiB;
constexpr size_t WS_MOE_GU = 40 * MiB, WS_MOE_D = 152 * MiB, WS_DOUT = 208 * MiB;
constexpr size_t WS_MOE_GU8 = 40 * MiB, WS_MOE_D8 = 96 * MiB, WS_X3F8 = 124 * MiB;
constexpr size_t WS_X1F8 = 256 * MiB;
constexpr float MOE_GU_WS = 32.f, MOE_D_WS = 128.f, MOE_H_S = 4.f;
constexpr size_t WS_END = 476 * MiB;
constexpr int CW_BAR = 4096;
constexpr int CW_ECNT = 16384;
constexpr int RING_BYTES = 161792;
constexpr int MISC_OFF = RING_BYTES + 320;
constexpr int LDS_BYTES = 163840;
constexpr int NWAVES = 8;
static_assert(nsa::L_END <= RING_BYTES && mla::L_END <= RING_BYTES, "attention LDS");

#define RLX_AGENT __ATOMIC_RELAXED, __HIP_MEMORY_SCOPE_AGENT
#define LDS_WAIT() asm volatile("s_waitcnt lgkmcnt(0)" ::: "memory")
#define VM_WAIT() asm volatile("s_waitcnt vmcnt(0)" ::: "memory")
__device__ __forceinline__ unsigned f2bf(float f) { unsigned u = __builtin_bit_cast(unsigned, f); return (u + 0x7fffu + ((u >> 16) & 1u)) >> 16; }
__device__ __forceinline__ unsigned pk2(float lo, float hi) { return f2bf(lo) | (f2bf(hi) << 16); }

#define XB_TMO      128
#define XB_XCNT(j)  (256  + 64 * (j))
#define XB_XSUB(j)  (1280 + 64 * (j))
#define XB_XGEN(j)  (2304 + 64 * (j))
#define XB_TOP      3328
#define XB_TOPGEN   3392
#define XCD_BAR_WORDS 3456
#define XB_SPIN_CAP (1u << 20)
__device__ __forceinline__ unsigned xb_ld(unsigned* p)              { return __hip_atomic_load(p, __ATOMIC_RELAXED, __HIP_MEMORY_SCOPE_AGENT); }
__device__ __forceinline__ unsigned xb_add(unsigned* p, unsigned v) { return __hip_atomic_fetch_add(p, v, __ATOMIC_RELAXED, __HIP_MEMORY_SCOPE_AGENT); }
__device__ __forceinline__ unsigned xb_xcc_id() { return (unsigned)__builtin_amdgcn_s_getreg((3 << 11) | 20) & 0xFu; }
#define XB_SPIN(cond, bar) do { unsigned _sp = 0; while (cond) { __builtin_amdgcn_s_sleep(1); \
    if ((++_sp & 255u) == 0u) { if (xb_ld(&(bar)[XB_TMO])) break; if (_sp > XB_SPIN_CAP) { atomicAdd(&(bar)[XB_TMO], 1u); break; } } } } while (0)
struct XcdBarrier { unsigned* bar; unsigned x; volatile LAS unsigned* st; };
__device__ __forceinline__ XcdBarrier xcd_barrier_post(unsigned* bar, volatile LAS unsigned* st) {
    XcdBarrier b; b.bar = bar; b.x = xb_xcc_id(); b.st = st;
    if (threadIdx.x == 0) (void)xb_add(&bar[XB_XCNT(b.x)], 1u);
    return b;
}
__device__ __forceinline__ void xcd_barrier_complete(unsigned* bar, unsigned x, unsigned& nloc, unsigned& nx) {
    const unsigned G = gridDim.x * gridDim.y * gridDim.z;
    unsigned sum, cnt, mine, sp = 0u;
    for (;;) {
        sum = 0u; cnt = 0u; mine = 0u;
#pragma unroll
        for (unsigned j = 0; j < 16; ++j) { const unsigned c = xb_ld(&bar[XB_XCNT(j)]); sum += c; cnt += (c > 0u) ? 1u : 0u; mine = (j == x) ? c : mine; }
        if (sum == G) break;
        __builtin_amdgcn_s_sleep(1);
        if ((++sp & 255u) == 0u) { if (xb_ld(&bar[XB_TMO])) break; if (sp > XB_SPIN_CAP) { atomicAdd(&bar[XB_TMO], 1u); break; } }
    }
    nloc = mine > 0u ? mine : 1u; nx = cnt > 0u ? cnt : 1u;
}
__device__ __forceinline__ void xcd_barrier(const XcdBarrier& b) {
    asm volatile("s_waitcnt vmcnt(0)" ::: "memory");
    __syncthreads();
    if (threadIdx.x == 0) {
        unsigned* bar = b.bar;
        __builtin_amdgcn_s_waitcnt(0);
        unsigned nloc = b.st[0], nx = b.st[1];
        if (nloc == 0u) { xcd_barrier_complete(bar, b.x, nloc, nx); b.st[0] = nloc; b.st[1] = nx; }
        const unsigned old = xb_add(&bar[XB_XSUB(b.x)], 1u);
        const unsigned gen = old / nloc;
        if (old + 1u == (gen + 1u) * nloc) {
            __builtin_amdgcn_fence(__ATOMIC_RELEASE, "agent");
            asm volatile("s_waitcnt vmcnt(0)" ::: "memory");
            const unsigned og = xb_add(&bar[XB_TOP], 1u);
            const unsigned tg = og / nx;
            if (og + 1u == (tg + 1u) * nx) xb_add(&bar[XB_TOPGEN], 1u);
            else XB_SPIN(xb_ld(&bar[XB_TOPGEN]) == tg, bar);
            __builtin_amdgcn_fence(__ATOMIC_ACQUIRE, "agent");
            xb_add(&bar[XB_XGEN(b.x)], 1u);
            asm volatile("s_waitcnt vmcnt(0)" ::: "memory");
        } else {
            XB_SPIN(xb_ld(&bar[XB_XGEN(b.x)]) == gen, bar);
            __builtin_amdgcn_fence(__ATOMIC_ACQUIRE, "agent");
            asm volatile("s_waitcnt vmcnt(0)" ::: "memory");
        }
    }
    __syncthreads();
}

__device__ __forceinline__ float wave_sum(float v) {
#pragma unroll
    for (int o = 1; o < 64; o <<= 1) v += __shfl_xor(v, o);
    return v;
}
template <class RM> __device__ __forceinline__ void tr_item(const float* W, int K, int N, bf16_t* WT, int ldk, const RM& rowmap, LAS float* scr, int item, int lane) {
    const int nblk = (N + 31) / 32, kb = item / nblk, nb = item % nblk, k0 = 64 * kb, n0 = 32 * nb;
    const bool nok = n0 + (lane & 31) < N;
#pragma unroll 8
    for (int i = 0; i < 32; ++i) { const int kk = 2 * i + (lane >> 5); scr[kk * 33 + (lane & 31)] = nok ? W[(size_t)(k0 + kk) * N + n0 + (lane & 31)] : 0.f; }
    LDS_WAIT(); asm volatile("" ::: "memory");
    const int c = lane & 7;
#pragma unroll
    for (int j = 0; j < 4; ++j) { const int nl = (lane >> 3) + 8 * j; const LAS float* s = scr + (8 * c) * 33 + nl;
        u32x4 o; o.x = pk2(s[0 * 33], s[1 * 33]); o.y = pk2(s[2 * 33], s[3 * 33]); o.z = pk2(s[4 * 33], s[5 * 33]); o.w = pk2(s[6 * 33], s[7 * 33]);
        if (n0 + nl < N) *(u32x4*)(WT + (size_t)rowmap(n0 + nl) * ldk + k0 + 8 * c) = o; }
    LDS_WAIT(); asm volatile("" ::: "memory");
}
struct RmId { int off; __device__ __forceinline__ int operator()(int n) const { return off + n; } };
struct RmGU { int off; __device__ __forceinline__ int operator()(int n) const { return off + (n >> 7) * 256 + (n & 127); } };
struct RmQup { __device__ __forceinline__ int operator()(int n) const { const int h = n / 192, j = n % 192; if (j < 128) return n; const int i = j - 128, ii = i & 31; return h * 192 + 128 + 8 * (ii >> 2) + (ii & 3) + ((i >> 5) << 2); } };
template <class RM> __device__ __forceinline__ void tr_matrix(const float* W, int K, int N, bf16_t* WT, int ldk, const RM& rm, LAS float* scr, int gw, int ngw, int lane) {
    const int nitems = (K / 64) * ((N + 31) / 32);
    for (int it = gw; it < nitems; it += ngw) tr_item(W, K, N, WT, ldk, rm, scr, it, lane);
}

__device__ __forceinline__ float clamp448(float v) { return fminf(fmaxf(v, -448.f), 448.f); }
__device__ __forceinline__ unsigned pk4_fp8(float a, float b, float c, float d) { int w = 0; w = __builtin_amdgcn_cvt_pk_fp8_f32(clamp448(a), clamp448(b), w, false); w = __builtin_amdgcn_cvt_pk_fp8_f32(clamp448(c), clamp448(d), w, true); return (unsigned)w; }
template <class RM> __device__ __forceinline__ void tr_item_f8(const float* W, int K, int N, unsigned char* WT, int ldk, float scale, const RM& rowmap, LAS float* scr, int item, int lane) {
    const int nblk = (N + 31) / 32, kb = item / nblk, nb = item % nblk, k0 = 64 * kb, n0 = 32 * nb;
    const bool nok = n0 + (lane & 31) < N;
#pragma unroll 8
    for (int i = 0; i < 32; ++i) { const int kk = 2 * i + (lane >> 5); scr[kk * 33 + (lane & 31)] = nok ? W[(size_t)(k0 + kk) * N + n0 + (lane & 31)] * scale : 0.f; }
    LDS_WAIT(); asm volatile("" ::: "memory");
    const int c = lane & 3;
#pragma unroll
    for (int j = 0; j < 2; ++j) { const int nl = (lane >> 2) + 16 * j; const LAS float* s = scr + (16 * c) * 33 + nl;
        u32x4 o; o.x = pk4_fp8(s[0 * 33], s[1 * 33], s[2 * 33], s[3 * 33]); o.y = pk4_fp8(s[4 * 33], s[5 * 33], s[6 * 33], s[7 * 33]);
        o.z = pk4_fp8(s[8 * 33], s[9 * 33], s[10 * 33], s[11 * 33]); o.w = pk4_fp8(s[12 * 33], s[13 * 33], s[14 * 33], s[15 * 33]);
        if (n0 + nl < N) *(u32x4*)(WT + (size_t)rowmap(n0 + nl) * ldk + k0 + 16 * c) = o; }
    LDS_WAIT(); asm volatile("" ::: "memory");
}
template <class RM> __device__ __forceinline__ void tr_matrix_f8(const float* W, int K, int N, unsigned char* WT, int ldk, float scale, const RM& rm, LAS float* scr, int gw, int ngw, int lane) {
    const int nitems = (K / 64) * ((N + 31) / 32);
    for (int it = gw; it < nitems; it += ngw) tr_item_f8(W, K, N, WT, ldk, scale, rm, scr, it, lane);
}
__device__ __forceinline__ void ln_inplace(f32x4 (&v)[4], const float* g, const float* b, int lane) {
    float s = 0.f;
#pragma unroll
    for (int j = 0; j < 4; ++j) s += (v[j].x + v[j].y) + (v[j].z + v[j].w);
    const float mean = wave_sum(s) * (1.f / D); float s2 = 0.f;
#pragma unroll
    for (int j = 0; j < 4; ++j) { v[j] = v[j] - mean; s2 += (v[j].x * v[j].x + v[j].y * v[j].y) + (v[j].z * v[j].z + v[j].w * v[j].w); }
    const float rstd = 1.f / sqrtf(wave_sum(s2) * (1.f / D) + 1e-5f);
#pragma unroll
    for (int j = 0; j < 4; ++j) { const f32x4 gg = *((const f32x4*)g + lane + 64 * j), bb = *((const f32x4*)b + lane + 64 * j); v[j] = v[j] * rstd * gg + bb; }
}
__device__ __forceinline__ void store_row_bf16(bf16_t* orow, const f32x4 (&v)[4], int lane) {
    u32x2* o8 = (u32x2*)orow + lane;
#pragma unroll
    for (int j = 0; j < 4; ++j) { u32x2 w; w.x = cvt_pk_bf16(v[j].x, v[j].y); w.y = cvt_pk_bf16(v[j].z, v[j].w); o8[64 * j] = w; }
}
__device__ __forceinline__ f32x4 bf4_to_f32(u32x2 w) { return (f32x4){bflo(w.x), bfhi(w.x), bflo(w.y), bfhi(w.y)}; }

__device__ __forceinline__ u32x4 pack8(f32x4 a, f32x4 b) { u32x4 w; w.x = cvt_pk_bf16(a[0], a[1]); w.y = cvt_pk_bf16(a[2], a[3]); w.z = cvt_pk_bf16(b[0], b[1]); w.w = cvt_pk_bf16(b[2], b[3]); return w; }
struct FBf16 { bf16_t* O; int ld; int rowoff;
    __device__ __forceinline__ void operator()(int row, int col, f32x4 a, f32x4 b) const { *(u32x4*)(O + (size_t)(rowoff + row) * ld + col) = pack8(a, b); } };
struct FBf16S { bf16_t* O; int ld; int rowoff; float sc;
    __device__ __forceinline__ void operator()(int row, int col, f32x4 a, f32x4 b) const { *(u32x4*)(O + (size_t)(rowoff + row) * ld + col) = pack8(a * sc, b * sc); } };
struct FSwigluF8 { unsigned char* A; int ld; float isc, osc;
    __device__ __forceinline__ void operator()(int row, int col, f32x4 g0, f32x4 g1, f32x4 u0, f32x4 u1) const {
        f32x4 a, b;
#pragma unroll
        for (int e = 0; e < 4; ++e) { a[e] = silu_f(g0[e] * isc) * (u0[e] * (isc * osc)); b[e] = silu_f(g1[e] * isc) * (u1[e] * (isc * osc)); }
        u32x2 w; w.x = pk4_fp8(a[0], a[1], a[2], a[3]); w.y = pk4_fp8(b[0], b[1], b[2], b[3]);
        *(u32x2*)(A + (size_t)row * ld + col) = w; } };
struct FQup { bf16_t* Q; const float* cs; const float* sn;
    __device__ __forceinline__ void operator()(int row, int col, f32x4 a, f32x4 b) const {
        const int j = col % 192;
        if (j >= 128) { const int i0 = ((j - 128) >> 3) * 4, s = row & (SEQ - 1);
            const f32x4 c = *(const f32x4*)(cs + s * 32 + i0), sv = *(const f32x4*)(sn + s * 32 + i0);
            const f32x4 o1 = a * c - b * sv, o2 = a * sv + b * c; a = o1; b = o2; }
        *(u32x4*)(Q + (size_t)row * 1536 + col) = pack8(a * C2_MLA, b * C2_MLA); } };
struct FKvup { bf16_t* KN; size_t vdelta;
    __device__ __forceinline__ void operator()(int row, int col, f32x4 a, f32x4 b) const {
        const int h = col >> 8, j = col & 255, bb = row >> 13, s = row & (SEQ - 1);
        bf16_t* base = KN + (j < 128 ? (size_t)0 : vdelta) + ((size_t)(bb * MLA_H + h) * SEQ + s) * 128 + (j & 127);
        *(u32x4*)base = pack8(a, b); } };
struct FResF32 { float* P; const float* rf; const bf16_t* rb; float sc;
    __device__ __forceinline__ void operator()(int row, int col, f32x4 a, f32x4 b) const {
        const size_t o = (size_t)row * D + col; f32x4 r0, r1;
        if (rf) { r0 = *(const f32x4*)(rf + o); r1 = *(const f32x4*)(rf + o + 4); }
        else { const u32x4 w = *(const u32x4*)(rb + o); r0 = (f32x4){bflo(w.x), bfhi(w.x), bflo(w.y), bfhi(w.y)}; r1 = (f32x4){bflo(w.z), bfhi(w.z), bflo(w.w), bfhi(w.w)}; }
        *(f32x4*)(P + o) = r0 * ALPHA + a * sc; *(f32x4*)(P + o + 4) = r1 * ALPHA + b * sc; } };
struct FResBf16 { bf16_t* P; const float* rf; const bf16_t* rb; float sc;
    __device__ __forceinline__ void operator()(int row, int col, f32x4 a, f32x4 b) const {
        const size_t o = (size_t)row * D + col; f32x4 r0, r1;
        if (rf) { r0 = *(const f32x4*)(rf + o); r1 = *(const f32x4*)(rf + o + 4); }
        else { const u32x4 w = *(const u32x4*)(rb + o); r0 = (f32x4){bflo(w.x), bfhi(w.x), bflo(w.y), bfhi(w.y)}; r1 = (f32x4){bflo(w.z), bfhi(w.z), bflo(w.w), bfhi(w.w)}; }
        *(u32x4*)(P + o) = pack8(r0 * ALPHA + a * sc, r1 * ALPHA + b * sc); } };
struct FSwiglu { bf16_t* A; int ld; int rowoff;
    __device__ __forceinline__ void operator()(int row, int col, f32x4 g0, f32x4 g1, f32x4 u0, f32x4 u1) const {
        f32x4 a, b;
#pragma unroll
        for (int e = 0; e < 4; ++e) { a[e] = silu_f(g0[e]) * u0[e]; b[e] = silu_f(g1[e]) * u1[e]; }
        *(u32x4*)(A + (size_t)(rowoff + row) * ld + col) = pack8(a, b); } };
struct FNsaIn { bf16_t *NQ, *KC, *VC; float* GT;
    __device__ __forceinline__ void operator()(int row, int col, f32x4 a, f32x4 b) const {
        const int bb = row >> 13, s = row & (SEQ - 1);
        if (col < 1536) { *(u32x4*)(NQ + (size_t)row * 1536 + col) = pack8(a * C2_NSA, b * C2_NSA); return; }
        if (col >= 3504) return;
        if (col >= 3456) { float* gp = GT + (size_t)row * 48 + (col - 3456);
            f32x4 x, y;
#pragma unroll
            for (int e = 0; e < 4; ++e) { x[e] = sigmoid_f(a[e]); y[e] = sigmoid_f(b[e]); }
            *(f32x4*)gp = x; *(f32x4*)(gp + 4) = y; return; }
        int cc = col - 1536; const int seg = cc / 640; cc -= seg * 640;
        const bool isk = cc < 384; if (!isk) cc -= 384;
        bf16_t* base = (isk ? KC : VC) + (size_t)seg * (40u * 1024u * 1024u / 2u);
        const int dd = isk ? 96 : 64, g = cc / dd, d = cc - g * dd;
        *(u32x4*)(base + ((size_t)(bb * NSA_G + g) * SEQ + s) * dd + d) = pack8(a, b); } };
struct FCmp1 { bf16_t* H; const float* bias;
    __device__ __forceinline__ void operator()(int row, int col, f32x4 a, f32x4 b) const {
        if (col >= 128) return;
        const f32x4 b0 = *(const f32x4*)(bias + col), b1 = *(const f32x4*)(bias + col + 4); f32x4 x, y;
#pragma unroll
        for (int e = 0; e < 4; ++e) { x[e] = gelu_tanh_f(a[e] + b0[e]); y[e] = gelu_tanh_f(b[e] + b1[e]); }
        *(u32x4*)(H + (size_t)row * 128 + col) = pack8(x, y); } };
struct FCmp2 { bf16_t* O; int nd;
    __device__ __forceinline__ void operator()(int row, int col, f32x4 a, f32x4 b) const {
        if (col >= nd) return;
        if ((row & 511) == 511) { a = (f32x4){0.f, 0.f, 0.f, 0.f}; b = a; }
        *(u32x4*)(O + (size_t)row * nd + col) = pack8(a, b); } };

struct MoeInfo { int cnt[NE]; int ts[NE + 1];
    __device__ __forceinline__ int expert_of(int ct) const { int e = 0;
#pragma unroll
        for (int i = 1; i < NE; ++i) e += (ct >= ts[i]) ? 1 : 0; return e; } };
struct SchedMoeGU {
    pg8::StaticOrder so; MoeInfo mi; int ct0; const int* rowtok; int rowbytes;
    __device__ __forceinline__ bool next(int i, pg8::Unit& u) const { return so.next(i, u); }
    __device__ __forceinline__ size_t a_off(const pg8::Unit&, const pg8::Gemm&) const { return 0; }
    __device__ __forceinline__ size_t b_off(const pg8::Unit& u, const pg8::Gemm& g) const { const int e = mi.expert_of(ct0 + u.pm); return ((size_t)e * (2 * FFE) + (size_t)u.pn * 256) * g.ldb; }
    __device__ __forceinline__ unsigned a_row(const pg8::Unit& u, int r) const {
        const int ct = ct0 + u.pm, e = mi.expert_of(ct); int c = 0, t0 = 0;
#pragma unroll
        for (int i = 0; i < NE; ++i) { c = (i == e) ? mi.cnt[i] : c; t0 = (i == e) ? mi.ts[i] : t0; }
        const int pos = (ct - t0) * 256 + r; const int tok = pos < c ? rowtok[e * ECAP + pos] : 0;
        return (unsigned)tok * (unsigned)rowbytes; }
};
struct SchedMoeD {
    pg8::StaticOrder so; MoeInfo mi; int ct0;
    __device__ __forceinline__ bool next(int i, pg8::Unit& u) const { return so.next(i, u); }
    __device__ __forceinline__ size_t a_off(const pg8::Unit& u, const pg8::Gemm& g) const { return (size_t)u.pm * 256 * g.lda; }
    __device__ __forceinline__ size_t b_off(const pg8::Unit& u, const pg8::Gemm& g) const { const int e = mi.expert_of(ct0 + u.pm); return ((size_t)e * D + (size_t)u.pn * 256) * g.ldb; }
    __device__ __forceinline__ unsigned a_row(const pg8::Unit&, int) const { return 0u; }
};
#if defined(SELFTEST)
namespace st {
constexpr int TB = 2;
constexpr int CW_ERR = 32768;
template <class AF, class OF> __device__ __forceinline__ void naive_mm(int M, int N, int K, const float* W, int ldw, int n0, const AF& a, const OF& o, int gt, int ngt) {
    for (long i = gt; i < (long)M * N; i += ngt) { const int m = (int)(i / N), n = (int)(i % N); float s = 0.f; for (int k = 0; k < K; ++k) s += a(m, k) * W[(size_t)k * ldw + n0 + n]; o(m, n, s); }
}
__device__ __forceinline__ float wave_max(float v) {
#pragma unroll
    for (int o = 1; o < 64; o <<= 1) v = fmaxf(v, __shfl_xor(v, o));
    return v;
}
__device__ __forceinline__ int rel_bucket_ref(int dist) {
    const int n = dist > 0 ? dist : 0; if (n < 16) return n;
    const float nf = (float)n; int large = 16 + (int)(logf(nf / 16.f) / 2.0794415416798357f * 16.f); return large < 31 ? large : 31;
}
}
#endif
constexpr int N_PHASES = 28;
struct Args { const float* in[27]; float* out; unsigned char* ws; int ph_lo, ph_hi; };
enum { I_X = 0, I_MLA_WIN, I_MLA_QN, I_MLA_WQ, I_MLA_KVN, I_MLA_WKV, I_MLA_WO, I_NSA_WIN, I_PE_K, I_W1_K, I_W2_K, I_PE_V, I_W1_V, I_W2_V, I_NSA_WO, I_RELB,
       I_FFN_G, I_FFN_U, I_FFN_D, I_ROUTER, I_MOE_G, I_MOE_U, I_MOE_D, I_LNM_G, I_LNM_B, I_LNF_G, I_LNF_B };

__device__ __forceinline__ int rel_bucket_dev(int n) {
    if (n < 16) return n;
    int bkt = 16;
    bkt += n >= 19; bkt += n >= 21; bkt += n >= 24; bkt += n >= 27; bkt += n >= 31; bkt += n >= 35; bkt += n >= 40; bkt += n >= 46;
    bkt += n >= 52; bkt += n >= 59; bkt += n >= 67; bkt += n >= 77; bkt += n >= 87; bkt += n >= 99; bkt += n >= 113;
    return bkt;
}

__global__ void __launch_bounds__(NWAVES * 64, 2) fwd(Args args) {
#if defined(__HIP_DEVICE_COMPILE__)
    extern __shared__ __attribute__((aligned(16))) unsigned char lds_raw[];
    LAS unsigned char* lds = (LAS unsigned char*)lds_raw;
    volatile LAS unsigned* MISC = (volatile LAS unsigned*)(lds + MISC_OFF);
    const int wave = __builtin_amdgcn_readfirstlane(threadIdx.x >> 6);
    const int G = gridDim.x, bx = blockIdx.x;
    const int vcu = (G % 8 == 0) ? (bx % 8) * (G / 8) + bx / 8 : bx;
    const int NGW = G * NWAVES;
    unsigned char* ws = args.ws;
    unsigned* ctl = (unsigned*)(ws + WS_CTL);
    for (int u = threadIdx.x; u < (LDS_BYTES - RING_BYTES) / 4; u += NWAVES * 64) ((LAS unsigned*)(lds + RING_BYTES))[u] = 0u;
    __syncthreads();
    XcdBarrier bar = xcd_barrier_post(ctl + CW_BAR, MISC + 8);
    const int lo = args.ph_lo, hi_ph = args.ph_hi;
#ifndef PHMASK
#define PHMASK 0xFFFFFFFFu
#endif
#define IN(k) (((PHMASK >> (k)) & 1u) && lo <= (k) && (k) < hi_ph)
#define SEAM(k) do { if (IN(k) && IN((k) + 1)) xcd_barrier(bar); } while (0)
#ifndef DUP_MASK
#define DUP_MASK 0u
#endif
#define REP(k) _Pragma("nounroll") for (int rep_ = 0; rep_ < 1 + (int)((DUP_MASK >> (k)) & 1u); ++rep_, (((DUP_MASK >> (k)) & 1u) && rep_ == 1) ? xcd_barrier(bar) : (void)0)
#define W_MLAIN ((bf16_t*)(ws + WS_W_MLAIN))
#define W_QUP ((bf16_t*)(ws + WS_W_QUP))
#define W_KVUP ((bf16_t*)(ws + WS_W_KVUP))
#define W_MLAOUT ((bf16_t*)(ws + WS_W_MLAOUT))
#define W_FFNGU ((bf16_t*)(ws + WS_W_FFNGU))
#define W_FFND ((bf16_t*)(ws + WS_W_FFND))
#define W_NSAIN ((bf16_t*)(ws + WS_W_NSAIN))
#define W_NSAOUT ((bf16_t*)(ws + WS_W_NSAOUT))
#define W_C1K ((bf16_t*)(ws + WS_W_C1K))
#define W_C1V ((bf16_t*)(ws + WS_W_C1V))
#define W_C2K ((bf16_t*)(ws + WS_W_C2K))
#define W_C2V ((bf16_t*)(ws + WS_W_C2V))
#define ROPE_C ((float*)(ws + WS_ROPE))
#define CBIAS ((float*)(ws + WS_CBIAS))
#define RBT ((float*)(ws + WS_RBT))
#define ROWTOK ((int*)(ws + WS_ROWTOK))
#define TOKINFO ((unsigned*)(ws + WS_TOKINFO))
#define TOKW ((float*)(ws + WS_TOKW))
#define XB ((bf16_t*)(ws + WS_XB))
#define LAT ((bf16_t*)(ws + WS_LAT))
#define QN ((bf16_t*)(ws + WS_QN))
#define KVN ((bf16_t*)(ws + WS_KVN))
#define KR ((bf16_t*)(ws + WS_KR))
#define Q ((bf16_t*)(ws + WS_Q))
#define KN ((bf16_t*)(ws + WS_KN))
#define V ((bf16_t*)(ws + WS_V))
#define O ((bf16_t*)(ws + WS_O))
#define X1 ((bf16_t*)(ws + WS_X1))
#define ACT ((bf16_t*)(ws + WS_ACT))
#define X2 ((bf16_t*)(ws + WS_X2))
#define NQ ((bf16_t*)(ws + WS_NQ))
#define KC ((bf16_t*)(ws + WS_KC))
#define VC ((bf16_t*)(ws + WS_VC))
#define KS ((bf16_t*)(ws + WS_KS))
#define VS ((bf16_t*)(ws + WS_VS))
#define KW ((bf16_t*)(ws + WS_KW))
#define VW ((bf16_t*)(ws + WS_VW))
#define GT ((float*)(ws + WS_GT))
#define HK ((bf16_t*)(ws + WS_HK))
#define HV ((bf16_t*)(ws + WS_HV))
#define KCMP ((bf16_t*)(ws + WS_KCMP))
#define VCMP ((bf16_t*)(ws + WS_VCMP))
#define ONSA ((bf16_t*)(ws + WS_ONSA))
#define X3 ((bf16_t*)(ws + WS_X3))
#define W_MOEGU ((bf16_t*)(ws + WS_MOE_GU))
#define W_MOED ((bf16_t*)(ws + WS_MOE_D))
#define DOUT ((bf16_t*)(ws + WS_DOUT))
#define W_MOEGU8 ((unsigned char*)(ws + WS_MOE_GU8))
#define W_MOED8 ((unsigned char*)(ws + WS_MOE_D8))
#define X3F8 ((unsigned char*)(ws + WS_X3F8))
#define ROPE_S (ROPE_C + SEQ * 32)
#define PB ((bf16_t*)args.out)
#define ACTC ((bf16_t*)args.out)
    typedef pg8::SchedPlain SP;
#define PH_LAUNDER() const int lane = fresh_lane(); const int tid = wave * 64 + lane; const int gw = vcu * NWAVES + wave; LAS float* scr = (LAS float*)(lds + wave * 8704); (void)lane; (void)gw; (void)scr;

    REP(0) if (IN(0)) {
        PH_LAUNDER();
        const float* const* in = args.in;
        tr_matrix(in[I_MLA_WIN], D, MLA_IN, W_MLAIN, D, RmId{0}, scr, gw, NGW, lane);
        tr_matrix(in[I_MLA_WQ], MLA_QR, 1536, W_QUP, MLA_QR, RmQup{}, scr, gw, NGW, lane);
        tr_matrix(in[I_MLA_WKV], MLA_KVR, 2048, W_KVUP, MLA_KVR, RmId{0}, scr, gw, NGW, lane);
        tr_matrix(in[I_MLA_WO], D, D, W_MLAOUT, D, RmId{0}, scr, gw, NGW, lane);
#if FFN_FP8
        tr_matrix_f8(in[I_FFN_G], D, FF, (unsigned char*)W_FFNGU, D, MOE_GU_WS, RmGU{0}, scr, gw, NGW, lane);
        tr_matrix_f8(in[I_FFN_U], D, FF, (unsigned char*)W_FFNGU, D, MOE_GU_WS, RmGU{128}, scr, gw, NGW, lane);
        tr_matrix_f8(in[I_FFN_D], FF, D, (unsigned char*)W_FFND, FF, MOE_D_WS, RmId{0}, scr, gw, NGW, lane);
#else
        tr_matrix(in[I_FFN_G], D, FF, W_FFNGU, D, RmGU{0}, scr, gw, NGW, lane);
        tr_matrix(in[I_FFN_U], D, FF, W_FFNGU, D, RmGU{128}, scr, gw, NGW, lane);
        tr_matrix(in[I_FFN_D], FF, D, W_FFND, FF, RmId{0}, scr, gw, NGW, lane);
#endif
        tr_matrix(in[I_NSA_WIN], D, NSA_IN, W_NSAIN, D, RmId{0}, scr, gw, NGW, lane);
        tr_matrix(in[I_NSA_WO], D, D, W_NSAOUT, D, RmId{0}, scr, gw, NGW, lane);
        const int gt = vcu * 512 + tid, NGT = G * 512;
        for (int i = gt; i < (1024 - MLA_IN) * D / 8; i += NGT) ((u32x4*)(W_MLAIN + (size_t)MLA_IN * D))[i] = (u32x4){0u, 0u, 0u, 0u};
        for (int i = gt; i < (NSA_INP - NSA_IN) * D / 8; i += NGT) ((u32x4*)(W_NSAIN + (size_t)NSA_IN * D))[i] = (u32x4){0u, 0u, 0u, 0u};
        for (int i = gt; i < 256 * 3072; i += NGT) { const int n = i / 3072, k = i % 3072; W_C1K[i] = (bf16_t)(n < 96 ? f2bf(in[I_W1_K][(size_t)k * 96 + n]) : 0u); }
        for (int i = gt; i < 256 * 2048; i += NGT) { const int n = i / 2048, k = i % 2048; W_C1V[i] = (bf16_t)(n < 64 ? f2bf(in[I_W1_V][(size_t)k * 64 + n]) : 0u); }
        for (int i = gt; i < 256 * 128; i += NGT) { const int n = i / 128, k = i % 128;
            W_C2K[i] = (bf16_t)((n < 96 && k < 96) ? f2bf(in[I_W2_K][k * 96 + n]) : 0u); W_C2V[i] = (bf16_t)((n < 64 && k < 64) ? f2bf(in[I_W2_V][k * 64 + n]) : 0u); }
        for (int i = gw; i < 256; i += NGW) { const int isv = i >> 7, e = i & 127; const int nd = isv ? 64 : 96; float s = 0.f;
            if (e < nd) { const float* pe = in[isv ? I_PE_V : I_PE_K]; const float* w1 = in[isv ? I_W1_V : I_W1_K]; for (int k = lane; k < 32 * nd; k += 64) s += pe[k] * w1[(size_t)k * nd + e]; }
            s = wave_sum(s); if (lane == 0) CBIAS[i] = s; }
        for (int i = gt; i < SEQ * 32; i += NGT) { const int pos = i >> 5, j = i & 31; const float fr = (float)pow(10000.0, -(double)j / 32.0); const float ang = (float)pos * fr;
            ROPE_C[i] = (float)cos((double)ang); ROPE_S[i] = (float)sin((double)ang); }
        for (int i = gt; i < 16 * nsa::TABW; i += NGT) { const int h = i / nsa::TABW, d = i % nsa::TABW; const float* rb = in[I_RELB];
            RBT[i] = d < 128 ? (rb[rel_bucket_dev(d) * 16 + h] - rb[31 * 16 + h]) * LOG2E : 0.f; }
        for (int m = gw; m < T; m += NGW) { const f32x4* xr = (const f32x4*)(in[I_X] + (size_t)m * D) + lane; f32x4 v[4];
#pragma unroll
            for (int j = 0; j < 4; ++j) v[j] = xr[64 * j];
            store_row_bf16(XB + (size_t)m * D, v, lane); }
    }
    SEAM(0);
    REP(1) if (IN(1)) { pg8::Gemm g{XB, W_MLAIN, (D) * 2, (D) * 2, (D) * 2}; SP S; S.init(T / 256, 4, G, bx);
        pg8::EpiRow8<FBf16> E{FBf16{LAT, 1024, 0}}; pg8::gemm_phase<pg8::EpiRow8<FBf16>, SP, true, false>(lds, wave, g, S, E); }
    SEAM(1);
    REP(2) if (IN(2)) {
        PH_LAUNDER();
        const float* qg = args.in[I_MLA_QN]; const float* kg = args.in[I_MLA_KVN];
        for (int m = gw; m < T; m += NGW) {
            const bf16_t* row = LAT + (size_t)m * 1024;
            const u32x4 wq = *((const u32x4*)row + lane);
            const u32x2 wk = *((const u32x2*)(row + 512) + lane);
            float q[8] = {bflo(wq.x), bfhi(wq.x), bflo(wq.y), bfhi(wq.y), bflo(wq.z), bfhi(wq.z), bflo(wq.w), bfhi(wq.w)};
            float k[4] = {bflo(wk.x), bfhi(wk.x), bflo(wk.y), bfhi(wk.y)};
            float sq = 0.f, sk = 0.f;
#pragma unroll
            for (int e = 0; e < 8; ++e) sq += q[e] * q[e];
#pragma unroll
            for (int e = 0; e < 4; ++e) sk += k[e] * k[e];
            const float rq = 1.f / sqrtf(wave_sum(sq) * (1.f / 512.f) + 1e-6f), rk = 1.f / sqrtf(wave_sum(sk) * (1.f / 256.f) + 1e-6f);
            const f32x4 g0 = *((const f32x4*)qg + 2 * lane), g1 = *((const f32x4*)qg + 2 * lane + 1), g2 = *((const f32x4*)kg + lane);
            u32x4 oq; oq.x = cvt_pk_bf16(q[0] * rq * g0[0], q[1] * rq * g0[1]); oq.y = cvt_pk_bf16(q[2] * rq * g0[2], q[3] * rq * g0[3]);
            oq.z = cvt_pk_bf16(q[4] * rq * g1[0], q[5] * rq * g1[1]); oq.w = cvt_pk_bf16(q[6] * rq * g1[2], q[7] * rq * g1[3]);
            *((u32x4*)(QN + (size_t)m * 512) + lane) = oq;
            u32x2 ok; ok.x = cvt_pk_bf16(k[0] * rk * g2[0], k[1] * rk * g2[1]); ok.y = cvt_pk_bf16(k[2] * rk * g2[2], k[3] * rk * g2[3]);
            *((u32x2*)(KVN + (size_t)m * 256) + lane) = ok;
            if (lane < 32) { const float x1 = bf2f(row[768 + lane]), x2 = bf2f(row[800 + lane]); const int s = m & (SEQ - 1);
                const float c = ROPE_C[s * 32 + lane], sn = ROPE_S[s * 32 + lane]; const int p = 8 * (lane >> 2) + (lane & 3);
                bf16_t* kr = KR + (size_t)m * 64; kr[p] = (bf16_t)f2bf(x1 * c - x2 * sn); kr[p + 4] = (bf16_t)f2bf(x1 * sn + x2 * c); }
        }
    }
    SEAM(2);
    REP(3) if (IN(3)) { pg8::Gemm g{QN, W_QUP, (MLA_QR) * 2, (MLA_QR) * 2, (MLA_QR) * 2}; SP S; S.init(T / 256, 6, G, bx);
        pg8::EpiRow8<FQup> E{FQup{Q, ROPE_C, ROPE_S}}; pg8::gemm_phase<pg8::EpiRow8<FQup>, SP, true, false>(lds, wave, g, S, E);
        { pg8::Gemm g{KVN, W_KVUP, (MLA_KVR) * 2, (MLA_KVR) * 2, (MLA_KVR) * 2}; SP S; S.init(T / 256, 8, G, bx);
        pg8::EpiRow8<FKvup> E{FKvup{KN, (size_t)(WS_V - WS_KN) / 2}}; pg8::gemm_phase<pg8::EpiRow8<FKvup>, SP, true, false>(lds, wave, g, S, E); }
    }
    SEAM(4);
    REP(5) if (IN(5)) {
        PH_LAUNDER();
        att::Plan<mla::R> plan; plan.init(wave, lane);
        for (int it2 = 2 * bx; it2 < 2 * NB * MLA_H * 16; it2 += (it2 & 1) ? 2 * G - 1 : 1) { const int it = it2 >> 1, bh = it & 31, x = it >> 5;
            mla::unit((LAS char*)lds, plan, bh >> 3, bh & 7, (it2 & 1) ? x : 31 - x, Q, KN, KR, V, O, tid, wave); }
    }
    SEAM(5);

#if defined(SELFTEST) && SELFTEST == 1
    {
        PH_LAUNDER();
        const float* const* in = args.in; const int gt = vcu * 512 + tid, NGT = G * 512;
        float* TKV = (float*)(ws + 104 * MiB); float* TLAT = (float*)(ws + 168 * MiB); float* TQ = (float*)(ws + 200 * MiB);
        float* TKR = (float*)(ws + 250 * MiB); float* TKVN = (float*)(ws + 256 * MiB); float* TQN = (float*)(ws + 264 * MiB);
        const float* xb = in[I_X] + (size_t)st::TB * SEQ * D;
        st::naive_mm(SEQ, 832, 1024, in[I_MLA_WIN], 832, 0, [&](int m, int k) { return xb[(size_t)m * D + k]; }, [&](int m, int n, float v) { TLAT[(size_t)m * 832 + n] = v; }, gt, NGT);
        xcd_barrier(bar);
        for (int m = gw; m < SEQ; m += NGW) { const float* r = TLAT + (size_t)m * 832; float sq = 0.f, sk = 0.f;
            for (int k = lane; k < 512; k += 64) sq += r[k] * r[k];
            for (int k = lane; k < 256; k += 64) sk += r[512 + k] * r[512 + k];
            sq = wave_sum(sq); sk = wave_sum(sk);
            const float rq = 1.f / sqrtf(sq / 512.f + 1e-6f), rk = 1.f / sqrtf(sk / 256.f + 1e-6f);
            for (int k = lane; k < 512; k += 64) TQN[(size_t)m * 512 + k] = r[k] * rq * in[I_MLA_QN][k];
            for (int k = lane; k < 256; k += 64) TKVN[(size_t)m * 256 + k] = r[512 + k] * rk * in[I_MLA_KVN][k];
            if (lane < 32) { const float fr = powf(10000.f, -(float)lane / 32.f), ang = (float)m * fr, c = cosf(ang), sn = sinf(ang), x1 = r[768 + lane], x2 = r[800 + lane];
                TKR[(size_t)m * 64 + lane] = x1 * c - x2 * sn; TKR[(size_t)m * 64 + 32 + lane] = x1 * sn + x2 * c; } }
        xcd_barrier(bar);
        st::naive_mm(SEQ, 1536, 512, in[I_MLA_WQ], 1536, 0, [&](int m, int k) { return TQN[(size_t)m * 512 + k]; }, [&](int m, int n, float v) { TQ[(size_t)m * 1536 + n] = v; }, gt, NGT);
        st::naive_mm(SEQ, 2048, 256, in[I_MLA_WKV], 2048, 0, [&](int m, int k) { return TKVN[(size_t)m * 256 + k]; }, [&](int m, int n, float v) { TKV[(size_t)m * 2048 + n] = v; }, gt, NGT);
        xcd_barrier(bar);
        for (int m = gw; m < SEQ; m += NGW) for (int e = lane; e < 256; e += 64) { const int h = e >> 5, i = e & 31; float* q = TQ + (size_t)m * 1536 + h * 192 + 128;
            const float fr = powf(10000.f, -(float)i / 32.f), ang = (float)m * fr, c = cosf(ang), sn = sinf(ang), x1 = q[i], x2 = q[32 + i]; q[i] = x1 * c - x2 * sn; q[32 + i] = x1 * sn + x2 * c; }
        xcd_barrier(bar);
        float err = 0.f, ref2 = 0.f;
        for (int row = gw; row < MLA_H * SEQ; row += NGW) { const int h = row & 7, q = row >> 3;
            const float* qv = TQ + (size_t)q * 1536 + h * 192; const float q0 = qv[lane], q1 = qv[64 + lane], q2 = qv[128 + lane];
            float mm = -__builtin_inff(), l = 0.f, a0 = 0.f, a1 = 0.f;
            for (int k = 0; k <= q; ++k) { const float* kn = TKV + (size_t)k * 2048 + h * 256; const float* kr = TKR + (size_t)k * 64;
                const float sc = wave_sum(q0 * kn[lane] + q1 * kn[64 + lane] + q2 * kr[lane]) * 0.07216878364870323f;
                const float mn = fmaxf(mm, sc), al = __expf(mm - mn), p = __expf(sc - mn);
                l = l * al + p; a0 = a0 * al + p * kn[128 + lane]; a1 = a1 * al + p * kn[192 + lane]; mm = mn; }
            const float o0 = a0 / l, o1 = a1 / l; const bf16_t* fo = O + ((size_t)st::TB * SEQ + q) * 1024 + h * 128;
            const float f0 = bf2f(fo[lane]), f1 = bf2f(fo[64 + lane]);
            err += (f0 - o0) * (f0 - o0) + (f1 - o1) * (f1 - o1); ref2 += o0 * o0 + o1 * o1; }
        err = wave_sum(err); ref2 = wave_sum(ref2);
        if (lane == 0) { atomicAdd((float*)(ctl + st::CW_ERR), err); atomicAdd((float*)(ctl + st::CW_ERR + 1), ref2); }
        xcd_barrier(bar);
    }
#endif
    REP(6) if (IN(6)) { pg8::Gemm g{O, W_MLAOUT, (D) * 2, (D) * 2, (D) * 2}; SP S; S.init(T / 256, 4, G, bx);
        pg8::EpiRow8<FResBf16> E{FResBf16{PB, args.in[I_X], nullptr, 1.f}}; pg8::gemm_phase<pg8::EpiRow8<FResBf16>, SP, true, false>(lds, wave, g, S, E); }
    SEAM(6);
    REP(7) if (IN(7)) {
        PH_LAUNDER();
        for (int m = gw; m < T; m += NGW) { const u32x2* pr = (const u32x2*)(PB + (size_t)m * D) + lane; f32x4 v[4];
#pragma unroll
            for (int j = 0; j < 4; ++j) v[j] = bf4_to_f32(pr[64 * j]);
            ln_inplace(v, args.in[I_LNM_G], args.in[I_LNM_B], lane); store_row_bf16(X1 + (size_t)m * D, v, lane);
#if FFN_FP8
#pragma unroll
            for (int j = 0; j < 4; ++j) *((unsigned*)(ws + WS_X1F8 + (size_t)m * D) + lane + 64 * j) = pk4_fp8(v[j].x, v[j].y, v[j].z, v[j].w);
#endif
        }
    }
    SEAM(7);
#if FFN_FP8
    REP(8) if (IN(8)) { pg8::Gemm g{ws + WS_X1F8, W_FFNGU, D, D, D}; SP S; S.init(T / 256, 22, G, bx);
        pg8::EpiGateUp<FSwigluF8> E{FSwigluF8{(unsigned char*)ACT, FF, 1.f / MOE_GU_WS, MOE_H_S}}; pg8::gemm_phase<pg8::EpiGateUp<FSwigluF8>, SP, true, false, true>(lds, wave, g, S, E); }
#else
    REP(8) if (IN(8)) { pg8::Gemm g{X1, W_FFNGU, (D) * 2, (D) * 2, (D) * 2}; SP S; S.init(T / 256, 22, G, bx);
        pg8::EpiGateUp<FSwiglu> E{FSwiglu{ACT, FF, 0}}; pg8::gemm_phase<pg8::EpiGateUp<FSwiglu>, SP, true, false>(lds, wave, g, S, E); }
#endif
    SEAM(8);
#if FFN_FP8
    REP(9) if (IN(9)) { pg8::Gemm g{ACT, W_FFND, FF, FF, FF}; SP S; S.init(T / 256, 4, G, bx);
        pg8::EpiRow8<FResBf16> E{FResBf16{PB, nullptr, X1, 1.f / (MOE_D_WS * MOE_H_S)}}; pg8::gemm_phase<pg8::EpiRow8<FResBf16>, SP, true, false, true>(lds, wave, g, S, E); }
#else
    REP(9) if (IN(9)) { pg8::Gemm g{ACT, W_FFND, (FF) * 2, (FF) * 2, (FF) * 2}; SP S; S.init(T / 256, 4, G, bx);
        pg8::EpiRow8<FResBf16> E{FResBf16{PB, nullptr, X1, 1.f}}; pg8::gemm_phase<pg8::EpiRow8<FResBf16>, SP, true, false>(lds, wave, g, S, E); }
#endif
    SEAM(9);
    REP(10) if (IN(10)) {
        PH_LAUNDER();
        for (int m = gw; m < T; m += NGW) { const u32x2* pr = (const u32x2*)(PB + (size_t)m * D) + lane; f32x4 v[4];
#pragma unroll
            for (int j = 0; j < 4; ++j) v[j] = bf4_to_f32(pr[64 * j]);
            ln_inplace(v, args.in[I_LNF_G], args.in[I_LNF_B], lane); store_row_bf16(X2 + (size_t)m * D, v, lane); }
    }
    SEAM(10);
    REP(11) if (IN(11)) { pg8::Gemm g{X2, W_NSAIN, (D) * 2, (D) * 2, (D) * 2}; SP S; S.init(T / 256, NSA_INP / 256, G, bx);
        pg8::EpiRow8<FNsaIn> E{FNsaIn{NQ, KC, VC, GT}}; pg8::gemm_phase<pg8::EpiRow8<FNsaIn>, SP, true, false>(lds, wave, g, S, E); }
    SEAM(11);
    REP(12) if (IN(12)) {
        { pg8::Gemm g{KC, W_C1K, (16 * 96) * 2, (3072) * 2, (3072) * 2}; SP S; S.init(32, 1, G, bx);
          pg8::EpiRow8<FCmp1> E{FCmp1{HK, CBIAS}}; pg8::gemm_phase<pg8::EpiRow8<FCmp1>, SP, false, false>(lds, wave, g, S, E); }
        { pg8::Gemm g{VC, W_C1V, (16 * 64) * 2, (2048) * 2, (2048) * 2}; SP S; S.init(32, 1, G, (bx + G / 2) % G);
          pg8::EpiRow8<FCmp1> E{FCmp1{HV, CBIAS + 128}}; pg8::gemm_phase<pg8::EpiRow8<FCmp1>, SP, false, false>(lds, wave, g, S, E); }
    }
    SEAM(12);
    REP(13) if (IN(13)) {
        { pg8::Gemm g{HK, W_C2K, (128) * 2, (128) * 2, (128) * 2}; SP S; S.init(32, 1, G, bx);
          pg8::EpiRow8<FCmp2> E{FCmp2{KCMP, 96}}; pg8::gemm_phase<pg8::EpiRow8<FCmp2>, SP, false, false>(lds, wave, g, S, E); }
        { pg8::Gemm g{HV, W_C2V, (128) * 2, (128) * 2, (128) * 2}; SP S; S.init(32, 1, G, (bx + G / 2) % G);
          pg8::EpiRow8<FCmp2> E{FCmp2{VCMP, 64}}; pg8::gemm_phase<pg8::EpiRow8<FCmp2>, SP, false, false>(lds, wave, g, S, E); }
    }
    SEAM(13);

#if defined(SELFTEST) && SELFTEST == 3
    {
        PH_LAUNDER();
        const float* const* in = args.in; const int gt = vcu * 512 + tid, NGT = G * 512;
        float* TPROJ = (float*)(ws + 348 * MiB);
        float* THK = (float*)(ws + 460 * MiB); float* THV = (float*)(ws + 461 * MiB); float* TKC = (float*)(ws + 462 * MiB); float* TVC = (float*)(ws + 463 * MiB);
        const bf16_t* xb = X2 + (size_t)st::TB * SEQ * D;
        st::naive_mm(SEQ, 3504, 1024, in[I_NSA_WIN], 3504, 0, [&](int m, int k) { return bf2f(xb[(size_t)m * D + k]); }, [&](int m, int n, float v) { TPROJ[(size_t)m * 3504 + n] = v; }, gt, NGT);
        xcd_barrier(bar);
        for (int i = gt; i < 4 * 511 * 96; i += NGT) { const int e = i % 96, n = (i / 96) % 511, g = i / (96 * 511); float s = 0.f;
            for (int l = 0; l < 32; ++l) for (int d = 0; d < 96; ++d) s += (TPROJ[(size_t)(16 * n + l) * 3504 + 1536 + g * 96 + d] + in[I_PE_K][l * 96 + d]) * in[I_W1_K][(size_t)(l * 96 + d) * 96 + e];
            THK[(g * 512 + n) * 96 + e] = 0.5f * s * (1.f + tanhf(0.7978845608028654f * (s + 0.044715f * s * s * s))); }
        for (int i = gt; i < 4 * 511 * 64; i += NGT) { const int e = i % 64, n = (i / 64) % 511, g = i / (64 * 511); float s = 0.f;
            for (int l = 0; l < 32; ++l) for (int d = 0; d < 64; ++d) s += (TPROJ[(size_t)(16 * n + l) * 3504 + 1920 + g * 64 + d] + in[I_PE_V][l * 64 + d]) * in[I_W1_V][(size_t)(l * 64 + d) * 64 + e];
            THV[(g * 512 + n) * 64 + e] = 0.5f * s * (1.f + tanhf(0.7978845608028654f * (s + 0.044715f * s * s * s))); }
        xcd_barrier(bar);
        float err = 0.f, ref2 = 0.f;
        for (int i = gt; i < 4 * 511 * 96; i += NGT) { const int e = i % 96, n = (i / 96) % 511, g = i / (96 * 511); float s = 0.f; for (int d = 0; d < 96; ++d) s += THK[(g * 512 + n) * 96 + d] * in[I_W2_K][d * 96 + e];
            const float f = bf2f(KCMP[((size_t)(st::TB * 4 + g) * 512 + n) * 96 + e]); err += (f - s) * (f - s); ref2 += s * s; }
        for (int i = gt; i < 4 * 511 * 64; i += NGT) { const int e = i % 64, n = (i / 64) % 511, g = i / (64 * 511); float s = 0.f; for (int d = 0; d < 64; ++d) s += THV[(g * 512 + n) * 64 + d] * in[I_W2_V][d * 64 + e];
            const float f = bf2f(VCMP[((size_t)(st::TB * 4 + g) * 512 + n) * 64 + e]); err += (f - s) * (f - s); ref2 += s * s; }
        for (long i = gt; i < (long)SEQ * 3504; i += NGT) { const int m = (int)(i / 3504), c = (int)(i % 3504); const float r = TPROJ[i]; const size_t trow = (size_t)st::TB * SEQ + m; float f, rr = r;
            if (c < 1536) { f = bf2f(NQ[trow * 1536 + c]); rr = r * C2_NSA; }
            else if (c >= 3456) { f = GT[trow * 48 + (c - 3456)]; rr = 1.f / (1.f + __expf(-r)); }
            else { int cc = c - 1536; const bf16_t* base; int dd;
                if (cc < 384) { base = KC; dd = 96; } else if (cc < 640) { base = VC; dd = 64; cc -= 384; } else if (cc < 1024) { base = KS; dd = 96; cc -= 640; } else if (cc < 1280) { base = VS; dd = 64; cc -= 1024; }
                else if (cc < 1664) { base = KW; dd = 96; cc -= 1280; } else { base = VW; dd = 64; cc -= 1664; }
                const int g = cc / dd, d = cc % dd; f = bf2f(base[((size_t)(st::TB * 4 + g) * SEQ + m) * dd + d]); }
            err += (f - rr) * (f - rr); ref2 += rr * rr; }
        err = wave_sum(err); ref2 = wave_sum(ref2);
        if (lane == 0) { atomicAdd((float*)(ctl + st::CW_ERR), err); atomicAdd((float*)(ctl + st::CW_ERR + 1), ref2); }
        xcd_barrier(bar);
    }
#endif
#if defined(XNSA)
    {
        PH_LAUNDER();
        const nsa::Tensors X{NQ, KCMP, VCMP, KS, VS, KW, VW, GT, RBT, (bf16_t*)args.out};
        att::Plan<nsa::R> plan; plan.init(wave, lane);
        for (int it2 = 2 * bx; it2 < 2 * NB * NSA_G * 64; it2 += (it2 & 1) ? 2 * G - 1 : 1) { const int it = it2 >> 1, bg = it & 15, x = it >> 4;
            nsa::unit<XNSA>((LAS char*)lds, plan, X, bg >> 2, bg & 3, (it2 & 1) ? x : 127 - x, tid, wave); }
        xcd_barrier(bar);
    }
#endif
    REP(14) if (IN(14)) {
        PH_LAUNDER();
        const nsa::Tensors X{NQ, KCMP, VCMP, KS, VS, KW, VW, GT, RBT, ONSA};
        att::Plan<nsa::R> plan; plan.init(wave, lane);
        for (int it2 = 2 * bx; it2 < 2 * NB * NSA_G * 64; it2 += (it2 & 1) ? 2 * G - 1 : 1) { const int it = it2 >> 1, bg = it & 15, x = it >> 4;
            nsa::unit((LAS char*)lds, plan, X, bg >> 2, bg & 3, (it2 & 1) ? x : 127 - x, tid, wave); }
    }
    SEAM(14);

#if defined(SELFTEST) && SELFTEST == 2
    {
        PH_LAUNDER();
        const float* rb = args.in[I_RELB];
        LAS float* buf = (LAS float*)(lds + wave * 6144); LAS float* imp = buf + 1024; LAS int* sel = (LAS int*)(imp + 128);
        const float scale_q = 1.f / LOG2E;
        float err = 0.f, ref2 = 0.f;
        for (int item = gw; item < NSA_G * SEQ; item += NGW) { const int g = item & 3, q = item >> 2, qpos = q, cur = q >> 6; const size_t trow = (size_t)st::TB * SEQ + q; const int bg = st::TB * NSA_G + g;
            float oacc[4] = {0.f, 0.f, 0.f, 0.f};
            imp[lane] = 0.f; imp[64 + lane] = 0.f;
            int nvalid = qpos >= 31 ? ((qpos - 31) >> 4) + 1 : 0; if (nvalid > 511) nvalid = 511;
            const bf16_t* kc = KCMP + (size_t)bg * 512 * 96; const bf16_t* vc = VCMP + (size_t)bg * 512 * 64;
            const bf16_t* ks = KS + (size_t)bg * SEQ * 96; const bf16_t* vs = VS + (size_t)bg * SEQ * 64; const bf16_t* kw = KW + (size_t)bg * SEQ * 96; const bf16_t* vw = VW + (size_t)bg * SEQ * 64;
            for (int h = 0; h < 4; ++h) { const int head = g * 4 + h; const bf16_t* qv = NQ + trow * 1536 + head * 96;
                float mx = -__builtin_inff();
                for (int n = lane; n < nvalid; n += 64) { float s = 0.f; for (int d = 0; d < 96; ++d) s += bf2f(qv[d]) * bf2f(kc[(size_t)n * 96 + d]);
                    s = s * scale_q + rb[st::rel_bucket_ref(qpos - 16 * n - 31) * 16 + head]; buf[n] = s; mx = fmaxf(mx, s); }
                mx = st::wave_max(mx); if (!(mx > -1e38f)) mx = 0.f;
                float sum = 0.f; LDS_WAIT();
                for (int n = lane; n < nvalid; n += 64) { const float p = __expf(buf[n] - mx); buf[n] = p; sum += p; }
                sum = wave_sum(sum); const float inv = 1.f / fmaxf(sum, 1e-30f);
                for (int n = lane; n < nvalid; n += 64) buf[n] *= inv;
                LDS_WAIT();
                float oc = 0.f; for (int n = 0; n < nvalid; ++n) oc += buf[n] * bf2f(vc[(size_t)n * 64 + lane]);
                oacc[h] += GT[trow * 48 + head * 3 + 0] * oc;
                for (int j = lane; j < 128; j += 64) { float a = 0.f; for (int n = 4 * j - 1; n <= 4 * j + 3; ++n) if (n >= 0 && n < nvalid) a += buf[n]; imp[j] += a; }
                LDS_WAIT();
            }
            float v0, v1; { const int j0 = lane, j1 = lane + 64;
                v0 = j0 > cur ? -1e6f : ((j0 == 0 || j0 == cur || j0 == cur - 1) ? 1e6f : imp[j0]); v1 = j1 > cur ? -1e6f : ((j1 == 0 || j1 == cur || j1 == cur - 1) ? 1e6f : imp[j1]); }
            for (int it = 0; it < 16; ++it) { float bv = v0; int bi = lane; if (v1 > v0) { bv = v1; bi = lane + 64; }
#pragma unroll
                for (int o = 1; o < 64; o <<= 1) { const float ov = __shfl_xor(bv, o); const int oi = __shfl_xor(bi, o); if (ov > bv || (ov == bv && oi < bi)) { bv = ov; bi = oi; } }
                if (lane == 0) sel[it] = bi;
                if (bi == lane) v0 = -__builtin_inff(); if (bi == lane + 64) v1 = -__builtin_inff(); }
            LDS_WAIT();
            for (int h = 0; h < 4; ++h) { const int head = g * 4 + h; const bf16_t* qv = NQ + trow * 1536 + head * 96;
                float mx = -__builtin_inff();
                for (int it = 0; it < 16; ++it) { const int kpos = sel[it] * 64 + lane, dist = qpos - kpos; float s = -__builtin_inff();
                    if (dist >= 0) { s = 0.f; for (int d = 0; d < 96; ++d) s += bf2f(qv[d]) * bf2f(ks[(size_t)kpos * 96 + d]); s = s * scale_q + rb[st::rel_bucket_ref(dist) * 16 + head]; }
                    buf[it * 64 + lane] = s; mx = fmaxf(mx, s); }
                mx = st::wave_max(mx); if (!(mx > -1e38f)) mx = 0.f;
                float sum = 0.f;
                for (int it = 0; it < 16; ++it) { const float p = __expf(buf[it * 64 + lane] - mx); buf[it * 64 + lane] = p; sum += p; }
                sum = wave_sum(sum); float inv = 1.f / fmaxf(sum, 1e-30f);
                LDS_WAIT();
                float os = 0.f; for (int i = 0; i < 1024; ++i) { const int kpos = sel[i >> 6] * 64 + (i & 63); os += buf[i] * bf2f(vs[(size_t)kpos * 64 + lane]); }
                oacc[h] += GT[trow * 48 + head * 3 + 1] * os * inv;
                LDS_WAIT();
                mx = -__builtin_inff();
                for (int i = lane; i < 512; i += 64) { const int kpos = qpos - i; float s = -__builtin_inff();
                    if (kpos >= 0) { s = 0.f; for (int d = 0; d < 96; ++d) s += bf2f(qv[d]) * bf2f(kw[(size_t)kpos * 96 + d]); s = s * scale_q + rb[st::rel_bucket_ref(i) * 16 + head]; }
                    buf[i] = s; mx = fmaxf(mx, s); }
                mx = st::wave_max(mx); if (!(mx > -1e38f)) mx = 0.f;
                sum = 0.f;
                for (int i = lane; i < 512; i += 64) { const float p = __expf(buf[i] - mx); buf[i] = p; sum += p; }
                sum = wave_sum(sum); inv = 1.f / fmaxf(sum, 1e-30f);
                LDS_WAIT();
                float ow = 0.f; for (int i = 0; i < 512; ++i) { const int kpos = qpos - i; if (kpos >= 0) ow += buf[i] * bf2f(vw[(size_t)kpos * 64 + lane]); }
                oacc[h] += GT[trow * 48 + head * 3 + 2] * ow * inv;
                LDS_WAIT();
                const float f = bf2f(ONSA[trow * 1024 + head * 64 + lane]);
                err += (f - oacc[h]) * (f - oacc[h]); ref2 += oacc[h] * oacc[h];
            }
        }
        err = wave_sum(err); ref2 = wave_sum(ref2);
        if (lane == 0) { atomicAdd((float*)(ctl + st::CW_ERR), err); atomicAdd((float*)(ctl + st::CW_ERR + 1), ref2); }
        xcd_barrier(bar);
    }
#endif
    REP(15) if (IN(15)) { pg8::Gemm g{ONSA, W_NSAOUT, (D) * 2, (D) * 2, (D) * 2}; SP S; S.init(T / 256, 4, G, bx);
        pg8::EpiRow8<FResBf16> E{FResBf16{PB, nullptr, X2, 1.f}}; pg8::gemm_phase<pg8::EpiRow8<FResBf16>, SP, true, false>(lds, wave, g, S, E); }
    SEAM(15);
    if (IN(16)) {
        PH_LAUNDER();
        LAS float* wr = (LAS float*)(lds + 69632);
        LAS unsigned* lcnt = (LAS unsigned*)(lds + 69632 + 32768);
        LAS unsigned* lrec = lcnt + 16;
        for (int i = tid; i < D * NE; i += 512) wr[i] = args.in[I_ROUTER][i];
        if (tid < 16) lcnt[tid] = 0u;
        __syncthreads();
        int nrec = 0;
        for (int m = gw; m < T; m += NGW, ++nrec) { const u32x2* pr = (const u32x2*)(PB + (size_t)m * D) + lane; f32x4 v[4];
#pragma unroll
            for (int j = 0; j < 4; ++j) v[j] = bf4_to_f32(pr[64 * j]);
            ln_inplace(v, args.in[I_LNM_G] + D, args.in[I_LNM_B] + D, lane); store_row_bf16(X3 + (size_t)m * D, v, lane);
#if MOE_FP8
#pragma unroll
            for (int j = 0; j < 4; ++j) *((unsigned*)(X3F8 + (size_t)m * D) + lane + 64 * j) = pk4_fp8(v[j].x, v[j].y, v[j].z, v[j].w);
#endif
            float lg[NE];
#pragma unroll
            for (int e = 0; e < NE; ++e) lg[e] = 0.f;
#pragma unroll
            for (int j = 0; j < 4; ++j)
#pragma unroll
                for (int c = 0; c < 4; ++c) { const int k = 4 * lane + 256 * j + c; const f32x4 w0 = *(const LAS f32x4*)(wr + k * 8), w1 = *(const LAS f32x4*)(wr + k * 8 + 4); const float xv = v[j][c];
                    lg[0] += xv * w0[0]; lg[1] += xv * w0[1]; lg[2] += xv * w0[2]; lg[3] += xv * w0[3]; lg[4] += xv * w1[0]; lg[5] += xv * w1[1]; lg[6] += xv * w1[2]; lg[7] += xv * w1[3]; }
#pragma unroll
            for (int e = 0; e < NE; ++e) lg[e] = wave_sum(lg[e]);
            int e0 = 0; float v0 = lg[0];
#pragma unroll
            for (int e = 1; e < NE; ++e) if (lg[e] > v0) { v0 = lg[e]; e0 = e; }
            int e1 = -1; float v1 = -__builtin_inff();
#pragma unroll
            for (int e = 0; e < NE; ++e) if (e != e0 && lg[e] > v1) { v1 = lg[e]; e1 = e; }
            const float w1s = fast_rcp(1.f + __expf(v0 - v1)), w0s = 1.f - w1s;
            if (lane == 0) { const unsigned p0 = atomicAdd((unsigned*)(lcnt + e0), 1u), p1 = atomicAdd((unsigned*)(lcnt + e1), 1u);
                LAS unsigned* r = lrec + (wave * 32 + nrec) * 4; r[0] = (unsigned)m; r[1] = (unsigned)e0 | (p0 << 8); r[2] = (unsigned)e1 | (p1 << 8);
                TOKW[2 * m] = w0s; TOKW[2 * m + 1] = w1s; }
        }
        __syncthreads();
        if (tid < NE) lcnt[8 + tid] = __hip_atomic_fetch_add(ctl + CW_ECNT + 64 * tid, lcnt[tid], RLX_AGENT);
        __syncthreads();
        if (lane == 0) for (int i = 0; i < nrec; ++i) { const LAS unsigned* r = lrec + (wave * 32 + i) * 4; const unsigned m = r[0];
#pragma unroll
            for (int k = 0; k < 2; ++k) { const unsigned e = r[1 + k] & 255u, pos = lcnt[8 + e] + (r[1 + k] >> 8); ROWTOK[e * ECAP + pos] = (int)m; TOKINFO[2 * m + k] = (e << 16) | pos; } }
        for (int e = 0; e < NE; ++e) {
#if MOE_FP8
            tr_matrix_f8(args.in[I_MOE_G] + (size_t)e * D * FFE, D, FFE, W_MOEGU8 + (size_t)e * 2 * FFE * D, D, MOE_GU_WS, RmGU{0}, scr, gw, NGW, lane);
            tr_matrix_f8(args.in[I_MOE_U] + (size_t)e * D * FFE, D, FFE, W_MOEGU8 + (size_t)e * 2 * FFE * D, D, MOE_GU_WS, RmGU{128}, scr, gw, NGW, lane);
            tr_matrix_f8(args.in[I_MOE_D] + (size_t)e * FFE * D, FFE, D, W_MOED8 + (size_t)e * D * FFE, FFE, MOE_D_WS, RmId{0}, scr, gw, NGW, lane);
#else
            tr_matrix(args.in[I_MOE_G] + (size_t)e * D * FFE, D, FFE, W_MOEGU + (size_t)e * 2 * FFE * D, D, RmGU{0}, scr, gw, NGW, lane);
            tr_matrix(args.in[I_MOE_U] + (size_t)e * D * FFE, D, FFE, W_MOEGU + (size_t)e * 2 * FFE * D, D, RmGU{128}, scr, gw, NGW, lane);
            tr_matrix(args.in[I_MOE_D] + (size_t)e * FFE * D, FFE, D, W_MOED + (size_t)e * D * FFE, FFE, RmId{0}, scr, gw, NGW, lane);
#endif
        }
    }
    SEAM(16);
    REP(17) if (hi_ph > 17 && lo < 27) {
        MoeInfo mi; int acc_t = 0;
#pragma unroll
        for (int e = 0; e < NE; ++e) { const int c = (int)__builtin_amdgcn_readfirstlane(__hip_atomic_load(ctl + CW_ECNT + 64 * e, RLX_AGENT)); mi.cnt[e] = c; mi.ts[e] = acc_t; acc_t += (c + 255) >> 8; }
        mi.ts[NE] = acc_t;
        constexpr int MCH = MOE_FP8 ? 128 : 64, NCH = MOE_FP8 ? 2 : 5;
        for (int c = 0; c < NCH; ++c) {
            const int ct0 = MCH * c; int nM = acc_t - ct0; nM = nM < 0 ? 0 : ((c + 1 < NCH && nM > MCH) ? MCH : nM);
#if MOE_FP8
            if (IN(17 + 2 * c) && nM > 0) { pg8::Gemm g{X3F8, W_MOEGU8, D, D, D}; SchedMoeGU S; S.so.init(nM, 2 * FFE / 256, G, bx); S.mi = mi; S.ct0 = ct0; S.rowtok = ROWTOK; S.rowbytes = D;
                pg8::EpiGateUp<FSwigluF8> E{FSwigluF8{(unsigned char*)args.out, FFE, 1.f / MOE_GU_WS, MOE_H_S}}; pg8::gemm_phase<pg8::EpiGateUp<FSwigluF8>, SchedMoeGU, true, true, true>(lds, wave, g, S, E); }
            SEAM(17 + 2 * c);
            if (IN(18 + 2 * c) && nM > 0) { pg8::Gemm g{(unsigned char*)args.out, W_MOED8, FFE, FFE, FFE}; SchedMoeD S; S.so.init(nM, 4, G, bx); S.mi = mi; S.ct0 = ct0;
                pg8::EpiRow8<FBf16S> E{FBf16S{DOUT, D, ct0 * 256, 1.f / (MOE_D_WS * MOE_H_S)}}; pg8::gemm_phase<pg8::EpiRow8<FBf16S>, SchedMoeD, true, false, true>(lds, wave, g, S, E); }
#else
            if (IN(17 + 2 * c) && nM > 0) { pg8::Gemm g{X3, W_MOEGU, (D) * 2, (D) * 2, (D) * 2}; SchedMoeGU S; S.so.init(nM, 2 * FFE / 256, G, bx); S.mi = mi; S.ct0 = ct0; S.rowtok = ROWTOK; S.rowbytes = D * 2;
                pg8::EpiGateUp<FSwiglu> E{FSwiglu{ACTC, FFE, 0}}; pg8::gemm_phase<pg8::EpiGateUp<FSwiglu>, SchedMoeGU, true, true>(lds, wave, g, S, E); }
            SEAM(17 + 2 * c);
            if (IN(18 + 2 * c) && nM > 0) { pg8::Gemm g{ACTC, W_MOED, (FFE) * 2, (FFE) * 2, (FFE) * 2}; SchedMoeD S; S.so.init(nM, 4, G, bx); S.mi = mi; S.ct0 = ct0;
                pg8::EpiRow8<FBf16> E{FBf16{DOUT, D, ct0 * 256}}; pg8::gemm_phase<pg8::EpiRow8<FBf16>, SchedMoeD, true, false>(lds, wave, g, S, E); }
#endif
            SEAM(18 + 2 * c);
        }
    }
    REP(27) if (IN(27)) {
        PH_LAUNDER();
        int ts[NE]; { int acc_t = 0;
#pragma unroll
            for (int e = 0; e < NE; ++e) { const int c = (int)__builtin_amdgcn_readfirstlane(__hip_atomic_load(ctl + CW_ECNT + 64 * e, RLX_AGENT)); ts[e] = acc_t; acc_t += (c + 255) >> 8; } }
        for (int m = gw; m < T; m += NGW) {
            const unsigned i0 = TOKINFO[2 * m], i1 = TOKINFO[2 * m + 1]; const float w0 = TOKW[2 * m], w1 = TOKW[2 * m + 1];
            int t0 = 0, t1 = 0;
#pragma unroll
            for (int e = 0; e < NE; ++e) { t0 = ((int)(i0 >> 16) == e) ? ts[e] : t0; t1 = ((int)(i1 >> 16) == e) ? ts[e] : t1; }
            const size_t r0 = (size_t)t0 * 256 + (i0 & 0xffffu), r1 = (size_t)t1 * 256 + (i1 & 0xffffu);
            const u32x2* xr = (const u32x2*)(X3 + (size_t)m * D) + lane; const u32x2* d0 = (const u32x2*)(DOUT + r0 * D) + lane; const u32x2* d1 = (const u32x2*)(DOUT + r1 * D) + lane;
            f32x4 v[4];
#pragma unroll
            for (int j = 0; j < 4; ++j) v[j] = bf4_to_f32(xr[64 * j]) * ALPHA + (bf4_to_f32(d0[64 * j]) * w0 + bf4_to_f32(d1[64 * j]) * w1);
            ln_inplace(v, args.in[I_LNF_G] + D, args.in[I_LNF_B] + D, lane);
            f32x4* orow = (f32x4*)(args.out + (size_t)m * D) + lane;
#pragma unroll
            for (int j = 0; j < 4; ++j) orow[64 * j] = v[j];
        }
    }

#if defined(SELFTEST)
    {
        xcd_barrier(bar);
        const float e2 = __hip_atomic_load((float*)(ctl + st::CW_ERR), RLX_AGENT), r2 = __hip_atomic_load((float*)(ctl + st::CW_ERR + 1), RLX_AGENT);
        const float E = e2 / r2; float code = -log10f(E); code = code < 0.f ? 0.f : (code > 9.9f ? 9.9f : code);
        const float A = (E == E && r2 > 0.f) ? sqrtf(100.f * code) : 40.f;
        for (long i = (long)vcu * 512 + threadIdx.x; i < (long)T * D / 4; i += (long)G * 512) ((f32x4*)args.out)[i] = (f32x4){A, A, A, A};
    }
#endif
#undef IN
#undef SEAM
#undef REP
#undef W_MLAIN
#undef W_QUP
#undef W_KVUP
#undef W_MLAOUT
#undef W_FFNGU
#undef W_FFND
#undef W_NSAIN
#undef W_NSAOUT
#undef W_C1K
#undef W_C1V
#undef W_C2K
#undef W_C2V
#undef ROPE_C
#undef CBIAS
#undef RBT
#undef ROWTOK
#undef TOKINFO
#undef TOKW
#undef XB
#undef LAT
#undef QN
#undef KVN
#undef KR
#undef Q
#undef KN
#undef V
#undef O
#undef X1
#undef ACT
#undef X2
#undef NQ
#undef KC
#undef VC
#undef KS
#undef VS
#undef KW
#undef VW
#undef GT
#undef HK
#undef HV
#undef KCMP
#undef VCMP
#undef ONSA
#undef X3
#undef W_MOEGU
#undef W_MOED
#undef DOUT
#undef ROPE_S
#undef P
#undef ACTC
#undef PH_LAUNDER
#endif
}

#ifndef MK_PER_PHASE
#define MK_PER_PHASE 0
#endif
extern "C" void kernel_launch(void* const* d_in, const int* in_sizes, int n_in, void* d_out, int out_size, void* d_ws, size_t ws_size, hipStream_t stream) {
    static int grid = 0;
    if (grid == 0) {
        if (n_in != 27 || out_size != T * D || ws_size < WS_END) { fprintf(stderr, "kernel_launch: unexpected shapes (n_in %d out %d ws %zu)\n", n_in, out_size, ws_size); grid = -1; return; }
        int dev = 0, cus = 0, per_cu = 0;
        if (hipGetDevice(&dev) != hipSuccess || hipDeviceGetAttribute(&cus, hipDeviceAttributeMultiprocessorCount, dev) != hipSuccess) { grid = -1; return; }
        if (hipFuncSetAttribute((const void*)fwd, hipFuncAttributeMaxDynamicSharedMemorySize, LDS_BYTES) != hipSuccess) { fprintf(stderr, "kernel_launch: hipFuncSetAttribute failed\n"); grid = -1; return; }
        if (hipOccupancyMaxActiveBlocksPerMultiprocessor(&per_cu, (const void*)fwd, NWAVES * 64, LDS_BYTES) != hipSuccess || per_cu < 1) { fprintf(stderr, "kernel_launch: occupancy query reports %d\n", per_cu); }
        (void)hipGetLastError();
        grid = cus;
    }
    if (grid < 0) return;
    if (hipMemsetAsync((char*)d_ws + WS_CTL, 0, CTL_ZERO_BYTES, stream) != hipSuccess) return;
    Args a{};
    for (int i = 0; i < 27; ++i) a.in[i] = (const float*)d_in[i];
    a.out = (float*)d_out; a.ws = (unsigned char*)d_ws;
#if MK_PER_PHASE
    for (int p = 0; p < N_PHASES; ++p) { a.ph_lo = p; a.ph_hi = p + 1; hipLaunchKernelGGL(fwd, dim3(grid), dim3(NWAVES * 64), LDS_BYTES, stream, a); }
#else
    a.ph_lo = 0; a.ph_hi = N_PHASES;
    hipLaunchKernelGGL(fwd, dim3(grid), dim3(NWAVES * 64), LDS_BYTES, stream, a);
#endif
}
```

```cpp
#include <hip/hip_runtime.h>
#include <cstdio>
#include <cstdint>

#define LAS __attribute__((address_space(3)))
#define GAS __attribute__((address_space(1)))
typedef unsigned short bf16_t;
typedef short bf16x8 __attribute__((ext_vector_type(8)));
typedef short s16x4 __attribute__((ext_vector_type(4)));
typedef float f32x4 __attribute__((ext_vector_type(4)));
typedef float f32x2 __attribute__((ext_vector_type(2)));
typedef float f32x16 __attribute__((ext_vector_type(16)));
typedef unsigned u32x4 __attribute__((ext_vector_type(4)));
typedef unsigned u32x2 __attribute__((ext_vector_type(2)));

#ifndef FFN_FP8
#define FFN_FP8 2
#endif
#ifndef NSAIN_FP8
#define NSAIN_FP8 1
#endif
#ifndef MOE_FP8
#define MOE_FP8 1
#endif
constexpr int NB = 4, SEQ = 8192, T = NB * SEQ, D = 1024;
constexpr int MLA_H = 8, MLA_QR = 512, MLA_KVR = 256, MLA_DQK = 192, MLA_DV = 128, MLA_IN = 832;
constexpr int NSA_G = 4, NSA_DK = 96, NSA_DV = 64, NSA_IN = 3504, NSA_INP = 3584;
constexpr int FF = 2816, NE = 8, FFE = 3584, ECAP = 32768;
constexpr float ALPHA = 1.41421356237309515f;
constexpr float LOG2E = 1.4426950408889634f;
constexpr float C2_MLA = 0.07216878364870323f * LOG2E;
constexpr float C2_NSA = 0.10206207261596577f * LOG2E;

__device__ __forceinline__ int fresh_lane() { int l; asm volatile("v_mbcnt_lo_u32_b32 %0, -1, 0\n\tv_mbcnt_hi_u32_b32 %0, -1, %0" : "=v"(l)); return l; }
__device__ __forceinline__ unsigned cvt_pk_bf16(float lo, float hi) { unsigned r; asm volatile("v_cvt_pk_bf16_f32 %0, %1, %2" : "=v"(r) : "v"(lo), "v"(hi)); return r; }
__device__ __forceinline__ float bf2f(unsigned short h) { return __uint_as_float(((unsigned)h) << 16); }
__device__ __forceinline__ float bflo(unsigned w) { return __uint_as_float(w << 16); }
__device__ __forceinline__ float bfhi(unsigned w) { return __uint_as_float(w & 0xffff0000u); }
__device__ __forceinline__ float fast_exp2(float x) { return __builtin_amdgcn_exp2f(x); }
__device__ __forceinline__ float fast_rcp(float x) { return __builtin_amdgcn_rcpf(x); }
__device__ __forceinline__ float silu_f(float x) { return x * fast_rcp(1.f + fast_exp2(-x * LOG2E)); }
__device__ __forceinline__ float sigmoid_f(float x) { return fast_rcp(1.f + fast_exp2(-x * LOG2E)); }
__device__ __forceinline__ float gelu_tanh_f(float x) {
    const float z = 0.7978845608028654f * (x + 0.044715f * x * x * x);
    return x * fast_rcp(1.f + fast_exp2(-2.f * LOG2E * z));
}

namespace pg8 {
constexpr int BM = 256, BK = 64, HALF = 128, HTB = HALF * BK * 2, STAGE_BYTES = 8 * HTB, NXCD = 8, WGM = 8;
__host__ __device__ __forceinline__ int lds_byte(int r, int c) { const int st = (r >> 4) * 2 + (c >> 5), rr = r & 15, cc = c & 31, ob = rr * 64 + cc * 2; return st * 1024 + (ob ^ (((ob >> 9) & 1) << 5)); }
__host__ __device__ __forceinline__ void stage_rc(int b, int& R, int& C) { const int st = b / 1024, sb = b % 1024, swz = sb ^ (((sb >> 9) & 1) << 5); R = (st >> 1) * 16 + swz / 64; C = (st & 1) * 32 + (swz % 64) / 2; }
__host__ __device__ __forceinline__ int perm32(int rho) { const int n = rho >> 4, i = rho & 15; return 8 * (i >> 2) + 4 * n + (i & 3); }

typedef int v8i32 __attribute__((ext_vector_type(8)));
__device__ __forceinline__ v8i32 cat8(bf16x8 a, bf16x8 b) { const u32x4 x = __builtin_bit_cast(u32x4, a), y = __builtin_bit_cast(u32x4, b); return (v8i32){(int)x[0], (int)x[1], (int)x[2], (int)x[3], (int)y[0], (int)y[1], (int)y[2], (int)y[3]}; }
__device__ __forceinline__ void mfma_f8_inplace(f32x4& acc, v8i32 a, v8i32 b, int one) {
    asm volatile("v_mfma_scale_f32_16x16x128_f8f6f4 %0, %1, %2, %0, %3, %3 op_sel_hi:[0,0,0]" : "+v"(acc) : "v"(a), "v"(b), "v"(one));
}
__device__ __forceinline__ void mfma_drain() { asm volatile("s_nop 15\n\ts_nop 15" ::: "memory"); }
struct Unit { int pm, pn; };
struct Gemm { const void* A; const void* Bt; int lda, ldb, K; };

struct StaticOrder {
    int nM, nN, nwg, G, c;
    __device__ void init(int nM_, int nN_, int G_, int c_) { nM = nM_; nN = nN_; nwg = nM * nN; G = G_; c = c_; }
    __device__ bool next(int i, Unit& u) const {
        const long L = (long)i * G + c; if (L >= nwg) return false;
        int wgid = (int)L; { const int q = nwg / NXCD, r = nwg % NXCD, xcd = wgid % NXCD, off = wgid / NXCD; wgid = (xcd < r ? xcd * (q + 1) : r * (q + 1) + (xcd - r) * q) + off; }
        const int nig = WGM * nN, gid = wgid / nig, fm = gid * WGM, gsz = (nM - fm) < WGM ? (nM - fm) : WGM;
        u.pm = fm + ((wgid % nig) % gsz); u.pn = (wgid % nig) / gsz; return true;
    }
};
struct SchedPlain {
    StaticOrder so;
    __device__ void init(int nM, int nN, int G, int c) { so.init(nM, nN, G, c); }
    __device__ __forceinline__ bool next(int i, Unit& u) const { return so.next(i, u); }
    __device__ __forceinline__ size_t a_off(const Unit& u, const Gemm& g) const { return (size_t)u.pm * 256 * g.lda; }
    __device__ __forceinline__ size_t b_off(const Unit& u, const Gemm& g) const { return (size_t)u.pn * 256 * g.ldb; }
    __device__ __forceinline__ unsigned a_row(const Unit&, int) const { return 0u; }
};

template <class F> struct EpiRow8 {
    static constexpr bool PERM = true;
    F f;
    __device__ __forceinline__ void operator()(const f32x4 (&acc)[2][2][4][2], const Unit& u, int wr, int wc, int fr, int fq) const {
#pragma unroll
        for (int ai = 0; ai < 2; ++ai)
#pragma unroll
            for (int m = 0; m < 4; ++m) { const int row = u.pm * BM + ai * HALF + wr * 64 + m * 16 + fr;
#pragma unroll
                for (int bj = 0; bj < 2; ++bj) f(row, u.pn * BM + bj * HALF + wc * 32 + 8 * fq, acc[ai][bj][m][0], acc[ai][bj][m][1]); }
    }
};
template <class F, class RS> struct EpiRow8S {
    static constexpr bool PERM = true;
    F f; RS rs;
    __device__ __forceinline__ void operator()(const f32x4 (&acc)[2][2][4][2], const Unit& u, int wr, int wc, int fr, int fq) const {
#pragma unroll
        for (int ai = 0; ai < 2; ++ai)
#pragma unroll
            for (int m = 0; m < 4; ++m) { const int row = u.pm * BM + ai * HALF + wr * 64 + m * 16 + fr; const float s = rs(row, fq);
#pragma unroll
                for (int bj = 0; bj < 2; ++bj) f(row, u.pn * BM + bj * HALF + wc * 32 + 8 * fq, acc[ai][bj][m][0] * s, acc[ai][bj][m][1] * s); }
    }
};
template <class F> struct EpiRow8C {
    static constexpr bool PERM = true;
    F f;
    __device__ __forceinline__ void operator()(const f32x4 (&acc)[2][2][4][2], const Unit& u, int wr, int wc, int fr, int fq) const {
#pragma unroll
        for (int bj = 0; bj < 2; ++bj) { const auto cs = f.col(u.pn * BM + bj * HALF + wc * 32 + 8 * fq);
#pragma unroll
            for (int ai = 0; ai < 2; ++ai)
#pragma unroll
                for (int m = 0; m < 4; ++m) f.st(cs, u.pm * BM + ai * HALF + wr * 64 + m * 16 + fr, acc[ai][bj][m][0], acc[ai][bj][m][1]); }
    }
};
template <class F> struct EpiGateUp {
    static constexpr bool PERM = true;
    F f;
    __device__ __forceinline__ void operator()(const f32x4 (&acc)[2][2][4][2], const Unit& u, int wr, int wc, int fr, int fq) const {
#pragma unroll
        for (int ai = 0; ai < 2; ++ai)
#pragma unroll
            for (int m = 0; m < 4; ++m) { const int row = u.pm * BM + ai * HALF + wr * 64 + m * 16 + fr;
                f(row, u.pn * HALF + wc * 32 + 8 * fq, acc[ai][0][m][0], acc[ai][0][m][1], acc[ai][1][m][0], acc[ai][1][m][1]); }
    }
};

template <class Epi, class Sched, bool ALIGN_EPI, bool GATHER, bool FP8 = false>
__device__ __forceinline__ void gemm_phase(LAS unsigned char* lds, const int wid, const Gemm g, const Sched& S, const Epi& E) {
    const int lane = fresh_lane(), tid = wid * 64 + lane;
    const int  wr = wid >> 2, wc = wid & 3, fr = lane & 15, fq = lane >> 4;
    const int nt = g.K / (BK * 2);
    int sR[2], sC[2]; unsigned voffB[2];
#pragma unroll
    for (int i = 0; i < 2; ++i) { int R, C; stage_rc(tid * 16 + i * 8192, R, C); sR[i] = R; sC[i] = C; const int Rb = Epi::PERM ? ((R & ~31) + perm32(R & 31)) : R; voffB[i] = (unsigned)(Rb * g.ldb + C * 2); }
    const int kstep = BK * 2;
    const int hstepB = HALF * g.ldb;
    const auto rsA = __builtin_amdgcn_make_buffer_rsrc((void*)g.A, 0, 0x7fffffff, 0x00020000);
    const auto rsB = __builtin_amdgcn_make_buffer_rsrc((void*)g.Bt, 0, 0x7fffffff, 0x00020000);
    const unsigned ldsw = (unsigned)wid * 1024u;
    const int aoff = lds_byte(wr * 64 + fr, fq * 8), boff = lds_byte(wc * 32 + fr, fq * 8);
#define PG8_SA(b, h) (((b) * 2 + (h)) * HTB)
#define PG8_SB(b, h) ((4 + (b) * 2 + (h)) * HTB)
#define PG8_STAGE2(bufoff, rsrc, soff, o0, o1) do { \
        __builtin_amdgcn_raw_ptr_buffer_load_lds(rsrc, (LAS unsigned*)(lds + (bufoff) + ldsw), 16, (int)(o0), (int)(soff), 0, 0); \
        __builtin_amdgcn_raw_ptr_buffer_load_lds(rsrc, (LAS unsigned*)(lds + (bufoff) + ldsw + 8192), 16, (int)(o1), (int)(soff), 0, 0); } while (0)
#define PG8_STAGEA(bufoff, soff, o0, o1) PG8_STAGE2(bufoff, rsA, soff, o0, o1)
#define PG8_STAGEB(bufoff, soff) PG8_STAGE2(bufoff, rsB, soff, voffB[0], voffB[1])
#define PG8_LDA(dst, b, h) do { _Pragma("unroll") for (int m = 0; m < 4; ++m) _Pragma("unroll") for (int k = 0; k < 2; ++k) dst[m][k] = *(const LAS bf16x8*)(lds + PG8_SA(b, h) + aoff + m * 2048 + k * 1024); } while (0)
#define PG8_LDB(dst, b, h) do { _Pragma("unroll") for (int n = 0; n < 2; ++n) _Pragma("unroll") for (int k = 0; k < 2; ++k) dst[n][k] = *(const LAS bf16x8*)(lds + PG8_SB(b, h) + boff + n * 2048 + k * 1024); } while (0)
#define PG8_MMA(ai, bj, At, Bt) do { __builtin_amdgcn_s_setprio(1); \
        if constexpr (FP8) { _Pragma("unroll") for (int m = 0; m < 4; ++m) _Pragma("unroll") for (int n = 0; n < 2; ++n) \
            mfma_f8_inplace(acc[ai][bj][m][n], cat8(Bt[n][0], Bt[n][1]), cat8(At[m][0], At[m][1]), f8one); } \
        else { _Pragma("unroll") for (int m = 0; m < 4; ++m) _Pragma("unroll") for (int n = 0; n < 2; ++n) _Pragma("unroll") for (int k = 0; k < 2; ++k) \
            acc[ai][bj][m][n] = __builtin_amdgcn_mfma_f32_16x16x32_bf16(Bt[n][k], At[m][k], acc[ai][bj][m][n], 0, 0, 0); } \
        __builtin_amdgcn_s_setprio(0); } while (0)
#define PG8_WAIT_V(n) asm volatile("s_waitcnt vmcnt(" #n ")" ::: "memory")
#define PG8_WAIT_L(n) asm volatile("s_waitcnt lgkmcnt(" #n ")" ::: "memory")
#define PG8_BAR __builtin_amdgcn_s_barrier()
#define PG8_SCHED __builtin_amdgcn_sched_barrier(0)
    Unit cur, nxt; int ui = 0;
    if (!S.next(0, cur)) return;
    int f8one = 127; if (FP8) asm volatile("" : "+v"(f8one));
    f32x4 acc[2][2][4][2];
#pragma unroll
    for (int a = 0; a < 2; ++a)
#pragma unroll
        for (int b = 0; b < 2; ++b)
#pragma unroll
            for (int m = 0; m < 4; ++m)
#pragma unroll
                for (int n = 0; n < 2; ++n) acc[a][b][m][n] = (f32x4){0.f, 0.f, 0.f, 0.f};
    bf16x8 At[4][2], B0[2][2], B1[2][2];
    unsigned vc[2][2], vn[2][2];
#pragma unroll
    for (int h = 0; h < 2; ++h)
#pragma unroll
        for (int i = 0; i < 2; ++i) { vc[h][i] = GATHER ? S.a_row(cur, h * HALF + sR[i]) + (unsigned)sC[i] * 2u : (unsigned)((h * HALF + sR[i]) * g.lda + sC[i] * 2); vn[h][i] = vc[h][i]; }
    int cA = (int)S.a_off(cur, g), cB = (int)S.b_off(cur, g);
    PG8_STAGEB(PG8_SB(0, 0), cB); PG8_STAGEB(PG8_SB(0, 1), cB + hstepB); PG8_STAGEA(PG8_SA(0, 0), cA, vc[0][0], vc[0][1]); PG8_STAGEA(PG8_SA(0, 1), cA, vc[1][0], vc[1][1]);
    if (wr == 1) PG8_BAR;
    PG8_WAIT_V(2); PG8_BAR;
    PG8_STAGEB(PG8_SB(1, 0), cB + kstep); PG8_STAGEA(PG8_SA(1, 0), cA + kstep, vc[0][0], vc[0][1]); PG8_STAGEB(PG8_SB(1, 1), cB + hstepB + kstep);
    PG8_WAIT_V(6); PG8_BAR;
    for (;;) {
        const bool has_next = S.next(ui + 1, nxt);
        const int nA = has_next ? (int)S.a_off(nxt, g) : cA, nB = has_next ? (int)S.b_off(nxt, g) : cB;
        if (GATHER) {
#pragma unroll
            for (int h = 0; h < 2; ++h)
#pragma unroll
                for (int i = 0; i < 2; ++i) vn[h][i] = has_next ? S.a_row(nxt, h * HALF + sR[i]) + (unsigned)sC[i] * 2u : vc[h][i];
        }
#pragma clang loop unroll(disable)
        for (int t = 0; t < nt; t += 2) {
            const bool last = (t == nt - 2);
            const int a1 = cA + (t + 1) * kstep;
            const int a2 = last ? nA : cA + (t + 2) * kstep, b2 = last ? nB : cB + (t + 2) * kstep;
            const int a3 = a2 + kstep, b3 = b2 + kstep;
            unsigned w00 = vc[0][0], w01 = vc[0][1], w10 = vc[1][0], w11 = vc[1][1];
            if (GATHER) { if (last) { asm volatile("" : "+v"(vn[0][0]), "+v"(vn[0][1]), "+v"(vn[1][0]), "+v"(vn[1][1])); w00 = vn[0][0]; w01 = vn[0][1]; w10 = vn[1][0]; w11 = vn[1][1]; } }
            PG8_LDB(B0, 0, 0); PG8_LDB(B1, 0, 1); PG8_SCHED; PG8_LDA(At, 0, 0); PG8_STAGEA(PG8_SA(1, 1), a1, vc[1][0], vc[1][1]);
            PG8_WAIT_V(8); PG8_WAIT_L(0); PG8_BAR; PG8_MMA(0, 0, At, B0); PG8_MMA(0, 1, At, B1); PG8_BAR; PG8_SCHED;
            PG8_LDA(At, 0, 1); PG8_STAGEB(PG8_SB(0, 0), b2); PG8_STAGEB(PG8_SB(0, 1), b2 + hstepB); PG8_STAGEA(PG8_SA(0, 0), a2, w00, w01);
            PG8_WAIT_V(8); PG8_WAIT_L(0); PG8_BAR; PG8_MMA(1, 0, At, B0); PG8_MMA(1, 1, At, B1); PG8_BAR; PG8_SCHED;
            PG8_LDB(B0, 1, 0); PG8_LDB(B1, 1, 1); PG8_SCHED; PG8_LDA(At, 1, 0); PG8_STAGEA(PG8_SA(0, 1), a2, w10, w11);
            PG8_WAIT_V(8); PG8_WAIT_L(0); PG8_BAR; PG8_MMA(0, 0, At, B0); PG8_MMA(0, 1, At, B1); PG8_BAR; PG8_SCHED;
            PG8_LDA(At, 1, 1); PG8_STAGEB(PG8_SB(1, 0), b3); PG8_STAGEB(PG8_SB(1, 1), b3 + hstepB); PG8_STAGEA(PG8_SA(1, 0), a3, w00, w01);
            PG8_WAIT_V(8); PG8_WAIT_L(0); PG8_BAR; PG8_MMA(1, 0, At, B0); PG8_MMA(1, 1, At, B1); PG8_BAR; PG8_SCHED;
        }
        if constexpr (ALIGN_EPI) { if (wr == 0) PG8_BAR; }
        if (FP8) mfma_drain();
        { const int l_ = fresh_lane();
          E(acc, cur, wr, wc, l_ & 15, l_ >> 4); }
        if (!has_next) break;
#pragma unroll
        for (int a = 0; a < 2; ++a)
#pragma unroll
            for (int b = 0; b < 2; ++b)
#pragma unroll
                for (int m = 0; m < 4; ++m)
#pragma unroll
                    for (int n = 0; n < 2; ++n) acc[a][b][m][n] = (f32x4){0.f, 0.f, 0.f, 0.f};
        cur = nxt; cA = nA; cB = nB; ++ui;
        if (GATHER) {
#pragma unroll
            for (int h = 0; h < 2; ++h)
#pragma unroll
                for (int i = 0; i < 2; ++i) vc[h][i] = vn[h][i];
        }
        if constexpr (ALIGN_EPI) { if (wr == 1) PG8_BAR; }
    }
    PG8_WAIT_V(0);
    if constexpr (!ALIGN_EPI) { if (wr == 0) PG8_BAR; }
    PG8_BAR;
#undef PG8_SA
#undef PG8_SB
#undef PG8_STAGE2
#undef PG8_STAGEA
#undef PG8_STAGEB
#undef PG8_LDA
#undef PG8_LDB
#undef PG8_MMA
#undef PG8_WAIT_V
#undef PG8_WAIT_L
#undef PG8_BAR
#undef PG8_SCHED
}
}
#if defined(__HIP_DEVICE_COMPILE__)
namespace att {
__device__ __forceinline__ int crow(int r, int hi) { return (r & 3) + 8 * (r >> 2) + 4 * hi; }
constexpr float THR = 6.f;
constexpr int NBUF = 3;
struct MlaRing { static constexpr int NS = 3, NI = 46, NPW = 6, BUF = 47104;
    static __device__ __forceinline__ constexpr int OFF(int s) { return s == 0 ? 0 : (s == 1 ? 17408 : 26624); }
    static __device__ __forceinline__ constexpr int NK(int s) { return s == 0 ? 17 : (s == 1 ? 9 : 20); }
    static __device__ __forceinline__ constexpr int GS(int s) { return s == 1 ? 128 : 256; }
    static __device__ __forceinline__ constexpr int CH(int s) { return s == 1 ? 8 : 16; }
    static __device__ __forceinline__ constexpr int ROW(int s) { return s == 0 ? 272 : (s == 1 ? 144 : 320); } };
struct NsaRing { static constexpr int NS = 2, NI = 25, NPW = 4, BUF = 25600;
    static __device__ __forceinline__ constexpr int OFF(int s) { return s == 0 ? 0 : 13312; }
    static __device__ __forceinline__ constexpr int NK(int s) { return s == 0 ? 13 : 12; }
    static __device__ __forceinline__ constexpr int GS(int s) { return s == 0 ? 192 : 128; }
    static __device__ __forceinline__ constexpr int CH(int s) { return s == 0 ? 12 : 8; }
    static __device__ __forceinline__ constexpr int ROW(int s) { return s == 0 ? 208 : 192; } };
typedef __amdgpu_buffer_rsrc_t rsrc_t;
__device__ __forceinline__ rsrc_t make_rsrc(const void* p) { return __builtin_amdgcn_make_buffer_rsrc((void*)p, 0, 0x7fffffff, 0x00020000); }
template <class R> struct Plan {
    int ldsd[R::NPW]; int strm[R::NPW]; int jj[R::NPW]; int lane16;
    __device__ __forceinline__ void init(int wid, int lane) {
        lane16 = 16 * lane;
#pragma unroll
        for (int k = 0; k < R::NPW; ++k) { int j = wid + 8 * k; if (j >= R::NI) j -= R::NI;
            int s = 0, q_ = j;
#pragma unroll
            for (int q = 0; q + 1 < R::NS; ++q) if (q_ >= R::NK(q) && s == q) { q_ -= R::NK(q); s = q + 1; }
            strm[k] = s; jj[k] = q_; ldsd[k] = (s == 0 ? R::OFF(0) : (s == 1 ? R::OFF(1) : R::OFF(R::NS - 1))) + 1024 * q_; }
    }
    template <int S> __device__ __forceinline__ int voff(int k) const { const int x = 1024 * jj[k] + lane16, r = x / R::ROW(S), cc = (x - r * R::ROW(S)) >> 4; return r * R::GS(S) + (cc < R::CH(S) ? cc : 0) * 16; }
};
template <class R> struct Src { rsrc_t rs0, rs1, rs2; int t0; };
template <class R> __device__ __forceinline__ void issue_tile(const Plan<R>& p, const Src<R>& src, int t, LAS char* buf) {
#pragma unroll
    for (int k = 0; k < R::NPW; ++k) { const int s = p.strm[k];
        if (s == 0) __builtin_amdgcn_raw_ptr_buffer_load_lds(src.rs0, (LAS unsigned*)(buf + p.ldsd[k]), 16, p.template voff<0>(k), (src.t0 + t) * 64 * R::GS(0), 0, 0);
        else if (s == 1 || R::NS == 2) __builtin_amdgcn_raw_ptr_buffer_load_lds(src.rs1, (LAS unsigned*)(buf + p.ldsd[k]), 16, p.template voff<1>(k), (src.t0 + t) * 64 * R::GS(1), 0, 0);
        else __builtin_amdgcn_raw_ptr_buffer_load_lds(src.rs2, (LAS unsigned*)(buf + p.ldsd[k]), 16, p.template voff<R::NS - 1>(k), (src.t0 + t) * 64 * R::GS(R::NS - 1), 0, 0); }
}
#define ATT_WAIT_V(n) asm volatile("s_waitcnt vmcnt(%0)" :: "i"(n) : "memory")
template <class R, int DQK> __device__ __forceinline__ void qk_tile(f32x16& p0, f32x16& p1, LAS const char* Kb, int r32, int hi, const bf16x8* qr, const f32x16& cinit) {
    p0 = cinit; p1 = cinit;
    if constexpr (R::NS == 3) {
        LAS const char* a = Kb + r32 * R::ROW(0) + hi * 16; LAS const char* b = Kb + R::OFF(1) + r32 * R::ROW(1) + hi * 16;
#pragma unroll
        for (int d0 = 0; d0 < 8; ++d0) { const bf16x8 k0 = *(LAS const bf16x8*)(a + d0 * 32); const bf16x8 k1 = *(LAS const bf16x8*)(a + 32 * R::ROW(0) + d0 * 32);
            p0 = __builtin_amdgcn_mfma_f32_32x32x16_bf16(k0, qr[d0], p0, 0, 0, 0); p1 = __builtin_amdgcn_mfma_f32_32x32x16_bf16(k1, qr[d0], p1, 0, 0, 0); }
#pragma unroll
        for (int d0 = 0; d0 < 4; ++d0) { const bf16x8 k0 = *(LAS const bf16x8*)(b + d0 * 32); const bf16x8 k1 = *(LAS const bf16x8*)(b + 32 * R::ROW(1) + d0 * 32);
            p0 = __builtin_amdgcn_mfma_f32_32x32x16_bf16(k0, qr[8 + d0], p0, 0, 0, 0); p1 = __builtin_amdgcn_mfma_f32_32x32x16_bf16(k1, qr[8 + d0], p1, 0, 0, 0); }
    } else {
        LAS const char* a = Kb + r32 * R::ROW(0) + hi * 16;
#pragma unroll
        for (int d0 = 0; d0 < DQK / 16; ++d0) { const bf16x8 k0 = *(LAS const bf16x8*)(a + d0 * 32); const bf16x8 k1 = *(LAS const bf16x8*)(a + 32 * R::ROW(0) + d0 * 32);
            p0 = __builtin_amdgcn_mfma_f32_32x32x16_bf16(k0, qr[d0], p0, 0, 0, 0); p1 = __builtin_amdgcn_mfma_f32_32x32x16_bf16(k1, qr[d0], p1, 0, 0, 0); }
    }
}
template <int DV, int VROW> __device__ __forceinline__ void pv_tile(f32x16* o, unsigned vaddr, bf16x8 pa0, bf16x8 pa1, bf16x8 pa2, bf16x8 pa3) {
#define ATT_TRRD(dst, off) asm volatile("ds_read_b64_tr_b16 %0, %1 offset:%2" : "=&v"(dst) : "v"(vaddr), "i"(off) : "memory")
#pragma unroll
    for (int d0 = 0; d0 < DV / 32; ++d0) {
        { s16x4 l0, l1, h0, h1;
        ATT_TRRD(l0, (0 * 16 + 0) * VROW + d0 * 64); ATT_TRRD(h0, (0 * 16 + 4) * VROW + d0 * 64);
        ATT_TRRD(l1, (1 * 16 + 0) * VROW + d0 * 64); ATT_TRRD(h1, (1 * 16 + 4) * VROW + d0 * 64);
        asm volatile("s_waitcnt lgkmcnt(0)" ::: "memory"); __builtin_amdgcn_sched_barrier(0);
        o[d0] = __builtin_amdgcn_mfma_f32_32x32x16_bf16(pa0, (bf16x8){l0[0], l0[1], l0[2], l0[3], h0[0], h0[1], h0[2], h0[3]}, o[d0], 0, 0, 0);
        o[d0] = __builtin_amdgcn_mfma_f32_32x32x16_bf16(pa1, (bf16x8){l1[0], l1[1], l1[2], l1[3], h1[0], h1[1], h1[2], h1[3]}, o[d0], 0, 0, 0); }
        { s16x4 l2, l3, h2, h3;
        ATT_TRRD(l2, (2 * 16 + 0) * VROW + d0 * 64); ATT_TRRD(h2, (2 * 16 + 4) * VROW + d0 * 64);
        ATT_TRRD(l3, (3 * 16 + 0) * VROW + d0 * 64); ATT_TRRD(h3, (3 * 16 + 4) * VROW + d0 * 64);
        asm volatile("s_waitcnt lgkmcnt(0)" ::: "memory"); __builtin_amdgcn_sched_barrier(0);
        o[d0] = __builtin_amdgcn_mfma_f32_32x32x16_bf16(pa2, (bf16x8){l2[0], l2[1], l2[2], l2[3], h2[0], h2[1], h2[2], h2[3]}, o[d0], 0, 0, 0);
        o[d0] = __builtin_amdgcn_mfma_f32_32x32x16_bf16(pa3, (bf16x8){l3[0], l3[1], l3[2], l3[3], h3[0], h3[1], h3[2], h3[3]}, o[d0], 0, 0, 0); }
    }
#undef ATT_TRRD
}
__device__ __forceinline__ float lane_pair_max(float v) { auto rr = __builtin_amdgcn_permlane32_swap(__float_as_uint(v), __float_as_uint(v), false, false); return fmaxf(__uint_as_float(rr[0]), __uint_as_float(rr[1])); }
__device__ __forceinline__ float lane_pair_sum(float v) { auto rr = __builtin_amdgcn_permlane32_swap(__float_as_uint(v), __float_as_uint(v), false, false); return __uint_as_float(rr[0]) + __uint_as_float(rr[1]); }
__device__ __forceinline__ void pack_p(const f32x16& p0, const f32x16& p1, bf16x8& pa0, bf16x8& pa1, bf16x8& pa2, bf16x8& pa3) {
#define ATT_PK4(P, B_, OUT) do { unsigned a0 = cvt_pk_bf16(P[B_ + 0], P[B_ + 1]), a1 = cvt_pk_bf16(P[B_ + 2], P[B_ + 3]); \
        unsigned b0 = cvt_pk_bf16(P[B_ + 4], P[B_ + 5]), b1 = cvt_pk_bf16(P[B_ + 6], P[B_ + 7]); \
        auto r0 = __builtin_amdgcn_permlane32_swap(a0, b0, false, false); auto r1 = __builtin_amdgcn_permlane32_swap(a1, b1, false, false); \
        u32x4 w = {r0[0], r1[0], r0[1], r1[1]}; OUT = __builtin_bit_cast(bf16x8, w); } while (0)
    ATT_PK4(p0, 0, pa0); ATT_PK4(p0, 8, pa1); ATT_PK4(p1, 0, pa2); ATT_PK4(p1, 8, pa3);
#undef ATT_PK4
}
template <class R, class Body> __device__ __forceinline__ void ring_loop(LAS char* lds, const Plan<R>& plan, const Src<R>& src, int nt, Body&& body) {
    issue_tile<R>(plan, src, 0, lds); if (nt > 1) issue_tile<R>(plan, src, 1, lds + R::BUF);
    if (nt > 1) ATT_WAIT_V(R::NPW); else ATT_WAIT_V(0);
    __builtin_amdgcn_s_barrier();
    int bi = 0;
    for (int t = 0; t < nt; ++t) {
        if (t + 2 < nt) { const int b2 = bi == 0 ? 2 : bi - 1; issue_tile<R>(plan, src, t + 2, lds + b2 * R::BUF); }
        body(t, lds + bi * R::BUF);
        if (t + 2 < nt) ATT_WAIT_V(R::NPW); else ATT_WAIT_V(0);
        __builtin_amdgcn_s_barrier(); bi = bi == 2 ? 0 : bi + 1;
    }
}
template <class R, class Body> __device__ __forceinline__ void ring_loop1(LAS char* lds, const Plan<R>& plan, const Src<R>& src, int nt, Body&& body) {
    issue_tile<R>(plan, src, 0, lds); ATT_WAIT_V(0);
    __builtin_amdgcn_s_barrier();
    int bi = 0;
    for (int t = 0; t < nt; ++t) {
        const int bn = bi == 2 ? 0 : bi + 1;
        if (t + 1 < nt) issue_tile<R>(plan, src, t + 1, lds + bn * R::BUF);
        body(t, lds + bi * R::BUF);
        ATT_WAIT_V(0);
        __builtin_amdgcn_s_barrier(); bi = bn;
    }
}
template <class R, int DQK, int DV, bool DO_PV, class Msk, int DBG = 0, bool NEGM = true>
__device__ __forceinline__ void run_online(LAS char* lds, LAS float* wsc, int nt, const Plan<R>& plan, const Src<R>& src, const Msk& msk, const bf16x8* qr, float& m_reg, float& l_reg, f32x16* o, int lane, int wid) {
    const int r32 = lane & 31, hi = lane >> 5;
    if (nt <= 0) return;
    constexpr int VROW = R::ROW(R::NS - 1), VOFF = R::OFF(R::NS - 1);
    const unsigned vlane = (unsigned)((8 * hi + ((lane & 15) >> 2)) * VROW + (16 * ((lane >> 4) & 1) + 4 * (lane & 3)) * 2);
    f32x16 negm;
#pragma unroll
    for (int r = 0; r < 16; ++r) negm[r] = NEGM ? -m_reg : 0.f;
    ring_loop<R>(lds, plan, src, nt, [&](int t, LAS char* Kb) {
        const int kind = DBG == 1 ? 0 : msk.kind(t);
        if (kind) {
            f32x16 p0, p1;
            if (kind == 3) {
                const bool live = msk.live(t); f32x16 ci;
#pragma unroll
                for (int r = 0; r < 16; ++r) ci[r] = live ? negm[r] : -__builtin_inff();
                qk_tile<R, DQK>(p0, p1, Kb, r32, hi, qr, ci);
            } else {
                if (NEGM) qk_tile<R, DQK>(p0, p1, Kb, r32, hi, qr, negm); else qk_tile<R, DQK>(p0, p1, Kb, r32, hi, qr, f32x16{});
                if (kind == 2) msk.apply(p0, p1, t, kind);
            }
            if (DBG == 2) { asm volatile("" :: "v"(p0), "v"(p1)); return; }
            float pmax = fmaxf(p0[0], p1[0]);
#pragma unroll
            for (int r = 1; r < 16; ++r) pmax = fmaxf(pmax, fmaxf(p0[r], p1[r]));
            pmax = lane_pair_max(pmax);
            if (!NEGM) pmax -= m_reg;
            const bool upd = pmax > THR || (l_reg == 0.f && pmax < -THR && pmax > -__builtin_inff());
            float alpha = 1.f;
            if (__any(upd)) {
                const float delta = upd ? pmax : 0.f;
                alpha = l_reg == 0.f ? 1.f : fast_exp2(-delta); m_reg += delta;
                if (NEGM) {
#pragma unroll
                    for (int r = 0; r < 16; ++r) { p0[r] -= delta; p1[r] -= delta; negm[r] = -m_reg; } }
            }
            if (NEGM) {
#pragma unroll
                for (int r = 0; r < 16; ++r) { p0[r] = fast_exp2(p0[r]); p1[r] = fast_exp2(p1[r]); }
            } else {
#pragma unroll
                for (int r = 0; r < 16; ++r) { p0[r] = fast_exp2(p0[r] - m_reg); p1[r] = fast_exp2(p1[r] - m_reg); }
            }
            float ps = 0.f;
#pragma unroll
            for (int r = 0; r < 16; ++r) ps += p0[r] + p1[r];
            ps = lane_pair_sum(ps);
            l_reg = l_reg * alpha + ps;
            if (DO_PV && DBG != 3) {
                if (__any(alpha != 1.f)) {
                    if (hi == 0) wsc[32 + r32] = alpha;
                    asm volatile("s_waitcnt lgkmcnt(0)" ::: "memory");
#pragma unroll
                    for (int r = 0; r < 16; ++r) { const float a = wsc[32 + crow(r, hi)];
#pragma unroll
                        for (int d = 0; d < DV / 32; ++d) o[d][r] *= a; }
                }
                bf16x8 pa0, pa1, pa2, pa3; pack_p(p0, p1, pa0, pa1, pa2, pa3);
                pv_tile<DV, VROW>(o, (unsigned)(uintptr_t)(Kb + VOFF) + vlane, pa0, pa1, pa2, pa3);
            }
        }
    });
}
}
namespace mla {
constexpr int DQK = 192, DV = 128;
using R = att::MlaRing;
constexpr int L_WSC = att::NBUF * R::BUF, L_END = L_WSC + 8 * 256;
struct Msk {
    int qlo, qpos;
    int hi;
    __device__ __forceinline__ int kind(int t) const { const int kb = 64 * t; return kb > qlo + 31 ? 0 : (kb + 63 <= qlo ? 1 : 2); }
    __device__ __forceinline__ bool live(int) const { return true; }
    __device__ __forceinline__ void apply(f32x16& p0, f32x16& p1, int t, int) const {
        const float NEG = -__builtin_inff(); const int d = qpos - 64 * t - 4 * hi;
#pragma unroll
        for (int r = 0; r < 16; ++r) { const int c = (r & 3) + 8 * (r >> 2); if (c > d) p0[r] = NEG; if (c + 32 > d) p1[r] = NEG; }
    }
};
__device__ __forceinline__ void unit(LAS char* lds, const att::Plan<R>& plan, int b, int h, int qb, const bf16_t* Q, const bf16_t* KN, const bf16_t* KR, const bf16_t* V, bf16_t* O, int tid, int wid) {
    const int lane = fresh_lane(); (void)tid;
    const int r32 = lane & 31, hi = lane >> 5;
    LAS float* wsc = (LAS float*)(lds + L_WSC) + wid * 64;
    const int q0 = qb * 256 + wid * 32;
    const size_t trow = (size_t)b * SEQ + q0 + r32;
    bf16x8 qr[DQK / 16];
#pragma unroll
    for (int d0 = 0; d0 < DQK / 16; ++d0) qr[d0] = *(const bf16x8*)(Q + trow * 1536 + h * 192 + d0 * 16 + hi * 8);
    att::Src<R> src{att::make_rsrc(KN + (size_t)(b * MLA_H + h) * SEQ * 128), att::make_rsrc(KR + (size_t)b * SEQ * 64), att::make_rsrc(V + (size_t)(b * MLA_H + h) * SEQ * 128), 0};
    Msk msk{q0, q0 + r32, hi};
    float m_reg = 0.f, l_reg = 0.f; f32x16 o[DV / 32] = {};
    att::run_online<R, DQK, DV, true, Msk, 0, false>(lds, wsc, 4 * (qb + 1), plan, src, msk, qr, m_reg, l_reg, o, lane, wid);
    if (hi == 0) wsc[r32] = l_reg;
    asm volatile("s_waitcnt lgkmcnt(0)" ::: "memory");
    bf16_t* Ow = O + ((size_t)b * SEQ + q0) * 1024 + h * 128;
#pragma unroll
    for (int r = 0; r < 16; ++r) { const int orow = att::crow(r, hi); const float l = wsc[orow]; const float rl = l > 0.f ? fast_rcp(l) : 0.f;
#pragma unroll
        for (int d0 = 0; d0 < DV / 32; ++d0) { const float v = o[d0][r] * rl; const float vn = __shfl_xor(v, 1);
            if ((r32 & 1) == 0) *(unsigned*)(Ow + (size_t)orow * 1024 + d0 * 32 + r32) = cvt_pk_bf16(v, vn); } }
    asm volatile("s_waitcnt lgkmcnt(0)" ::: "memory");
}
}

namespace nsa {
constexpr int DQK = 96, DV = 64;
using R = att::NsaRing;
constexpr int L_WSC = att::NBUF * R::BUF;
constexpr int L_TAB = L_WSC + 8 * 256;
constexpr int TABW = 132;
constexpr int L_PSUM = L_TAB + 4 * TABW * 4;
constexpr int PSW = 68;
constexpr int L_IMP = L_PSUM + 8 * 8 * PSW * 4;
constexpr int L_SELW = L_IMP + 8 * 8 * 128 * 4;
constexpr int L_END = L_SELW + 8 * 8 * 4 * 4;
__device__ __forceinline__ float lds_ld(const LAS float* base, int idx) { float v; asm volatile("ds_read_b32 %0, %1" : "=&v"(v) : "v"((unsigned)(uintptr_t)(base + idx)) : "memory"); return v; }
__device__ __forceinline__ void lds_ld_wait(float (&a)[16], float (&b)[16]) {
    asm volatile("s_waitcnt lgkmcnt(0)" : "+v"(a[0]), "+v"(a[1]), "+v"(a[2]), "+v"(a[3]), "+v"(a[4]), "+v"(a[5]), "+v"(a[6]), "+v"(a[7]), "+v"(a[8]), "+v"(a[9]), "+v"(a[10]), "+v"(a[11]), "+v"(a[12]), "+v"(a[13]), "+v"(a[14]), "+v"(a[15]) :: "memory");
    asm volatile("" : "+v"(b[0]), "+v"(b[1]), "+v"(b[2]), "+v"(b[3]), "+v"(b[4]), "+v"(b[5]), "+v"(b[6]), "+v"(b[7]), "+v"(b[8]), "+v"(b[9]), "+v"(b[10]), "+v"(b[11]), "+v"(b[12]), "+v"(b[13]), "+v"(b[14]), "+v"(b[15]) :: "memory");
}
struct MskCmp {
    int qlo, qpos, hi; const LAS float* tab;
    __device__ __forceinline__ int kind(int t) const {
        const int n0 = 64 * t;
        if (qlo + 7 - (16 * n0 + 31) < 0) return 0;
        return (qlo - (16 * (n0 + 63) + 31) >= 128) ? 1 : 2;
    }
    __device__ __forceinline__ bool live(int) const { return true; }
    __device__ __forceinline__ void apply(f32x16& p0, f32x16& p1, int t, int) const {
        const float NEG = -__builtin_inff(); const int dq = qpos - 31 - 16 * (64 * t + 4 * hi);
        float bv0[16], bv1[16];
#pragma unroll
        for (int r = 0; r < 16; ++r) { const int c = 16 * ((r & 3) + 8 * (r >> 2)); const int d0 = dq - c, d1 = dq - c - 512;
            bv0[r] = lds_ld(tab, (unsigned)d0 < 128u ? d0 : 128); bv1[r] = lds_ld(tab, (unsigned)d1 < 128u ? d1 : 128); }
        lds_ld_wait(bv0, bv1);
#pragma unroll
        for (int r = 0; r < 16; ++r) { const int c = 16 * ((r & 3) + 8 * (r >> 2));
            p0[r] = dq - c >= 0 ? p0[r] + bv0[r] : NEG; p1[r] = dq - c - 512 >= 0 ? p1[r] + bv1[r] : NEG; }
    }
};
struct MskSel {
    int qpos, hi, cur; const LAS float* tab; const LAS unsigned* selw;
    __device__ __forceinline__ bool mine(int j) const { return (selw[j >> 5] >> (j & 31)) & 1u; }
    __device__ __forceinline__ int kind(int j) const {
        const bool s = mine(j);
        if (!__any(s)) return 0;
        if (j >= cur - 2) return 2;
        return __all(s) ? 1 : 3;
    }
    __device__ __forceinline__ bool live(int j) const { return mine(j); }
    __device__ __forceinline__ void apply(f32x16& p0, f32x16& p1, int j, int) const {
        const float NEG = -__builtin_inff(); const bool s = mine(j); const int dq = qpos - 64 * j - 4 * hi;
        float bv0[16], bv1[16];
#pragma unroll
        for (int r = 0; r < 16; ++r) { const int c = (r & 3) + 8 * (r >> 2); const int d0 = dq - c, d1 = dq - c - 32;
            bv0[r] = lds_ld(tab, (unsigned)d0 < 128u ? d0 : 128); bv1[r] = lds_ld(tab, (unsigned)d1 < 128u ? d1 : 128); }
        lds_ld_wait(bv0, bv1);
#pragma unroll
        for (int r = 0; r < 16; ++r) { const int c = (r & 3) + 8 * (r >> 2);
            p0[r] = (s && dq - c >= 0) ? p0[r] + bv0[r] : NEG; p1[r] = (s && dq - c - 32 >= 0) ? p1[r] + bv1[r] : NEG; }
    }
};
struct MskWin {
    int qpos, hi, cur, j0; const LAS float* tab;
    __device__ __forceinline__ int kind(int t) const { const int j = j0 + t; return (j >= cur - 2 || j <= cur - 8) ? 2 : 1; }
    __device__ __forceinline__ bool live(int) const { return true; }
    __device__ __forceinline__ void apply(f32x16& p0, f32x16& p1, int t, int) const {
        const float NEG = -__builtin_inff(); const int dq = qpos - 64 * (j0 + t) - 4 * hi;
        float bv0[16], bv1[16];
#pragma unroll
        for (int r = 0; r < 16; ++r) { const int c = (r & 3) + 8 * (r >> 2); const int d0 = dq - c, d1 = dq - c - 32;
            bv0[r] = lds_ld(tab, (unsigned)d0 < 128u ? d0 : 128); bv1[r] = lds_ld(tab, (unsigned)d1 < 128u ? d1 : 128); }
        lds_ld_wait(bv0, bv1);
#pragma unroll
        for (int r = 0; r < 16; ++r) { const int c = (r & 3) + 8 * (r >> 2);
            p0[r] = (unsigned)(dq - c) < 512u ? p0[r] + bv0[r] : NEG; p1[r] = (unsigned)(dq - c - 32) < 512u ? p1[r] + bv1[r] : NEG; }
    }
};
__device__ __forceinline__ void fold(f32x16* ofin, const f32x16* o, float f, LAS float* wsc, int r32, int hi) {
    if (hi == 0) wsc[r32] = f;
    asm volatile("s_waitcnt lgkmcnt(0)" ::: "memory");
#pragma unroll
    for (int r = 0; r < 16; ++r) { const float a = wsc[att::crow(r, hi)];
#pragma unroll
        for (int d = 0; d < DV / 32; ++d) ofin[d][r] += o[d][r] * a; }
    asm volatile("s_waitcnt lgkmcnt(0)" : "+v"(ofin[0]), "+v"(ofin[1]) :: "memory");
}
struct Tensors { const bf16_t *NQ, *KCMP, *VCMP, *KS, *VS, *KW, *VW; const float *GT, *RBT; bf16_t* O; };
#define NSA_LAUNDER() const int lane = fresh_lane(), tid = wid * 64 + lane, r32 = lane & 31, hi = lane >> 5, qi = r32 >> 2, hg = r32 & 3; \
    LAS float* wsc = (LAS float*)(lds + L_WSC) + wid * 64; const LAS float* tab = (LAS float*)(lds + L_TAB) + hg * TABW; const int qpos = qlo + qi;
template <int DBG = 0> __device__ __forceinline__ void unit(LAS char* lds, const att::Plan<R>& plan, const Tensors& X, int b, int g, int qblk, int tid0, int wid) {
    const int s0 = qblk * 64, cur = qblk, qlo = s0 + 8 * wid;
    const int bg = b * NSA_G + g;
    bf16x8 qr[DQK / 16]; float gc, gs, gw;
    f32x16 ofin[DV / 32] = {};
    LAS float* imp = (LAS float*)(lds + L_IMP) + wid * 8 * 128;
    LAS unsigned* selw = (LAS unsigned*)(lds + L_SELW) + wid * 32;
    {
    NSA_LAUNDER();
    LAS float* tabs = (LAS float*)(lds + L_TAB);
    LAS float* psum = (LAS float*)(lds + L_PSUM) + wid * 8 * PSW;
    for (int i = tid; i < 4 * TABW; i += 512) tabs[i] = X.RBT[(g * 4 + i / TABW) * TABW + i % TABW];
    for (int i = lane; i < 8 * 128; i += 64) imp[i] = 0.f;
    if (lane < 8) psum[lane * PSW] = 0.f;
    if (lane < 32) selw[lane] = 0u;
    const size_t trow = (size_t)b * SEQ + qpos;
#pragma unroll
    for (int d0 = 0; d0 < DQK / 16; ++d0) qr[d0] = *(const bf16x8*)(X.NQ + trow * 1536 + (g * 4 + hg) * 96 + d0 * 16 + hi * 8);
    gc = X.GT[trow * 48 + (g * 4 + hg) * 3 + 0]; gs = X.GT[trow * 48 + (g * 4 + hg) * 3 + 1]; gw = X.GT[trow * 48 + (g * 4 + hg) * 3 + 2];
    __syncthreads();
    }
    const int ncv = (s0 + 63 >= 31) ? ((s0 + 63 - 31) >> 4) + 1 : 0;
    const int ntc = (ncv + 63) >> 6;
#ifndef NSA_NO_CMP
    {
        NSA_LAUNDER();
        att::Src<R> srcC{att::make_rsrc(X.KCMP + (size_t)bg * 512 * 96), att::make_rsrc(X.VCMP + (size_t)bg * 512 * 64), att::make_rsrc(X.VCMP), 0};
        MskCmp mc{qlo, qpos, hi, tab};
        LAS float* psum = (LAS float*)(lds + L_PSUM) + wid * 8 * PSW;
        float m_reg = 0.f, l_reg = 0.f; f32x16 od[DV / 32];
        att::run_online<R, DQK, DV, false>(lds, wsc, ntc, plan, srcC, mc, qr, m_reg, l_reg, od, lane, wid);
        f32x16 cin2; { const float c2 = l_reg > 0.f ? -(m_reg + __builtin_amdgcn_logf(l_reg)) : -__builtin_inff();
#pragma unroll
            for (int r = 0; r < 16; ++r) cin2[r] = c2; }
        f32x16 o[DV / 32] = {};
        if (ntc > 0) {
            constexpr int VROW = R::ROW(1), VOFF = R::OFF(1);
            const unsigned vlane = (unsigned)((8 * hi + ((lane & 15) >> 2)) * VROW + (16 * ((lane >> 4) & 1) + 4 * (lane & 3)) * 2);
            att::ring_loop<R>(lds, plan, srcC, ntc, [&](int t, LAS char* Kb) {
                const int kind = mc.kind(t);
                if (kind) {
                    f32x16 p0, p1;
                    att::qk_tile<R, DQK>(p0, p1, Kb, r32, hi, qr, cin2);
                    if (kind >= 2) mc.apply(p0, p1, t, kind);
#pragma unroll
                    for (int r = 0; r < 16; ++r) { p0[r] = fast_exp2(p0[r]); p1[r] = fast_exp2(p1[r]); }
#pragma unroll
                    for (int r = 0; r < 16; ++r) {
                        float a = p0[r]; a += __shfl_xor(a, 1); a += __shfl_xor(a, 2);
                        float c = p1[r]; c += __shfl_xor(c, 1); c += __shfl_xor(c, 2);
                        if (hg == 0) { psum[qi * PSW + 1 + att::crow(r, hi)] = a; psum[qi * PSW + 33 + att::crow(r, hi)] = c; }
                    }
                    asm volatile("s_waitcnt lgkmcnt(0)" ::: "memory");
                    {
                        const int q = lane >> 3;
#pragma unroll
                        for (int e = 0; e < 2; ++e) { const int jl = (lane & 7) * 2 + e; const LAS float* ps = psum + q * PSW + 4 * jl;
                            imp[q * 128 + 16 * t + jl] = (ps[0] + ps[1]) + (ps[2] + ps[3]) + ps[4]; }
                    }
                    asm volatile("s_waitcnt lgkmcnt(0)" ::: "memory");
                    if (lane < 8) psum[lane * PSW] = psum[lane * PSW + 64];
                    asm volatile("s_waitcnt lgkmcnt(0)" ::: "memory");
                    bf16x8 pa0, pa1, pa2, pa3; att::pack_p(p0, p1, pa0, pa1, pa2, pa3);
                    att::pv_tile<DV, VROW>(o, (unsigned)(uintptr_t)(Kb + VOFF) + vlane, pa0, pa1, pa2, pa3);
                }
            });
        }
        fold(ofin, o, gc, wsc, r32, hi);
    }
#endif
#ifndef NSA_NO_TOPK
    {
        NSA_LAUNDER();
        const int q = lane >> 3, jl = lane & 7;
        float v[16];
#pragma unroll
        for (int i = 0; i < 16; ++i) { const int j = jl + 8 * i; const float x = imp[q * 128 + j];
            v[i] = (j == 0 || j == cur || j == cur - 1) ? 1e6f : (j > cur ? -1e6f : x); }
        unsigned wd[4] = {0u, 0u, 0u, 0u};
        const int nsel = cur + 1 < 16 ? cur + 1 : 16;
        for (int it = 0; it < nsel; ++it) {
            float bv = v[0]; int bj = jl;
#pragma unroll
            for (int i = 1; i < 16; ++i) { const bool g = v[i] > bv; bv = g ? v[i] : bv; bj = g ? jl + 8 * i : bj; }
#pragma unroll
            for (int o = 1; o < 8; o <<= 1) { const float ov = __shfl_xor(bv, o); const int oj = __shfl_xor(bj, o); const bool g = ov > bv || (ov == bv && oj < bj); bv = g ? ov : bv; bj = g ? oj : bj; }
            const bool mine = (bj & 7) == jl; const int wi = bj >> 3;
#pragma unroll
            for (int i = 0; i < 16; ++i) v[i] = (mine && i == wi) ? -__builtin_inff() : v[i];
            const unsigned bit = (mine && bj <= cur) ? 1u << (jl + 8 * (wi & 3)) : 0u;
#pragma unroll
            for (int w = 0; w < 4; ++w) wd[w] |= (w == (wi >> 2)) ? bit : 0u;
        }
#pragma unroll
        for (int w = 0; w < 4; ++w) if (wd[w]) atomicOr((unsigned*)(selw + q * 4 + w), wd[w]);
        asm volatile("s_waitcnt lgkmcnt(0)" ::: "memory");
    }
#endif
#ifndef NSA_NO_SEL
    {
        NSA_LAUNDER();
        att::Src<R> srcS{att::make_rsrc(X.KS + (size_t)bg * SEQ * 96), att::make_rsrc(X.VS + (size_t)bg * SEQ * 64), att::make_rsrc(X.VS), 0};
        MskSel ms{qpos, hi, cur, tab, selw + qi * 4};
        float m_reg = 0.f, l_reg = 0.f; f32x16 o[DV / 32] = {};
        att::run_online<R, DQK, DV, true, MskSel, DBG>(lds, wsc, cur + 1, plan, srcS, ms, qr, m_reg, l_reg, o, lane, wid);
        fold(ofin, o, l_reg > 0.f ? gs * fast_rcp(l_reg) : 0.f, wsc, r32, hi);
    }
#endif
#ifndef NSA_NO_WIN
    {
        NSA_LAUNDER();
        const int j0 = cur >= 8 ? cur - 8 : 0;
        att::Src<R> srcW{att::make_rsrc(X.KW + (size_t)bg * SEQ * 96), att::make_rsrc(X.VW + (size_t)bg * SEQ * 64), att::make_rsrc(X.VW), j0};
        MskWin mw{qpos, hi, cur, j0, tab};
        float m_reg = 0.f, l_reg = 0.f; f32x16 o[DV / 32] = {};
        att::run_online<R, DQK, DV, true, MskWin, DBG>(lds, wsc, cur - j0 + 1, plan, srcW, mw, qr, m_reg, l_reg, o, lane, wid);
        fold(ofin, o, l_reg > 0.f ? gw * fast_rcp(l_reg) : 0.f, wsc, r32, hi);
    }
#endif
    NSA_LAUNDER();
    bf16_t* Ow = X.O + ((size_t)b * SEQ + qlo) * 1024 + g * 256;
#pragma unroll
    for (int r = 0; r < 16; ++r) { const int orow = att::crow(r, hi);
#pragma unroll
        for (int d0 = 0; d0 < DV / 32; ++d0) { const float v = ofin[d0][r]; const float vn = __shfl_xor(v, 1);
            if ((r32 & 1) == 0) *(unsigned*)(Ow + (size_t)(orow >> 2) * 1024 + (orow & 3) * 64 + d0 * 32 + r32) = cvt_pk_bf16(v, vn); } }
    __syncthreads();
}
}
#endif
#if !defined(__HIP_DEVICE_COMPILE__)
namespace nsa { constexpr int L_END = 0, TABW = 132; } namespace mla { constexpr int L_END = 0; }
#endif
constexpr size_t MiB = 1u << 20;
constexpr size_t WS_CTL = 0, CTL_ZERO_BYTES = 1 * MiB;
constexpr size_t WS_W_MLAIN = 1 * MiB;
constexpr size_t WS_W_QUP   = 3 * MiB;
constexpr size_t WS_W_KVUP  = WS_W_QUP + 1536 * 1024;
constexpr size_t WS_W_MLAOUT = WS_W_KVUP + 1 * MiB;
constexpr size_t WS_W_FFNGU = WS_W_MLAOUT + 2 * MiB;
constexpr size_t WS_W_FFND  = WS_W_FFNGU + 11 * MiB;
constexpr size_t WS_W_NSAIN = WS_W_FFND + 5632 * 1024;
constexpr size_t WS_W_NSAOUT = WS_W_NSAIN + 7 * MiB;
constexpr size_t WS_W_C1K = WS_W_NSAOUT + 2 * MiB;
constexpr size_t WS_W_C1V = WS_W_C1K + 256 * 3072 * 2;
constexpr size_t WS_W_C2K = WS_W_C1V + 256 * 2048 * 2;
constexpr size_t WS_W_C2V = WS_W_C2K + 256 * 128 * 2;
constexpr size_t WS_ROPE  = WS_W_C2V + 256 * 128 * 2;
constexpr size_t WS_CBIAS = WS_ROPE + 2 * MiB;
constexpr size_t WS_RBT   = WS_CBIAS + 1024;
constexpr size_t WS_ROWTOK = 38 * MiB;
constexpr size_t WS_TOKINFO = 39 * MiB;
constexpr size_t WS_TOKW = WS_TOKINFO + 256 * 1024;
static_assert(WS_RBT + 16 * 132 * 4 <= WS_ROWTOK && WS_TOKW + 256 * 1024 <= 40 * MiB, "small region");
constexpr size_t WS_XB = 40 * MiB, WS_LAT = 104 * MiB, WS_QN = 168 * MiB, WS_KVN = 200 * MiB, WS_KR = 216 * MiB, WS_Q = 220 * MiB, WS_KN = 316 * MiB, WS_V = 380 * MiB;
constexpr size_t WS_O = 40 * MiB, WS_X1 = 104 * MiB, WS_ACT = 168 * MiB, WS_X2 = 40 * MiB;
constexpr size_t WS_NQ = 104 * MiB, WS_KC = 200 * MiB, WS_VC = 224 * MiB, WS_KS = 240 * MiB, WS_VS = 264 * MiB, WS_KW = 280 * MiB, WS_VW = 304 * MiB, WS_GT = 320 * MiB;
static_assert(WS_KS - WS_KC == 40 * MiB && WS_KW - WS_KS == 40 * MiB && WS_VS - WS_VC == 40 * MiB && WS_VW - WS_VS == 40 * MiB, "FNsaIn segment stride");
constexpr size_t WS_HK = 328 * MiB, WS_HV = 330 * MiB, WS_KCMP = 332 * MiB, WS_VCMP = 334 * MiB;
constexpr size_t WS_ONSA = 348 * MiB, WS_X3 = MOE_FP8 ? 40 * MiB : 412 * MiB;
constexpr size_t WS_MOE_GU = 40 * MiB, WS_MOE_D = 152 * MiB, WS_DOUT = 208 * MiB;
constexpr size_t WS_MOE_GU8 = 412 * MiB, WS_MOE_D8 = 468 * MiB, WS_X3F8 = 124 * MiB;
constexpr size_t WS_X2F8 = 348 * MiB;
constexpr size_t WS_X1F8 = 348 * MiB;
constexpr float MOE_GU_WS = 32.f, MOE_D_WS = 128.f, MOE_H_S = 4.f;
constexpr size_t WS_PART = 336 * MiB;
constexpr int MOE_KSPLIT = 7;
static_assert(FFE % (MOE_KSPLIT * 256) == 0, "split-K slice = an even number of 128-byte K tiles");
constexpr size_t WS_END = 496 * MiB;
constexpr int CW_BAR = 4096;
constexpr int CW_ECNT = 16384;
constexpr int RING_BYTES = 161792;
constexpr int MISC_OFF = RING_BYTES + 320;
constexpr int LDS_BYTES = 163840;
constexpr int NWAVES = 8;
static_assert(nsa::L_END <= RING_BYTES && mla::L_END <= RING_BYTES, "attention LDS");

#define RLX_AGENT __ATOMIC_RELAXED, __HIP_MEMORY_SCOPE_AGENT
#define LDS_WAIT() asm volatile("s_waitcnt lgkmcnt(0)" ::: "memory")
#define VM_WAIT() asm volatile("s_waitcnt vmcnt(0)" ::: "memory")
__device__ __forceinline__ unsigned f2bf(float f) { unsigned u = __builtin_bit_cast(unsigned, f); return (u + 0x7fffu + ((u >> 16) & 1u)) >> 16; }
__device__ __forceinline__ unsigned pk2(float lo, float hi) { return f2bf(lo) | (f2bf(hi) << 16); }

#define XB_TMO      128
#define XB_XCNT(j)  (256  + 64 * (j))
#define XB_XSUB(j)  (1280 + 64 * (j))
#define XB_XGEN(j)  (2304 + 64 * (j))
#define XB_TOP      3328
#define XB_TOPGEN   3392
#define XCD_BAR_WORDS 3456
#define XB_SPIN_CAP (1u << 20)
__device__ __forceinline__ unsigned xb_ld(unsigned* p)              { return __hip_atomic_load(p, __ATOMIC_RELAXED, __HIP_MEMORY_SCOPE_AGENT); }
__device__ __forceinline__ unsigned xb_add(unsigned* p, unsigned v) { return __hip_atomic_fetch_add(p, v, __ATOMIC_RELAXED, __HIP_MEMORY_SCOPE_AGENT); }
__device__ __forceinline__ unsigned xb_xcc_id() { return (unsigned)__builtin_amdgcn_s_getreg((3 << 11) | 20) & 0xFu; }
#define XB_SPIN(cond, bar) do { unsigned _sp = 0; while (cond) { __builtin_amdgcn_s_sleep(1); \
    if ((++_sp & 255u) == 0u) { if (xb_ld(&(bar)[XB_TMO])) break; if (_sp > XB_SPIN_CAP) { atomicAdd(&(bar)[XB_TMO], 1u); break; } } } } while (0)
struct XcdBarrier { unsigned* bar; unsigned x; volatile LAS unsigned* st; };
__device__ __forceinline__ XcdBarrier xcd_barrier_post(unsigned* bar, volatile LAS unsigned* st) {
    XcdBarrier b; b.bar = bar; b.x = xb_xcc_id(); b.st = st;
    if (threadIdx.x == 0) (void)xb_add(&bar[XB_XCNT(b.x)], 1u);
    return b;
}
__device__ __forceinline__ void xcd_barrier_complete(unsigned* bar, unsigned x, unsigned& nloc, unsigned& nx) {
    const unsigned G = gridDim.x * gridDim.y * gridDim.z;
    unsigned sum, cnt, mine, sp = 0u;
    for (;;) {
        sum = 0u; cnt = 0u; mine = 0u;
#pragma unroll
        for (unsigned j = 0; j < 16; ++j) { const unsigned c = xb_ld(&bar[XB_XCNT(j)]); sum += c; cnt += (c > 0u) ? 1u : 0u; mine = (j == x) ? c : mine; }
        if (sum == G) break;
        __builtin_amdgcn_s_sleep(1);
        if ((++sp & 255u) == 0u) { if (xb_ld(&bar[XB_TMO])) break; if (sp > XB_SPIN_CAP) { atomicAdd(&bar[XB_TMO], 1u); break; } }
    }
    nloc = mine > 0u ? mine : 1u; nx = cnt > 0u ? cnt : 1u;
}
__device__ __forceinline__ void xcd_barrier(const XcdBarrier& b) {
    asm volatile("s_waitcnt vmcnt(0)" ::: "memory");
    __syncthreads();
    if (threadIdx.x == 0) {
        unsigned* bar = b.bar;
        __builtin_amdgcn_s_waitcnt(0);
        unsigned nloc = b.st[0], nx = b.st[1];
        if (nloc == 0u) { xcd_barrier_complete(bar, b.x, nloc, nx); b.st[0] = nloc; b.st[1] = nx; }
        const unsigned old = xb_add(&bar[XB_XSUB(b.x)], 1u);
        const unsigned gen = old / nloc;
        if (old + 1u == (gen + 1u) * nloc) {
            __builtin_amdgcn_fence(__ATOMIC_RELEASE, "agent");
            asm volatile("s_waitcnt vmcnt(0)" ::: "memory");
            const unsigned og = xb_add(&bar[XB_TOP], 1u);
            const unsigned tg = og / nx;
            if (og + 1u == (tg + 1u) * nx) xb_add(&bar[XB_TOPGEN], 1u);
            else XB_SPIN(xb_ld(&bar[XB_TOPGEN]) == tg, bar);
            __builtin_amdgcn_fence(__ATOMIC_ACQUIRE, "agent");
            xb_add(&bar[XB_XGEN(b.x)], 1u);
            asm volatile("s_waitcnt vmcnt(0)" ::: "memory");
        } else {
            XB_SPIN(xb_ld(&bar[XB_XGEN(b.x)]) == gen, bar);
            __builtin_amdgcn_fence(__ATOMIC_ACQUIRE, "agent");
            asm volatile("s_waitcnt vmcnt(0)" ::: "memory");
        }
    }
    __syncthreads();
}

__device__ __forceinline__ float wave_sum(float v) {
#pragma unroll
    for (int o = 1; o < 64; o <<= 1) v += __shfl_xor(v, o);
    return v;
}
template <class RM> __device__ __forceinline__ void tr_item(const float* W, int K, int N, bf16_t* WT, int ldk, const RM& rowmap, LAS float* scr, int item, int lane, const float* ksc = nullptr) {
    const int nblk = (N + 31) / 32, kb = item / nblk, nb = item % nblk, k0 = 64 * kb, n0 = 32 * nb;
    const bool nok = n0 + (lane & 31) < N;
#pragma unroll 8
    for (int i = 0; i < 32; ++i) { const int kk = 2 * i + (lane >> 5); scr[kk * 33 + (lane & 31)] = nok ? W[(size_t)(k0 + kk) * N + n0 + (lane & 31)] * (ksc ? ksc[k0 + kk] : 1.f) : 0.f; }
    LDS_WAIT(); asm volatile("" ::: "memory");
    const int c = lane & 7;
#pragma unroll
    for (int j = 0; j < 4; ++j) { const int nl = (lane >> 3) + 8 * j; const LAS float* s = scr + (8 * c) * 33 + nl;
        u32x4 o; o.x = pk2(s[0 * 33], s[1 * 33]); o.y = pk2(s[2 * 33], s[3 * 33]); o.z = pk2(s[4 * 33], s[5 * 33]); o.w = pk2(s[6 * 33], s[7 * 33]);
        if (n0 + nl < N) *(u32x4*)(WT + (size_t)rowmap(n0 + nl) * ldk + k0 + 8 * c) = o; }
    LDS_WAIT(); asm volatile("" ::: "memory");
}
struct RmId { int off; __device__ __forceinline__ int operator()(int n) const { return off + n; } };
struct RmGU { int off; __device__ __forceinline__ int operator()(int n) const { return off + (n >> 7) * 256 + (n & 127); } };
struct RmLat { __device__ __forceinline__ int operator()(int n) const { if (n < 768) return n; const int i = (n - 768) & 31, second = (n - 768) >> 5; return 768 + 8 * (i >> 2) + 4 * second + (i & 3); } };
struct RmQup { __device__ __forceinline__ int operator()(int n) const { const int h = n / 192, j = n % 192; if (j < 128) return n; const int i = j - 128, ii = i & 31; return h * 192 + 128 + 8 * (ii >> 2) + (ii & 3) + ((i >> 5) << 2); } };
template <class RM> __device__ __forceinline__ void tr_matrix(const float* W, int K, int N, bf16_t* WT, int ldk, const RM& rm, LAS float* scr, int gw, int ngw, int lane, const float* ksc = nullptr) {
    const int nitems = (K / 64) * ((N + 31) / 32);
    for (int it = gw; it < nitems; it += ngw) tr_item(W, K, N, WT, ldk, rm, scr, it, lane, ksc);
}

__device__ __forceinline__ float clamp448(float v) { return fminf(fmaxf(v, -448.f), 448.f); }
__device__ __forceinline__ unsigned pk4_fp8(float a, float b, float c, float d) { int w = 0; w = __builtin_amdgcn_cvt_pk_fp8_f32(clamp448(a), clamp448(b), w, false); w = __builtin_amdgcn_cvt_pk_fp8_f32(clamp448(c), clamp448(d), w, true); return (unsigned)w; }
template <class RM> __device__ __forceinline__ void tr_item_f8(const float* W, int K, int N, unsigned char* WT, int ldk, float scale, const RM& rowmap, LAS float* scr, int item, int lane) {
    const int nblk = (N + 31) / 32, kb = item / nblk, nb = item % nblk, k0 = 64 * kb, n0 = 32 * nb;
    const bool nok = n0 + (lane & 31) < N;
#pragma unroll 8
    for (int i = 0; i < 32; ++i) { const int kk = 2 * i + (lane >> 5); scr[kk * 33 + (lane & 31)] = nok ? W[(size_t)(k0 + kk) * N + n0 + (lane & 31)] * scale : 0.f; }
    LDS_WAIT(); asm volatile("" ::: "memory");
    const int c = lane & 3;
#pragma unroll
    for (int j = 0; j < 2; ++j) { const int nl = (lane >> 2) + 16 * j; const LAS float* s = scr + (16 * c) * 33 + nl;
        u32x4 o; o.x = pk4_fp8(s[0 * 33], s[1 * 33], s[2 * 33], s[3 * 33]); o.y = pk4_fp8(s[4 * 33], s[5 * 33], s[6 * 33], s[7 * 33]);
        o.z = pk4_fp8(s[8 * 33], s[9 * 33], s[10 * 33], s[11 * 33]); o.w = pk4_fp8(s[12 * 33], s[13 * 33], s[14 * 33], s[15 * 33]);
        if (n0 + nl < N) *(u32x4*)(WT + (size_t)rowmap(n0 + nl) * ldk + k0 + 16 * c) = o; }
    LDS_WAIT(); asm volatile("" ::: "memory");
}
template <class RM> __device__ __forceinline__ void tr_matrix_f8(const float* W, int K, int N, unsigned char* WT, int ldk, float scale, const RM& rm, LAS float* scr, int gw, int ngw, int lane) {
    const int nitems = (K / 64) * ((N + 31) / 32);
    for (int it = gw; it < nitems; it += ngw) tr_item_f8(W, K, N, WT, ldk, scale, rm, scr, it, lane);
}
#if defined(__HIP_DEVICE_COMPILE__)
__device__ __forceinline__ void tr_load32(float (&v)[32], const float* W, int K, int N, int item, int lane) {
    const auto rs = __builtin_amdgcn_make_buffer_rsrc((void*)W, 0, K * N * 4, 0x00020000);
    const int nblk = (N + 31) / 32, kb = item / nblk, nb = item % nblk;
    const int soff = (64 * kb * N + 32 * nb) * 4;
    const int voff = (32 * nb + (lane & 31) < N) ? ((lane >> 5) * N + (lane & 31)) * 4 : 0x40000000;
#pragma unroll
    for (int i = 0; i < 32; ++i) v[i] = __builtin_bit_cast(float, __builtin_amdgcn_raw_buffer_load_b32(rs, voff, soff + 2 * i * N * 4, 0));
}
template <class RM> __device__ __forceinline__ void tr_emit32_bf16(const float (&v)[32], int N, bf16_t* WT, int ldk, const RM& rowmap, LAS float* scr, int item, int lane) {
    const int nblk = (N + 31) / 32, kb = item / nblk, nb = item % nblk, k0 = 64 * kb, n0 = 32 * nb;
#pragma unroll
    for (int i = 0; i < 32; ++i) scr[(2 * i + (lane >> 5)) * 33 + (lane & 31)] = v[i];
    LDS_WAIT(); asm volatile("" ::: "memory");
    const int c = lane & 7;
#pragma unroll
    for (int j = 0; j < 4; ++j) { const int nl = (lane >> 3) + 8 * j; const LAS float* s = scr + (8 * c) * 33 + nl;
        u32x4 o; o.x = pk2(s[0 * 33], s[1 * 33]); o.y = pk2(s[2 * 33], s[3 * 33]); o.z = pk2(s[4 * 33], s[5 * 33]); o.w = pk2(s[6 * 33], s[7 * 33]);
        if (n0 + nl < N) *(u32x4*)(WT + (size_t)rowmap(n0 + nl) * ldk + k0 + 8 * c) = o; }
    LDS_WAIT(); asm volatile("" ::: "memory");
}
template <class RM> __device__ __forceinline__ void tr_emit32_f8(const float (&v)[32], int N, unsigned char* WT, int ldk, float scale, const RM& rowmap, LAS float* scr, int item, int lane) {
    const int nblk = (N + 31) / 32, kb = item / nblk, nb = item % nblk, k0 = 64 * kb, n0 = 32 * nb;
#pragma unroll
    for (int i = 0; i < 32; ++i) scr[(2 * i + (lane >> 5)) * 33 + (lane & 31)] = v[i] * scale;
    LDS_WAIT(); asm volatile("" ::: "memory");
    const int c = lane & 3;
#pragma unroll
    for (int j = 0; j < 2; ++j) { const int nl = (lane >> 2) + 16 * j; const LAS float* s = scr + (16 * c) * 33 + nl;
        u32x4 o; o.x = pk4_fp8(s[0 * 33], s[1 * 33], s[2 * 33], s[3 * 33]); o.y = pk4_fp8(s[4 * 33], s[5 * 33], s[6 * 33], s[7 * 33]);
        o.z = pk4_fp8(s[8 * 33], s[9 * 33], s[10 * 33], s[11 * 33]); o.w = pk4_fp8(s[12 * 33], s[13 * 33], s[14 * 33], s[15 * 33]);
        if (n0 + nl < N) *(u32x4*)(WT + (size_t)rowmap(n0 + nl) * ldk + k0 + 16 * c) = o; }
    LDS_WAIT(); asm volatile("" ::: "memory");
}
#endif
__device__ __forceinline__ void ln_inplace(f32x4 (&v)[4], const float* g, const float* b, int lane) {
    float s = 0.f;
#pragma unroll
    for (int j = 0; j < 4; ++j) s += (v[j].x + v[j].y) + (v[j].z + v[j].w);
    const float mean = wave_sum(s) * (1.f / D); float s2 = 0.f;
#pragma unroll
    for (int j = 0; j < 4; ++j) { v[j] = v[j] - mean; s2 += (v[j].x * v[j].x + v[j].y * v[j].y) + (v[j].z * v[j].z + v[j].w * v[j].w); }
    const float rstd = 1.f / sqrtf(wave_sum(s2) * (1.f / D) + 1e-5f);
#pragma unroll
    for (int j = 0; j < 4; ++j) { const f32x4 gg = *((const f32x4*)g + lane + 64 * j), bb = *((const f32x4*)b + lane + 64 * j); v[j] = v[j] * rstd * gg + bb; }
}
__device__ __forceinline__ void store_row_bf16(bf16_t* orow, const f32x4 (&v)[4], int lane) {
    u32x2* o8 = (u32x2*)orow + lane;
#pragma unroll
    for (int j = 0; j < 4; ++j) { u32x2 w; w.x = cvt_pk_bf16(v[j].x, v[j].y); w.y = cvt_pk_bf16(v[j].z, v[j].w); o8[64 * j] = w; }
}
__device__ __forceinline__ f32x4 bf4_to_f32(u32x2 w) { return (f32x4){bflo(w.x), bfhi(w.x), bflo(w.y), bfhi(w.y)}; }

__device__ __forceinline__ u32x4 pack8(f32x4 a, f32x4 b) { u32x4 w; w.x = cvt_pk_bf16(a[0], a[1]); w.y = cvt_pk_bf16(a[2], a[3]); w.z = cvt_pk_bf16(b[0], b[1]); w.w = cvt_pk_bf16(b[2], b[3]); return w; }
struct FBf16 { bf16_t* O; int ld; int rowoff;
    __device__ __forceinline__ void operator()(int row, int col, f32x4 a, f32x4 b) const { *(u32x4*)(O + (size_t)(rowoff + row) * ld + col) = pack8(a, b); } };
struct FBf16S { bf16_t* O; int ld; int rowoff; float sc;
    __device__ __forceinline__ void operator()(int row, int col, f32x4 a, f32x4 b) const { *(u32x4*)(O + (size_t)(rowoff + row) * ld + col) = pack8(a * sc, b * sc); } };
struct FF32S { float* O; float sc;
    __device__ __forceinline__ void operator()(int row, int col, f32x4 a, f32x4 b) const { float* o = O + (size_t)row * D + col; *(f32x4*)o = a * sc; *(f32x4*)(o + 4) = b * sc; } };
struct FSwigluF8 { unsigned char* A; int ld; float isc, osc;
    __device__ __forceinline__ void operator()(int row, int col, f32x4 g0, f32x4 g1, f32x4 u0, f32x4 u1) const {
        f32x4 a, b;
#pragma unroll
        for (int e = 0; e < 4; ++e) { a[e] = silu_f(g0[e] * isc) * (u0[e] * (isc * osc)); b[e] = silu_f(g1[e] * isc) * (u1[e] * (isc * osc)); }
        u32x2 w; w.x = pk4_fp8(a[0], a[1], a[2], a[3]); w.y = pk4_fp8(b[0], b[1], b[2], b[3]);
        *(u32x2*)(A + (size_t)row * ld + col) = w; } };
struct FLat { bf16_t* LAT; float* SSQ; bf16_t* KR; const float* cs; const float* sn;
    __device__ __forceinline__ void operator()(int row, int col, f32x4 a, f32x4 b) const {
        if (col < 768) {
            const u32x4 w = pack8(a, b);
            *(u32x4*)(LAT + (size_t)row * 1024 + col) = w;
            const float v0 = bflo(w.x), v1 = bfhi(w.x), v2 = bflo(w.y), v3 = bfhi(w.y), v4 = bflo(w.z), v5 = bfhi(w.z), v6 = bflo(w.w), v7 = bfhi(w.w);
            float s = ((v0 * v0 + v1 * v1) + (v2 * v2 + v3 * v3)) + ((v4 * v4 + v5 * v5) + (v6 * v6 + v7 * v7));
            s += __shfl_xor(s, 16); s += __shfl_xor(s, 32);
            if ((col & 31) == 0) SSQ[(size_t)row * 24 + (col >> 5)] = s;
        } else if (col < 832) {
            const int i0 = ((col - 768) >> 3) * 4, s = row & (SEQ - 1);
            const f32x4 c = *(const f32x4*)(cs + s * 32 + i0), sv = *(const f32x4*)(sn + s * 32 + i0);
            *(u32x4*)(KR + (size_t)row * 64 + (col - 768)) = pack8(a * c - b * sv, a * sv + b * c);
        } } };
struct RsQ { const float* SSQ;
    __device__ __forceinline__ float operator()(int row, int fq) const { const f32x4 p = *(const f32x4*)(SSQ + (size_t)row * 24 + 4 * fq); float s = (p[0] + p[1]) + (p[2] + p[3]);
        s += __shfl_xor(s, 16); s += __shfl_xor(s, 32); return 1.f / sqrtf(s * (1.f / 512.f) + 1e-6f); } };
struct RsKv { const float* SSQ;
    __device__ __forceinline__ float operator()(int row, int fq) const { const float* p = SSQ + (size_t)row * 24 + 16 + 2 * fq; float s = p[0] + p[1];
        s += __shfl_xor(s, 16); s += __shfl_xor(s, 32); return 1.f / sqrtf(s * (1.f / 256.f) + 1e-6f); } };
struct FQup { bf16_t* Q; const float* cs; const float* sn;
    __device__ __forceinline__ void operator()(int row, int col, f32x4 a, f32x4 b) const {
        const int j = col % 192;
        if (j >= 128) { const int i0 = ((j - 128) >> 3) * 4, s = row & (SEQ - 1);
            const f32x4 c = *(const f32x4*)(cs + s * 32 + i0), sv = *(const f32x4*)(sn + s * 32 + i0);
            const f32x4 o1 = a * c - b * sv, o2 = a * sv + b * c; a = o1; b = o2; }
        *(u32x4*)(Q + (size_t)row * 1536 + col) = pack8(a * C2_MLA, b * C2_MLA); } };
struct FKvup { bf16_t* KN; size_t vdelta;
    __device__ __forceinline__ void operator()(int row, int col, f32x4 a, f32x4 b) const {
        const int h = col >> 8, j = col & 255, bb = row >> 13, s = row & (SEQ - 1);
        bf16_t* base = KN + (j < 128 ? (size_t)0 : vdelta) + ((size_t)(bb * MLA_H + h) * SEQ + s) * 128 + (j & 127);
        *(u32x4*)base = pack8(a, b); } };
struct FResF32 { float* P; const float* rf; const bf16_t* rb; float sc;
    __device__ __forceinline__ void operator()(int row, int col, f32x4 a, f32x4 b) const {
        const size_t o = (size_t)row * D + col; f32x4 r0, r1;
        if (rf) { r0 = *(const f32x4*)(rf + o); r1 = *(const f32x4*)(rf + o + 4); }
        else { const u32x4 w = *(const u32x4*)(rb + o); r0 = (f32x4){bflo(w.x), bfhi(w.x), bflo(w.y), bfhi(w.y)}; r1 = (f32x4){bflo(w.z), bfhi(w.z), bflo(w.w), bfhi(w.w)}; }
        *(f32x4*)(P + o) = r0 * ALPHA + a * sc; *(f32x4*)(P + o + 4) = r1 * ALPHA + b * sc; } };
struct FResBf16 { bf16_t* P; const float* rf; const bf16_t* rb; float sc;
    __device__ __forceinline__ void operator()(int row, int col, f32x4 a, f32x4 b) const {
        const size_t o = (size_t)row * D + col; f32x4 r0, r1;
        if (rf) { r0 = *(const f32x4*)(rf + o); r1 = *(const f32x4*)(rf + o + 4); }
        else { const u32x4 w = *(const u32x4*)(rb + o); r0 = (f32x4){bflo(w.x), bfhi(w.x), bflo(w.y), bfhi(w.y)}; r1 = (f32x4){bflo(w.z), bfhi(w.z), bflo(w.w), bfhi(w.w)}; }
        *(u32x4*)(P + o) = pack8(r0 * ALPHA + a * sc, r1 * ALPHA + b * sc); } };
struct FSwiglu { bf16_t* A; int ld; int rowoff;
    __device__ __forceinline__ void operator()(int row, int col, f32x4 g0, f32x4 g1, f32x4 u0, f32x4 u1) const {
        f32x4 a, b;
#pragma unroll
        for (int e = 0; e < 4; ++e) { a[e] = silu_f(g0[e]) * u0[e]; b[e] = silu_f(g1[e]) * u1[e]; }
        *(u32x4*)(A + (size_t)(rowoff + row) * ld + col) = pack8(a, b); } };
struct FSwigluS { bf16_t* A; int ld; float isc;
    __device__ __forceinline__ void operator()(int row, int col, f32x4 g0, f32x4 g1, f32x4 u0, f32x4 u1) const {
        f32x4 a, b;
#pragma unroll
        for (int e = 0; e < 4; ++e) { a[e] = silu_f(g0[e] * isc) * (u0[e] * isc); b[e] = silu_f(g1[e] * isc) * (u1[e] * isc); }
        *(u32x4*)(A + (size_t)row * ld + col) = pack8(a, b); } };
struct FNsaIn { bf16_t *NQ, *KC, *VC; float* GT; float sc;
    struct CS { int kind; int dd; bf16_t* base; float* gbase; };
    __device__ __forceinline__ CS col(int col) const { CS c; c.dd = 0; c.base = NQ; c.gbase = GT;
        if (col < 1536) { c.kind = 0; c.base = NQ + col; return c; }
        if (col >= 3504) { c.kind = 3; return c; }
        if (col >= 3456) { c.kind = 2; c.gbase = GT + (col - 3456); return c; }
        int cc = col - 1536; const int seg = cc / 640; cc -= seg * 640;
        const bool isk = cc < 384; if (!isk) cc -= 384;
        const int dd = isk ? 96 : 64, g = cc / dd, d = cc - g * dd;
        c.kind = 1; c.dd = dd; c.base = (isk ? KC : VC) + (size_t)seg * (40u * 1024u * 1024u / 2u) + (size_t)g * SEQ * dd + d; return c; }
    __device__ __forceinline__ void st(const CS& c, int row, f32x4 a, f32x4 b) const {
        a = a * sc; b = b * sc;
        if (c.kind == 0) { *(u32x4*)(c.base + (size_t)row * 1536) = pack8(a * C2_NSA, b * C2_NSA); }
        else if (c.kind == 1) { const int bb = row >> 13; *(u32x4*)(c.base + (size_t)(row + 3 * bb * SEQ) * c.dd) = pack8(a, b); }
        else if (c.kind == 2) { float* gp = c.gbase + (size_t)row * 48; f32x4 x, y;
#pragma unroll
            for (int e = 0; e < 4; ++e) { x[e] = sigmoid_f(a[e]); y[e] = sigmoid_f(b[e]); }
            *(f32x4*)gp = x; *(f32x4*)(gp + 4) = y; } }
};
struct FCmp1 { bf16_t* H; const float* bias;
    __device__ __forceinline__ void operator()(int row, int col, f32x4 a, f32x4 b) const {
        if (col >= 128) return;
        const f32x4 b0 = *(const f32x4*)(bias + col), b1 = *(const f32x4*)(bias + col + 4); f32x4 x, y;
#pragma unroll
        for (int e = 0; e < 4; ++e) { x[e] = gelu_tanh_f(a[e] + b0[e]); y[e] = gelu_tanh_f(b[e] + b1[e]); }
        *(u32x4*)(H + (size_t)row * 128 + col) = pack8(x, y); } };
struct FCmp2 { bf16_t* O; int nd;
    __device__ __forceinline__ void operator()(int row, int col, f32x4 a, f32x4 b) const {
        if (col >= nd) return;
        if ((row & 511) == 511) { a = (f32x4){0.f, 0.f, 0.f, 0.f}; b = a; }
        *(u32x4*)(O + (size_t)row * nd + col) = pack8(a, b); } };

struct MoeInfo { int cnt[NE]; int ts[NE + 1];
    __device__ __forceinline__ int expert_of(int ct) const { int e = 0;
#pragma unroll
        for (int i = 1; i < NE; ++i) e += (ct >= ts[i]) ? 1 : 0; return e; } };
struct SchedMoeGU {
    pg8::StaticOrder so; MoeInfo mi; int ct0; const int* rowtok; int rowbytes;
    __device__ __forceinline__ bool next(int i, pg8::Unit& u) const { return so.next(i, u); }
    __device__ __forceinline__ size_t a_off(const pg8::Unit&, const pg8::Gemm&) const { return 0; }
    __device__ __forceinline__ size_t b_off(const pg8::Unit& u, const pg8::Gemm& g) const { const int e = mi.expert_of(ct0 + u.pm); return ((size_t)e * (2 * FFE) + (size_t)u.pn * 256) * g.ldb; }
    __device__ __forceinline__ unsigned a_row(const pg8::Unit& u, int r) const {
        const int ct = ct0 + u.pm, e = mi.expert_of(ct); int c = 0, t0 = 0;
#pragma unroll
        for (int i = 0; i < NE; ++i) { c = (i == e) ? mi.cnt[i] : c; t0 = (i == e) ? mi.ts[i] : t0; }
        const int pos = (ct - t0) * 256 + r; const int tok = pos < c ? rowtok[e * ECAP + pos] : 0;
        return (unsigned)tok * (unsigned)rowbytes; }
};
struct SchedMoeDS {
    pg8::StaticOrder so; MoeInfo mi; int ct0; int lt0;
    __device__ __forceinline__ bool next(int i, pg8::Unit& u) const { return so.next(i, u); }
    __device__ __forceinline__ size_t a_off(const pg8::Unit& u, const pg8::Gemm& g) const { const int lt = u.pm / MOE_KSPLIT, kp = u.pm % MOE_KSPLIT; return (size_t)(lt0 + lt) * 256 * g.lda + (size_t)kp * g.K; }
    __device__ __forceinline__ size_t b_off(const pg8::Unit& u, const pg8::Gemm& g) const { const int lt = u.pm / MOE_KSPLIT, kp = u.pm % MOE_KSPLIT; const int e = mi.expert_of(ct0 + lt0 + lt);
        return ((size_t)e * D + (size_t)u.pn * 256) * g.ldb + (size_t)kp * g.K; }
    __device__ __forceinline__ unsigned a_row(const pg8::Unit&, int) const { return 0u; }
};
struct SchedMoeD {
    pg8::StaticOrder so; MoeInfo mi; int ct0;
    __device__ __forceinline__ bool next(int i, pg8::Unit& u) const { return so.next(i, u); }
    __device__ __forceinline__ size_t a_off(const pg8::Unit& u, const pg8::Gemm& g) const { return (size_t)u.pm * 256 * g.lda; }
    __device__ __forceinline__ size_t b_off(const pg8::Unit& u, const pg8::Gemm& g) const { const int e = mi.expert_of(ct0 + u.pm); return ((size_t)e * D + (size_t)u.pn * 256) * g.ldb; }
    __device__ __forceinline__ unsigned a_row(const pg8::Unit&, int) const { return 0u; }
};
#if defined(SELFTEST)
namespace st {
constexpr int TB = 2;
constexpr int CW_ERR = 32768;
template <class AF, class OF> __device__ __forceinline__ void naive_mm(int M, int N, int K, const float* W, int ldw, int n0, const AF& a, const OF& o, int gt, int ngt) {
    for (long i = gt; i < (long)M * N; i += ngt) { const int m = (int)(i / N), n = (int)(i % N); float s = 0.f; for (int k = 0; k < K; ++k) s += a(m, k) * W[(size_t)k * ldw + n0 + n]; o(m, n, s); }
}
__device__ __forceinline__ float wave_max(float v) {
#pragma unroll
    for (int o = 1; o < 64; o <<= 1) v = fmaxf(v, __shfl_xor(v, o));
    return v;
}
__device__ __forceinline__ int rel_bucket_ref(int dist) {
    const int n = dist > 0 ? dist : 0; if (n < 16) return n;
    const float nf = (float)n; int large = 16 + (int)(logf(nf / 16.f) / 2.0794415416798357f * 16.f); return large < 31 ? large : 31;
}
}
#endif
constexpr int N_PHASES = 28;
struct Args { const float* in[27]; float* out; unsigned char* ws; int ph_lo, ph_hi; };
enum { I_X = 0, I_MLA_WIN, I_MLA_QN, I_MLA_WQ, I_MLA_KVN, I_MLA_WKV, I_MLA_WO, I_NSA_WIN, I_PE_K, I_W1_K, I_W2_K, I_PE_V, I_W1_V, I_W2_V, I_NSA_WO, I_RELB,
       I_FFN_G, I_FFN_U, I_FFN_D, I_ROUTER, I_MOE_G, I_MOE_U, I_MOE_D, I_LNM_G, I_LNM_B, I_LNF_G, I_LNF_B };

__device__ __forceinline__ int rel_bucket_dev(int n) {
    if (n < 16) return n;
    int bkt = 16;
    bkt += n >= 19; bkt += n >= 21; bkt += n >= 24; bkt += n >= 27; bkt += n >= 31; bkt += n >= 35; bkt += n >= 40; bkt += n >= 46;
    bkt += n >= 52; bkt += n >= 59; bkt += n >= 67; bkt += n >= 77; bkt += n >= 87; bkt += n >= 99; bkt += n >= 113;
    return bkt;
}

#if defined(__HIP_DEVICE_COMPILE__)
__device__ __forceinline__ void moe_convert_slice(const Args& args, unsigned char* ws, LAS unsigned char* lds, int e, int vcu, int wave, int G) {
    constexpr int NIT = (D / 64) * (FFE / 32);
    static_assert(NIT == (FFE / 64) * (D / 32) && FFE % 64 == 0, "item count");
    const int lane = fresh_lane();
    LAS float* scr = (LAS float*)(lds + wave * 8704);
    const float* wg = args.in[I_MOE_G] + (size_t)e * D * FFE; const float* wu = args.in[I_MOE_U] + (size_t)e * D * FFE; const float* wd = args.in[I_MOE_D] + (size_t)e * FFE * D;
    unsigned char* gu8 = ws + WS_MOE_GU8 + (size_t)e * 2 * FFE * D; unsigned char* d8 = ws + WS_MOE_D8 + (size_t)e * D * FFE;
    _Pragma("nounroll") for (int j = vcu * NWAVES + wave; j < NIT; j += G * NWAVES) {
        float va[32], vb[32], vc[32];
        tr_load32(va, wg, D, FFE, j, lane); tr_load32(vb, wu, D, FFE, j, lane); tr_load32(vc, wd, FFE, D, j, lane);
        tr_emit32_f8(va, FFE, gu8, D, MOE_GU_WS, RmGU{0}, scr, j, lane);
        tr_emit32_f8(vb, FFE, gu8, D, MOE_GU_WS, RmGU{128}, scr, j, lane);
        tr_emit32_f8(vc, D, d8, FFE, MOE_D_WS, RmId{0}, scr, j, lane);
    }
}
#endif

#if defined(__HIP_DEVICE_COMPILE__)
__device__ __forceinline__ void layer_convert_slice(const Args& args, unsigned char* ws, LAS unsigned char* lds, int s, int vcu, int wave, int G) {
    const int lane = fresh_lane();
    LAS float* scr = (LAS float*)(lds + wave * 8704);
    const int j0 = vcu * NWAVES + wave, dj = G * NWAVES;
    constexpr int NF = (D / 64) * (FF / 32), NO = (D / 64) * (D / 32), NI = (D / 64) * ((NSA_IN + 31) / 32);
    static_assert(NF == (FF / 64) * (D / 32) && FF % 64 == 0, "item count");
    if (s == 0) {
        _Pragma("nounroll") for (int j = j0; j < NF; j += dj) { float va[32], vb[32];
            tr_load32(va, args.in[I_FFN_G], D, FF, j, lane); if (j < NO) tr_load32(vb, args.in[I_NSA_WO], D, D, j, lane);
#if FFN_FP8
            tr_emit32_f8(va, FF, ws + WS_W_FFNGU, D, MOE_GU_WS, RmGU{0}, scr, j, lane);
#else
            tr_emit32_bf16(va, FF, (bf16_t*)(ws + WS_W_FFNGU), D, RmGU{0}, scr, j, lane);
#endif
            if (j < NO) tr_emit32_bf16(vb, D, (bf16_t*)(ws + WS_W_NSAOUT), D, RmId{0}, scr, j, lane); }
    } else if (s == 1) {
        _Pragma("nounroll") for (int j = j0; j < NF; j += dj) { float va[32];
            tr_load32(va, args.in[I_FFN_U], D, FF, j, lane);
#if FFN_FP8
            tr_emit32_f8(va, FF, ws + WS_W_FFNGU, D, MOE_GU_WS, RmGU{128}, scr, j, lane); }
#else
            tr_emit32_bf16(va, FF, (bf16_t*)(ws + WS_W_FFNGU), D, RmGU{128}, scr, j, lane); }
#endif
    } else if (s == 2) {
        _Pragma("nounroll") for (int j = j0; j < NF; j += dj) { float va[32];
            tr_load32(va, args.in[I_FFN_D], FF, D, j, lane);
#if FFN_FP8 == 1
            tr_emit32_f8(va, D, ws + WS_W_FFND, FF, MOE_D_WS, RmId{0}, scr, j, lane); }
#else
            tr_emit32_bf16(va, D, (bf16_t*)(ws + WS_W_FFND), FF, RmId{0}, scr, j, lane); }
#endif
    } else {
        _Pragma("nounroll") for (int j = j0; j < NI; j += dj) { float va[32];
            tr_load32(va, args.in[I_NSA_WIN], D, NSA_IN, j, lane);
#if NSAIN_FP8
            tr_emit32_f8(va, NSA_IN, ws + WS_W_NSAIN, D, MOE_GU_WS, RmId{0}, scr, j, lane);
#else
            tr_emit32_bf16(va, NSA_IN, (bf16_t*)(ws + WS_W_NSAIN), D, RmId{0}, scr, j, lane);
#endif
        }
    }
}
#endif

__global__ void __launch_bounds__(NWAVES * 64, 2) fwd(Args args) {
#if defined(__HIP_DEVICE_COMPILE__)
    extern __shared__ __attribute__((aligned(16))) unsigned char lds_raw[];
    LAS unsigned char* lds = (LAS unsigned char*)lds_raw;
    volatile LAS unsigned* MISC = (volatile LAS unsigned*)(lds + MISC_OFF);
    const int wave = __builtin_amdgcn_readfirstlane(threadIdx.x >> 6);
    const int G = gridDim.x, bx = blockIdx.x;
    const int vcu = (G % 8 == 0) ? (bx % 8) * (G / 8) + bx / 8 : bx;
    const int NGW = G * NWAVES;
    unsigned char* ws = args.ws;
    unsigned* ctl = (unsigned*)(ws + WS_CTL);
    for (int u = threadIdx.x; u < (LDS_BYTES - RING_BYTES) / 4; u += NWAVES * 64) ((LAS unsigned*)(lds + RING_BYTES))[u] = 0u;
    __syncthreads();
    XcdBarrier bar = xcd_barrier_post(ctl + CW_BAR, MISC + 8);
    const int lo = args.ph_lo, hi_ph = args.ph_hi;
#ifndef PHMASK
#define PHMASK 0xFFFFFFFFu
#endif
#define IN(k) (((PHMASK >> (k)) & 1u) && lo <= (k) && (k) < hi_ph)
#define SEAM(k) do { if (IN(k) && IN((k) + 1)) xcd_barrier(bar); } while (0)
#if defined(STAMP_PH)
    unsigned long long st_t0 = 0, st_t1 = 0;
#ifndef STAMP_N
#define STAMP_N 1
#endif
#ifndef STAMP_SHIFT
#define STAMP_SHIFT 0.0f
#endif
#define STAMP_AT(idx) do { if ((idx) + 1 == STAMP_PH) st_t0 = __builtin_amdgcn_s_memrealtime(); if ((idx) == STAMP_PH + STAMP_N - 1) st_t1 = __builtin_amdgcn_s_memrealtime(); } while (0)
#else
#define STAMP_AT(idx) do { } while (0)
#endif
#ifndef DUP_MASK
#define DUP_MASK 0u
#endif
#define REP(k) _Pragma("nounroll") for (int rep_ = 0; rep_ < 1 + (int)((DUP_MASK >> (k)) & 1u); ++rep_, (((DUP_MASK >> (k)) & 1u) && rep_ == 1) ? xcd_barrier(bar) : (void)0)
#define W_MLAIN ((bf16_t*)(ws + WS_W_MLAIN))
#define W_QUP ((bf16_t*)(ws + WS_W_QUP))
#define W_KVUP ((bf16_t*)(ws + WS_W_KVUP))
#define W_MLAOUT ((bf16_t*)(ws + WS_W_MLAOUT))
#define W_FFNGU ((bf16_t*)(ws + WS_W_FFNGU))
#define W_FFND ((bf16_t*)(ws + WS_W_FFND))
#define W_NSAIN ((bf16_t*)(ws + WS_W_NSAIN))
#define W_NSAOUT ((bf16_t*)(ws + WS_W_NSAOUT))
#define W_C1K ((bf16_t*)(ws + WS_W_C1K))
#define W_C1V ((bf16_t*)(ws + WS_W_C1V))
#define W_C2K ((bf16_t*)(ws + WS_W_C2K))
#define W_C2V ((bf16_t*)(ws + WS_W_C2V))
#define ROPE_C ((float*)(ws + WS_ROPE))
#define CBIAS ((float*)(ws + WS_CBIAS))
#define RBT ((float*)(ws + WS_RBT))
#define ROWTOK ((int*)(ws + WS_ROWTOK))
#define TOKINFO ((unsigned*)(ws + WS_TOKINFO))
#define TOKW ((float*)(ws + WS_TOKW))
#define XB ((bf16_t*)(ws + WS_XB))
#define LAT ((bf16_t*)(ws + WS_LAT))
#define QN ((bf16_t*)(ws + WS_QN))
#define SSQ ((float*)(ws + WS_QN))
#define KVN ((bf16_t*)(ws + WS_KVN))
#define KR ((bf16_t*)(ws + WS_KR))
#define Q ((bf16_t*)(ws + WS_Q))
#define KN ((bf16_t*)(ws + WS_KN))
#define V ((bf16_t*)(ws + WS_V))
#define O ((bf16_t*)(ws + WS_O))
#define X1 ((bf16_t*)(ws + WS_X1))
#define ACT ((bf16_t*)(ws + WS_ACT))
#define X2 ((bf16_t*)(ws + WS_X2))
#define NQ ((bf16_t*)(ws + WS_NQ))
#define KC ((bf16_t*)(ws + WS_KC))
#define VC ((bf16_t*)(ws + WS_VC))
#define KS ((bf16_t*)(ws + WS_KS))
#define VS ((bf16_t*)(ws + WS_VS))
#define KW ((bf16_t*)(ws + WS_KW))
#define VW ((bf16_t*)(ws + WS_VW))
#define GT ((float*)(ws + WS_GT))
#define HK ((bf16_t*)(ws + WS_HK))
#define HV ((bf16_t*)(ws + WS_HV))
#define KCMP ((bf16_t*)(ws + WS_KCMP))
#define VCMP ((bf16_t*)(ws + WS_VCMP))
#define ONSA ((bf16_t*)(ws + WS_ONSA))
#define X3 ((bf16_t*)(ws + WS_X3))
#define W_MOEGU ((bf16_t*)(ws + WS_MOE_GU))
#define W_MOED ((bf16_t*)(ws + WS_MOE_D))
#define DOUT ((bf16_t*)(ws + WS_DOUT))
#define W_MOEGU8 ((unsigned char*)(ws + WS_MOE_GU8))
#define W_MOED8 ((unsigned char*)(ws + WS_MOE_D8))
#define X3F8 ((unsigned char*)(ws + WS_X3F8))
#define ROPE_S (ROPE_C + SEQ * 32)
#define PB ((bf16_t*)args.out)
#define ACTC ((bf16_t*)args.out)
    typedef pg8::SchedPlain SP;
#define PH_LAUNDER() const int lane = fresh_lane(); const int tid = wave * 64 + lane; const int gw = vcu * NWAVES + wave; LAS float* scr = (LAS float*)(lds + wave * 8704); (void)lane; (void)gw; (void)scr;

    REP(0) if (IN(0)) {
        PH_LAUNDER();
        const float* const* in = args.in;
#ifndef P0SUB
#define P0SUB 0
#endif
        _Pragma("nounroll") for (int rp_ = 0; rp_ < (P0SUB == 1 ? 2 : 1); ++rp_) {
        tr_matrix(in[I_MLA_WIN], D, MLA_IN, W_MLAIN, D, RmLat{}, scr, gw, NGW, lane);
        tr_matrix(in[I_MLA_WQ], MLA_QR, 1536, W_QUP, MLA_QR, RmQup{}, scr, gw, NGW, lane, in[I_MLA_QN]);
        tr_matrix(in[I_MLA_WKV], MLA_KVR, 2048, W_KVUP, MLA_KVR, RmId{0}, scr, gw, NGW, lane, in[I_MLA_KVN]);
        tr_matrix(in[I_MLA_WO], D, D, W_MLAOUT, D, RmId{0}, scr, gw, NGW, lane);
        }
        const int gt = vcu * 512 + tid, NGT = G * 512;
        _Pragma("nounroll") for (int rp_ = 0; rp_ < (P0SUB == 2 ? 2 : 1); ++rp_) {
        for (int i = gt; i < (1024 - MLA_IN) * D / 8; i += NGT) ((u32x4*)(W_MLAIN + (size_t)MLA_IN * D))[i] = (u32x4){0u, 0u, 0u, 0u};
#if NSAIN_FP8
        for (int i = gt; i < (NSA_INP - NSA_IN) * D / 16; i += NGT) ((u32x4*)((unsigned char*)W_NSAIN + (size_t)NSA_IN * D))[i] = (u32x4){0u, 0u, 0u, 0u};
#else
        for (int i = gt; i < (NSA_INP - NSA_IN) * D / 8; i += NGT) ((u32x4*)(W_NSAIN + (size_t)NSA_IN * D))[i] = (u32x4){0u, 0u, 0u, 0u};
#endif
        for (int i = gt; i < 256 * 3072; i += NGT) { const int n = i / 3072, k = i % 3072; W_C1K[i] = (bf16_t)(n < 96 ? f2bf(in[I_W1_K][(size_t)k * 96 + n]) : 0u); }
        for (int i = gt; i < 256 * 2048; i += NGT) { const int n = i / 2048, k = i % 2048; W_C1V[i] = (bf16_t)(n < 64 ? f2bf(in[I_W1_V][(size_t)k * 64 + n]) : 0u); }
        for (int i = gt; i < 256 * 128; i += NGT) { const int n = i / 128, k = i % 128;
            W_C2K[i] = (bf16_t)((n < 96 && k < 96) ? f2bf(in[I_W2_K][k * 96 + n]) : 0u); W_C2V[i] = (bf16_t)((n < 64 && k < 64) ? f2bf(in[I_W2_V][k * 64 + n]) : 0u); }
        for (int i = gw; i < 256; i += NGW) { const int isv = i >> 7, e = i & 127; const int nd = isv ? 64 : 96; float s = 0.f;
            if (e < nd) { const float* pe = in[isv ? I_PE_V : I_PE_K]; const float* w1 = in[isv ? I_W1_V : I_W1_K]; _Pragma("unroll 8") for (int k = lane; k < 32 * nd; k += 64) s += pe[k] * w1[(size_t)k * nd + e]; }
            s = wave_sum(s); if (lane == 0) CBIAS[i] = s; }
        for (int i = gt; i < SEQ * 32; i += NGT) { const int pos = i >> 5, j = i & 31; const float fr = (float)exp2(-(double)j * (13.287712379549449 / 32.0));
            const float ang = (float)pos * fr;
            const double a = (double)ang, red = a - rint(a * 0.15915494309189535) * 6.283185307179586;
            ROPE_C[i] = cosf((float)red); ROPE_S[i] = sinf((float)red); }
        for (int i = gt; i < 16 * nsa::TABW; i += NGT) { const int h = i / nsa::TABW, d = i % nsa::TABW; const float* rb = in[I_RELB];
            RBT[i] = d < 128 ? (rb[rel_bucket_dev(d) * 16 + h] - rb[31 * 16 + h]) * LOG2E : 0.f; }
        }
        _Pragma("nounroll") for (int rp_ = 0; rp_ < (P0SUB == 3 ? 2 : 1); ++rp_) {
        for (int m0 = gw; m0 < T; m0 += 4 * NGW) { f32x4 v[4][4];
#pragma unroll
            for (int r = 0; r < 4; ++r) { const int m = m0 + r * NGW; const f32x4* xr = (const f32x4*)(in[I_X] + (size_t)(m < T ? m : 0) * D) + lane;
#pragma unroll
                for (int j = 0; j < 4; ++j) v[r][j] = xr[64 * j]; }
#pragma unroll
            for (int r = 0; r < 4; ++r) { const int m = m0 + r * NGW; if (m < T) store_row_bf16(XB + (size_t)m * D, v[r], lane); } }
        }
    }
    SEAM(0);
    STAMP_AT(0);
    REP(1) if (IN(1)) { pg8::Gemm g{XB, W_MLAIN, (D) * 2, (D) * 2, (D) * 2}; SP S; S.init(T / 256, 4, G, bx);
        pg8::EpiRow8<FLat> E{FLat{LAT, SSQ, KR, ROPE_C, ROPE_S}}; pg8::gemm_phase<pg8::EpiRow8<FLat>, SP, true, false>(lds, wave, g, S, E); }
    SEAM(1);
    STAMP_AT(1);
    REP(3) if (IN(3)) { pg8::Gemm g{LAT, W_QUP, 1024 * 2, (MLA_QR) * 2, (MLA_QR) * 2}; SP S; S.init(T / 256, 6, G, bx);
        pg8::EpiRow8S<FQup, RsQ> E{FQup{Q, ROPE_C, ROPE_S}, RsQ{SSQ}}; pg8::gemm_phase<pg8::EpiRow8S<FQup, RsQ>, SP, true, false>(lds, wave, g, S, E);
        { pg8::Gemm g{LAT + 512, W_KVUP, 1024 * 2, (MLA_KVR) * 2, (MLA_KVR) * 2}; SP S; S.init(T / 256, 8, G, bx);
        pg8::EpiRow8S<FKvup, RsKv> E{FKvup{KN, (size_t)(WS_V - WS_KN) / 2}, RsKv{SSQ}}; pg8::gemm_phase<pg8::EpiRow8S<FKvup, RsKv>, SP, true, false>(lds, wave, g, S, E); }
    }
    SEAM(4);
    STAMP_AT(4);
    REP(5) if (IN(5)) {
        PH_LAUNDER();
        att::Plan<mla::R> plan; plan.init(wave, lane);
        int cs = 0;
        for (int it2 = 2 * bx; it2 < 2 * NB * MLA_H * 16; it2 += (it2 & 1) ? 2 * G - 1 : 1) { const int it = it2 >> 1, bh = it & 31, x = it >> 5;
            mla::unit((LAS char*)lds, plan, bh >> 3, bh & 7, (it2 & 1) ? x : 31 - x, Q, KN, KR, V, O, tid, wave);
            if (cs < 4) { __syncthreads(); layer_convert_slice(args, ws, lds, cs, vcu, wave, G); ++cs; __syncthreads(); } }
        if (cs < 4) __syncthreads();
        _Pragma("nounroll") for (; cs < 4; ++cs) layer_convert_slice(args, ws, lds, cs, vcu, wave, G);
    }
    SEAM(5);
    STAMP_AT(5);

#if defined(SELFTEST) && SELFTEST == 1
    {
        PH_LAUNDER();
        const float* const* in = args.in; const int gt = vcu * 512 + tid, NGT = G * 512;
        float* TKV = (float*)(ws + 104 * MiB); float* TLAT = (float*)(ws + 168 * MiB); float* TQ = (float*)(ws + 200 * MiB);
        float* TKR = (float*)(ws + 250 * MiB); float* TKVN = (float*)(ws + 256 * MiB); float* TQN = (float*)(ws + 264 * MiB);
        const float* xb = in[I_X] + (size_t)st::TB * SEQ * D;
        st::naive_mm(SEQ, 832, 1024, in[I_MLA_WIN], 832, 0, [&](int m, int k) { return xb[(size_t)m * D + k]; }, [&](int m, int n, float v) { TLAT[(size_t)m * 832 + n] = v; }, gt, NGT);
        xcd_barrier(bar);
        for (int m = gw; m < SEQ; m += NGW) { const float* r = TLAT + (size_t)m * 832; float sq = 0.f, sk = 0.f;
            for (int k = lane; k < 512; k += 64) sq += r[k] * r[k];
            for (int k = lane; k < 256; k += 64) sk += r[512 + k] * r[512 + k];
            sq = wave_sum(sq); sk = wave_sum(sk);
            const float rq = 1.f / sqrtf(sq / 512.f + 1e-6f), rk = 1.f / sqrtf(sk / 256.f + 1e-6f);
            for (int k = lane; k < 512; k += 64) TQN[(size_t)m * 512 + k] = r[k] * rq * in[I_MLA_QN][k];
            for (int k = lane; k < 256; k += 64) TKVN[(size_t)m * 256 + k] = r[512 + k] * rk * in[I_MLA_KVN][k];
            if (lane < 32) { const float fr = powf(10000.f, -(float)lane / 32.f), ang = (float)m * fr, c = cosf(ang), sn = sinf(ang), x1 = r[768 + lane], x2 = r[800 + lane];
                TKR[(size_t)m * 64 + lane] = x1 * c - x2 * sn; TKR[(size_t)m * 64 + 32 + lane] = x1 * sn + x2 * c; } }
        xcd_barrier(bar);
        st::naive_mm(SEQ, 1536, 512, in[I_MLA_WQ], 1536, 0, [&](int m, int k) { return TQN[(size_t)m * 512 + k]; }, [&](int m, int n, float v) { TQ[(size_t)m * 1536 + n] = v; }, gt, NGT);
        st::naive_mm(SEQ, 2048, 256, in[I_MLA_WKV], 2048, 0, [&](int m, int k) { return TKVN[(size_t)m * 256 + k]; }, [&](int m, int n, float v) { TKV[(size_t)m * 2048 + n] = v; }, gt, NGT);
        xcd_barrier(bar);
        for (int m = gw; m < SEQ; m += NGW) for (int e = lane; e < 256; e += 64) { const int h = e >> 5, i = e & 31; float* q = TQ + (size_t)m * 1536 + h * 192 + 128;
            const float fr = powf(10000.f, -(float)i / 32.f), ang = (float)m * fr, c = cosf(ang), sn = sinf(ang), x1 = q[i], x2 = q[32 + i]; q[i] = x1 * c - x2 * sn; q[32 + i] = x1 * sn + x2 * c; }
        xcd_barrier(bar);
        float err = 0.f, ref2 = 0.f;
        for (int row = gw; row < MLA_H * SEQ; row += NGW) { const int h = row & 7, q = row >> 3;
            const float* qv = TQ + (size_t)q * 1536 + h * 192; const float q0 = qv[lane], q1 = qv[64 + lane], q2 = qv[128 + lane];
            float mm = -__builtin_inff(), l = 0.f, a0 = 0.f, a1 = 0.f;
            for (int k = 0; k <= q; ++k) { const float* kn = TKV + (size_t)k * 2048 + h * 256; const float* kr = TKR + (size_t)k * 64;
                const float sc = wave_sum(q0 * kn[lane] + q1 * kn[64 + lane] + q2 * kr[lane]) * 0.07216878364870323f;
                const float mn = fmaxf(mm, sc), al = __expf(mm - mn), p = __expf(sc - mn);
                l = l * al + p; a0 = a0 * al + p * kn[128 + lane]; a1 = a1 * al + p * kn[192 + lane]; mm = mn; }
            const float o0 = a0 / l, o1 = a1 / l; const bf16_t* fo = O + ((size_t)st::TB * SEQ + q) * 1024 + h * 128;
            const float f0 = bf2f(fo[lane]), f1 = bf2f(fo[64 + lane]);
            err += (f0 - o0) * (f0 - o0) + (f1 - o1) * (f1 - o1); ref2 += o0 * o0 + o1 * o1; }
        err = wave_sum(err); ref2 = wave_sum(ref2);
        if (lane == 0) { atomicAdd((float*)(ctl + st::CW_ERR), err); atomicAdd((float*)(ctl + st::CW_ERR + 1), ref2); }
        xcd_barrier(bar);
    }
#endif
    REP(6) if (IN(6)) { pg8::Gemm g{O, W_MLAOUT, (D) * 2, (D) * 2, (D) * 2}; SP S; S.init(T / 256, 4, G, bx);
        pg8::EpiRow8<FResBf16> E{FResBf16{PB, args.in[I_X], nullptr, 1.f}}; pg8::gemm_phase<pg8::EpiRow8<FResBf16>, SP, true, false>(lds, wave, g, S, E); }
    SEAM(6);
    STAMP_AT(6);
    REP(7) if (IN(7)) {
        PH_LAUNDER();
        for (int m0 = gw; m0 < T; m0 += 4 * NGW) { f32x4 v[4][4];
#pragma unroll
            for (int r = 0; r < 4; ++r) { const int m = m0 + r * NGW < T ? m0 + r * NGW : 0; const u32x2* pr = (const u32x2*)(PB + (size_t)m * D) + lane;
#pragma unroll
                for (int j = 0; j < 4; ++j) v[r][j] = bf4_to_f32(pr[64 * j]); }
#pragma unroll
            for (int r = 0; r < 4; ++r) { const int m = m0 + r * NGW; if (m >= T) continue;
                ln_inplace(v[r], args.in[I_LNM_G], args.in[I_LNM_B], lane); store_row_bf16(X1 + (size_t)m * D, v[r], lane);
#if FFN_FP8
#pragma unroll
                for (int j = 0; j < 4; ++j) *((unsigned*)(ws + WS_X1F8 + (size_t)m * D) + lane + 64 * j) = pk4_fp8(v[r][j].x, v[r][j].y, v[r][j].z, v[r][j].w);
#endif
 }
        }
    }
    SEAM(7);
    STAMP_AT(7);
#if FFN_FP8 == 2
    REP(8) if (IN(8)) { pg8::Gemm g{ws + WS_X1F8, W_FFNGU, D, D, D}; SP S; S.init(T / 256, 22, G, bx);
        pg8::EpiGateUp<FSwigluS> E{FSwigluS{ACT, FF, 1.f / MOE_GU_WS}}; pg8::gemm_phase<pg8::EpiGateUp<FSwigluS>, SP, true, false, true>(lds, wave, g, S, E); }
#elif FFN_FP8
    REP(8) if (IN(8)) { pg8::Gemm g{ws + WS_X1F8, W_FFNGU, D, D, D}; SP S; S.init(T / 256, 22, G, bx);
        pg8::EpiGateUp<FSwigluF8> E{FSwigluF8{(unsigned char*)ACT, FF, 1.f / MOE_GU_WS, MOE_H_S}}; pg8::gemm_phase<pg8::EpiGateUp<FSwigluF8>, SP, true, false, true>(lds, wave, g, S, E); }
#else
    REP(8) if (IN(8)) { pg8::Gemm g{X1, W_FFNGU, (D) * 2, (D) * 2, (D) * 2}; SP S; S.init(T / 256, 22, G, bx);
        pg8::EpiGateUp<FSwiglu> E{FSwiglu{ACT, FF, 0}}; pg8::gemm_phase<pg8::EpiGateUp<FSwiglu>, SP, true, false>(lds, wave, g, S, E); }
#endif
    SEAM(8);
    STAMP_AT(8);
#if defined(XBAR)
    for (int i_ = 0; i_ < XBAR; ++i_) xcd_barrier(bar);
#endif
#if FFN_FP8 == 1
    REP(9) if (IN(9)) { pg8::Gemm g{ACT, W_FFND, FF, FF, FF}; SP S; S.init(T / 256, 4, G, bx);
        pg8::EpiRow8<FResBf16> E{FResBf16{PB, nullptr, X1, 1.f / (MOE_D_WS * MOE_H_S)}}; pg8::gemm_phase<pg8::EpiRow8<FResBf16>, SP, true, false, true>(lds, wave, g, S, E); }
#else
    REP(9) if (IN(9)) { pg8::Gemm g{ACT, W_FFND, (FF) * 2, (FF) * 2, (FF) * 2}; SP S; S.init(T / 256, 4, G, bx);
        pg8::EpiRow8<FResBf16> E{FResBf16{PB, nullptr, X1, 1.f}}; pg8::gemm_phase<pg8::EpiRow8<FResBf16>, SP, true, false>(lds, wave, g, S, E); }
#endif
    SEAM(9);
    STAMP_AT(9);
    REP(10) if (IN(10)) {
        PH_LAUNDER();
        for (int m0 = gw; m0 < T; m0 += 4 * NGW) { f32x4 v[4][4];
#pragma unroll
            for (int r = 0; r < 4; ++r) { const int m = m0 + r * NGW < T ? m0 + r * NGW : 0; const u32x2* pr = (const u32x2*)(PB + (size_t)m * D) + lane;
#pragma unroll
                for (int j = 0; j < 4; ++j) v[r][j] = bf4_to_f32(pr[64 * j]); }
#pragma unroll
            for (int r = 0; r < 4; ++r) { const int m = m0 + r * NGW; if (m >= T) continue;
                ln_inplace(v[r], args.in[I_LNF_G], args.in[I_LNF_B], lane); store_row_bf16(X2 + (size_t)m * D, v[r], lane);
#if NSAIN_FP8
#pragma unroll
                for (int j = 0; j < 4; ++j) *((unsigned*)(ws + WS_X2F8 + (size_t)m * D) + lane + 64 * j) = pk4_fp8(v[r][j].x, v[r][j].y, v[r][j].z, v[r][j].w);
#endif
            }
        }
    }
    SEAM(10);
    STAMP_AT(10);
#if NSAIN_FP8
    REP(11) if (IN(11)) { pg8::Gemm g{ws + WS_X2F8, W_NSAIN, D, D, D}; SP S; S.init(T / 256, NSA_INP / 256, G, bx);
        pg8::EpiRow8C<FNsaIn> E{FNsaIn{NQ, KC, VC, GT, 1.f / MOE_GU_WS}}; pg8::gemm_phase<pg8::EpiRow8C<FNsaIn>, SP, true, false, true>(lds, wave, g, S, E); }
#else
    REP(11) if (IN(11)) { pg8::Gemm g{X2, W_NSAIN, (D) * 2, (D) * 2, (D) * 2}; SP S; S.init(T / 256, NSA_INP / 256, G, bx);
        pg8::EpiRow8C<FNsaIn> E{FNsaIn{NQ, KC, VC, GT, 1.f}}; pg8::gemm_phase<pg8::EpiRow8C<FNsaIn>, SP, true, false>(lds, wave, g, S, E); }
#endif
    SEAM(11);
    STAMP_AT(11);
    REP(12) if (IN(12)) {
        { pg8::Gemm g{KC, W_C1K, (16 * 96) * 2, (3072) * 2, (3072) * 2}; SP S; S.init(32, 1, G, bx);
          pg8::EpiRow8<FCmp1> E{FCmp1{HK, CBIAS}}; pg8::gemm_phase<pg8::EpiRow8<FCmp1>, SP, false, false>(lds, wave, g, S, E); }
        { pg8::Gemm g{VC, W_C1V, (16 * 64) * 2, (2048) * 2, (2048) * 2}; SP S; S.init(32, 1, G, (bx + G / 2) % G);
          pg8::EpiRow8<FCmp1> E{FCmp1{HV, CBIAS + 128}}; pg8::gemm_phase<pg8::EpiRow8<FCmp1>, SP, false, false>(lds, wave, g, S, E); }
    }
    if (IN(12) && IN(13)) { __builtin_amdgcn_fence(__ATOMIC_RELEASE, "workgroup"); __builtin_amdgcn_s_barrier(); __builtin_amdgcn_fence(__ATOMIC_ACQUIRE, "workgroup"); }
    REP(13) if (IN(13)) {
        { pg8::Gemm g{HK, W_C2K, (128) * 2, (128) * 2, (128) * 2}; SP S; S.init(32, 1, G, bx);
          pg8::EpiRow8<FCmp2> E{FCmp2{KCMP, 96}}; pg8::gemm_phase<pg8::EpiRow8<FCmp2>, SP, false, false>(lds, wave, g, S, E); }
        { pg8::Gemm g{HV, W_C2V, (128) * 2, (128) * 2, (128) * 2}; SP S; S.init(32, 1, G, (bx + G / 2) % G);
          pg8::EpiRow8<FCmp2> E{FCmp2{VCMP, 64}}; pg8::gemm_phase<pg8::EpiRow8<FCmp2>, SP, false, false>(lds, wave, g, S, E); }
    }
    SEAM(13);
    STAMP_AT(13);

#if defined(SELFTEST) && SELFTEST == 3
    {
        PH_LAUNDER();
        const float* const* in = args.in; const int gt = vcu * 512 + tid, NGT = G * 512;
        float* TPROJ = (float*)(ws + 348 * MiB);
        float* THK = (float*)(ws + 460 * MiB); float* THV = (float*)(ws + 461 * MiB); float* TKC = (float*)(ws + 462 * MiB); float* TVC = (float*)(ws + 463 * MiB);
        const bf16_t* xb = X2 + (size_t)st::TB * SEQ * D;
        st::naive_mm(SEQ, 3504, 1024, in[I_NSA_WIN], 3504, 0, [&](int m, int k) { return bf2f(xb[(size_t)m * D + k]); }, [&](int m, int n, float v) { TPROJ[(size_t)m * 3504 + n] = v; }, gt, NGT);
        xcd_barrier(bar);
        for (int i = gt; i < 4 * 511 * 96; i += NGT) { const int e = i % 96, n = (i / 96) % 511, g = i / (96 * 511); float s = 0.f;
            for (int l = 0; l < 32; ++l) for (int d = 0; d < 96; ++d) s += (TPROJ[(size_t)(16 * n + l) * 3504 + 1536 + g * 96 + d] + in[I_PE_K][l * 96 + d]) * in[I_W1_K][(size_t)(l * 96 + d) * 96 + e];
            THK[(g * 512 + n) * 96 + e] = 0.5f * s * (1.f + tanhf(0.7978845608028654f * (s + 0.044715f * s * s * s))); }
        for (int i = gt; i < 4 * 511 * 64; i += NGT) { const int e = i % 64, n = (i / 64) % 511, g = i / (64 * 511); float s = 0.f;
            for (int l = 0; l < 32; ++l) for (int d = 0; d < 64; ++d) s += (TPROJ[(size_t)(16 * n + l) * 3504 + 1920 + g * 64 + d] + in[I_PE_V][l * 64 + d]) * in[I_W1_V][(size_t)(l * 64 + d) * 64 + e];
            THV[(g * 512 + n) * 64 + e] = 0.5f * s * (1.f + tanhf(0.7978845608028654f * (s + 0.044715f * s * s * s))); }
        xcd_barrier(bar);
        float err = 0.f, ref2 = 0.f;
        for (int i = gt; i < 4 * 511 * 96; i += NGT) { const int e = i % 96, n = (i / 96) % 511, g = i / (96 * 511); float s = 0.f; for (int d = 0; d < 96; ++d) s += THK[(g * 512 + n) * 96 + d] * in[I_W2_K][d * 96 + e];
            const float f = bf2f(KCMP[((size_t)(st::TB * 4 + g) * 512 + n) * 96 + e]); err += (f - s) * (f - s); ref2 += s * s; }
        for (int i = gt; i < 4 * 511 * 64; i += NGT) { const int e = i % 64, n = (i / 64) % 511, g = i / (64 * 511); float s = 0.f; for (int d = 0; d < 64; ++d) s += THV[(g * 512 + n) * 64 + d] * in[I_W2_V][d * 64 + e];
            const float f = bf2f(VCMP[((size_t)(st::TB * 4 + g) * 512 + n) * 64 + e]); err += (f - s) * (f - s); ref2 += s * s; }
        for (long i = gt; i < (long)SEQ * 3504; i += NGT) { const int m = (int)(i / 3504), c = (int)(i % 3504); const float r = TPROJ[i]; const size_t trow = (size_t)st::TB * SEQ + m; float f, rr = r;
            if (c < 1536) { f = bf2f(NQ[trow * 1536 + c]); rr = r * C2_NSA; }
            else if (c >= 3456) { f = GT[trow * 48 + (c - 3456)]; rr = 1.f / (1.f + __expf(-r)); }
            else { int cc = c - 1536; const bf16_t* base; int dd;
                if (cc < 384) { base = KC; dd = 96; } else if (cc < 640) { base = VC; dd = 64; cc -= 384; } else if (cc < 1024) { base = KS; dd = 96; cc -= 640; } else if (cc < 1280) { base = VS; dd = 64; cc -= 1024; }
                else if (cc < 1664) { base = KW; dd = 96; cc -= 1280; } else { base = VW; dd = 64; cc -= 1664; }
                const int g = cc / dd, d = cc % dd; f = bf2f(base[((size_t)(st::TB * 4 + g) * SEQ + m) * dd + d]); }
            err += (f - rr) * (f - rr); ref2 += rr * rr; }
        err = wave_sum(err); ref2 = wave_sum(ref2);
        if (lane == 0) { atomicAdd((float*)(ctl + st::CW_ERR), err); atomicAdd((float*)(ctl + st::CW_ERR + 1), ref2); }
        xcd_barrier(bar);
    }
#endif
#if defined(XNSA)
    {
        PH_LAUNDER();
        const nsa::Tensors X{NQ, KCMP, VCMP, KS, VS, KW, VW, GT, RBT, (bf16_t*)args.out};
        att::Plan<nsa::R> plan; plan.init(wave, lane);
        for (int it2 = 2 * bx; it2 < 2 * NB * NSA_G * 64; it2 += (it2 & 1) ? 2 * G - 1 : 1) { const int it = it2 >> 1, bg = it & 15, x = it >> 4;
            nsa::unit<XNSA>((LAS char*)lds, plan, X, bg >> 2, bg & 3, (it2 & 1) ? x : 127 - x, tid, wave); }
        xcd_barrier(bar);
    }
#endif
    REP(14) if (IN(14)) {
        PH_LAUNDER();
        const nsa::Tensors X{NQ, KCMP, VCMP, KS, VS, KW, VW, GT, RBT, ONSA};
        att::Plan<nsa::R> plan; plan.init(wave, lane);
        int cs = 0;
        for (int it2 = 2 * bx; it2 < 2 * NB * NSA_G * 64; it2 += (it2 & 1) ? 2 * G - 1 : 1) { const int it = it2 >> 1, bg = it & 15, x = it >> 4;
            nsa::unit((LAS char*)lds, plan, X, bg >> 2, bg & 3, (it2 & 1) ? x : 127 - x, tid, wave);
#if MOE_FP8
            if (cs < NE) { moe_convert_slice(args, ws, lds, cs, vcu, wave, G); ++cs; __syncthreads(); }
#endif
        }
#if MOE_FP8
        _Pragma("nounroll") for (; cs < NE; ++cs) moe_convert_slice(args, ws, lds, cs, vcu, wave, G);
#endif
    }
    SEAM(14);
    STAMP_AT(14);

#if defined(SELFTEST) && SELFTEST == 2
    {
        PH_LAUNDER();
        const float* rb = args.in[I_RELB];
        LAS float* buf = (LAS float*)(lds + wave * 6144); LAS float* imp = buf + 1024; LAS int* sel = (LAS int*)(imp + 128);
        const float scale_q = 1.f / LOG2E;
        float err = 0.f, ref2 = 0.f;
        for (int item = gw; item < NSA_G * SEQ; item += NGW) { const int g = item & 3, q = item >> 2, qpos = q, cur = q >> 6; const size_t trow = (size_t)st::TB * SEQ + q; const int bg = st::TB * NSA_G + g;
            float oacc[4] = {0.f, 0.f, 0.f, 0.f};
            imp[lane] = 0.f; imp[64 + lane] = 0.f;
            int nvalid = qpos >= 31 ? ((qpos - 31) >> 4) + 1 : 0; if (nvalid > 511) nvalid = 511;
            const bf16_t* kc = KCMP + (size_t)bg * 512 * 96; const bf16_t* vc = VCMP + (size_t)bg * 512 * 64;
            const bf16_t* ks = KS + (size_t)bg * SEQ * 96; const bf16_t* vs = VS + (size_t)bg * SEQ * 64; const bf16_t* kw = KW + (size_t)bg * SEQ * 96; const bf16_t* vw = VW + (size_t)bg * SEQ * 64;
            for (int h = 0; h < 4; ++h) { const int head = g * 4 + h; const bf16_t* qv = NQ + trow * 1536 + head * 96;
                float mx = -__builtin_inff();
                for (int n = lane; n < nvalid; n += 64) { float s = 0.f; for (int d = 0; d < 96; ++d) s += bf2f(qv[d]) * bf2f(kc[(size_t)n * 96 + d]);
                    s = s * scale_q + rb[st::rel_bucket_ref(qpos - 16 * n - 31) * 16 + head]; buf[n] = s; mx = fmaxf(mx, s); }
                mx = st::wave_max(mx); if (!(mx > -1e38f)) mx = 0.f;
                float sum = 0.f; LDS_WAIT();
                for (int n = lane; n < nvalid; n += 64) { const float p = __expf(buf[n] - mx); buf[n] = p; sum += p; }
                sum = wave_sum(sum); const float inv = 1.f / fmaxf(sum, 1e-30f);
                for (int n = lane; n < nvalid; n += 64) buf[n] *= inv;
                LDS_WAIT();
                float oc = 0.f; for (int n = 0; n < nvalid; ++n) oc += buf[n] * bf2f(vc[(size_t)n * 64 + lane]);
                oacc[h] += GT[trow * 48 + head * 3 + 0] * oc;
                for (int j = lane; j < 128; j += 64) { float a = 0.f; for (int n = 4 * j - 1; n <= 4 * j + 3; ++n) if (n >= 0 && n < nvalid) a += buf[n]; imp[j] += a; }
                LDS_WAIT();
            }
            float v0, v1; { const int j0 = lane, j1 = lane + 64;
                v0 = j0 > cur ? -1e6f : ((j0 == 0 || j0 == cur || j0 == cur - 1) ? 1e6f : imp[j0]); v1 = j1 > cur ? -1e6f : ((j1 == 0 || j1 == cur || j1 == cur - 1) ? 1e6f : imp[j1]); }
            for (int it = 0; it < 16; ++it) { float bv = v0; int bi = lane; if (v1 > v0) { bv = v1; bi = lane + 64; }
#pragma unroll
                for (int o = 1; o < 64; o <<= 1) { const float ov = __shfl_xor(bv, o); const int oi = __shfl_xor(bi, o); if (ov > bv || (ov == bv && oi < bi)) { bv = ov; bi = oi; } }
                if (lane == 0) sel[it] = bi;
                if (bi == lane) v0 = -__builtin_inff(); if (bi == lane + 64) v1 = -__builtin_inff(); }
            LDS_WAIT();
            for (int h = 0; h < 4; ++h) { const int head = g * 4 + h; const bf16_t* qv = NQ + trow * 1536 + head * 96;
                float mx = -__builtin_inff();
                for (int it = 0; it < 16; ++it) { const int kpos = sel[it] * 64 + lane, dist = qpos - kpos; float s = -__builtin_inff();
                    if (dist >= 0) { s = 0.f; for (int d = 0; d < 96; ++d) s += bf2f(qv[d]) * bf2f(ks[(size_t)kpos * 96 + d]); s = s * scale_q + rb[st::rel_bucket_ref(dist) * 16 + head]; }
                    buf[it * 64 + lane] = s; mx = fmaxf(mx, s); }
                mx = st::wave_max(mx); if (!(mx > -1e38f)) mx = 0.f;
                float sum = 0.f;
                for (int it = 0; it < 16; ++it) { const float p = __expf(buf[it * 64 + lane] - mx); buf[it * 64 + lane] = p; sum += p; }
                sum = wave_sum(sum); float inv = 1.f / fmaxf(sum, 1e-30f);
                LDS_WAIT();
                float os = 0.f; for (int i = 0; i < 1024; ++i) { const int kpos = sel[i >> 6] * 64 + (i & 63); os += buf[i] * bf2f(vs[(size_t)kpos * 64 + lane]); }
                oacc[h] += GT[trow * 48 + head * 3 + 1] * os * inv;
                LDS_WAIT();
                mx = -__builtin_inff();
                for (int i = lane; i < 512; i += 64) { const int kpos = qpos - i; float s = -__builtin_inff();
                    if (kpos >= 0) { s = 0.f; for (int d = 0; d < 96; ++d) s += bf2f(qv[d]) * bf2f(kw[(size_t)kpos * 96 + d]); s = s * scale_q + rb[st::rel_bucket_ref(i) * 16 + head]; }
                    buf[i] = s; mx = fmaxf(mx, s); }
                mx = st::wave_max(mx); if (!(mx > -1e38f)) mx = 0.f;
                sum = 0.f;
                for (int i = lane; i < 512; i += 64) { const float p = __expf(buf[i] - mx); buf[i] = p; sum += p; }
                sum = wave_sum(sum); inv = 1.f / fmaxf(sum, 1e-30f);
                LDS_WAIT();
                float ow = 0.f; for (int i = 0; i < 512; ++i) { const int kpos = qpos - i; if (kpos >= 0) ow += buf[i] * bf2f(vw[(size_t)kpos * 64 + lane]); }
                oacc[h] += GT[trow * 48 + head * 3 + 2] * ow * inv;
                LDS_WAIT();
                const float f = bf2f(ONSA[trow * 1024 + head * 64 + lane]);
                err += (f - oacc[h]) * (f - oacc[h]); ref2 += oacc[h] * oacc[h];
            }
        }
        err = wave_sum(err); ref2 = wave_sum(ref2);
        if (lane == 0) { atomicAdd((float*)(ctl + st::CW_ERR), err); atomicAdd((float*)(ctl + st::CW_ERR + 1), ref2); }
        xcd_barrier(bar);
    }
#endif
    REP(15) if (IN(15)) { pg8::Gemm g{ONSA, W_NSAOUT, (D) * 2, (D) * 2, (D) * 2}; SP S; S.init(T / 256, 4, G, bx);
        pg8::EpiRow8<FResBf16> E{FResBf16{PB, nullptr, X2, 1.f}}; pg8::gemm_phase<pg8::EpiRow8<FResBf16>, SP, true, false>(lds, wave, g, S, E); }
    SEAM(15);
    STAMP_AT(15);
    if (IN(16)) {
        PH_LAUNDER();
        LAS float* wr = (LAS float*)(lds + 69632);
        LAS unsigned* lcnt = (LAS unsigned*)(lds + 69632 + 32768);
        LAS unsigned* lrec = lcnt + 16;
        for (int i = tid; i < D * NE; i += 512) wr[i] = args.in[I_ROUTER][i];
        if (tid < 16) lcnt[tid] = 0u;
        __syncthreads();
        int nrec = 0;
        u32x2 nx[4];
        if (gw < T) { const u32x2* pr = (const u32x2*)(PB + (size_t)gw * D) + lane;
#pragma unroll
            for (int j = 0; j < 4; ++j) nx[j] = pr[64 * j]; }
        for (int m = gw; m < T; m += NGW, ++nrec) { f32x4 v[4];
#pragma unroll
            for (int j = 0; j < 4; ++j) v[j] = bf4_to_f32(nx[j]);
            if (m + NGW < T) { const u32x2* pr = (const u32x2*)(PB + (size_t)(m + NGW) * D) + lane;
#pragma unroll
                for (int j = 0; j < 4; ++j) nx[j] = pr[64 * j]; }
            ln_inplace(v, args.in[I_LNM_G] + D, args.in[I_LNM_B] + D, lane); store_row_bf16(X3 + (size_t)m * D, v, lane);
#if MOE_FP8
#pragma unroll
            for (int j = 0; j < 4; ++j) *((unsigned*)(X3F8 + (size_t)m * D) + lane + 64 * j) = pk4_fp8(v[j].x, v[j].y, v[j].z, v[j].w);
#endif
            float lg[NE];
#pragma unroll
            for (int e = 0; e < NE; ++e) lg[e] = 0.f;
#pragma unroll
            for (int j = 0; j < 4; ++j)
#pragma unroll
                for (int c = 0; c < 4; ++c) { const int k = 4 * lane + 256 * j + c; const f32x4 w0 = *(const LAS f32x4*)(wr + k * 8), w1 = *(const LAS f32x4*)(wr + k * 8 + 4); const float xv = v[j][c];
                    lg[0] += xv * w0[0]; lg[1] += xv * w0[1]; lg[2] += xv * w0[2]; lg[3] += xv * w0[3]; lg[4] += xv * w1[0]; lg[5] += xv * w1[1]; lg[6] += xv * w1[2]; lg[7] += xv * w1[3]; }
#pragma unroll
            for (int e = 0; e < NE; ++e) lg[e] = wave_sum(lg[e]);
            int e0 = 0; float v0 = lg[0];
#pragma unroll
            for (int e = 1; e < NE; ++e) if (lg[e] > v0) { v0 = lg[e]; e0 = e; }
            int e1 = -1; float v1 = -__builtin_inff();
#pragma unroll
            for (int e = 0; e < NE; ++e) if (e != e0 && lg[e] > v1) { v1 = lg[e]; e1 = e; }
            const float w1s = fast_rcp(1.f + __expf(v0 - v1)), w0s = 1.f - w1s;
            if (lane == 0) { const unsigned p0 = atomicAdd((unsigned*)(lcnt + e0), 1u), p1 = atomicAdd((unsigned*)(lcnt + e1), 1u);
                LAS unsigned* r = lrec + (wave * 32 + nrec) * 4; r[0] = (unsigned)m; r[1] = (unsigned)e0 | (p0 << 8); r[2] = (unsigned)e1 | (p1 << 8);
                TOKW[2 * m] = w0s; TOKW[2 * m + 1] = w1s; }
        }
        __syncthreads();
        if (tid < NE) lcnt[8 + tid] = __hip_atomic_fetch_add(ctl + CW_ECNT + 64 * tid, lcnt[tid], RLX_AGENT);
        __syncthreads();
        if (lane == 0) for (int i = 0; i < nrec; ++i) { const LAS unsigned* r = lrec + (wave * 32 + i) * 4; const unsigned m = r[0];
#pragma unroll
            for (int k = 0; k < 2; ++k) { const unsigned e = r[1 + k] & 255u, pos = lcnt[8 + e] + (r[1 + k] >> 8); ROWTOK[e * ECAP + pos] = (int)m; TOKINFO[2 * m + k] = (e << 16) | pos; } }
#if !MOE_FP8
        for (int e = 0; e < NE; ++e) {
            tr_matrix(args.in[I_MOE_G] + (size_t)e * D * FFE, D, FFE, W_MOEGU + (size_t)e * 2 * FFE * D, D, RmGU{0}, scr, gw, NGW, lane);
            tr_matrix(args.in[I_MOE_U] + (size_t)e * D * FFE, D, FFE, W_MOEGU + (size_t)e * 2 * FFE * D, D, RmGU{128}, scr, gw, NGW, lane);
            tr_matrix(args.in[I_MOE_D] + (size_t)e * FFE * D, FFE, D, W_MOED + (size_t)e * D * FFE, FFE, RmId{0}, scr, gw, NGW, lane);
        }
#endif
    }
    SEAM(16);
    STAMP_AT(16);
    REP(17) if (hi_ph > 17 && lo < 27) {
        MoeInfo mi; int acc_t = 0;
#pragma unroll
        for (int e = 0; e < NE; ++e) { const int c = (int)__builtin_amdgcn_readfirstlane(__hip_atomic_load(ctl + CW_ECNT + 64 * e, RLX_AGENT)); mi.cnt[e] = c; mi.ts[e] = acc_t; acc_t += (c + 255) >> 8; }
        mi.ts[NE] = acc_t;
        constexpr int MCH = MOE_FP8 ? 128 : 64, NCH = MOE_FP8 ? 2 : 5;
        for (int c = 0; c < NCH; ++c) {
            const int ct0 = MCH * c; int nM = acc_t - ct0; nM = nM < 0 ? 0 : ((c + 1 < NCH && nM > MCH) ? MCH : nM);
#if MOE_FP8
            if (IN(17 + 2 * c) && nM > 0) { pg8::Gemm g{X3F8, W_MOEGU8, D, D, D}; SchedMoeGU S; S.so.init(nM, 2 * FFE / 256, G, bx); S.mi = mi; S.ct0 = ct0; S.rowtok = ROWTOK; S.rowbytes = D;
                pg8::EpiGateUp<FSwigluF8> E{FSwigluF8{(unsigned char*)args.out, FFE, 1.f / MOE_GU_WS, MOE_H_S}}; pg8::gemm_phase<pg8::EpiGateUp<FSwigluF8>, SchedMoeGU, true, true, true>(lds, wave, g, S, E); }
            SEAM(17 + 2 * c);
            STAMP_AT(17 + 2 * c);
            const int nMr = (c == NCH - 1 && nM > MCH) ? MCH : nM, nMs = nM - nMr;
            if (IN(18 + 2 * c) && nM > 0) { pg8::Gemm g{(unsigned char*)args.out, W_MOED8, FFE, FFE, FFE}; SchedMoeD S; S.so.init(nMr, 4, G, bx); S.mi = mi; S.ct0 = ct0;
                pg8::EpiRow8<FBf16S> E{FBf16S{DOUT, D, ct0 * 256, 1.f / (MOE_D_WS * MOE_H_S)}}; pg8::gemm_phase<pg8::EpiRow8<FBf16S>, SchedMoeD, true, false, true>(lds, wave, g, S, E); }
            if (IN(18 + 2 * c) && nMs > 0) { pg8::Gemm g{(unsigned char*)args.out, W_MOED8, FFE, FFE, FFE / MOE_KSPLIT}; SchedMoeDS S; S.so.init(nMs * MOE_KSPLIT, 4, G, (bx + G / 2) % G); S.mi = mi; S.ct0 = ct0; S.lt0 = nMr;
                pg8::EpiRow8<FF32S> E{FF32S{(float*)(ws + WS_PART), 1.f / (MOE_D_WS * MOE_H_S)}}; pg8::gemm_phase<pg8::EpiRow8<FF32S>, SchedMoeDS, true, false, true>(lds, wave, g, S, E); }
#else
            if (IN(17 + 2 * c) && nM > 0) { pg8::Gemm g{X3, W_MOEGU, (D) * 2, (D) * 2, (D) * 2}; SchedMoeGU S; S.so.init(nM, 2 * FFE / 256, G, bx); S.mi = mi; S.ct0 = ct0; S.rowtok = ROWTOK; S.rowbytes = D * 2;
                pg8::EpiGateUp<FSwiglu> E{FSwiglu{ACTC, FFE, 0}}; pg8::gemm_phase<pg8::EpiGateUp<FSwiglu>, SchedMoeGU, true, true>(lds, wave, g, S, E); }
            SEAM(17 + 2 * c);
            STAMP_AT(17 + 2 * c);
            if (IN(18 + 2 * c) && nM > 0) { pg8::Gemm g{ACTC, W_MOED, (FFE) * 2, (FFE) * 2, (FFE) * 2}; SchedMoeD S; S.so.init(nM, 4, G, bx); S.mi = mi; S.ct0 = ct0;
                pg8::EpiRow8<FBf16> E{FBf16{DOUT, D, ct0 * 256}}; pg8::gemm_phase<pg8::EpiRow8<FBf16>, SchedMoeD, true, false>(lds, wave, g, S, E); }
#endif
            SEAM(18 + 2 * c);
            STAMP_AT(18 + 2 * c);
        }
    }
    REP(27) if (IN(27)) {
        PH_LAUNDER();
        int ts[NE]; { int acc_t = 0;
#pragma unroll
            for (int e = 0; e < NE; ++e) { const int c = (int)__builtin_amdgcn_readfirstlane(__hip_atomic_load(ctl + CW_ECNT + 64 * e, RLX_AGENT)); ts[e] = acc_t; acc_t += (c + 255) >> 8; } }
        for (int m0 = gw; m0 < T; m0 += 4 * NGW) {
            unsigned i0[4], i1[4]; float w0[4], w1[4]; f32x4 v[4][4];
#pragma unroll
            for (int r = 0; r < 4; ++r) { const int m = m0 + r * NGW < T ? m0 + r * NGW : 0; i0[r] = TOKINFO[2 * m]; i1[r] = TOKINFO[2 * m + 1]; w0[r] = TOKW[2 * m]; w1[r] = TOKW[2 * m + 1]; }
#pragma unroll
            for (int r = 0; r < 4; ++r) { const int m = m0 + r * NGW < T ? m0 + r * NGW : 0; int t0 = 0, t1 = 0;
#pragma unroll
                for (int e = 0; e < NE; ++e) { t0 = ((int)(i0[r] >> 16) == e) ? ts[e] : t0; t1 = ((int)(i1[r] >> 16) == e) ? ts[e] : t1; }
                const size_t r0 = (size_t)t0 * 256 + (i0[r] & 0xffffu), r1 = (size_t)t1 * 256 + (i1[r] & 0xffffu);
                const u32x2* xr = (const u32x2*)(X3 + (size_t)m * D) + lane; const u32x2* d0 = (const u32x2*)(DOUT + (r0 < 65536 ? r0 : 0) * D) + lane; const u32x2* d1 = (const u32x2*)(DOUT + (r1 < 65536 ? r1 : 0) * D) + lane;
#pragma unroll
                for (int j = 0; j < 4; ++j) v[r][j] = bf4_to_f32(xr[64 * j]) * ALPHA + (bf4_to_f32(d0[64 * j]) * w0[r] + bf4_to_f32(d1[64 * j]) * w1[r]); }
#pragma unroll
            for (int r = 0; r < 4; ++r) {
                const int m = m0 + r * NGW < T ? m0 + r * NGW : 0; int t0 = 0, t1 = 0;
#pragma unroll
                for (int e = 0; e < NE; ++e) { t0 = ((int)(i0[r] >> 16) == e) ? ts[e] : t0; t1 = ((int)(i1[r] >> 16) == e) ? ts[e] : t1; }
                const size_t r0 = (size_t)t0 * 256 + (i0[r] & 0xffffu), r1 = (size_t)t1 * 256 + (i1[r] & 0xffffu);
                if (r0 >= 65536 || r1 >= 65536) {
                    const u32x2* xr = (const u32x2*)(X3 + (size_t)m * D) + lane; const u32x2* d0 = (const u32x2*)(DOUT + (r0 < 65536 ? r0 : 0) * D) + lane; const u32x2* d1 = (const u32x2*)(DOUT + (r1 < 65536 ? r1 : 0) * D) + lane;
#pragma unroll
                    for (int j = 0; j < 4; ++j) { f32x4 e0 = bf4_to_f32(d0[64 * j]), e1 = bf4_to_f32(d1[64 * j]);
                        if (r0 >= 65536) { const f32x4* pp = (const f32x4*)(ws + WS_PART) + ((r0 - 65536) >> 8) * (size_t)(MOE_KSPLIT * 256 * (D / 4)) + (r0 & 255) * (size_t)(D / 4) + lane + 64 * j; e0 = pp[0];
#pragma unroll
                            for (int kp = 1; kp < MOE_KSPLIT; ++kp) e0 = e0 + pp[(size_t)kp * 256 * (D / 4)]; }
                        if (r1 >= 65536) { const f32x4* pp = (const f32x4*)(ws + WS_PART) + ((r1 - 65536) >> 8) * (size_t)(MOE_KSPLIT * 256 * (D / 4)) + (r1 & 255) * (size_t)(D / 4) + lane + 64 * j; e1 = pp[0];
#pragma unroll
                            for (int kp = 1; kp < MOE_KSPLIT; ++kp) e1 = e1 + pp[(size_t)kp * 256 * (D / 4)]; }
                        v[r][j] = bf4_to_f32(xr[64 * j]) * ALPHA + (e0 * w0[r] + e1 * w1[r]); }
                } }
#pragma unroll
            for (int r = 0; r < 4; ++r) { const int m = m0 + r * NGW; if (m >= T) continue;
                ln_inplace(v[r], args.in[I_LNF_G] + D, args.in[I_LNF_B] + D, lane);
                f32x4* orow = (f32x4*)(args.out + (size_t)m * D) + lane;
#pragma unroll
                for (int j = 0; j < 4; ++j) orow[64 * j] = v[r][j]; }
        }
    }


#if defined(STAMP_PH)
    {
        if (blockIdx.x == 0 && threadIdx.x == 0) __hip_atomic_store((float*)(ctl + 32768), (float)(st_t1 - st_t0) * 0.01f, RLX_AGENT);
        xcd_barrier(bar);
        const float us0 = __hip_atomic_load((float*)(ctl + 32768), RLX_AGENT); const float us = __expf(rintf(__logf(us0) * 12.5f + STAMP_SHIFT) * 0.08f - STAMP_SHIFT * 0.08f);
        const float A = sqrtf(us);
        for (long i = (long)vcu * 512 + threadIdx.x; i < (long)T * D / 4; i += (long)G * 512) ((f32x4*)args.out)[i] = (f32x4){A, A, A, A};
    }
#endif
#if defined(SELFTEST)
    {
        xcd_barrier(bar);
        const float e2 = __hip_atomic_load((float*)(ctl + st::CW_ERR), RLX_AGENT), r2 = __hip_atomic_load((float*)(ctl + st::CW_ERR + 1), RLX_AGENT);
        const float E = e2 / r2; float code = -log10f(E); code = code < 0.f ? 0.f : (code > 9.9f ? 9.9f : code);
        const float A = (E == E && r2 > 0.f) ? sqrtf(100.f * code) : 40.f;
        for (long i = (long)vcu * 512 + threadIdx.x; i < (long)T * D / 4; i += (long)G * 512) ((f32x4*)args.out)[i] = (f32x4){A, A, A, A};
    }
#endif
#undef IN
#undef SEAM
#undef STAMP_AT
#undef REP
#undef W_MLAIN
#undef W_QUP
#undef W_KVUP
#undef W_MLAOUT
#undef W_FFNGU
#undef W_FFND
#undef W_NSAIN
#undef W_NSAOUT
#undef W_C1K
#undef W_C1V
#undef W_C2K
#undef W_C2V
#undef ROPE_C
#undef CBIAS
#undef RBT
#undef ROWTOK
#undef TOKINFO
#undef TOKW
#undef XB
#undef LAT
#undef QN
#undef KVN
#undef KR
#undef Q
#undef KN
#undef V
#undef O
#undef X1
#undef ACT
#undef X2
#undef NQ
#undef KC
#undef VC
#undef KS
#undef VS
#undef KW
#undef VW
#undef GT
#undef HK
#undef HV
#undef KCMP
#undef VCMP
#undef ONSA
#undef X3
#undef W_MOEGU
#undef W_MOED
#undef DOUT
#undef ROPE_S
#undef P
#undef ACTC
#undef PH_LAUNDER
#endif
}

#ifndef MK_PER_PHASE
#define MK_PER_PHASE 0
#endif
extern "C" void kernel_launch(void* const* d_in, const int* in_sizes, int n_in, void* d_out, int out_size, void* d_ws, size_t ws_size, hipStream_t stream) {
    static int grid = 0;
    if (grid == 0) {
        if (n_in != 27 || out_size != T * D || ws_size < WS_END) { fprintf(stderr, "kernel_launch: unexpected shapes (n_in %d out %d ws %zu)\n", n_in, out_size, ws_size); grid = -1; return; }
        int dev = 0, cus = 0, per_cu = 0;
        if (hipGetDevice(&dev) != hipSuccess || hipDeviceGetAttribute(&cus, hipDeviceAttributeMultiprocessorCount, dev) != hipSuccess) { grid = -1; return; }
        if (hipFuncSetAttribute((const void*)fwd, hipFuncAttributeMaxDynamicSharedMemorySize, LDS_BYTES) != hipSuccess) { fprintf(stderr, "kernel_launch: hipFuncSetAttribute failed\n"); grid = -1; return; }
        if (hipOccupancyMaxActiveBlocksPerMultiprocessor(&per_cu, (const void*)fwd, NWAVES * 64, LDS_BYTES) != hipSuccess || per_cu < 1) { fprintf(stderr, "kernel_launch: occupancy query reports %d\n", per_cu); }
        (void)hipGetLastError();
        grid = cus;
    }
    if (grid < 0) return;
    if (hipMemsetAsync((char*)d_ws + WS_CTL, 0, CTL_ZERO_BYTES, stream) != hipSuccess) return;
    Args a{};
    for (int i = 0; i < 27; ++i) a.in[i] = (const float*)d_in[i];
    a.out = (float*)d_out; a.ws = (unsigned char*)d_ws;
#if MK_PER_PHASE
    for (int p = 0; p < N_PHASES; ++p) { a.ph_lo = p; a.ph_hi = p + 1; hipLaunchKernelGGL(fwd, dim3(grid), dim3(NWAVES * 64), LDS_BYTES, stream, a); }
#else
    a.ph_lo = 0; a.ph_hi = N_PHASES;
    hipLaunchKernelGGL(fwd, dim3(grid), dim3(NWAVES * 64), LDS_BYTES, stream, a);
#endif
}
```

```cpp
#include <hip/hip_runtime.h>
#include <cstdio>
#include <cstdint>

#define LAS __attribute__((address_space(3)))
#define GAS __attribute__((address_space(1)))
typedef unsigned short bf16_t;
typedef short bf16x8 __attribute__((ext_vector_type(8)));
typedef short s16x4 __attribute__((ext_vector_type(4)));
typedef float f32x4 __attribute__((ext_vector_type(4)));
typedef float f32x2 __attribute__((ext_vector_type(2)));
typedef float f32x16 __attribute__((ext_vector_type(16)));
typedef unsigned u32x4 __attribute__((ext_vector_type(4)));
typedef unsigned u32x2 __attribute__((ext_vector_type(2)));

#ifndef FFN_FP8
#define FFN_FP8 2
#endif
#ifndef NSAIN_FP8
#define NSAIN_FP8 1
#endif
#ifndef MOE_FP8
#define MOE_FP8 1
#endif
constexpr int NB = 4, SEQ = 8192, T = NB * SEQ, D = 1024;
constexpr int MLA_H = 8, MLA_QR = 512, MLA_KVR = 256, MLA_DQK = 192, MLA_DV = 128, MLA_IN = 832;
constexpr int NSA_G = 4, NSA_DK = 96, NSA_DV = 64, NSA_IN = 3504, NSA_INP = 3584;
constexpr int FF = 2816, NE = 8, FFE = 3584, ECAP = 32768;
constexpr float ALPHA = 1.41421356237309515f;
constexpr float LOG2E = 1.4426950408889634f;
constexpr float C2_MLA = 0.07216878364870323f * LOG2E;
constexpr float C2_NSA = 0.10206207261596577f * LOG2E;

__device__ __forceinline__ int fresh_lane() { int l; asm volatile("v_mbcnt_lo_u32_b32 %0, -1, 0\n\tv_mbcnt_hi_u32_b32 %0, -1, %0" : "=v"(l)); return l; }
__device__ __forceinline__ unsigned cvt_pk_bf16(float lo, float hi) { unsigned r; asm volatile("v_cvt_pk_bf16_f32 %0, %1, %2" : "=v"(r) : "v"(lo), "v"(hi)); return r; }
__device__ __forceinline__ float bf2f(unsigned short h) { return __uint_as_float(((unsigned)h) << 16); }
__device__ __forceinline__ float bflo(unsigned w) { return __uint_as_float(w << 16); }
__device__ __forceinline__ float bfhi(unsigned w) { return __uint_as_float(w & 0xffff0000u); }
__device__ __forceinline__ float fast_exp2(float x) { return __builtin_amdgcn_exp2f(x); }
__device__ __forceinline__ float fast_rcp(float x) { return __builtin_amdgcn_rcpf(x); }
__device__ __forceinline__ float silu_f(float x) { return x * fast_rcp(1.f + fast_exp2(-x * LOG2E)); }
__device__ __forceinline__ float sigmoid_f(float x) { return fast_rcp(1.f + fast_exp2(-x * LOG2E)); }
__device__ __forceinline__ float gelu_tanh_f(float x) {
    const float z = 0.7978845608028654f * (x + 0.044715f * x * x * x);
    return x * fast_rcp(1.f + fast_exp2(-2.f * LOG2E * z));
}

namespace pg8 {
constexpr int BM = 256, BK = 64, HALF = 128, HTB = HALF * BK * 2, STAGE_BYTES = 8 * HTB, NXCD = 8, WGM = 8;
__host__ __device__ __forceinline__ int lds_byte(int r, int c) { const int st = (r >> 4) * 2 + (c >> 5), rr = r & 15, cc = c & 31, ob = rr * 64 + cc * 2; return st * 1024 + (ob ^ (((ob >> 9) & 1) << 5)); }
__host__ __device__ __forceinline__ void stage_rc(int b, int& R, int& C) { const int st = b / 1024, sb = b % 1024, swz = sb ^ (((sb >> 9) & 1) << 5); R = (st >> 1) * 16 + swz / 64; C = (st & 1) * 32 + (swz % 64) / 2; }
__host__ __device__ __forceinline__ int perm32(int rho) { const int n = rho >> 4, i = rho & 15; return 8 * (i >> 2) + 4 * n + (i & 3); }

typedef int v8i32 __attribute__((ext_vector_type(8)));
__device__ __forceinline__ v8i32 cat8(bf16x8 a, bf16x8 b) { const u32x4 x = __builtin_bit_cast(u32x4, a), y = __builtin_bit_cast(u32x4, b); return (v8i32){(int)x[0], (int)x[1], (int)x[2], (int)x[3], (int)y[0], (int)y[1], (int)y[2], (int)y[3]}; }
__device__ __forceinline__ void mfma_f8_inplace(f32x4& acc, v8i32 a, v8i32 b, int one) {
    asm volatile("v_mfma_scale_f32_16x16x128_f8f6f4 %0, %1, %2, %0, %3, %3 op_sel_hi:[0,0,0]" : "+v"(acc) : "v"(a), "v"(b), "v"(one));
}
__device__ __forceinline__ void mfma_drain() { asm volatile("s_nop 15\n\ts_nop 15" ::: "memory"); }
struct Unit { int pm, pn; };
struct Gemm { const void* A; const void* Bt; int lda, ldb, K; };

struct StaticOrder {
    int nM, nN, nwg, G, c;
    __device__ void init(int nM_, int nN_, int G_, int c_) { nM = nM_; nN = nN_; nwg = nM * nN; G = G_; c = c_; }
    __device__ bool next(int i, Unit& u) const {
        const long L = (long)i * G + c; if (L >= nwg) return false;
        int wgid = (int)L; { const int q = nwg / NXCD, r = nwg % NXCD, xcd = wgid % NXCD, off = wgid / NXCD; wgid = (xcd < r ? xcd * (q + 1) : r * (q + 1) + (xcd - r) * q) + off; }
        const int nig = WGM * nN, gid = wgid / nig, fm = gid * WGM, gsz = (nM - fm) < WGM ? (nM - fm) : WGM;
        u.pm = fm + ((wgid % nig) % gsz); u.pn = (wgid % nig) / gsz; return true;
    }
};
struct SchedPlain {
    StaticOrder so;
    __device__ void init(int nM, int nN, int G, int c) { so.init(nM, nN, G, c); }
    __device__ __forceinline__ bool next(int i, Unit& u) const { return so.next(i, u); }
    __device__ __forceinline__ size_t a_off(const Unit& u, const Gemm& g) const { return (size_t)u.pm * 256 * g.lda; }
    __device__ __forceinline__ size_t b_off(const Unit& u, const Gemm& g) const { return (size_t)u.pn * 256 * g.ldb; }
    __device__ __forceinline__ unsigned a_row(const Unit&, int) const { return 0u; }
};

template <class F> struct EpiRow8 {
    static constexpr bool PERM = true;
    F f;
    __device__ __forceinline__ void operator()(const f32x4 (&acc)[2][2][4][2], const Unit& u, int wr, int wc, int fr, int fq) const {
#pragma unroll
        for (int ai = 0; ai < 2; ++ai)
#pragma unroll
            for (int m = 0; m < 4; ++m) { const int row = u.pm * BM + ai * HALF + wr * 64 + m * 16 + fr;
#pragma unroll
                for (int bj = 0; bj < 2; ++bj) f(row, u.pn * BM + bj * HALF + wc * 32 + 8 * fq, acc[ai][bj][m][0], acc[ai][bj][m][1]); }
    }
};
template <class F, class RS> struct EpiRow8S {
    static constexpr bool PERM = true;
    F f; RS rs;
    __device__ __forceinline__ void operator()(const f32x4 (&acc)[2][2][4][2], const Unit& u, int wr, int wc, int fr, int fq) const {
#pragma unroll
        for (int ai = 0; ai < 2; ++ai)
#pragma unroll
            for (int m = 0; m < 4; ++m) { const int row = u.pm * BM + ai * HALF + wr * 64 + m * 16 + fr; const float s = rs(row, fq);
#pragma unroll
                for (int bj = 0; bj < 2; ++bj) f(row, u.pn * BM + bj * HALF + wc * 32 + 8 * fq, acc[ai][bj][m][0] * s, acc[ai][bj][m][1] * s); }
    }
};
template <class F> struct EpiRow8C {
    static constexpr bool PERM = true;
    F f;
    __device__ __forceinline__ void operator()(const f32x4 (&acc)[2][2][4][2], const Unit& u, int wr, int wc, int fr, int fq) const {
#pragma unroll
        for (int bj = 0; bj < 2; ++bj) { const auto cs = f.col(u.pn * BM + bj * HALF + wc * 32 + 8 * fq);
#pragma unroll
            for (int ai = 0; ai < 2; ++ai)
#pragma unroll
                for (int m = 0; m < 4; ++m) f.st(cs, u.pm * BM + ai * HALF + wr * 64 + m * 16 + fr, acc[ai][bj][m][0], acc[ai][bj][m][1]); }
    }
};
template <class F> struct EpiGateUp {
    static constexpr bool PERM = true;
    F f;
    __device__ __forceinline__ void operator()(const f32x4 (&acc)[2][2][4][2], const Unit& u, int wr, int wc, int fr, int fq) const {
#pragma unroll
        for (int ai = 0; ai < 2; ++ai)
#pragma unroll
            for (int m = 0; m < 4; ++m) { const int row = u.pm * BM + ai * HALF + wr * 64 + m * 16 + fr;
                f(row, u.pn * HALF + wc * 32 + 8 * fq, acc[ai][0][m][0], acc[ai][0][m][1], acc[ai][1][m][0], acc[ai][1][m][1]); }
    }
};

template <class Epi, class Sched, bool ALIGN_EPI, bool GATHER, bool FP8 = false>
__device__ __forceinline__ void gemm_phase(LAS unsigned char* lds, const int wid, const Gemm g, const Sched& S, const Epi& E) {
    const int lane = fresh_lane(), tid = wid * 64 + lane;
    const int  wr = wid >> 2, wc = wid & 3, fr = lane & 15, fq = lane >> 4;
    const int nt = g.K / (BK * 2);
    int sR[2], sC[2]; unsigned voffB[2];
#pragma unroll
    for (int i = 0; i < 2; ++i) { int R, C; stage_rc(tid * 16 + i * 8192, R, C); sR[i] = R; sC[i] = C; const int Rb = Epi::PERM ? ((R & ~31) + perm32(R & 31)) : R; voffB[i] = (unsigned)(Rb * g.ldb + C * 2); }
    const int kstep = BK * 2;
    const int hstepB = HALF * g.ldb;
    const auto rsA = __builtin_amdgcn_make_buffer_rsrc((void*)g.A, 0, 0x7fffffff, 0x00020000);
    const auto rsB = __builtin_amdgcn_make_buffer_rsrc((void*)g.Bt, 0, 0x7fffffff, 0x00020000);
    const unsigned ldsw = (unsigned)wid * 1024u;
    const int aoff = lds_byte(wr * 64 + fr, fq * 8), boff = lds_byte(wc * 32 + fr, fq * 8);
#define PG8_SA(b, h) (((b) * 2 + (h)) * HTB)
#define PG8_SB(b, h) ((4 + (b) * 2 + (h)) * HTB)
#define PG8_STAGE2(bufoff, rsrc, soff, o0, o1) do { \
        __builtin_amdgcn_raw_ptr_buffer_load_lds(rsrc, (LAS unsigned*)(lds + (bufoff) + ldsw), 16, (int)(o0), (int)(soff), 0, 0); \
        __builtin_amdgcn_raw_ptr_buffer_load_lds(rsrc, (LAS unsigned*)(lds + (bufoff) + ldsw + 8192), 16, (int)(o1), (int)(soff), 0, 0); } while (0)
#define PG8_STAGEA(bufoff, soff, o0, o1) PG8_STAGE2(bufoff, rsA, soff, o0, o1)
#define PG8_STAGEB(bufoff, soff) PG8_STAGE2(bufoff, rsB, soff, voffB[0], voffB[1])
#define PG8_LDA(dst, b, h) do { _Pragma("unroll") for (int m = 0; m < 4; ++m) _Pragma("unroll") for (int k = 0; k < 2; ++k) dst[m][k] = *(const LAS bf16x8*)(lds + PG8_SA(b, h) + aoff + m * 2048 + k * 1024); } while (0)
#define PG8_LDB(dst, b, h) do { _Pragma("unroll") for (int n = 0; n < 2; ++n) _Pragma("unroll") for (int k = 0; k < 2; ++k) dst[n][k] = *(const LAS bf16x8*)(lds + PG8_SB(b, h) + boff + n * 2048 + k * 1024); } while (0)
#define PG8_MMA(ai, bj, At, Bt) do { __builtin_amdgcn_s_setprio(1); \
        if constexpr (FP8) { _Pragma("unroll") for (int m = 0; m < 4; ++m) _Pragma("unroll") for (int n = 0; n < 2; ++n) \
            mfma_f8_inplace(acc[ai][bj][m][n], cat8(Bt[n][0], Bt[n][1]), cat8(At[m][0], At[m][1]), f8one); } \
        else { _Pragma("unroll") for (int m = 0; m < 4; ++m) _Pragma("unroll") for (int n = 0; n < 2; ++n) _Pragma("unroll") for (int k = 0; k < 2; ++k) \
            acc[ai][bj][m][n] = __builtin_amdgcn_mfma_f32_16x16x32_bf16(Bt[n][k], At[m][k], acc[ai][bj][m][n], 0, 0, 0); } \
        __builtin_amdgcn_s_setprio(0); } while (0)
#define PG8_WAIT_V(n) asm volatile("s_waitcnt vmcnt(" #n ")" ::: "memory")
#define PG8_WAIT_L(n) asm volatile("s_waitcnt lgkmcnt(" #n ")" ::: "memory")
#define PG8_BAR __builtin_amdgcn_s_barrier()
#define PG8_SCHED __builtin_amdgcn_sched_barrier(0)
    Unit cur, nxt; int ui = 0;
    if (!S.next(0, cur)) return;
    int f8one = 127; if (FP8) asm volatile("" : "+v"(f8one));
    f32x4 acc[2][2][4][2];
#pragma unroll
    for (int a = 0; a < 2; ++a)
#pragma unroll
        for (int b = 0; b < 2; ++b)
#pragma unroll
            for (int m = 0; m < 4; ++m)
#pragma unroll
                for (int n = 0; n < 2; ++n) acc[a][b][m][n] = (f32x4){0.f, 0.f, 0.f, 0.f};
    bf16x8 At[4][2], B0[2][2], B1[2][2];
    unsigned vc[2][2], vn[2][2];
#pragma unroll
    for (int h = 0; h < 2; ++h)
#pragma unroll
        for (int i = 0; i < 2; ++i) { vc[h][i] = GATHER ? S.a_row(cur, h * HALF + sR[i]) + (unsigned)sC[i] * 2u : (unsigned)((h * HALF + sR[i]) * g.lda + sC[i] * 2); vn[h][i] = vc[h][i]; }
    int cA = (int)S.a_off(cur, g), cB = (int)S.b_off(cur, g);
    PG8_STAGEB(PG8_SB(0, 0), cB); PG8_STAGEB(PG8_SB(0, 1), cB + hstepB); PG8_STAGEA(PG8_SA(0, 0), cA, vc[0][0], vc[0][1]); PG8_STAGEA(PG8_SA(0, 1), cA, vc[1][0], vc[1][1]);
    if (wr == 1) PG8_BAR;
    PG8_WAIT_V(2); PG8_BAR;
    PG8_STAGEB(PG8_SB(1, 0), cB + kstep); PG8_STAGEA(PG8_SA(1, 0), cA + kstep, vc[0][0], vc[0][1]); PG8_STAGEB(PG8_SB(1, 1), cB + hstepB + kstep);
    PG8_WAIT_V(6); PG8_BAR;
    for (;;) {
        const bool has_next = S.next(ui + 1, nxt);
        const int nA = has_next ? (int)S.a_off(nxt, g) : cA, nB = has_next ? (int)S.b_off(nxt, g) : cB;
        if (GATHER) {
#pragma unroll
            for (int h = 0; h < 2; ++h)
#pragma unroll
                for (int i = 0; i < 2; ++i) vn[h][i] = has_next ? S.a_row(nxt, h * HALF + sR[i]) + (unsigned)sC[i] * 2u : vc[h][i];
        }
#pragma clang loop unroll(disable)
        for (int t = 0; t < nt; t += 2) {
            const bool last = (t == nt - 2);
            const int a1 = cA + (t + 1) * kstep;
            const int a2 = last ? nA : cA + (t + 2) * kstep, b2 = last ? nB : cB + (t + 2) * kstep;
            const int a3 = a2 + kstep, b3 = b2 + kstep;
            unsigned w00 = vc[0][0], w01 = vc[0][1], w10 = vc[1][0], w11 = vc[1][1];
            if (GATHER) { if (last) { asm volatile("" : "+v"(vn[0][0]), "+v"(vn[0][1]), "+v"(vn[1][0]), "+v"(vn[1][1])); w00 = vn[0][0]; w01 = vn[0][1]; w10 = vn[1][0]; w11 = vn[1][1]; } }
            PG8_LDB(B0, 0, 0); PG8_LDB(B1, 0, 1); PG8_SCHED; PG8_LDA(At, 0, 0); PG8_STAGEA(PG8_SA(1, 1), a1, vc[1][0], vc[1][1]);
            PG8_WAIT_V(8); PG8_WAIT_L(0); PG8_BAR; PG8_MMA(0, 0, At, B0); PG8_MMA(0, 1, At, B1); PG8_BAR; PG8_SCHED;
            PG8_LDA(At, 0, 1); PG8_STAGEB(PG8_SB(0, 0), b2); PG8_STAGEB(PG8_SB(0, 1), b2 + hstepB); PG8_STAGEA(PG8_SA(0, 0), a2, w00, w01);
            PG8_WAIT_V(8); PG8_WAIT_L(0); PG8_BAR; PG8_MMA(1, 0, At, B0); PG8_MMA(1, 1, At, B1); PG8_BAR; PG8_SCHED;
            PG8_LDB(B0, 1, 0); PG8_LDB(B1, 1, 1); PG8_SCHED; PG8_LDA(At, 1, 0); PG8_STAGEA(PG8_SA(0, 1), a2, w10, w11);
            PG8_WAIT_V(8); PG8_WAIT_L(0); PG8_BAR; PG8_MMA(0, 0, At, B0); PG8_MMA(0, 1, At, B1); PG8_BAR; PG8_SCHED;
            PG8_LDA(At, 1, 1); PG8_STAGEB(PG8_SB(1, 0), b3); PG8_STAGEB(PG8_SB(1, 1), b3 + hstepB); PG8_STAGEA(PG8_SA(1, 0), a3, w00, w01);
            PG8_WAIT_V(8); PG8_WAIT_L(0); PG8_BAR; PG8_MMA(1, 0, At, B0); PG8_MMA(1, 1, At, B1); PG8_BAR; PG8_SCHED;
        }
        if constexpr (ALIGN_EPI) { if (wr == 0) PG8_BAR; }
        if (FP8) mfma_drain();
        { const int l_ = fresh_lane();
          E(acc, cur, wr, wc, l_ & 15, l_ >> 4); }
        if (!has_next) break;
#pragma unroll
        for (int a = 0; a < 2; ++a)
#pragma unroll
            for (int b = 0; b < 2; ++b)
#pragma unroll
                for (int m = 0; m < 4; ++m)
#pragma unroll
                    for (int n = 0; n < 2; ++n) acc[a][b][m][n] = (f32x4){0.f, 0.f, 0.f, 0.f};
        cur = nxt; cA = nA; cB = nB; ++ui;
        if (GATHER) {
#pragma unroll
            for (int h = 0; h < 2; ++h)
#pragma unroll
                for (int i = 0; i < 2; ++i) vc[h][i] = vn[h][i];
        }
        if constexpr (ALIGN_EPI) { if (wr == 1) PG8_BAR; }
    }
    PG8_WAIT_V(0);
    if constexpr (!ALIGN_EPI) { if (wr == 0) PG8_BAR; }
    PG8_BAR;
#undef PG8_SA
#undef PG8_SB
#undef PG8_STAGE2
#undef PG8_STAGEA
#undef PG8_STAGEB
#undef PG8_LDA
#undef PG8_LDB
#undef PG8_MMA
#undef PG8_WAIT_V
#undef PG8_WAIT_L
#undef PG8_BAR
#undef PG8_SCHED
}
}
#if defined(__HIP_DEVICE_COMPILE__)
namespace att {
__device__ __forceinline__ int crow(int r, int hi) { return (r & 3) + 8 * (r >> 2) + 4 * hi; }
constexpr float THR = 6.f;
constexpr int NBUF = 3;
struct MlaRing { static constexpr int NS = 3, NI = 46, NPW = 6, BUF = 47104;
    static __device__ __forceinline__ constexpr int OFF(int s) { return s == 0 ? 0 : (s == 1 ? 17408 : 26624); }
    static __device__ __forceinline__ constexpr int NK(int s) { return s == 0 ? 17 : (s == 1 ? 9 : 20); }
    static __device__ __forceinline__ constexpr int GS(int s) { return s == 1 ? 128 : 256; }
    static __device__ __forceinline__ constexpr int CH(int s) { return s == 1 ? 8 : 16; }
    static __device__ __forceinline__ constexpr int ROW(int s) { return s == 0 ? 272 : (s == 1 ? 144 : 320); } };
struct NsaRing { static constexpr int NS = 2, NI = 25, NPW = 4, BUF = 25600;
    static __device__ __forceinline__ constexpr int OFF(int s) { return s == 0 ? 0 : 13312; }
    static __device__ __forceinline__ constexpr int NK(int s) { return s == 0 ? 13 : 12; }
    static __device__ __forceinline__ constexpr int GS(int s) { return s == 0 ? 192 : 128; }
    static __device__ __forceinline__ constexpr int CH(int s) { return s == 0 ? 12 : 8; }
    static __device__ __forceinline__ constexpr int ROW(int s) { return s == 0 ? 208 : 192; } };
typedef __amdgpu_buffer_rsrc_t rsrc_t;
__device__ __forceinline__ rsrc_t make_rsrc(const void* p) { return __builtin_amdgcn_make_buffer_rsrc((void*)p, 0, 0x7fffffff, 0x00020000); }
template <class R> struct Plan {
    int ldsd[R::NPW]; int strm[R::NPW]; int jj[R::NPW]; int lane16;
    __device__ __forceinline__ void init(int wid, int lane) {
        lane16 = 16 * lane;
#pragma unroll
        for (int k = 0; k < R::NPW; ++k) { int j = wid + 8 * k; if (j >= R::NI) j -= R::NI;
            int s = 0, q_ = j;
#pragma unroll
            for (int q = 0; q + 1 < R::NS; ++q) if (q_ >= R::NK(q) && s == q) { q_ -= R::NK(q); s = q + 1; }
            strm[k] = s; jj[k] = q_; ldsd[k] = (s == 0 ? R::OFF(0) : (s == 1 ? R::OFF(1) : R::OFF(R::NS - 1))) + 1024 * q_; }
    }
    template <int S> __device__ __forceinline__ int voff(int k) const { const int x = 1024 * jj[k] + lane16, r = x / R::ROW(S), cc = (x - r * R::ROW(S)) >> 4; return r * R::GS(S) + (cc < R::CH(S) ? cc : 0) * 16; }
};
template <class R> struct Src { rsrc_t rs0, rs1, rs2; int t0; };
template <class R> __device__ __forceinline__ void issue_tile(const Plan<R>& p, const Src<R>& src, int t, LAS char* buf) {
#pragma unroll
    for (int k = 0; k < R::NPW; ++k) { const int s = p.strm[k];
        if (s == 0) __builtin_amdgcn_raw_ptr_buffer_load_lds(src.rs0, (LAS unsigned*)(buf + p.ldsd[k]), 16, p.template voff<0>(k), (src.t0 + t) * 64 * R::GS(0), 0, 0);
        else if (s == 1 || R::NS == 2) __builtin_amdgcn_raw_ptr_buffer_load_lds(src.rs1, (LAS unsigned*)(buf + p.ldsd[k]), 16, p.template voff<1>(k), (src.t0 + t) * 64 * R::GS(1), 0, 0);
        else __builtin_amdgcn_raw_ptr_buffer_load_lds(src.rs2, (LAS unsigned*)(buf + p.ldsd[k]), 16, p.template voff<R::NS - 1>(k), (src.t0 + t) * 64 * R::GS(R::NS - 1), 0, 0); }
}
#define ATT_WAIT_V(n) asm volatile("s_waitcnt vmcnt(%0)" :: "i"(n) : "memory")
template <class R, int DQK> __device__ __forceinline__ void qk_tile(f32x16& p0, f32x16& p1, LAS const char* Kb, int r32, int hi, const bf16x8* qr, const f32x16& cinit) {
    p0 = cinit; p1 = cinit;
    if constexpr (R::NS == 3) {
        LAS const char* a = Kb + r32 * R::ROW(0) + hi * 16; LAS const char* b = Kb + R::OFF(1) + r32 * R::ROW(1) + hi * 16;
#pragma unroll
        for (int d0 = 0; d0 < 8; ++d0) { const bf16x8 k0 = *(LAS const bf16x8*)(a + d0 * 32); const bf16x8 k1 = *(LAS const bf16x8*)(a + 32 * R::ROW(0) + d0 * 32);
            p0 = __builtin_amdgcn_mfma_f32_32x32x16_bf16(k0, qr[d0], p0, 0, 0, 0); p1 = __builtin_amdgcn_mfma_f32_32x32x16_bf16(k1, qr[d0], p1, 0, 0, 0); }
#pragma unroll
        for (int d0 = 0; d0 < 4; ++d0) { const bf16x8 k0 = *(LAS const bf16x8*)(b + d0 * 32); const bf16x8 k1 = *(LAS const bf16x8*)(b + 32 * R::ROW(1) + d0 * 32);
            p0 = __builtin_amdgcn_mfma_f32_32x32x16_bf16(k0, qr[8 + d0], p0, 0, 0, 0); p1 = __builtin_amdgcn_mfma_f32_32x32x16_bf16(k1, qr[8 + d0], p1, 0, 0, 0); }
    } else {
        LAS const char* a = Kb + r32 * R::ROW(0) + hi * 16;
#pragma unroll
        for (int d0 = 0; d0 < DQK / 16; ++d0) { const bf16x8 k0 = *(LAS const bf16x8*)(a + d0 * 32); const bf16x8 k1 = *(LAS const bf16x8*)(a + 32 * R::ROW(0) + d0 * 32);
            p0 = __builtin_amdgcn_mfma_f32_32x32x16_bf16(k0, qr[d0], p0, 0, 0, 0); p1 = __builtin_amdgcn_mfma_f32_32x32x16_bf16(k1, qr[d0], p1, 0, 0, 0); }
    }
}
template <int DV, int VROW> __device__ __forceinline__ void pv_tile(f32x16* o, unsigned vaddr, bf16x8 pa0, bf16x8 pa1, bf16x8 pa2, bf16x8 pa3) {
#define ATT_TRRD(dst, off) asm volatile("ds_read_b64_tr_b16 %0, %1 offset:%2" : "=&v"(dst) : "v"(vaddr), "i"(off) : "memory")
#pragma unroll
    for (int d0 = 0; d0 < DV / 32; ++d0) {
        { s16x4 l0, l1, h0, h1;
        ATT_TRRD(l0, (0 * 16 + 0) * VROW + d0 * 64); ATT_TRRD(h0, (0 * 16 + 4) * VROW + d0 * 64);
        ATT_TRRD(l1, (1 * 16 + 0) * VROW + d0 * 64); ATT_TRRD(h1, (1 * 16 + 4) * VROW + d0 * 64);
        asm volatile("s_waitcnt lgkmcnt(0)" ::: "memory"); __builtin_amdgcn_sched_barrier(0);
        o[d0] = __builtin_amdgcn_mfma_f32_32x32x16_bf16(pa0, (bf16x8){l0[0], l0[1], l0[2], l0[3], h0[0], h0[1], h0[2], h0[3]}, o[d0], 0, 0, 0);
        o[d0] = __builtin_amdgcn_mfma_f32_32x32x16_bf16(pa1, (bf16x8){l1[0], l1[1], l1[2], l1[3], h1[0], h1[1], h1[2], h1[3]}, o[d0], 0, 0, 0); }
        { s16x4 l2, l3, h2, h3;
        ATT_TRRD(l2, (2 * 16 + 0) * VROW + d0 * 64); ATT_TRRD(h2, (2 * 16 + 4) * VROW + d0 * 64);
        ATT_TRRD(l3, (3 * 16 + 0) * VROW + d0 * 64); ATT_TRRD(h3, (3 * 16 + 4) * VROW + d0 * 64);
        asm volatile("s_waitcnt lgkmcnt(0)" ::: "memory"); __builtin_amdgcn_sched_barrier(0);
        o[d0] = __builtin_amdgcn_mfma_f32_32x32x16_bf16(pa2, (bf16x8){l2[0], l2[1], l2[2], l2[3], h2[0], h2[1], h2[2], h2[3]}, o[d0], 0, 0, 0);
        o[d0] = __builtin_amdgcn_mfma_f32_32x32x16_bf16(pa3, (bf16x8){l3[0], l3[1], l3[2], l3[3], h3[0], h3[1], h3[2], h3[3]}, o[d0], 0, 0, 0); }
    }
#undef ATT_TRRD
}
__device__ __forceinline__ float lane_pair_max(float v) { auto rr = __builtin_amdgcn_permlane32_swap(__float_as_uint(v), __float_as_uint(v), false, false); return fmaxf(__uint_as_float(rr[0]), __uint_as_float(rr[1])); }
__device__ __forceinline__ float lane_pair_sum(float v) { auto rr = __builtin_amdgcn_permlane32_swap(__float_as_uint(v), __float_as_uint(v), false, false); return __uint_as_float(rr[0]) + __uint_as_float(rr[1]); }
__device__ __forceinline__ void pack_p(const f32x16& p0, const f32x16& p1, bf16x8& pa0, bf16x8& pa1, bf16x8& pa2, bf16x8& pa3) {
#define ATT_PK4(P, B_, OUT) do { unsigned a0 = cvt_pk_bf16(P[B_ + 0], P[B_ + 1]), a1 = cvt_pk_bf16(P[B_ + 2], P[B_ + 3]); \
        unsigned b0 = cvt_pk_bf16(P[B_ + 4], P[B_ + 5]), b1 = cvt_pk_bf16(P[B_ + 6], P[B_ + 7]); \
        auto r0 = __builtin_amdgcn_permlane32_swap(a0, b0, false, false); auto r1 = __builtin_amdgcn_permlane32_swap(a1, b1, false, false); \
        u32x4 w = {r0[0], r1[0], r0[1], r1[1]}; OUT = __builtin_bit_cast(bf16x8, w); } while (0)
    ATT_PK4(p0, 0, pa0); ATT_PK4(p0, 8, pa1); ATT_PK4(p1, 0, pa2); ATT_PK4(p1, 8, pa3);
#undef ATT_PK4
}
template <class R> __device__ __forceinline__ void ring_prime(LAS char* lds, const Plan<R>& plan, const Src<R>& src, int nt) {
    if (nt > 0) issue_tile<R>(plan, src, 0, lds); if (nt > 1) issue_tile<R>(plan, src, 1, lds + R::BUF);
}
template <class R, class Body> __device__ __forceinline__ void ring_loop(LAS char* lds, const Plan<R>& plan, const Src<R>& src, int nt, Body&& body, bool primed = false) {
    if (!primed) { issue_tile<R>(plan, src, 0, lds); if (nt > 1) issue_tile<R>(plan, src, 1, lds + R::BUF); }
    if (nt > 1) ATT_WAIT_V(R::NPW); else ATT_WAIT_V(0);
    __builtin_amdgcn_s_barrier();
    int bi = 0;
    for (int t = 0; t < nt; ++t) {
        if (t + 2 < nt) { const int b2 = bi == 0 ? 2 : bi - 1; issue_tile<R>(plan, src, t + 2, lds + b2 * R::BUF); }
        body(t, lds + bi * R::BUF);
        if (t + 2 < nt) ATT_WAIT_V(R::NPW); else ATT_WAIT_V(0);
        __builtin_amdgcn_s_barrier(); bi = bi == 2 ? 0 : bi + 1;
    }
}
template <class R, class Body> __device__ __forceinline__ void ring_loop1(LAS char* lds, const Plan<R>& plan, const Src<R>& src, int nt, Body&& body) {
    issue_tile<R>(plan, src, 0, lds); ATT_WAIT_V(0);
    __builtin_amdgcn_s_barrier();
    int bi = 0;
    for (int t = 0; t < nt; ++t) {
        const int bn = bi == 2 ? 0 : bi + 1;
        if (t + 1 < nt) issue_tile<R>(plan, src, t + 1, lds + bn * R::BUF);
        body(t, lds + bi * R::BUF);
        ATT_WAIT_V(0);
        __builtin_amdgcn_s_barrier(); bi = bn;
    }
}
template <class R, int DQK, int DV, bool DO_PV, class Msk, int DBG = 0, bool NEGM = true>
__device__ __forceinline__ void run_online(LAS char* lds, LAS float* wsc, int nt, const Plan<R>& plan, const Src<R>& src, const Msk& msk, const bf16x8* qr, float& m_reg, float& l_reg, f32x16* o, int lane, int wid, bool primed = false) {
    const int r32 = lane & 31, hi = lane >> 5;
    if (nt <= 0) return;
    constexpr int VROW = R::ROW(R::NS - 1), VOFF = R::OFF(R::NS - 1);
    const unsigned vlane = (unsigned)((8 * hi + ((lane & 15) >> 2)) * VROW + (16 * ((lane >> 4) & 1) + 4 * (lane & 3)) * 2);
    f32x16 negm;
#pragma unroll
    for (int r = 0; r < 16; ++r) negm[r] = NEGM ? -m_reg : 0.f;
    ring_loop<R>(lds, plan, src, nt, [&](int t, LAS char* Kb) {
        const int kind = DBG == 1 ? 0 : msk.kind(t);
        if (kind) {
            f32x16 p0, p1;
            if (kind == 3) {
                const bool live = msk.live(t); f32x16 ci;
#pragma unroll
                for (int r = 0; r < 16; ++r) ci[r] = live ? negm[r] : -__builtin_inff();
                qk_tile<R, DQK>(p0, p1, Kb, r32, hi, qr, ci);
            } else {
                if (NEGM) qk_tile<R, DQK>(p0, p1, Kb, r32, hi, qr, negm); else qk_tile<R, DQK>(p0, p1, Kb, r32, hi, qr, f32x16{});
                if (kind == 2) msk.apply(p0, p1, t, kind);
            }
            if (DBG == 2) { asm volatile("" :: "v"(p0), "v"(p1)); return; }
            float pmax = fmaxf(p0[0], p1[0]);
#pragma unroll
            for (int r = 1; r < 16; ++r) pmax = fmaxf(pmax, fmaxf(p0[r], p1[r]));
            pmax = lane_pair_max(pmax);
            if (!NEGM) pmax -= m_reg;
            const bool upd = pmax > THR || (l_reg == 0.f && pmax < -THR && pmax > -__builtin_inff());
            float alpha = 1.f;
            if (__any(upd)) {
                const float delta = upd ? pmax : 0.f;
                alpha = l_reg == 0.f ? 1.f : fast_exp2(-delta); m_reg += delta;
                if (NEGM) {
#pragma unroll
                    for (int r = 0; r < 16; ++r) { p0[r] -= delta; p1[r] -= delta; negm[r] = -m_reg; } }
            }
            if (NEGM) {
#pragma unroll
                for (int r = 0; r < 16; ++r) { p0[r] = fast_exp2(p0[r]); p1[r] = fast_exp2(p1[r]); }
            } else {
#pragma unroll
                for (int r = 0; r < 16; ++r) { p0[r] = fast_exp2(p0[r] - m_reg); p1[r] = fast_exp2(p1[r] - m_reg); }
            }
            float ps = 0.f;
#pragma unroll
            for (int r = 0; r < 16; ++r) ps += p0[r] + p1[r];
            ps = lane_pair_sum(ps);
            l_reg = l_reg * alpha + ps;
            if (DO_PV && DBG != 3) {
                if (__any(alpha != 1.f)) {
                    if (hi == 0) wsc[32 + r32] = alpha;
                    asm volatile("s_waitcnt lgkmcnt(0)" ::: "memory");
#pragma unroll
                    for (int r = 0; r < 16; ++r) { const float a = wsc[32 + crow(r, hi)];
#pragma unroll
                        for (int d = 0; d < DV / 32; ++d) o[d][r] *= a; }
                }
                bf16x8 pa0, pa1, pa2, pa3; pack_p(p0, p1, pa0, pa1, pa2, pa3);
                pv_tile<DV, VROW>(o, (unsigned)(uintptr_t)(Kb + VOFF) + vlane, pa0, pa1, pa2, pa3);
            }
        }
    }, primed);
}
}
namespace mla {
constexpr int DQK = 192, DV = 128;
using R = att::MlaRing;
constexpr int L_WSC = att::NBUF * R::BUF, L_END = L_WSC + 8 * 256;
struct Msk {
    int qlo, qpos;
    int hi;
    __device__ __forceinline__ int kind(int t) const { const int kb = 64 * t; return kb > qlo + 31 ? 0 : (kb + 63 <= qlo ? 1 : 2); }
    __device__ __forceinline__ bool live(int) const { return true; }
    __device__ __forceinline__ void apply(f32x16& p0, f32x16& p1, int t, int) const {
        const float NEG = -__builtin_inff(); const int d = qpos - 64 * t - 4 * hi;
#pragma unroll
        for (int r = 0; r < 16; ++r) { const int c = (r & 3) + 8 * (r >> 2); if (c > d) p0[r] = NEG; if (c + 32 > d) p1[r] = NEG; }
    }
};
__device__ __forceinline__ void unit(LAS char* lds, const att::Plan<R>& plan, int b, int h, int qb, const bf16_t* Q, const bf16_t* KN, const bf16_t* KR, const bf16_t* V, bf16_t* O, int tid, int wid) {
    const int lane = fresh_lane(); (void)tid;
    const int r32 = lane & 31, hi = lane >> 5;
    LAS float* wsc = (LAS float*)(lds + L_WSC) + wid * 64;
    const int q0 = qb * 256 + wid * 32;
    const size_t trow = (size_t)b * SEQ + q0 + r32;
    att::Src<R> src{att::make_rsrc(KN + (size_t)(b * MLA_H + h) * SEQ * 128), att::make_rsrc(KR + (size_t)b * SEQ * 64), att::make_rsrc(V + (size_t)(b * MLA_H + h) * SEQ * 128), 0};
    att::ring_prime<R>(lds, plan, src, 4 * (qb + 1));
    bf16x8 qr[DQK / 16];
#pragma unroll
    for (int d0 = 0; d0 < DQK / 16; ++d0) qr[d0] = *(const bf16x8*)(Q + trow * 1536 + h * 192 + d0 * 16 + hi * 8);
    Msk msk{q0, q0 + r32, hi};
    float m_reg = 0.f, l_reg = 0.f; f32x16 o[DV / 32] = {};
    att::run_online<R, DQK, DV, true, Msk, 0, false>(lds, wsc, 4 * (qb + 1), plan, src, msk, qr, m_reg, l_reg, o, lane, wid, true);
    if (hi == 0) wsc[r32] = l_reg;
    asm volatile("s_waitcnt lgkmcnt(0)" ::: "memory");
    bf16_t* Ow = O + ((size_t)b * SEQ + q0) * 1024 + h * 128;
#pragma unroll
    for (int r = 0; r < 16; ++r) { const int orow = att::crow(r, hi); const float l = wsc[orow]; const float rl = l > 0.f ? fast_rcp(l) : 0.f;
#pragma unroll
        for (int d0 = 0; d0 < DV / 32; ++d0) { const float v = o[d0][r] * rl; const float vn = __shfl_xor(v, 1);
            if ((r32 & 1) == 0) *(unsigned*)(Ow + (size_t)orow * 1024 + d0 * 32 + r32) = cvt_pk_bf16(v, vn); } }
    asm volatile("s_waitcnt lgkmcnt(0)" ::: "memory");
}
}

namespace nsa {
constexpr int DQK = 96, DV = 64;
using R = att::NsaRing;
constexpr int L_WSC = att::NBUF * R::BUF;
constexpr int L_TAB = L_WSC + 8 * 256;
constexpr int TABW = 132;
constexpr int L_PSUM = L_TAB + 4 * TABW * 4;
constexpr int PSW = 68;
constexpr int L_IMP = L_PSUM + 8 * 8 * PSW * 4;
constexpr int L_SELW = L_IMP + 8 * 8 * 128 * 4;
constexpr int L_END = L_SELW + 8 * 8 * 4 * 4;
__device__ __forceinline__ float lds_ld(const LAS float* base, int idx) { float v; asm volatile("ds_read_b32 %0, %1" : "=&v"(v) : "v"((unsigned)(uintptr_t)(base + idx)) : "memory"); return v; }
__device__ __forceinline__ void lds_ld_wait(float (&a)[16], float (&b)[16]) {
    asm volatile("s_waitcnt lgkmcnt(0)" : "+v"(a[0]), "+v"(a[1]), "+v"(a[2]), "+v"(a[3]), "+v"(a[4]), "+v"(a[5]), "+v"(a[6]), "+v"(a[7]), "+v"(a[8]), "+v"(a[9]), "+v"(a[10]), "+v"(a[11]), "+v"(a[12]), "+v"(a[13]), "+v"(a[14]), "+v"(a[15]) :: "memory");
    asm volatile("" : "+v"(b[0]), "+v"(b[1]), "+v"(b[2]), "+v"(b[3]), "+v"(b[4]), "+v"(b[5]), "+v"(b[6]), "+v"(b[7]), "+v"(b[8]), "+v"(b[9]), "+v"(b[10]), "+v"(b[11]), "+v"(b[12]), "+v"(b[13]), "+v"(b[14]), "+v"(b[15]) :: "memory");
}
struct MskCmp {
    int qlo, qpos, hi; const LAS float* tab;
    __device__ __forceinline__ int kind(int t) const {
        const int n0 = 64 * t;
        if (qlo + 7 - (16 * n0 + 31) < 0) return 0;
        return (qlo - (16 * (n0 + 63) + 31) >= 128) ? 1 : 2;
    }
    __device__ __forceinline__ bool live(int) const { return true; }
    __device__ __forceinline__ void apply(f32x16& p0, f32x16& p1, int t, int) const {
        const float NEG = -__builtin_inff(); const int dq = qpos - 31 - 16 * (64 * t + 4 * hi);
        float bv0[16], bv1[16];
#pragma unroll
        for (int r = 0; r < 16; ++r) { const int c = 16 * ((r & 3) + 8 * (r >> 2)); const int d0 = dq - c, d1 = dq - c - 512;
            bv0[r] = lds_ld(tab, (unsigned)d0 < 128u ? d0 : 128); bv1[r] = lds_ld(tab, (unsigned)d1 < 128u ? d1 : 128); }
        lds_ld_wait(bv0, bv1);
#pragma unroll
        for (int r = 0; r < 16; ++r) { const int c = 16 * ((r & 3) + 8 * (r >> 2));
            p0[r] = dq - c >= 0 ? p0[r] + bv0[r] : NEG; p1[r] = dq - c - 512 >= 0 ? p1[r] + bv1[r] : NEG; }
    }
};
struct MskSel {
    int qpos, hi, cur; const LAS float* tab; const LAS unsigned* selw;
    __device__ __forceinline__ bool mine(int j) const { return (selw[j >> 5] >> (j & 31)) & 1u; }
    __device__ __forceinline__ int kind(int j) const {
        const bool s = mine(j);
        if (!__any(s)) return 0;
        if (j >= cur - 2) return 2;
        return __all(s) ? 1 : 3;
    }
    __device__ __forceinline__ bool live(int j) const { return mine(j); }
    __device__ __forceinline__ void apply(f32x16& p0, f32x16& p1, int j, int) const {
        const float NEG = -__builtin_inff(); const bool s = mine(j); const int dq = qpos - 64 * j - 4 * hi;
        float bv0[16], bv1[16];
#pragma unroll
        for (int r = 0; r < 16; ++r) { const int c = (r & 3) + 8 * (r >> 2); const int d0 = dq - c, d1 = dq - c - 32;
            bv0[r] = lds_ld(tab, (unsigned)d0 < 128u ? d0 : 128); bv1[r] = lds_ld(tab, (unsigned)d1 < 128u ? d1 : 128); }
        lds_ld_wait(bv0, bv1);
#pragma unroll
        for (int r = 0; r < 16; ++r) { const int c = (r & 3) + 8 * (r >> 2);
            p0[r] = (s && dq - c >= 0) ? p0[r] + bv0[r] : NEG; p1[r] = (s && dq - c - 32 >= 0) ? p1[r] + bv1[r] : NEG; }
    }
};
struct MskWin {
    int qpos, hi, cur, j0; const LAS float* tab;
    __device__ __forceinline__ int kind(int t) const { const int j = j0 + t; return (j >= cur - 2 || j <= cur - 8) ? 2 : 1; }
    __device__ __forceinline__ bool live(int) const { return true; }
    __device__ __forceinline__ void apply(f32x16& p0, f32x16& p1, int t, int) const {
        const float NEG = -__builtin_inff(); const int dq = qpos - 64 * (j0 + t) - 4 * hi;
        float bv0[16], bv1[16];
#pragma unroll
        for (int r = 0; r < 16; ++r) { const int c = (r & 3) + 8 * (r >> 2); const int d0 = dq - c, d1 = dq - c - 32;
            bv0[r] = lds_ld(tab, (unsigned)d0 < 128u ? d0 : 128); bv1[r] = lds_ld(tab, (unsigned)d1 < 128u ? d1 : 128); }
        lds_ld_wait(bv0, bv1);
#pragma unroll
        for (int r = 0; r < 16; ++r) { const int c = (r & 3) + 8 * (r >> 2);
            p0[r] = (unsigned)(dq - c) < 512u ? p0[r] + bv0[r] : NEG; p1[r] = (unsigned)(dq - c - 32) < 512u ? p1[r] + bv1[r] : NEG; }
    }
};
__device__ __forceinline__ void fold(f32x16* ofin, const f32x16* o, float f, LAS float* wsc, int r32, int hi) {
    if (hi == 0) wsc[r32] = f;
    asm volatile("s_waitcnt lgkmcnt(0)" ::: "memory");
#pragma unroll
    for (int r = 0; r < 16; ++r) { const float a = wsc[att::crow(r, hi)];
#pragma unroll
        for (int d = 0; d < DV / 32; ++d) ofin[d][r] += o[d][r] * a; }
    asm volatile("s_waitcnt lgkmcnt(0)" : "+v"(ofin[0]), "+v"(ofin[1]) :: "memory");
}
struct Tensors { const bf16_t *NQ, *KCMP, *VCMP, *KS, *VS, *KW, *VW; const float *GT, *RBT; bf16_t* O; };
#define NSA_LAUNDER() const int lane = fresh_lane(), tid = wid * 64 + lane, r32 = lane & 31, hi = lane >> 5, qi = r32 >> 2, hg = r32 & 3; \
    LAS float* wsc = (LAS float*)(lds + L_WSC) + wid * 64; const LAS float* tab = (LAS float*)(lds + L_TAB) + hg * TABW; const int qpos = qlo + qi;
template <int DBG = 0> __device__ __forceinline__ void unit(LAS char* lds, const att::Plan<R>& plan, const Tensors& X, int b, int g, int qblk, int tid0, int wid) {
    const int s0 = qblk * 64, cur = qblk, qlo = s0 + 8 * wid;
    const int bg = b * NSA_G + g;
    bf16x8 qr[DQK / 16]; float gc, gs, gw;
    f32x16 ofin[DV / 32] = {};
    LAS float* imp = (LAS float*)(lds + L_IMP) + wid * 8 * 128;
    LAS unsigned* selw = (LAS unsigned*)(lds + L_SELW) + wid * 32;
    const int ncv = (s0 + 63 >= 31) ? ((s0 + 63 - 31) >> 4) + 1 : 0;
    const int ntc = (ncv + 63) >> 6;
    { att::Src<R> srcC{att::make_rsrc(X.KCMP + (size_t)bg * 512 * 96), att::make_rsrc(X.VCMP + (size_t)bg * 512 * 64), att::make_rsrc(X.VCMP), 0}; att::ring_prime<R>(lds, plan, srcC, ntc); }
    {
    NSA_LAUNDER();
    LAS float* tabs = (LAS float*)(lds + L_TAB);
    LAS float* psum = (LAS float*)(lds + L_PSUM) + wid * 8 * PSW;
    for (int i = tid; i < 4 * TABW; i += 512) tabs[i] = X.RBT[(g * 4 + i / TABW) * TABW + i % TABW];
    for (int i = lane; i < 8 * 128; i += 64) imp[i] = 0.f;
    if (lane < 8) psum[lane * PSW] = 0.f;
    if (lane < 32) selw[lane] = 0u;
    const size_t trow = (size_t)b * SEQ + qpos;
#pragma unroll
    for (int d0 = 0; d0 < DQK / 16; ++d0) qr[d0] = *(const bf16x8*)(X.NQ + trow * 1536 + (g * 4 + hg) * 96 + d0 * 16 + hi * 8);
    gc = X.GT[trow * 48 + (g * 4 + hg) * 3 + 0]; gs = X.GT[trow * 48 + (g * 4 + hg) * 3 + 1]; gw = X.GT[trow * 48 + (g * 4 + hg) * 3 + 2];
    __syncthreads();
    }
#ifndef NSA_NO_CMP
    {
        NSA_LAUNDER();
        att::Src<R> srcC{att::make_rsrc(X.KCMP + (size_t)bg * 512 * 96), att::make_rsrc(X.VCMP + (size_t)bg * 512 * 64), att::make_rsrc(X.VCMP), 0};
        MskCmp mc{qlo, qpos, hi, tab};
        LAS float* psum = (LAS float*)(lds + L_PSUM) + wid * 8 * PSW;
        float m_reg = 0.f, l_reg = 0.f; f32x16 od[DV / 32];
        att::run_online<R, DQK, DV, false>(lds, wsc, ntc, plan, srcC, mc, qr, m_reg, l_reg, od, lane, wid, true);
        att::ring_prime<R>(lds, plan, srcC, ntc);
        f32x16 cin2; { const float c2 = l_reg > 0.f ? -(m_reg + __builtin_amdgcn_logf(l_reg)) : -__builtin_inff();
#pragma unroll
            for (int r = 0; r < 16; ++r) cin2[r] = c2; }
        f32x16 o[DV / 32] = {};
        if (ntc > 0) {
            constexpr int VROW = R::ROW(1), VOFF = R::OFF(1);
            const unsigned vlane = (unsigned)((8 * hi + ((lane & 15) >> 2)) * VROW + (16 * ((lane >> 4) & 1) + 4 * (lane & 3)) * 2);
            att::ring_loop<R>(lds, plan, srcC, ntc, [&](int t, LAS char* Kb) {
                const int kind = mc.kind(t);
                if (kind) {
                    f32x16 p0, p1;
                    att::qk_tile<R, DQK>(p0, p1, Kb, r32, hi, qr, cin2);
                    if (kind >= 2) mc.apply(p0, p1, t, kind);
#pragma unroll
                    for (int r = 0; r < 16; ++r) { p0[r] = fast_exp2(p0[r]); p1[r] = fast_exp2(p1[r]); }
#pragma unroll
                    for (int r = 0; r < 16; ++r) {
                        float a = p0[r]; a += __shfl_xor(a, 1); a += __shfl_xor(a, 2);
                        float c = p1[r]; c += __shfl_xor(c, 1); c += __shfl_xor(c, 2);
                        if (hg == 0) { psum[qi * PSW + 1 + att::crow(r, hi)] = a; psum[qi * PSW + 33 + att::crow(r, hi)] = c; }
                    }
                    asm volatile("s_waitcnt lgkmcnt(0)" ::: "memory");
                    {
                        const int q = lane >> 3;
#pragma unroll
                        for (int e = 0; e < 2; ++e) { const int jl = (lane & 7) * 2 + e; const LAS float* ps = psum + q * PSW + 4 * jl;
                            imp[q * 128 + 16 * t + jl] = (ps[0] + ps[1]) + (ps[2] + ps[3]) + ps[4]; }
                    }
                    asm volatile("s_waitcnt lgkmcnt(0)" ::: "memory");
                    if (lane < 8) psum[lane * PSW] = psum[lane * PSW + 64];
                    asm volatile("s_waitcnt lgkmcnt(0)" ::: "memory");
                    bf16x8 pa0, pa1, pa2, pa3; att::pack_p(p0, p1, pa0, pa1, pa2, pa3);
                    att::pv_tile<DV, VROW>(o, (unsigned)(uintptr_t)(Kb + VOFF) + vlane, pa0, pa1, pa2, pa3);
                }
            }, true);
        }
        { att::Src<R> srcS{att::make_rsrc(X.KS + (size_t)bg * SEQ * 96), att::make_rsrc(X.VS + (size_t)bg * SEQ * 64), att::make_rsrc(X.VS), 0}; att::ring_prime<R>(lds, plan, srcS, cur + 1); }
        fold(ofin, o, gc, wsc, r32, hi);
    }
#endif
#ifndef NSA_NO_TOPK
    {
        NSA_LAUNDER();
        const int q = lane >> 3, jl = lane & 7;
        float v[16];
#pragma unroll
        for (int i = 0; i < 16; ++i) { const int j = jl + 8 * i; const float x = imp[q * 128 + j];
            v[i] = (j == 0 || j == cur || j == cur - 1) ? 1e6f : (j > cur ? -1e6f : x); }
        unsigned wd[4] = {0u, 0u, 0u, 0u};
        const int nsel = cur + 1 < 16 ? cur + 1 : 16;
        for (int it = 0; it < nsel; ++it) {
            float bv = v[0]; int bj = jl;
#pragma unroll
            for (int i = 1; i < 16; ++i) { const bool g = v[i] > bv; bv = g ? v[i] : bv; bj = g ? jl + 8 * i : bj; }
#pragma unroll
            for (int o = 1; o < 8; o <<= 1) { const float ov = __shfl_xor(bv, o); const int oj = __shfl_xor(bj, o); const bool g = ov > bv || (ov == bv && oj < bj); bv = g ? ov : bv; bj = g ? oj : bj; }
            const bool mine = (bj & 7) == jl; const int wi = bj >> 3;
#pragma unroll
            for (int i = 0; i < 16; ++i) v[i] = (mine && i == wi) ? -__builtin_inff() : v[i];
            const unsigned bit = (mine && bj <= cur) ? 1u << (jl + 8 * (wi & 3)) : 0u;
#pragma unroll
            for (int w = 0; w < 4; ++w) wd[w] |= (w == (wi >> 2)) ? bit : 0u;
        }
#pragma unroll
        for (int w = 0; w < 4; ++w) if (wd[w]) atomicOr((unsigned*)(selw + q * 4 + w), wd[w]);
        asm volatile("s_waitcnt lgkmcnt(0)" ::: "memory");
    }
#endif
#ifndef NSA_NO_SEL
    {
        NSA_LAUNDER();
        att::Src<R> srcS{att::make_rsrc(X.KS + (size_t)bg * SEQ * 96), att::make_rsrc(X.VS + (size_t)bg * SEQ * 64), att::make_rsrc(X.VS), 0};
        MskSel ms{qpos, hi, cur, tab, selw + qi * 4};
        float m_reg = 0.f, l_reg = 0.f; f32x16 o[DV / 32] = {};
        att::run_online<R, DQK, DV, true, MskSel, DBG>(lds, wsc, cur + 1, plan, srcS, ms, qr, m_reg, l_reg, o, lane, wid, true);
        { const int j0 = cur >= 8 ? cur - 8 : 0; att::Src<R> srcW{att::make_rsrc(X.KW + (size_t)bg * SEQ * 96), att::make_rsrc(X.VW + (size_t)bg * SEQ * 64), att::make_rsrc(X.VW), j0}; att::ring_prime<R>(lds, plan, srcW, cur - j0 + 1); }
        fold(ofin, o, l_reg > 0.f ? gs * fast_rcp(l_reg) : 0.f, wsc, r32, hi);
    }
#endif
#ifndef NSA_NO_WIN
    {
        NSA_LAUNDER();
        const int j0 = cur >= 8 ? cur - 8 : 0;
        att::Src<R> srcW{att::make_rsrc(X.KW + (size_t)bg * SEQ * 96), att::make_rsrc(X.VW + (size_t)bg * SEQ * 64), att::make_rsrc(X.VW), j0};
        MskWin mw{qpos, hi, cur, j0, tab};
        float m_reg = 0.f, l_reg = 0.f; f32x16 o[DV / 32] = {};
        att::run_online<R, DQK, DV, true, MskWin, DBG>(lds, wsc, cur - j0 + 1, plan, srcW, mw, qr, m_reg, l_reg, o, lane, wid, true);
        fold(ofin, o, l_reg > 0.f ? gw * fast_rcp(l_reg) : 0.f, wsc, r32, hi);
    }
#endif
    NSA_LAUNDER();
    bf16_t* Ow = X.O + ((size_t)b * SEQ + qlo) * 1024 + g * 256;
#pragma unroll
    for (int r = 0; r < 16; ++r) { const int orow = att::crow(r, hi);
#pragma unroll
        for (int d0 = 0; d0 < DV / 32; ++d0) { const float v = ofin[d0][r]; const float vn = __shfl_xor(v, 1);
            if ((r32 & 1) == 0) *(unsigned*)(Ow + (size_t)(orow >> 2) * 1024 + (orow & 3) * 64 + d0 * 32 + r32) = cvt_pk_bf16(v, vn); } }
    __syncthreads();
}
}
#endif
#if !defined(__HIP_DEVICE_COMPILE__)
namespace nsa { constexpr int L_END = 0, TABW = 132; } namespace mla { constexpr int L_END = 0; }
#endif
constexpr size_t MiB = 1u << 20;
constexpr size_t WS_CTL = 0, CTL_ZERO_BYTES = 1 * MiB;
constexpr size_t WS_W_MLAIN = 1 * MiB;
constexpr size_t WS_W_QUP   = 3 * MiB;
constexpr size_t WS_W_KVUP  = WS_W_QUP + 1536 * 1024;
constexpr size_t WS_W_MLAOUT = WS_W_KVUP + 1 * MiB;
constexpr size_t WS_W_FFNGU = WS_W_MLAOUT + 2 * MiB;
constexpr size_t WS_W_FFND  = WS_W_FFNGU + 11 * MiB;
constexpr size_t WS_W_NSAIN = WS_W_FFND + 5632 * 1024;
constexpr size_t WS_W_NSAOUT = WS_W_NSAIN + 7 * MiB;
constexpr size_t WS_W_C1K = WS_W_NSAOUT + 2 * MiB;
constexpr size_t WS_W_C1V = WS_W_C1K + 256 * 3072 * 2;
constexpr size_t WS_W_C2K = WS_W_C1V + 256 * 2048 * 2;
constexpr size_t WS_W_C2V = WS_W_C2K + 256 * 128 * 2;
constexpr size_t WS_ROPE  = WS_W_C2V + 256 * 128 * 2;
constexpr size_t WS_CBIAS = WS_ROPE + 2 * MiB;
constexpr size_t WS_RBT   = WS_CBIAS + 1024;
constexpr size_t WS_ROWTOK = 38 * MiB;
constexpr size_t WS_TOKINFO = 39 * MiB;
constexpr size_t WS_TOKW = WS_TOKINFO + 256 * 1024;
static_assert(WS_RBT + 16 * 132 * 4 <= WS_ROWTOK && WS_TOKW + 256 * 1024 <= 40 * MiB, "small region");
constexpr size_t WS_XB = 40 * MiB, WS_LAT = 104 * MiB, WS_QN = 168 * MiB, WS_KVN = 200 * MiB, WS_KR = 216 * MiB, WS_Q = 220 * MiB, WS_KN = 316 * MiB, WS_V = 380 * MiB;
constexpr size_t WS_O = 40 * MiB, WS_X1 = 104 * MiB, WS_ACT = 168 * MiB, WS_X2 = 40 * MiB;
constexpr size_t WS_NQ = 104 * MiB, WS_KC = 200 * MiB, WS_VC = 224 * MiB, WS_KS = 240 * MiB, WS_VS = 264 * MiB, WS_KW = 280 * MiB, WS_VW = 304 * MiB, WS_GT = 320 * MiB;
static_assert(WS_KS - WS_KC == 40 * MiB && WS_KW - WS_KS == 40 * MiB && WS_VS - WS_VC == 40 * MiB && WS_VW - WS_VS == 40 * MiB, "FNsaIn segment stride");
constexpr size_t WS_HK = 328 * MiB, WS_HV = 330 * MiB, WS_KCMP = 332 * MiB, WS_VCMP = 334 * MiB;
constexpr size_t WS_ONSA = 348 * MiB, WS_X3 = MOE_FP8 ? 40 * MiB : 412 * MiB;
constexpr size_t WS_MOE_GU = 40 * MiB, WS_MOE_D = 152 * MiB, WS_DOUT = 208 * MiB;
constexpr size_t WS_MOE_GU8 = 412 * MiB, WS_MOE_D8 = 468 * MiB, WS_X3F8 = 124 * MiB;
constexpr size_t WS_X2F8 = 348 * MiB;
constexpr size_t WS_X1F8 = 348 * MiB;
constexpr float MOE_GU_WS = 32.f, MOE_D_WS = 128.f, MOE_H_S = 4.f;
constexpr size_t WS_END = 496 * MiB;
constexpr int CW_BAR = 4096;
constexpr int CW_ECNT = 16384;
constexpr int RING_BYTES = 161792;
constexpr int MISC_OFF = RING_BYTES + 320;
constexpr int LDS_BYTES = 163840;
constexpr int NWAVES = 8;
static_assert(nsa::L_END <= RING_BYTES && mla::L_END <= RING_BYTES, "attention LDS");

#define RLX_AGENT __ATOMIC_RELAXED, __HIP_MEMORY_SCOPE_AGENT
#define LDS_WAIT() asm volatile("s_waitcnt lgkmcnt(0)" ::: "memory")
#define VM_WAIT() asm volatile("s_waitcnt vmcnt(0)" ::: "memory")
__device__ __forceinline__ unsigned f2bf(float f) { unsigned u = __builtin_bit_cast(unsigned, f); return (u + 0x7fffu + ((u >> 16) & 1u)) >> 16; }
__device__ __forceinline__ unsigned pk2(float lo, float hi) { return f2bf(lo) | (f2bf(hi) << 16); }

#define XB_TMO      128
#define XB_XCNT(j)  (256  + 64 * (j))
#define XB_XSUB(j)  (1280 + 64 * (j))
#define XB_XGEN(j)  (2304 + 64 * (j))
#define XB_TOP      3328
#define XB_TOPGEN   3392
#define XCD_BAR_WORDS 3456
#define XB_SPIN_CAP (1u << 20)
__device__ __forceinline__ unsigned xb_ld(unsigned* p)              { return __hip_atomic_load(p, __ATOMIC_RELAXED, __HIP_MEMORY_SCOPE_AGENT); }
__device__ __forceinline__ unsigned xb_add(unsigned* p, unsigned v) { return __hip_atomic_fetch_add(p, v, __ATOMIC_RELAXED, __HIP_MEMORY_SCOPE_AGENT); }
__device__ __forceinline__ unsigned xb_xcc_id() { return (unsigned)__builtin_amdgcn_s_getreg((3 << 11) | 20) & 0xFu; }
#define XB_SPIN(cond, bar) do { unsigned _sp = 0; while (cond) { __builtin_amdgcn_s_sleep(1); \
    if ((++_sp & 255u) == 0u) { if (xb_ld(&(bar)[XB_TMO])) break; if (_sp > XB_SPIN_CAP) { atomicAdd(&(bar)[XB_TMO], 1u); break; } } } } while (0)
struct XcdBarrier { unsigned* bar; unsigned x; volatile LAS unsigned* st; };
__device__ __forceinline__ XcdBarrier xcd_barrier_post(unsigned* bar, volatile LAS unsigned* st) {
    XcdBarrier b; b.bar = bar; b.x = xb_xcc_id(); b.st = st;
    if (threadIdx.x == 0) (void)xb_add(&bar[XB_XCNT(b.x)], 1u);
    return b;
}
__device__ __forceinline__ void xcd_barrier_complete(unsigned* bar, unsigned x, unsigned& nloc, unsigned& nx) {
    const unsigned G = gridDim.x * gridDim.y * gridDim.z;
    unsigned sum, cnt, mine, sp = 0u;
    for (;;) {
        sum = 0u; cnt = 0u; mine = 0u;
#pragma unroll
        for (unsigned j = 0; j < 16; ++j) { const unsigned c = xb_ld(&bar[XB_XCNT(j)]); sum += c; cnt += (c > 0u) ? 1u : 0u; mine = (j == x) ? c : mine; }
        if (sum == G) break;
        __builtin_amdgcn_s_sleep(1);
        if ((++sp & 255u) == 0u) { if (xb_ld(&bar[XB_TMO])) break; if (sp > XB_SPIN_CAP) { atomicAdd(&bar[XB_TMO], 1u); break; } }
    }
    nloc = mine > 0u ? mine : 1u; nx = cnt > 0u ? cnt : 1u;
}
__device__ __forceinline__ void xcd_barrier(const XcdBarrier& b) {
    asm volatile("s_waitcnt vmcnt(0)" ::: "memory");
    __syncthreads();
    if (threadIdx.x == 0) {
        unsigned* bar = b.bar;
        __builtin_amdgcn_s_waitcnt(0);
        unsigned nloc = b.st[0], nx = b.st[1];
        if (nloc == 0u) { xcd_barrier_complete(bar, b.x, nloc, nx); b.st[0] = nloc; b.st[1] = nx; }
        const unsigned old = xb_add(&bar[XB_XSUB(b.x)], 1u);
        const unsigned gen = old / nloc;
        if (old + 1u == (gen + 1u) * nloc) {
            __builtin_amdgcn_fence(__ATOMIC_RELEASE, "agent");
            asm volatile("s_waitcnt vmcnt(0)" ::: "memory");
            const unsigned og = xb_add(&bar[XB_TOP], 1u);
            const unsigned tg = og / nx;
            if (og + 1u == (tg + 1u) * nx) xb_add(&bar[XB_TOPGEN], 1u);
            else XB_SPIN(xb_ld(&bar[XB_TOPGEN]) == tg, bar);
            __builtin_amdgcn_fence(__ATOMIC_ACQUIRE, "agent");
            xb_add(&bar[XB_XGEN(b.x)], 1u);
            asm volatile("s_waitcnt vmcnt(0)" ::: "memory");
        } else {
            XB_SPIN(xb_ld(&bar[XB_XGEN(b.x)]) == gen, bar);
            __builtin_amdgcn_fence(__ATOMIC_ACQUIRE, "agent");
            asm volatile("s_waitcnt vmcnt(0)" ::: "memory");
        }
    }
    __syncthreads();
}

__device__ __forceinline__ float wave_sum(float v) {
#pragma unroll
    for (int o = 1; o < 64; o <<= 1) v += __shfl_xor(v, o);
    return v;
}
template <class RM> __device__ __forceinline__ void tr_item(const float* W, int K, int N, bf16_t* WT, int ldk, const RM& rowmap, LAS float* scr, int item, int lane, const float* ksc = nullptr) {
    const int nblk = (N + 31) / 32, kb = item / nblk, nb = item % nblk, k0 = 64 * kb, n0 = 32 * nb;
    const bool nok = n0 + (lane & 31) < N;
#pragma unroll 8
    for (int i = 0; i < 32; ++i) { const int kk = 2 * i + (lane >> 5); scr[kk * 33 + (lane & 31)] = nok ? W[(size_t)(k0 + kk) * N + n0 + (lane & 31)] * (ksc ? ksc[k0 + kk] : 1.f) : 0.f; }
    LDS_WAIT(); asm volatile("" ::: "memory");
    const int c = lane & 7;
#pragma unroll
    for (int j = 0; j < 4; ++j) { const int nl = (lane >> 3) + 8 * j; const LAS float* s = scr + (8 * c) * 33 + nl;
        u32x4 o; o.x = pk2(s[0 * 33], s[1 * 33]); o.y = pk2(s[2 * 33], s[3 * 33]); o.z = pk2(s[4 * 33], s[5 * 33]); o.w = pk2(s[6 * 33], s[7 * 33]);
        if (n0 + nl < N) *(u32x4*)(WT + (size_t)rowmap(n0 + nl) * ldk + k0 + 8 * c) = o; }
    LDS_WAIT(); asm volatile("" ::: "memory");
}
struct RmId { int off; __device__ __forceinline__ int operator()(int n) const { return off + n; } };
struct RmGU { int off; __device__ __forceinline__ int operator()(int n) const { return off + (n >> 7) * 256 + (n & 127); } };
struct RmLat { __device__ __forceinline__ int operator()(int n) const { if (n < 768) return n; const int i = (n - 768) & 31, second = (n - 768) >> 5; return 768 + 8 * (i >> 2) + 4 * second + (i & 3); } };
struct RmQup { __device__ __forceinline__ int operator()(int n) const { const int h = n / 192, j = n % 192; if (j < 128) return n; const int i = j - 128, ii = i & 31; return h * 192 + 128 + 8 * (ii >> 2) + (ii & 3) + ((i >> 5) << 2); } };
template <class RM> __device__ __forceinline__ void tr_matrix(const float* W, int K, int N, bf16_t* WT, int ldk, const RM& rm, LAS float* scr, int gw, int ngw, int lane, const float* ksc = nullptr) {
    const int nitems = (K / 64) * ((N + 31) / 32);
    for (int it = gw; it < nitems; it += ngw) tr_item(W, K, N, WT, ldk, rm, scr, it, lane, ksc);
}

__device__ __forceinline__ float clamp448(float v) { return fminf(fmaxf(v, -448.f), 448.f); }
__device__ __forceinline__ unsigned pk4_fp8(float a, float b, float c, float d) { int w = 0; w = __builtin_amdgcn_cvt_pk_fp8_f32(clamp448(a), clamp448(b), w, false); w = __builtin_amdgcn_cvt_pk_fp8_f32(clamp448(c), clamp448(d), w, true); return (unsigned)w; }
template <class RM> __device__ __forceinline__ void tr_item_f8(const float* W, int K, int N, unsigned char* WT, int ldk, float scale, const RM& rowmap, LAS float* scr, int item, int lane) {
    const int nblk = (N + 31) / 32, kb = item / nblk, nb = item % nblk, k0 = 64 * kb, n0 = 32 * nb;
    const bool nok = n0 + (lane & 31) < N;
#pragma unroll 8
    for (int i = 0; i < 32; ++i) { const int kk = 2 * i + (lane >> 5); scr[kk * 33 + (lane & 31)] = nok ? W[(size_t)(k0 + kk) * N + n0 + (lane & 31)] * scale : 0.f; }
    LDS_WAIT(); asm volatile("" ::: "memory");
    const int c = lane & 3;
#pragma unroll
    for (int j = 0; j < 2; ++j) { const int nl = (lane >> 2) + 16 * j; const LAS float* s = scr + (16 * c) * 33 + nl;
        u32x4 o; o.x = pk4_fp8(s[0 * 33], s[1 * 33], s[2 * 33], s[3 * 33]); o.y = pk4_fp8(s[4 * 33], s[5 * 33], s[6 * 33], s[7 * 33]);
        o.z = pk4_fp8(s[8 * 33], s[9 * 33], s[10 * 33], s[11 * 33]); o.w = pk4_fp8(s[12 * 33], s[13 * 33], s[14 * 33], s[15 * 33]);
        if (n0 + nl < N) *(u32x4*)(WT + (size_t)rowmap(n0 + nl) * ldk + k0 + 16 * c) = o; }
    LDS_WAIT(); asm volatile("" ::: "memory");
}
template <class RM> __device__ __forceinline__ void tr_matrix_f8(const float* W, int K, int N, unsigned char* WT, int ldk, float scale, const RM& rm, LAS float* scr, int gw, int ngw, int lane) {
    const int nitems = (K / 64) * ((N + 31) / 32);
    for (int it = gw; it < nitems; it += ngw) tr_item_f8(W, K, N, WT, ldk, scale, rm, scr, it, lane);
}
#if defined(__HIP_DEVICE_COMPILE__)
__device__ __forceinline__ void tr_load32(float (&v)[32], const float* W, int K, int N, int item, int lane) {
    const auto rs = __builtin_amdgcn_make_buffer_rsrc((void*)W, 0, K * N * 4, 0x00020000);
    const int nblk = (N + 31) / 32, kb = item / nblk, nb = item % nblk;
    const int soff = (64 * kb * N + 32 * nb) * 4;
    const int voff = (32 * nb + (lane & 31) < N) ? ((lane >> 5) * N + (lane & 31)) * 4 : 0x40000000;
#pragma unroll
    for (int i = 0; i < 32; ++i) v[i] = __builtin_bit_cast(float, __builtin_amdgcn_raw_buffer_load_b32(rs, voff, soff + 2 * i * N * 4, 0));
}
template <class RM> __device__ __forceinline__ void tr_emit32_bf16(const float (&v)[32], int N, bf16_t* WT, int ldk, const RM& rowmap, LAS float* scr, int item, int lane) {
    const int nblk = (N + 31) / 32, kb = item / nblk, nb = item % nblk, k0 = 64 * kb, n0 = 32 * nb;
#pragma unroll
    for (int i = 0; i < 32; ++i) scr[(2 * i + (lane >> 5)) * 33 + (lane & 31)] = v[i];
    LDS_WAIT(); asm volatile("" ::: "memory");
    const int c = lane & 7;
#pragma unroll
    for (int j = 0; j < 4; ++j) { const int nl = (lane >> 3) + 8 * j; const LAS float* s = scr + (8 * c) * 33 + nl;
        u32x4 o; o.x = pk2(s[0 * 33], s[1 * 33]); o.y = pk2(s[2 * 33], s[3 * 33]); o.z = pk2(s[4 * 33], s[5 * 33]); o.w = pk2(s[6 * 33], s[7 * 33]);
        if (n0 + nl < N) *(u32x4*)(WT + (size_t)rowmap(n0 + nl) * ldk + k0 + 8 * c) = o; }
    LDS_WAIT(); asm volatile("" ::: "memory");
}
template <class RM> __device__ __forceinline__ void tr_emit32_f8(const float (&v)[32], int N, unsigned char* WT, int ldk, float scale, const RM& rowmap, LAS float* scr, int item, int lane) {
    const int nblk = (N + 31) / 32, kb = item / nblk, nb = item % nblk, k0 = 64 * kb, n0 = 32 * nb;
#pragma unroll
    for (int i = 0; i < 32; ++i) scr[(2 * i + (lane >> 5)) * 33 + (lane & 31)] = v[i] * scale;
    LDS_WAIT(); asm volatile("" ::: "memory");
    const int c = lane & 3;
#pragma unroll
    for (int j = 0; j < 2; ++j) { const int nl = (lane >> 2) + 16 * j; const LAS float* s = scr + (16 * c) * 33 + nl;
        u32x4 o; o.x = pk4_fp8(s[0 * 33], s[1 * 33], s[2 * 33], s[3 * 33]); o.y = pk4_fp8(s[4 * 33], s[5 * 33], s[6 * 33], s[7 * 33]);
        o.z = pk4_fp8(s[8 * 33], s[9 * 33], s[10 * 33], s[11 * 33]); o.w = pk4_fp8(s[12 * 33], s[13 * 33], s[14 * 33], s[15 * 33]);
        if (n0 + nl < N) *(u32x4*)(WT + (size_t)rowmap(n0 + nl) * ldk + k0 + 16 * c) = o; }
    LDS_WAIT(); asm volatile("" ::: "memory");
}
#endif
__device__ __forceinline__ void ln_inplace(f32x4 (&v)[4], const float* g, const float* b, int lane) {
    float s = 0.f;
#pragma unroll
    for (int j = 0; j < 4; ++j) s += (v[j].x + v[j].y) + (v[j].z + v[j].w);
    const float mean = wave_sum(s) * (1.f / D); float s2 = 0.f;
#pragma unroll
    for (int j = 0; j < 4; ++j) { v[j] = v[j] - mean; s2 += (v[j].x * v[j].x + v[j].y * v[j].y) + (v[j].z * v[j].z + v[j].w * v[j].w); }
    const float rstd = 1.f / sqrtf(wave_sum(s2) * (1.f / D) + 1e-5f);
#pragma unroll
    for (int j = 0; j < 4; ++j) { const f32x4 gg = *((const f32x4*)g + lane + 64 * j), bb = *((const f32x4*)b + lane + 64 * j); v[j] = v[j] * rstd * gg + bb; }
}
__device__ __forceinline__ void store_row_bf16(bf16_t* orow, const f32x4 (&v)[4], int lane) {
    u32x2* o8 = (u32x2*)orow + lane;
#pragma unroll
    for (int j = 0; j < 4; ++j) { u32x2 w; w.x = cvt_pk_bf16(v[j].x, v[j].y); w.y = cvt_pk_bf16(v[j].z, v[j].w); o8[64 * j] = w; }
}
__device__ __forceinline__ f32x4 bf4_to_f32(u32x2 w) { return (f32x4){bflo(w.x), bfhi(w.x), bflo(w.y), bfhi(w.y)}; }

__device__ __forceinline__ u32x4 pack8(f32x4 a, f32x4 b) { u32x4 w; w.x = cvt_pk_bf16(a[0], a[1]); w.y = cvt_pk_bf16(a[2], a[3]); w.z = cvt_pk_bf16(b[0], b[1]); w.w = cvt_pk_bf16(b[2], b[3]); return w; }
struct FBf16 { bf16_t* O; int ld; int rowoff;
    __device__ __forceinline__ void operator()(int row, int col, f32x4 a, f32x4 b) const { *(u32x4*)(O + (size_t)(rowoff + row) * ld + col) = pack8(a, b); } };
struct FBf16S { bf16_t* O; int ld; int rowoff; float sc;
    __device__ __forceinline__ void operator()(int row, int col, f32x4 a, f32x4 b) const { *(u32x4*)(O + (size_t)(rowoff + row) * ld + col) = pack8(a * sc, b * sc); } };
struct FSwigluF8 { unsigned char* A; int ld; float isc, osc;
    __device__ __forceinline__ void operator()(int row, int col, f32x4 g0, f32x4 g1, f32x4 u0, f32x4 u1) const {
        f32x4 a, b;
#pragma unroll
        for (int e = 0; e < 4; ++e) { a[e] = silu_f(g0[e] * isc) * (u0[e] * (isc * osc)); b[e] = silu_f(g1[e] * isc) * (u1[e] * (isc * osc)); }
        u32x2 w; w.x = pk4_fp8(a[0], a[1], a[2], a[3]); w.y = pk4_fp8(b[0], b[1], b[2], b[3]);
        *(u32x2*)(A + (size_t)row * ld + col) = w; } };
struct FLat { bf16_t* LAT; float* SSQ; bf16_t* KR; const float* cs; const float* sn;
    __device__ __forceinline__ void operator()(int row, int col, f32x4 a, f32x4 b) const {
        if (col < 768) {
            const u32x4 w = pack8(a, b);
            *(u32x4*)(LAT + (size_t)row * 1024 + col) = w;
            const float v0 = bflo(w.x), v1 = bfhi(w.x), v2 = bflo(w.y), v3 = bfhi(w.y), v4 = bflo(w.z), v5 = bfhi(w.z), v6 = bflo(w.w), v7 = bfhi(w.w);
            float s = ((v0 * v0 + v1 * v1) + (v2 * v2 + v3 * v3)) + ((v4 * v4 + v5 * v5) + (v6 * v6 + v7 * v7));
            s += __shfl_xor(s, 16); s += __shfl_xor(s, 32);
            if ((col & 31) == 0) SSQ[(size_t)row * 24 + (col >> 5)] = s;
        } else if (col < 832) {
            const int i0 = ((col - 768) >> 3) * 4, s = row & (SEQ - 1);
            const f32x4 c = *(const f32x4*)(cs + s * 32 + i0), sv = *(const f32x4*)(sn + s * 32 + i0);
            *(u32x4*)(KR + (size_t)row * 64 + (col - 768)) = pack8(a * c - b * sv, a * sv + b * c);
        } } };
struct RsQ { const float* SSQ;
    __device__ __forceinline__ float operator()(int row, int fq) const { const f32x4 p = *(const f32x4*)(SSQ + (size_t)row * 24 + 4 * fq); float s = (p[0] + p[1]) + (p[2] + p[3]);
        s += __shfl_xor(s, 16); s += __shfl_xor(s, 32); return 1.f / sqrtf(s * (1.f / 512.f) + 1e-6f); } };
struct RsKv { const float* SSQ;
    __device__ __forceinline__ float operator()(int row, int fq) const { const float* p = SSQ + (size_t)row * 24 + 16 + 2 * fq; float s = p[0] + p[1];
        s += __shfl_xor(s, 16); s += __shfl_xor(s, 32); return 1.f / sqrtf(s * (1.f / 256.f) + 1e-6f); } };
struct FQup { bf16_t* Q; const float* cs; const float* sn;
    __device__ __forceinline__ void operator()(int row, int col, f32x4 a, f32x4 b) const {
        const int j = col % 192;
        if (j >= 128) { const int i0 = ((j - 128) >> 3) * 4, s = row & (SEQ - 1);
            const f32x4 c = *(const f32x4*)(cs + s * 32 + i0), sv = *(const f32x4*)(sn + s * 32 + i0);
            const f32x4 o1 = a * c - b * sv, o2 = a * sv + b * c; a = o1; b = o2; }
        *(u32x4*)(Q + (size_t)row * 1536 + col) = pack8(a * C2_MLA, b * C2_MLA); } };
struct FKvup { bf16_t* KN; size_t vdelta;
    __device__ __forceinline__ void operator()(int row, int col, f32x4 a, f32x4 b) const {
        const int h = col >> 8, j = col & 255, bb = row >> 13, s = row & (SEQ - 1);
        bf16_t* base = KN + (j < 128 ? (size_t)0 : vdelta) + ((size_t)(bb * MLA_H + h) * SEQ + s) * 128 + (j & 127);
        *(u32x4*)base = pack8(a, b); } };
struct FResF32 { float* P; const float* rf; const bf16_t* rb; float sc;
    __device__ __forceinline__ void operator()(int row, int col, f32x4 a, f32x4 b) const {
        const size_t o = (size_t)row * D + col; f32x4 r0, r1;
        if (rf) { r0 = *(const f32x4*)(rf + o); r1 = *(const f32x4*)(rf + o + 4); }
        else { const u32x4 w = *(const u32x4*)(rb + o); r0 = (f32x4){bflo(w.x), bfhi(w.x), bflo(w.y), bfhi(w.y)}; r1 = (f32x4){bflo(w.z), bfhi(w.z), bflo(w.w), bfhi(w.w)}; }
        *(f32x4*)(P + o) = r0 * ALPHA + a * sc; *(f32x4*)(P + o + 4) = r1 * ALPHA + b * sc; } };
struct FResBf16 { bf16_t* P; const float* rf; const bf16_t* rb; float sc;
    __device__ __forceinline__ void operator()(int row, int col, f32x4 a, f32x4 b) const {
        const size_t o = (size_t)row * D + col; f32x4 r0, r1;
        if (rf) { r0 = *(const f32x4*)(rf + o); r1 = *(const f32x4*)(rf + o + 4); }
        else { const u32x4 w = *(const u32x4*)(rb + o); r0 = (f32x4){bflo(w.x), bfhi(w.x), bflo(w.y), bfhi(w.y)}; r1 = (f32x4){bflo(w.z), bfhi(w.z), bflo(w.w), bfhi(w.w)}; }
        *(u32x4*)(P + o) = pack8(r0 * ALPHA + a * sc, r1 * ALPHA + b * sc); } };
struct FSwiglu { bf16_t* A; int ld; int rowoff;
    __device__ __forceinline__ void operator()(int row, int col, f32x4 g0, f32x4 g1, f32x4 u0, f32x4 u1) const {
        f32x4 a, b;
#pragma unroll
        for (int e = 0; e < 4; ++e) { a[e] = silu_f(g0[e]) * u0[e]; b[e] = silu_f(g1[e]) * u1[e]; }
        *(u32x4*)(A + (size_t)(rowoff + row) * ld + col) = pack8(a, b); } };
struct FSwigluS { bf16_t* A; int ld; float isc;
    __device__ __forceinline__ void operator()(int row, int col, f32x4 g0, f32x4 g1, f32x4 u0, f32x4 u1) const {
        f32x4 a, b;
#pragma unroll
        for (int e = 0; e < 4; ++e) { a[e] = silu_f(g0[e] * isc) * (u0[e] * isc); b[e] = silu_f(g1[e] * isc) * (u1[e] * isc); }
        *(u32x4*)(A + (size_t)row * ld + col) = pack8(a, b); } };
struct FNsaIn { bf16_t *NQ, *KC, *VC; float* GT; float sc;
    struct CS { int kind; int dd; bf16_t* base; float* gbase; };
    __device__ __forceinline__ CS col(int col) const { CS c; c.dd = 0; c.base = NQ; c.gbase = GT;
        if (col < 1536) { c.kind = 0; c.base = NQ + col; return c; }
        if (col >= 3504) { c.kind = 3; return c; }
        if (col >= 3456) { c.kind = 2; c.gbase = GT + (col - 3456); return c; }
        int cc = col - 1536; const int seg = cc / 640; cc -= seg * 640;
        const bool isk = cc < 384; if (!isk) cc -= 384;
        const int dd = isk ? 96 : 64, g = cc / dd, d = cc - g * dd;
        c.kind = 1; c.dd = dd; c.base = (isk ? KC : VC) + (size_t)seg * (40u * 1024u * 1024u / 2u) + (size_t)g * SEQ * dd + d; return c; }
    __device__ __forceinline__ void st(const CS& c, int row, f32x4 a, f32x4 b) const {
        a = a * sc; b = b * sc;
        if (c.kind == 0) { *(u32x4*)(c.base + (size_t)row * 1536) = pack8(a * C2_NSA, b * C2_NSA); }
        else if (c.kind == 1) { const int bb = row >> 13; *(u32x4*)(c.base + (size_t)(row + 3 * bb * SEQ) * c.dd) = pack8(a, b); }
        else if (c.kind == 2) { float* gp = c.gbase + (size_t)row * 48; f32x4 x, y;
#pragma unroll
            for (int e = 0; e < 4; ++e) { x[e] = sigmoid_f(a[e]); y[e] = sigmoid_f(b[e]); }
            *(f32x4*)gp = x; *(f32x4*)(gp + 4) = y; } }
};
struct FCmp1 { bf16_t* H; const float* bias;
    __device__ __forceinline__ void operator()(int row, int col, f32x4 a, f32x4 b) const {
        if (col >= 128) return;
        const f32x4 b0 = *(const f32x4*)(bias + col), b1 = *(const f32x4*)(bias + col + 4); f32x4 x, y;
#pragma unroll
        for (int e = 0; e < 4; ++e) { x[e] = gelu_tanh_f(a[e] + b0[e]); y[e] = gelu_tanh_f(b[e] + b1[e]); }
        *(u32x4*)(H + (size_t)row * 128 + col) = pack8(x, y); } };
struct FCmp2 { bf16_t* O; int nd;
    __device__ __forceinline__ void operator()(int row, int col, f32x4 a, f32x4 b) const {
        if (col >= nd) return;
        if ((row & 511) == 511) { a = (f32x4){0.f, 0.f, 0.f, 0.f}; b = a; }
        *(u32x4*)(O + (size_t)row * nd + col) = pack8(a, b); } };

struct MoeInfo { int cnt[NE]; int ts[NE + 1];
    __device__ __forceinline__ int expert_of(int ct) const { int e = 0;
#pragma unroll
        for (int i = 1; i < NE; ++i) e += (ct >= ts[i]) ? 1 : 0; return e; } };
struct SchedMoeGU {
    pg8::StaticOrder so; MoeInfo mi; int ct0; const int* rowtok; int rowbytes;
    __device__ __forceinline__ bool next(int i, pg8::Unit& u) const { return so.next(i, u); }
    __device__ __forceinline__ size_t a_off(const pg8::Unit&, const pg8::Gemm&) const { return 0; }
    __device__ __forceinline__ size_t b_off(const pg8::Unit& u, const pg8::Gemm& g) const { const int e = mi.expert_of(ct0 + u.pm); return ((size_t)e * (2 * FFE) + (size_t)u.pn * 256) * g.ldb; }
    __device__ __forceinline__ unsigned a_row(const pg8::Unit& u, int r) const {
        const int ct = ct0 + u.pm, e = mi.expert_of(ct); int c = 0, t0 = 0;
#pragma unroll
        for (int i = 0; i < NE; ++i) { c = (i == e) ? mi.cnt[i] : c; t0 = (i == e) ? mi.ts[i] : t0; }
        const int pos = (ct - t0) * 256 + r; const int tok = pos < c ? rowtok[e * ECAP + pos] : 0;
        return (unsigned)tok * (unsigned)rowbytes; }
};
struct SchedMoeD {
    pg8::StaticOrder so; MoeInfo mi; int ct0;
    __device__ __forceinline__ bool next(int i, pg8::Unit& u) const { return so.next(i, u); }
    __device__ __forceinline__ size_t a_off(const pg8::Unit& u, const pg8::Gemm& g) const { return (size_t)u.pm * 256 * g.lda; }
    __device__ __forceinline__ size_t b_off(const pg8::Unit& u, const pg8::Gemm& g) const { const int e = mi.expert_of(ct0 + u.pm); return ((size_t)e * D + (size_t)u.pn * 256) * g.ldb; }
    __device__ __forceinline__ unsigned a_row(const pg8::Unit&, int) const { return 0u; }
};
#if defined(SELFTEST)
namespace st {
constexpr int TB = 2;
constexpr int CW_ERR = 32768;
template <class AF, class OF> __device__ __forceinline__ void naive_mm(int M, int N, int K, const float* W, int ldw, int n0, const AF& a, const OF& o, int gt, int ngt) {
    for (long i = gt; i < (long)M * N; i += ngt) { const int m = (int)(i / N), n = (int)(i % N); float s = 0.f; for (int k = 0; k < K; ++k) s += a(m, k) * W[(size_t)k * ldw + n0 + n]; o(m, n, s); }
}
__device__ __forceinline__ float wave_max(float v) {
#pragma unroll
    for (int o = 1; o < 64; o <<= 1) v = fmaxf(v, __shfl_xor(v, o));
    return v;
}
__device__ __forceinline__ int rel_bucket_ref(int dist) {
    const int n = dist > 0 ? dist : 0; if (n < 16) return n;
    const float nf = (float)n; int large = 16 + (int)(logf(nf / 16.f) / 2.0794415416798357f * 16.f); return large < 31 ? large : 31;
}
}
#endif
constexpr int N_PHASES = 28;
struct Args { const float* in[27]; float* out; unsigned char* ws; int ph_lo, ph_hi; };
enum { I_X = 0, I_MLA_WIN, I_MLA_QN, I_MLA_WQ, I_MLA_KVN, I_MLA_WKV, I_MLA_WO, I_NSA_WIN, I_PE_K, I_W1_K, I_W2_K, I_PE_V, I_W1_V, I_W2_V, I_NSA_WO, I_RELB,
       I_FFN_G, I_FFN_U, I_FFN_D, I_ROUTER, I_MOE_G, I_MOE_U, I_MOE_D, I_LNM_G, I_LNM_B, I_LNF_G, I_LNF_B };

__device__ __forceinline__ int rel_bucket_dev(int n) {
    if (n < 16) return n;
    int bkt = 16;
    bkt += n >= 19; bkt += n >= 21; bkt += n >= 24; bkt += n >= 27; bkt += n >= 31; bkt += n >= 35; bkt += n >= 40; bkt += n >= 46;
    bkt += n >= 52; bkt += n >= 59; bkt += n >= 67; bkt += n >= 77; bkt += n >= 87; bkt += n >= 99; bkt += n >= 113;
    return bkt;
}

#if defined(__HIP_DEVICE_COMPILE__)
__device__ __forceinline__ void moe_convert_slice(const Args& args, unsigned char* ws, LAS unsigned char* lds, int e, int vcu, int wave, int G) {
    constexpr int NIT = (D / 64) * (FFE / 32);
    static_assert(NIT == (FFE / 64) * (D / 32) && FFE % 64 == 0, "item count");
    const int lane = fresh_lane();
    LAS float* scr = (LAS float*)(lds + wave * 8704);
    const float* wg = args.in[I_MOE_G] + (size_t)e * D * FFE; const float* wu = args.in[I_MOE_U] + (size_t)e * D * FFE; const float* wd = args.in[I_MOE_D] + (size_t)e * FFE * D;
    unsigned char* gu8 = ws + WS_MOE_GU8 + (size_t)e * 2 * FFE * D; unsigned char* d8 = ws + WS_MOE_D8 + (size_t)e * D * FFE;
    _Pragma("nounroll") for (int j = vcu * NWAVES + wave; j < NIT; j += G * NWAVES) {
        float va[32], vb[32], vc[32];
        tr_load32(va, wg, D, FFE, j, lane); tr_load32(vb, wu, D, FFE, j, lane); tr_load32(vc, wd, FFE, D, j, lane);
        tr_emit32_f8(va, FFE, gu8, D, MOE_GU_WS, RmGU{0}, scr, j, lane);
        tr_emit32_f8(vb, FFE, gu8, D, MOE_GU_WS, RmGU{128}, scr, j, lane);
        tr_emit32_f8(vc, D, d8, FFE, MOE_D_WS, RmId{0}, scr, j, lane);
    }
}
#endif

#if defined(__HIP_DEVICE_COMPILE__)
__device__ __forceinline__ void layer_convert_slice(const Args& args, unsigned char* ws, LAS unsigned char* lds, int s, int vcu, int wave, int G) {
    const int lane = fresh_lane();
    LAS float* scr = (LAS float*)(lds + wave * 8704);
    const int j0 = vcu * NWAVES + wave, dj = G * NWAVES;
    constexpr int NF = (D / 64) * (FF / 32), NO = (D / 64) * (D / 32), NI = (D / 64) * ((NSA_IN + 31) / 32);
    static_assert(NF == (FF / 64) * (D / 32) && FF % 64 == 0, "item count");
    if (s == 0) {
        _Pragma("nounroll") for (int j = j0; j < NF; j += dj) { float va[32], vb[32];
            tr_load32(va, args.in[I_FFN_G], D, FF, j, lane); if (j < NO) tr_load32(vb, args.in[I_NSA_WO], D, D, j, lane);
#if FFN_FP8
            tr_emit32_f8(va, FF, ws + WS_W_FFNGU, D, MOE_GU_WS, RmGU{0}, scr, j, lane);
#else
            tr_emit32_bf16(va, FF, (bf16_t*)(ws + WS_W_FFNGU), D, RmGU{0}, scr, j, lane);
#endif
            if (j < NO) tr_emit32_bf16(vb, D, (bf16_t*)(ws + WS_W_NSAOUT), D, RmId{0}, scr, j, lane); }
    } else if (s == 1) {
        _Pragma("nounroll") for (int j = j0; j < NF; j += dj) { float va[32];
            tr_load32(va, args.in[I_FFN_U], D, FF, j, lane);
#if FFN_FP8
            tr_emit32_f8(va, FF, ws + WS_W_FFNGU, D, MOE_GU_WS, RmGU{128}, scr, j, lane); }
#else
            tr_emit32_bf16(va, FF, (bf16_t*)(ws + WS_W_FFNGU), D, RmGU{128}, scr, j, lane); }
#endif
    } else if (s == 2) {
        _Pragma("nounroll") for (int j = j0; j < NF; j += dj) { float va[32];
            tr_load32(va, args.in[I_FFN_D], FF, D, j, lane);
#if FFN_FP8 == 1
            tr_emit32_f8(va, D, ws + WS_W_FFND, FF, MOE_D_WS, RmId{0}, scr, j, lane); }
#else
            tr_emit32_bf16(va, D, (bf16_t*)(ws + WS_W_FFND), FF, RmId{0}, scr, j, lane); }
#endif
    } else {
        _Pragma("nounroll") for (int j = j0; j < NI; j += dj) { float va[32];
            tr_load32(va, args.in[I_NSA_WIN], D, NSA_IN, j, lane);
#if NSAIN_FP8
            tr_emit32_f8(va, NSA_IN, ws + WS_W_NSAIN, D, MOE_GU_WS, RmId{0}, scr, j, lane);
#else
            tr_emit32_bf16(va, NSA_IN, (bf16_t*)(ws + WS_W_NSAIN), D, RmId{0}, scr, j, lane);
#endif
        }
    }
}
#endif

__global__ void __launch_bounds__(NWAVES * 64, 2) fwd(Args args) {
#if defined(__HIP_DEVICE_COMPILE__)
    extern __shared__ __attribute__((aligned(16))) unsigned char lds_raw[];
    LAS unsigned char* lds = (LAS unsigned char*)lds_raw;
    volatile LAS unsigned* MISC = (volatile LAS unsigned*)(lds + MISC_OFF);
    const int wave = __builtin_amdgcn_readfirstlane(threadIdx.x >> 6);
    const int G = gridDim.x, bx = blockIdx.x;
    const int vcu = (G % 8 == 0) ? (bx % 8) * (G / 8) + bx / 8 : bx;
    const int NGW = G * NWAVES;
    unsigned char* ws = args.ws;
    unsigned* ctl = (unsigned*)(ws + WS_CTL);
    for (int u = threadIdx.x; u < (LDS_BYTES - RING_BYTES) / 4; u += NWAVES * 64) ((LAS unsigned*)(lds + RING_BYTES))[u] = 0u;
    __syncthreads();
    XcdBarrier bar = xcd_barrier_post(ctl + CW_BAR, MISC + 8);
    const int lo = args.ph_lo, hi_ph = args.ph_hi;
#ifndef PHMASK
#define PHMASK 0xFFFFFFFFu
#endif
#define IN(k) (((PHMASK >> (k)) & 1u) && lo <= (k) && (k) < hi_ph)
#define SEAM(k) do { if (IN(k) && IN((k) + 1)) xcd_barrier(bar); } while (0)
#if defined(STAMP_PH)
    unsigned long long st_t0 = 0, st_t1 = 0;
#ifndef STAMP_N
#define STAMP_N 1
#endif
#ifndef STAMP_SHIFT
#define STAMP_SHIFT 0.0f
#endif
#define STAMP_AT(idx) do { if ((idx) + 1 == STAMP_PH) st_t0 = __builtin_amdgcn_s_memrealtime(); if ((idx) == STAMP_PH + STAMP_N - 1) st_t1 = __builtin_amdgcn_s_memrealtime(); } while (0)
#else
#define STAMP_AT(idx) do { } while (0)
#endif
#ifndef DUP_MASK
#define DUP_MASK 0u
#endif
#define REP(k) _Pragma("nounroll") for (int rep_ = 0; rep_ < 1 + (int)((DUP_MASK >> (k)) & 1u); ++rep_, (((DUP_MASK >> (k)) & 1u) && rep_ == 1) ? xcd_barrier(bar) : (void)0)
#define W_MLAIN ((bf16_t*)(ws + WS_W_MLAIN))
#define W_QUP ((bf16_t*)(ws + WS_W_QUP))
#define W_KVUP ((bf16_t*)(ws + WS_W_KVUP))
#define W_MLAOUT ((bf16_t*)(ws + WS_W_MLAOUT))
#define W_FFNGU ((bf16_t*)(ws + WS_W_FFNGU))
#define W_FFND ((bf16_t*)(ws + WS_W_FFND))
#define W_NSAIN ((bf16_t*)(ws + WS_W_NSAIN))
#define W_NSAOUT ((bf16_t*)(ws + WS_W_NSAOUT))
#define W_C1K ((bf16_t*)(ws + WS_W_C1K))
#define W_C1V ((bf16_t*)(ws + WS_W_C1V))
#define W_C2K ((bf16_t*)(ws + WS_W_C2K))
#define W_C2V ((bf16_t*)(ws + WS_W_C2V))
#define ROPE_C ((float*)(ws + WS_ROPE))
#define CBIAS ((float*)(ws + WS_CBIAS))
#define RBT ((float*)(ws + WS_RBT))
#define ROWTOK ((int*)(ws + WS_ROWTOK))
#define TOKINFO ((unsigned*)(ws + WS_TOKINFO))
#define TOKW ((float*)(ws + WS_TOKW))
#define XB ((bf16_t*)(ws + WS_XB))
#define LAT ((bf16_t*)(ws + WS_LAT))
#define QN ((bf16_t*)(ws + WS_QN))
#define SSQ ((float*)(ws + WS_QN))
#define KVN ((bf16_t*)(ws + WS_KVN))
#define KR ((bf16_t*)(ws + WS_KR))
#define Q ((bf16_t*)(ws + WS_Q))
#define KN ((bf16_t*)(ws + WS_KN))
#define V ((bf16_t*)(ws + WS_V))
#define O ((bf16_t*)(ws + WS_O))
#define X1 ((bf16_t*)(ws + WS_X1))
#define ACT ((bf16_t*)(ws + WS_ACT))
#define X2 ((bf16_t*)(ws + WS_X2))
#define NQ ((bf16_t*)(ws + WS_NQ))
#define KC ((bf16_t*)(ws + WS_KC))
#define VC ((bf16_t*)(ws + WS_VC))
#define KS ((bf16_t*)(ws + WS_KS))
#define VS ((bf16_t*)(ws + WS_VS))
#define KW ((bf16_t*)(ws + WS_KW))
#define VW ((bf16_t*)(ws + WS_VW))
#define GT ((float*)(ws + WS_GT))
#define HK ((bf16_t*)(ws + WS_HK))
#define HV ((bf16_t*)(ws + WS_HV))
#define KCMP ((bf16_t*)(ws + WS_KCMP))
#define VCMP ((bf16_t*)(ws + WS_VCMP))
#define ONSA ((bf16_t*)(ws + WS_ONSA))
#define X3 ((bf16_t*)(ws + WS_X3))
#define W_MOEGU ((bf16_t*)(ws + WS_MOE_GU))
#define W_MOED ((bf16_t*)(ws + WS_MOE_D))
#define DOUT ((bf16_t*)(ws + WS_DOUT))
#define W_MOEGU8 ((unsigned char*)(ws + WS_MOE_GU8))
#define W_MOED8 ((unsigned char*)(ws + WS_MOE_D8))
#define X3F8 ((unsigned char*)(ws + WS_X3F8))
#define ROPE_S (ROPE_C + SEQ * 32)
#define PB ((bf16_t*)args.out)
#define ACTC ((bf16_t*)args.out)
    typedef pg8::SchedPlain SP;
#define PH_LAUNDER() const int lane = fresh_lane(); const int tid = wave * 64 + lane; const int gw = vcu * NWAVES + wave; LAS float* scr = (LAS float*)(lds + wave * 8704); (void)lane; (void)gw; (void)scr;

    REP(0) if (IN(0)) {
        PH_LAUNDER();
        const float* const* in = args.in;
#ifndef P0SUB
#define P0SUB 0
#endif
        _Pragma("nounroll") for (int rp_ = 0; rp_ < (P0SUB == 1 ? 2 : 1); ++rp_) {
        tr_matrix(in[I_MLA_WIN], D, MLA_IN, W_MLAIN, D, RmLat{}, scr, gw, NGW, lane);
        tr_matrix(in[I_MLA_WQ], MLA_QR, 1536, W_QUP, MLA_QR, RmQup{}, scr, gw, NGW, lane, in[I_MLA_QN]);
        tr_matrix(in[I_MLA_WKV], MLA_KVR, 2048, W_KVUP, MLA_KVR, RmId{0}, scr, gw, NGW, lane, in[I_MLA_KVN]);
        tr_matrix(in[I_MLA_WO], D, D, W_MLAOUT, D, RmId{0}, scr, gw, NGW, lane);
        }
        const int gt = vcu * 512 + tid, NGT = G * 512;
        _Pragma("nounroll") for (int rp_ = 0; rp_ < (P0SUB == 2 ? 2 : 1); ++rp_) {
        for (int i = gt; i < (1024 - MLA_IN) * D / 8; i += NGT) ((u32x4*)(W_MLAIN + (size_t)MLA_IN * D))[i] = (u32x4){0u, 0u, 0u, 0u};
#if NSAIN_FP8
        for (int i = gt; i < (NSA_INP - NSA_IN) * D / 16; i += NGT) ((u32x4*)((unsigned char*)W_NSAIN + (size_t)NSA_IN * D))[i] = (u32x4){0u, 0u, 0u, 0u};
#else
        for (int i = gt; i < (NSA_INP - NSA_IN) * D / 8; i += NGT) ((u32x4*)(W_NSAIN + (size_t)NSA_IN * D))[i] = (u32x4){0u, 0u, 0u, 0u};
#endif
        for (int i = gt; i < 256 * 3072; i += NGT) { const int n = i / 3072, k = i % 3072; W_C1K[i] = (bf16_t)(n < 96 ? f2bf(in[I_W1_K][(size_t)k * 96 + n]) : 0u); }
        for (int i = gt; i < 256 * 2048; i += NGT) { const int n = i / 2048, k = i % 2048; W_C1V[i] = (bf16_t)(n < 64 ? f2bf(in[I_W1_V][(size_t)k * 64 + n]) : 0u); }
        for (int i = gt; i < 256 * 128; i += NGT) { const int n = i / 128, k = i % 128;
            W_C2K[i] = (bf16_t)((n < 96 && k < 96) ? f2bf(in[I_W2_K][k * 96 + n]) : 0u); W_C2V[i] = (bf16_t)((n < 64 && k < 64) ? f2bf(in[I_W2_V][k * 64 + n]) : 0u); }
        for (int i = gw; i < 256; i += NGW) { const int isv = i >> 7, e = i & 127; const int nd = isv ? 64 : 96; float s = 0.f;
            if (e < nd) { const float* pe = in[isv ? I_PE_V : I_PE_K]; const float* w1 = in[isv ? I_W1_V : I_W1_K]; _Pragma("unroll 8") for (int k = lane; k < 32 * nd; k += 64) s += pe[k] * w1[(size_t)k * nd + e]; }
            s = wave_sum(s); if (lane == 0) CBIAS[i] = s; }
        for (int i = gt; i < SEQ * 32; i += NGT) { const int pos = i >> 5, j = i & 31; const float fr = (float)exp2(-(double)j * (13.287712379549449 / 32.0));
            const float ang = (float)pos * fr;
            const double a = (double)ang, red = a - rint(a * 0.15915494309189535) * 6.283185307179586;
            ROPE_C[i] = cosf((float)red); ROPE_S[i] = sinf((float)red); }
        for (int i = gt; i < 16 * nsa::TABW; i += NGT) { const int h = i / nsa::TABW, d = i % nsa::TABW; const float* rb = in[I_RELB];
            RBT[i] = d < 128 ? (rb[rel_bucket_dev(d) * 16 + h] - rb[31 * 16 + h]) * LOG2E : 0.f; }
        }
        _Pragma("nounroll") for (int rp_ = 0; rp_ < (P0SUB == 3 ? 2 : 1); ++rp_) {
        for (int m0 = gw; m0 < T; m0 += 4 * NGW) { f32x4 v[4][4];
#pragma unroll
            for (int r = 0; r < 4; ++r) { const int m = m0 + r * NGW; const f32x4* xr = (const f32x4*)(in[I_X] + (size_t)(m < T ? m : 0) * D) + lane;
#pragma unroll
                for (int j = 0; j < 4; ++j) v[r][j] = xr[64 * j]; }
#pragma unroll
            for (int r = 0; r < 4; ++r) { const int m = m0 + r * NGW; if (m < T) store_row_bf16(XB + (size_t)m * D, v[r], lane); } }
        }
    }
    SEAM(0);
    STAMP_AT(0);
    REP(1) if (IN(1)) { pg8::Gemm g{XB, W_MLAIN, (D) * 2, (D) * 2, (D) * 2}; SP S; S.init(T / 256, 4, G, bx);
        pg8::EpiRow8<FLat> E{FLat{LAT, SSQ, KR, ROPE_C, ROPE_S}}; pg8::gemm_phase<pg8::EpiRow8<FLat>, SP, true, false>(lds, wave, g, S, E); }
    SEAM(1);
    STAMP_AT(1);
    REP(3) if (IN(3)) { pg8::Gemm g{LAT, W_QUP, 1024 * 2, (MLA_QR) * 2, (MLA_QR) * 2}; SP S; S.init(T / 256, 6, G, bx);
        pg8::EpiRow8S<FQup, RsQ> E{FQup{Q, ROPE_C, ROPE_S}, RsQ{SSQ}}; pg8::gemm_phase<pg8::EpiRow8S<FQup, RsQ>, SP, true, false>(lds, wave, g, S, E);
        { pg8::Gemm g{LAT + 512, W_KVUP, 1024 * 2, (MLA_KVR) * 2, (MLA_KVR) * 2}; SP S; S.init(T / 256, 8, G, bx);
        pg8::EpiRow8S<FKvup, RsKv> E{FKvup{KN, (size_t)(WS_V - WS_KN) / 2}, RsKv{SSQ}}; pg8::gemm_phase<pg8::EpiRow8S<FKvup, RsKv>, SP, true, false>(lds, wave, g, S, E); }
    }
    SEAM(4);
    STAMP_AT(4);
    REP(5) if (IN(5)) {
        PH_LAUNDER();
        att::Plan<mla::R> plan; plan.init(wave, lane);
        int cs = 0;
        for (int it2 = 2 * bx; it2 < 2 * NB * MLA_H * 16; it2 += (it2 & 1) ? 2 * G - 1 : 1) { const int it = it2 >> 1, bh = it & 31, x = it >> 5;
            mla::unit((LAS char*)lds, plan, bh >> 3, bh & 7, (it2 & 1) ? x : 31 - x, Q, KN, KR, V, O, tid, wave);
            if (cs < 4) { __syncthreads(); layer_convert_slice(args, ws, lds, cs, vcu, wave, G); ++cs; __syncthreads(); } }
        if (cs < 4) __syncthreads();
        _Pragma("nounroll") for (; cs < 4; ++cs) layer_convert_slice(args, ws, lds, cs, vcu, wave, G);
    }
    SEAM(5);
    STAMP_AT(5);

#if defined(SELFTEST) && SELFTEST == 1
    {
        PH_LAUNDER();
        const float* const* in = args.in; const int gt = vcu * 512 + tid, NGT = G * 512;
        float* TKV = (float*)(ws + 104 * MiB); float* TLAT = (float*)(ws + 168 * MiB); float* TQ = (float*)(ws + 200 * MiB);
        float* TKR = (float*)(ws + 250 * MiB); float* TKVN = (float*)(ws + 256 * MiB); float* TQN = (float*)(ws + 264 * MiB);
        const float* xb = in[I_X] + (size_t)st::TB * SEQ * D;
        st::naive_mm(SEQ, 832, 1024, in[I_MLA_WIN], 832, 0, [&](int m, int k) { return xb[(size_t)m * D + k]; }, [&](int m, int n, float v) { TLAT[(size_t)m * 832 + n] = v; }, gt, NGT);
        xcd_barrier(bar);
        for (int m = gw; m < SEQ; m += NGW) { const float* r = TLAT + (size_t)m * 832; float sq = 0.f, sk = 0.f;
            for (int k = lane; k < 512; k += 64) sq += r[k] * r[k];
            for (int k = lane; k < 256; k += 64) sk += r[512 + k] * r[512 + k];
            sq = wave_sum(sq); sk = wave_sum(sk);
            const float rq = 1.f / sqrtf(sq / 512.f + 1e-6f), rk = 1.f / sqrtf(sk / 256.f + 1e-6f);
            for (int k = lane; k < 512; k += 64) TQN[(size_t)m * 512 + k] = r[k] * rq * in[I_MLA_QN][k];
            for (int k = lane; k < 256; k += 64) TKVN[(size_t)m * 256 + k] = r[512 + k] * rk * in[I_MLA_KVN][k];
            if (lane < 32) { const float fr = powf(10000.f, -(float)lane / 32.f), ang = (float)m * fr, c = cosf(ang), sn = sinf(ang), x1 = r[768 + lane], x2 = r[800 + lane];
                TKR[(size_t)m * 64 + lane] = x1 * c - x2 * sn; TKR[(size_t)m * 64 + 32 + lane] = x1 * sn + x2 * c; } }
        xcd_barrier(bar);
        st::naive_mm(SEQ, 1536, 512, in[I_MLA_WQ], 1536, 0, [&](int m, int k) { return TQN[(size_t)m * 512 + k]; }, [&](int m, int n, float v) { TQ[(size_t)m * 1536 + n] = v; }, gt, NGT);
        st::naive_mm(SEQ, 2048, 256, in[I_MLA_WKV], 2048, 0, [&](int m, int k) { return TKVN[(size_t)m * 256 + k]; }, [&](int m, int n, float v) { TKV[(size_t)m * 2048 + n] = v; }, gt, NGT);
        xcd_barrier(bar);
        for (int m = gw; m < SEQ; m += NGW) for (int e = lane; e < 256; e += 64) { const int h = e >> 5, i = e & 31; float* q = TQ + (size_t)m * 1536 + h * 192 + 128;
            const float fr = powf(10000.f, -(float)i / 32.f), ang = (float)m * fr, c = cosf(ang), sn = sinf(ang), x1 = q[i], x2 = q[32 + i]; q[i] = x1 * c - x2 * sn; q[32 + i] = x1 * sn + x2 * c; }
        xcd_barrier(bar);
        float err = 0.f, ref2 = 0.f;
        for (int row = gw; row < MLA_H * SEQ; row += NGW) { const int h = row & 7, q = row >> 3;
            const float* qv = TQ + (size_t)q * 1536 + h * 192; const float q0 = qv[lane], q1 = qv[64 + lane], q2 = qv[128 + lane];
            float mm = -__builtin_inff(), l = 0.f, a0 = 0.f, a1 = 0.f;
            for (int k = 0; k <= q; ++k) { const float* kn = TKV + (size_t)k * 2048 + h * 256; const float* kr = TKR + (size_t)k * 64;
                const float sc = wave_sum(q0 * kn[lane] + q1 * kn[64 + lane] + q2 * kr[lane]) * 0.07216878364870323f;
                const float mn = fmaxf(mm, sc), al = __expf(mm - mn), p = __expf(sc - mn);
                l = l * al + p; a0 = a0 * al + p * kn[128 + lane]; a1 = a1 * al + p * kn[192 + lane]; mm = mn; }
            const float o0 = a0 / l, o1 = a1 / l; const bf16_t* fo = O + ((size_t)st::TB * SEQ + q) * 1024 + h * 128;
            const float f0 = bf2f(fo[lane]), f1 = bf2f(fo[64 + lane]);
            err += (f0 - o0) * (f0 - o0) + (f1 - o1) * (f1 - o1); ref2 += o0 * o0 + o1 * o1; }
        err = wave_sum(err); ref2 = wave_sum(ref2);
        if (lane == 0) { atomicAdd((float*)(ctl + st::CW_ERR), err); atomicAdd((float*)(ctl + st::CW_ERR + 1), ref2); }
        xcd_barrier(bar);
    }
#endif
    REP(6) if (IN(6)) { pg8::Gemm g{O, W_MLAOUT, (D) * 2, (D) * 2, (D) * 2}; SP S; S.init(T / 256, 4, G, bx);
        pg8::EpiRow8<FResBf16> E{FResBf16{PB, args.in[I_X], nullptr, 1.f}}; pg8::gemm_phase<pg8::EpiRow8<FResBf16>, SP, true, false>(lds, wave, g, S, E); }
    SEAM(6);
    STAMP_AT(6);
    REP(7) if (IN(7)) {
        PH_LAUNDER();
        for (int m0 = gw; m0 < T; m0 += 4 * NGW) { f32x4 v[4][4];
#pragma unroll
            for (int r = 0; r < 4; ++r) { const int m = m0 + r * NGW < T ? m0 + r * NGW : 0; const u32x2* pr = (const u32x2*)(PB + (size_t)m * D) + lane;
#pragma unroll
                for (int j = 0; j < 4; ++j) v[r][j] = bf4_to_f32(pr[64 * j]); }
#pragma unroll
            for (int r = 0; r < 4; ++r) { const int m = m0 + r * NGW; if (m >= T) continue;
                ln_inplace(v[r], args.in[I_LNM_G], args.in[I_LNM_B], lane); store_row_bf16(X1 + (size_t)m * D, v[r], lane);
#if FFN_FP8
#pragma unroll
                for (int j = 0; j < 4; ++j) *((unsigned*)(ws + WS_X1F8 + (size_t)m * D) + lane + 64 * j) = pk4_fp8(v[r][j].x, v[r][j].y, v[r][j].z, v[r][j].w);
#endif
 }
        }
    }
    SEAM(7);
    STAMP_AT(7);
#if FFN_FP8 == 2
    REP(8) if (IN(8)) { pg8::Gemm g{ws + WS_X1F8, W_FFNGU, D, D, D}; SP S; S.init(T / 256, 22, G, bx);
        pg8::EpiGateUp<FSwigluS> E{FSwigluS{ACT, FF, 1.f / MOE_GU_WS}}; pg8::gemm_phase<pg8::EpiGateUp<FSwigluS>, SP, true, false, true>(lds, wave, g, S, E); }
#elif FFN_FP8
    REP(8) if (IN(8)) { pg8::Gemm g{ws + WS_X1F8, W_FFNGU, D, D, D}; SP S; S.init(T / 256, 22, G, bx);
        pg8::EpiGateUp<FSwigluF8> E{FSwigluF8{(unsigned char*)ACT, FF, 1.f / MOE_GU_WS, MOE_H_S}}; pg8::gemm_phase<pg8::EpiGateUp<FSwigluF8>, SP, true, false, true>(lds, wave, g, S, E); }
#else
    REP(8) if (IN(8)) { pg8::Gemm g{X1, W_FFNGU, (D) * 2, (D) * 2, (D) * 2}; SP S; S.init(T / 256, 22, G, bx);
        pg8::EpiGateUp<FSwiglu> E{FSwiglu{ACT, FF, 0}}; pg8::gemm_phase<pg8::EpiGateUp<FSwiglu>, SP, true, false>(lds, wave, g, S, E); }
#endif
    SEAM(8);
    STAMP_AT(8);
#if defined(XBAR)
    for (int i_ = 0; i_ < XBAR; ++i_) xcd_barrier(bar);
#endif
#if FFN_FP8 == 1
    REP(9) if (IN(9)) { pg8::Gemm g{ACT, W_FFND, FF, FF, FF}; SP S; S.init(T / 256, 4, G, bx);
        pg8::EpiRow8<FResBf16> E{FResBf16{PB, nullptr, X1, 1.f / (MOE_D_WS * MOE_H_S)}}; pg8::gemm_phase<pg8::EpiRow8<FResBf16>, SP, true, false, true>(lds, wave, g, S, E); }
#else
    REP(9) if (IN(9)) { pg8::Gemm g{ACT, W_FFND, (FF) * 2, (FF) * 2, (FF) * 2}; SP S; S.init(T / 256, 4, G, bx);
        pg8::EpiRow8<FResBf16> E{FResBf16{PB, nullptr, X1, 1.f}}; pg8::gemm_phase<pg8::EpiRow8<FResBf16>, SP, true, false>(lds, wave, g, S, E); }
#endif
    SEAM(9);
    STAMP_AT(9);
    REP(10) if (IN(10)) {
        PH_LAUNDER();
        for (int m0 = gw; m0 < T; m0 += 4 * NGW) { f32x4 v[4][4];
#pragma unroll
            for (int r = 0; r < 4; ++r) { const int m = m0 + r * NGW < T ? m0 + r * NGW : 0; const u32x2* pr = (const u32x2*)(PB + (size_t)m * D) + lane;
#pragma unroll
                for (int j = 0; j < 4; ++j) v[r][j] = bf4_to_f32(pr[64 * j]); }
#pragma unroll
            for (int r = 0; r < 4; ++r) { const int m = m0 + r * NGW; if (m >= T) continue;
                ln_inplace(v[r], args.in[I_LNF_G], args.in[I_LNF_B], lane); store_row_bf16(X2 + (size_t)m * D, v[r], lane);
#if NSAIN_FP8
#pragma unroll
                for (int j = 0; j < 4; ++j) *((unsigned*)(ws + WS_X2F8 + (size_t)m * D) + lane + 64 * j) = pk4_fp8(v[r][j].x, v[r][j].y, v[r][j].z, v[r][j].w);
#endif
            }
        }
    }
    SEAM(10);
    STAMP_AT(10);
#if NSAIN_FP8
    REP(11) if (IN(11)) { pg8::Gemm g{ws + WS_X2F8, W_NSAIN, D, D, D}; SP S; S.init(T / 256, NSA_INP / 256, G, bx);
        pg8::EpiRow8C<FNsaIn> E{FNsaIn{NQ, KC, VC, GT, 1.f / MOE_GU_WS}}; pg8::gemm_phase<pg8::EpiRow8C<FNsaIn>, SP, true, false, true>(lds, wave, g, S, E); }
#else
    REP(11) if (IN(11)) { pg8::Gemm g{X2, W_NSAIN, (D) * 2, (D) * 2, (D) * 2}; SP S; S.init(T / 256, NSA_INP / 256, G, bx);
        pg8::EpiRow8C<FNsaIn> E{FNsaIn{NQ, KC, VC, GT, 1.f}}; pg8::gemm_phase<pg8::EpiRow8C<FNsaIn>, SP, true, false>(lds, wave, g, S, E); }
#endif
    SEAM(11);
    STAMP_AT(11);
    REP(12) if (IN(12)) {
        { pg8::Gemm g{KC, W_C1K, (16 * 96) * 2, (3072) * 2, (3072) * 2}; SP S; S.init(32, 1, G, bx);
          pg8::EpiRow8<FCmp1> E{FCmp1{HK, CBIAS}}; pg8::gemm_phase<pg8::EpiRow8<FCmp1>, SP, false, false>(lds, wave, g, S, E); }
        { pg8::Gemm g{VC, W_C1V, (16 * 64) * 2, (2048) * 2, (2048) * 2}; SP S; S.init(32, 1, G, (bx + G / 2) % G);
          pg8::EpiRow8<FCmp1> E{FCmp1{HV, CBIAS + 128}}; pg8::gemm_phase<pg8::EpiRow8<FCmp1>, SP, false, false>(lds, wave, g, S, E); }
    }
    if (IN(12) && IN(13)) { __builtin_amdgcn_fence(__ATOMIC_RELEASE, "workgroup"); __builtin_amdgcn_s_barrier(); __builtin_amdgcn_fence(__ATOMIC_ACQUIRE, "workgroup"); }
    REP(13) if (IN(13)) {
        { pg8::Gemm g{HK, W_C2K, (128) * 2, (128) * 2, (128) * 2}; SP S; S.init(32, 1, G, bx);
          pg8::EpiRow8<FCmp2> E{FCmp2{KCMP, 96}}; pg8::gemm_phase<pg8::EpiRow8<FCmp2>, SP, false, false>(lds, wave, g, S, E); }
        { pg8::Gemm g{HV, W_C2V, (128) * 2, (128) * 2, (128) * 2}; SP S; S.init(32, 1, G, (bx + G / 2) % G);
          pg8::EpiRow8<FCmp2> E{FCmp2{VCMP, 64}}; pg8::gemm_phase<pg8::EpiRow8<FCmp2>, SP, false, false>(lds, wave, g, S, E); }
    }
    SEAM(13);
    STAMP_AT(13);

#if defined(SELFTEST) && SELFTEST == 3
    {
        PH_LAUNDER();
        const float* const* in = args.in; const int gt = vcu * 512 + tid, NGT = G * 512;
        float* TPROJ = (float*)(ws + 348 * MiB);
        float* THK = (float*)(ws + 460 * MiB); float* THV = (float*)(ws + 461 * MiB); float* TKC = (float*)(ws + 462 * MiB); float* TVC = (float*)(ws + 463 * MiB);
        const bf16_t* xb = X2 + (size_t)st::TB * SEQ * D;
        st::naive_mm(SEQ, 3504, 1024, in[I_NSA_WIN], 3504, 0, [&](int m, int k) { return bf2f(xb[(size_t)m * D + k]); }, [&](int m, int n, float v) { TPROJ[(size_t)m * 3504 + n] = v; }, gt, NGT);
        xcd_barrier(bar);
        for (int i = gt; i < 4 * 511 * 96; i += NGT) { const int e = i % 96, n = (i / 96) % 511, g = i / (96 * 511); float s = 0.f;
            for (int l = 0; l < 32; ++l) for (int d = 0; d < 96; ++d) s += (TPROJ[(size_t)(16 * n + l) * 3504 + 1536 + g * 96 + d] + in[I_PE_K][l * 96 + d]) * in[I_W1_K][(size_t)(l * 96 + d) * 96 + e];
            THK[(g * 512 + n) * 96 + e] = 0.5f * s * (1.f + tanhf(0.7978845608028654f * (s + 0.044715f * s * s * s))); }
        for (int i = gt; i < 4 * 511 * 64; i += NGT) { const int e = i % 64, n = (i / 64) % 511, g = i / (64 * 511); float s = 0.f;
            for (int l = 0; l < 32; ++l) for (int d = 0; d < 64; ++d) s += (TPROJ[(size_t)(16 * n + l) * 3504 + 1920 + g * 64 + d] + in[I_PE_V][l * 64 + d]) * in[I_W1_V][(size_t)(l * 64 + d) * 64 + e];
            THV[(g * 512 + n) * 64 + e] = 0.5f * s * (1.f + tanhf(0.7978845608028654f * (s + 0.044715f * s * s * s))); }
        xcd_barrier(bar);
        float err = 0.f, ref2 = 0.f;
        for (int i = gt; i < 4 * 511 * 96; i += NGT) { const int e = i % 96, n = (i / 96) % 511, g = i / (96 * 511); float s = 0.f; for (int d = 0; d < 96; ++d) s += THK[(g * 512 + n) * 96 + d] * in[I_W2_K][d * 96 + e];
            const float f = bf2f(KCMP[((size_t)(st::TB * 4 + g) * 512 + n) * 96 + e]); err += (f - s) * (f - s); ref2 += s * s; }
        for (int i = gt; i < 4 * 511 * 64; i += NGT) { const int e = i % 64, n = (i / 64) % 511, g = i / (64 * 511); float s = 0.f; for (int d = 0; d < 64; ++d) s += THV[(g * 512 + n) * 64 + d] * in[I_W2_V][d * 64 + e];
            const float f = bf2f(VCMP[((size_t)(st::TB * 4 + g) * 512 + n) * 64 + e]); err += (f - s) * (f - s); ref2 += s * s; }
        for (long i = gt; i < (long)SEQ * 3504; i += NGT) { const int m = (int)(i / 3504), c = (int)(i % 3504); const float r = TPROJ[i]; const size_t trow = (size_t)st::TB * SEQ + m; float f, rr = r;
            if (c < 1536) { f = bf2f(NQ[trow * 1536 + c]); rr = r * C2_NSA; }
            else if (c >= 3456) { f = GT[trow * 48 + (c - 3456)]; rr = 1.f / (1.f + __expf(-r)); }
            else { int cc = c - 1536; const bf16_t* base; int dd;
                if (cc < 384) { base = KC; dd = 96; } else if (cc < 640) { base = VC; dd = 64; cc -= 384; } else if (cc < 1024) { base = KS; dd = 96; cc -= 640; } else if (cc < 1280) { base = VS; dd = 64; cc -= 1024; }
                else if (cc < 1664) { base = KW; dd = 96; cc -= 1280; } else { base = VW; dd = 64; cc -= 1664; }
                const int g = cc / dd, d = cc % dd; f = bf2f(base[((size_t)(st::TB * 4 + g) * SEQ + m) * dd + d]); }
            err += (f - rr) * (f - rr); ref2 += rr * rr; }
        err = wave_sum(err); ref2 = wave_sum(ref2);
        if (lane == 0) { atomicAdd((float*)(ctl + st::CW_ERR), err); atomicAdd((float*)(ctl + st::CW_ERR + 1), ref2); }
        xcd_barrier(bar);
    }
#endif
#if defined(XNSA)
    {
        PH_LAUNDER();
        const nsa::Tensors X{NQ, KCMP, VCMP, KS, VS, KW, VW, GT, RBT, (bf16_t*)args.out};
        att::Plan<nsa::R> plan; plan.init(wave, lane);
        for (int it2 = 2 * bx; it2 < 2 * NB * NSA_G * 64; it2 += (it2 & 1) ? 2 * G - 1 : 1) { const int it = it2 >> 1, bg = it & 15, x = it >> 4;
            nsa::unit<XNSA>((LAS char*)lds, plan, X, bg >> 2, bg & 3, (it2 & 1) ? x : 127 - x, tid, wave); }
        xcd_barrier(bar);
    }
#endif
    REP(14) if (IN(14)) {
        PH_LAUNDER();
        const nsa::Tensors X{NQ, KCMP, VCMP, KS, VS, KW, VW, GT, RBT, ONSA};
        att::Plan<nsa::R> plan; plan.init(wave, lane);
        int cs = 0;
        for (int it2 = 2 * bx; it2 < 2 * NB * NSA_G * 64; it2 += (it2 & 1) ? 2 * G - 1 : 1) { const int it = it2 >> 1, bg = it & 15, x = it >> 4;
            nsa::unit((LAS char*)lds, plan, X, bg >> 2, bg & 3, (it2 & 1) ? x : 127 - x, tid, wave);
#if MOE_FP8
            if (cs < NE) { moe_convert_slice(args, ws, lds, cs, vcu, wave, G); ++cs; __syncthreads(); }
#endif
        }
#if MOE_FP8
        _Pragma("nounroll") for (; cs < NE; ++cs) moe_convert_slice(args, ws, lds, cs, vcu, wave, G);
#endif
    }
    SEAM(14);
    STAMP_AT(14);

#if defined(SELFTEST) && SELFTEST == 2
    {
        PH_LAUNDER();
        const float* rb = args.in[I_RELB];
        LAS float* buf = (LAS float*)(lds + wave * 6144); LAS float* imp = buf + 1024; LAS int* sel = (LAS int*)(imp + 128);
        const float scale_q = 1.f / LOG2E;
        float err = 0.f, ref2 = 0.f;
        for (int item = gw; item < NSA_G * SEQ; item += NGW) { const int g = item & 3, q = item >> 2, qpos = q, cur = q >> 6; const size_t trow = (size_t)st::TB * SEQ + q; const int bg = st::TB * NSA_G + g;
            float oacc[4] = {0.f, 0.f, 0.f, 0.f};
            imp[lane] = 0.f; imp[64 + lane] = 0.f;
            int nvalid = qpos >= 31 ? ((qpos - 31) >> 4) + 1 : 0; if (nvalid > 511) nvalid = 511;
            const bf16_t* kc = KCMP + (size_t)bg * 512 * 96; const bf16_t* vc = VCMP + (size_t)bg * 512 * 64;
            const bf16_t* ks = KS + (size_t)bg * SEQ * 96; const bf16_t* vs = VS + (size_t)bg * SEQ * 64; const bf16_t* kw = KW + (size_t)bg * SEQ * 96; const bf16_t* vw = VW + (size_t)bg * SEQ * 64;
            for (int h = 0; h < 4; ++h) { const int head = g * 4 + h; const bf16_t* qv = NQ + trow * 1536 + head * 96;
                float mx = -__builtin_inff();
                for (int n = lane; n < nvalid; n += 64) { float s = 0.f; for (int d = 0; d < 96; ++d) s += bf2f(qv[d]) * bf2f(kc[(size_t)n * 96 + d]);
                    s = s * scale_q + rb[st::rel_bucket_ref(qpos - 16 * n - 31) * 16 + head]; buf[n] = s; mx = fmaxf(mx, s); }
                mx = st::wave_max(mx); if (!(mx > -1e38f)) mx = 0.f;
                float sum = 0.f; LDS_WAIT();
                for (int n = lane; n < nvalid; n += 64) { const float p = __expf(buf[n] - mx); buf[n] = p; sum += p; }
                sum = wave_sum(sum); const float inv = 1.f / fmaxf(sum, 1e-30f);
                for (int n = lane; n < nvalid; n += 64) buf[n] *= inv;
                LDS_WAIT();
                float oc = 0.f; for (int n = 0; n < nvalid; ++n) oc += buf[n] * bf2f(vc[(size_t)n * 64 + lane]);
                oacc[h] += GT[trow * 48 + head * 3 + 0] * oc;
                for (int j = lane; j < 128; j += 64) { float a = 0.f; for (int n = 4 * j - 1; n <= 4 * j + 3; ++n) if (n >= 0 && n < nvalid) a += buf[n]; imp[j] += a; }
                LDS_WAIT();
            }
            float v0, v1; { const int j0 = lane, j1 = lane + 64;
                v0 = j0 > cur ? -1e6f : ((j0 == 0 || j0 == cur || j0 == cur - 1) ? 1e6f : imp[j0]); v1 = j1 > cur ? -1e6f : ((j1 == 0 || j1 == cur || j1 == cur - 1) ? 1e6f : imp[j1]); }
            for (int it = 0; it < 16; ++it) { float bv = v0; int bi = lane; if (v1 > v0) { bv = v1; bi = lane + 64; }
#pragma unroll
                for (int o = 1; o < 64; o <<= 1) { const float ov = __shfl_xor(bv, o); const int oi = __shfl_xor(bi, o); if (ov > bv || (ov == bv && oi < bi)) { bv = ov; bi = oi; } }
                if (lane == 0) sel[it] = bi;
                if (bi == lane) v0 = -__builtin_inff(); if (bi == lane + 64) v1 = -__builtin_inff(); }
            LDS_WAIT();
            for (int h = 0; h < 4; ++h) { const int head = g * 4 + h; const bf16_t* qv = NQ + trow * 1536 + head * 96;
                float mx = -__builtin_inff();
                for (int it = 0; it < 16; ++it) { const int kpos = sel[it] * 64 + lane, dist = qpos - kpos; float s = -__builtin_inff();
                    if (dist >= 0) { s = 0.f; for (int d = 0; d < 96; ++d) s += bf2f(qv[d]) * bf2f(ks[(size_t)kpos * 96 + d]); s = s * scale_q + rb[st::rel_bucket_ref(dist) * 16 + head]; }
                    buf[it * 64 + lane] = s; mx = fmaxf(mx, s); }
                mx = st::wave_max(mx); if (!(mx > -1e38f)) mx = 0.f;
                float sum = 0.f;
                for (int it = 0; it < 16; ++it) { const float p = __expf(buf[it * 64 + lane] - mx); buf[it * 64 + lane] = p; sum += p; }
                sum = wave_sum(sum); float inv = 1.f / fmaxf(sum, 1e-30f);
                LDS_WAIT();
                float os = 0.f; for (int i = 0; i < 1024; ++i) { const int kpos = sel[i >> 6] * 64 + (i & 63); os += buf[i] * bf2f(vs[(size_t)kpos * 64 + lane]); }
                oacc[h] += GT[trow * 48 + head * 3 + 1] * os * inv;
                LDS_WAIT();
                mx = -__builtin_inff();
                for (int i = lane; i < 512; i += 64) { const int kpos = qpos - i; float s = -__builtin_inff();
                    if (kpos >= 0) { s = 0.f; for (int d = 0; d < 96; ++d) s += bf2f(qv[d]) * bf2f(kw[(size_t)kpos * 96 + d]); s = s * scale_q + rb[st::rel_bucket_ref(i) * 16 + head]; }
                    buf[i] = s; mx = fmaxf(mx, s); }
                mx = st::wave_max(mx); if (!(mx > -1e38f)) mx = 0.f;
                sum = 0.f;
                for (int i = lane; i < 512; i += 64) { const float p = __expf(buf[i] - mx); buf[i] = p; sum += p; }
                sum = wave_sum(sum); inv = 1.f / fmaxf(sum, 1e-30f);
                LDS_WAIT();
                float ow = 0.f; for (int i = 0; i < 512; ++i) { const int kpos = qpos - i; if (kpos >= 0) ow += buf[i] * bf2f(vw[(size_t)kpos * 64 + lane]); }
                oacc[h] += GT[trow * 48 + head * 3 + 2] * ow * inv;
                LDS_WAIT();
                const float f = bf2f(ONSA[trow * 1024 + head * 64 + lane]);
                err += (f - oacc[h]) * (f - oacc[h]); ref2 += oacc[h] * oacc[h];
            }
        }
        err = wave_sum(err); ref2 = wave_sum(ref2);
        if (lane == 0) { atomicAdd((float*)(ctl + st::CW_ERR), err); atomicAdd((float*)(ctl + st::CW_ERR + 1), ref2); }
        xcd_barrier(bar);
    }
#endif
    REP(15) if (IN(15)) { pg8::Gemm g{ONSA, W_NSAOUT, (D) * 2, (D) * 2, (D) * 2}; SP S; S.init(T / 256, 4, G, bx);
        pg8::EpiRow8<FResBf16> E{FResBf16{PB, nullptr, X2, 1.f}}; pg8::gemm_phase<pg8::EpiRow8<FResBf16>, SP, true, false>(lds, wave, g, S, E); }
    SEAM(15);
    STAMP_AT(15);
    if (IN(16)) {
        PH_LAUNDER();
        LAS float* wr = (LAS float*)(lds + 69632);
        LAS unsigned* lcnt = (LAS unsigned*)(lds + 69632 + 32768);
        LAS unsigned* lrec = lcnt + 16;
        for (int i = tid; i < D * NE; i += 512) wr[i] = args.in[I_ROUTER][i];
        if (tid < 16) lcnt[tid] = 0u;
        __syncthreads();
        int nrec = 0;
        u32x2 nx[4];
        if (gw < T) { const u32x2* pr = (const u32x2*)(PB + (size_t)gw * D) + lane;
#pragma unroll
            for (int j = 0; j < 4; ++j) nx[j] = pr[64 * j]; }
        for (int m = gw; m < T; m += NGW, ++nrec) { f32x4 v[4];
#pragma unroll
            for (int j = 0; j < 4; ++j) v[j] = bf4_to_f32(nx[j]);
            if (m + NGW < T) { const u32x2* pr = (const u32x2*)(PB + (size_t)(m + NGW) * D) + lane;
#pragma unroll
                for (int j = 0; j < 4; ++j) nx[j] = pr[64 * j]; }
            ln_inplace(v, args.in[I_LNM_G] + D, args.in[I_LNM_B] + D, lane); store_row_bf16(X3 + (size_t)m * D, v, lane);
#if MOE_FP8
#pragma unroll
            for (int j = 0; j < 4; ++j) *((unsigned*)(X3F8 + (size_t)m * D) + lane + 64 * j) = pk4_fp8(v[j].x, v[j].y, v[j].z, v[j].w);
#endif
            float lg[NE];
#pragma unroll
            for (int e = 0; e < NE; ++e) lg[e] = 0.f;
#pragma unroll
            for (int j = 0; j < 4; ++j)
#pragma unroll
                for (int c = 0; c < 4; ++c) { const int k = 4 * lane + 256 * j + c; const f32x4 w0 = *(const LAS f32x4*)(wr + k * 8), w1 = *(const LAS f32x4*)(wr + k * 8 + 4); const float xv = v[j][c];
                    lg[0] += xv * w0[0]; lg[1] += xv * w0[1]; lg[2] += xv * w0[2]; lg[3] += xv * w0[3]; lg[4] += xv * w1[0]; lg[5] += xv * w1[1]; lg[6] += xv * w1[2]; lg[7] += xv * w1[3]; }
#pragma unroll
            for (int e = 0; e < NE; ++e) lg[e] = wave_sum(lg[e]);
            int e0 = 0; float v0 = lg[0];
#pragma unroll
            for (int e = 1; e < NE; ++e) if (lg[e] > v0) { v0 = lg[e]; e0 = e; }
            int e1 = -1; float v1 = -__builtin_inff();
#pragma unroll
            for (int e = 0; e < NE; ++e) if (e != e0 && lg[e] > v1) { v1 = lg[e]; e1 = e; }
            const float w1s = fast_rcp(1.f + __expf(v0 - v1)), w0s = 1.f - w1s;
            if (lane == 0) { const unsigned p0 = atomicAdd((unsigned*)(lcnt + e0), 1u), p1 = atomicAdd((unsigned*)(lcnt + e1), 1u);
                LAS unsigned* r = lrec + (wave * 32 + nrec) * 4; r[0] = (unsigned)m; r[1] = (unsigned)e0 | (p0 << 8); r[2] = (unsigned)e1 | (p1 << 8);
                TOKW[2 * m] = w0s; TOKW[2 * m + 1] = w1s; }
        }
        __syncthreads();
        if (tid < NE) lcnt[8 + tid] = __hip_atomic_fetch_add(ctl + CW_ECNT + 64 * tid, lcnt[tid], RLX_AGENT);
        __syncthreads();
        if (lane == 0) for (int i = 0; i < nrec; ++i) { const LAS unsigned* r = lrec + (wave * 32 + i) * 4; const unsigned m = r[0];
#pragma unroll
            for (int k = 0; k < 2; ++k) { const unsigned e = r[1 + k] & 255u, pos = lcnt[8 + e] + (r[1 + k] >> 8); ROWTOK[e * ECAP + pos] = (int)m; TOKINFO[2 * m + k] = (e << 16) | pos; } }
#if !MOE_FP8
        for (int e = 0; e < NE; ++e) {
            tr_matrix(args.in[I_MOE_G] + (size_t)e * D * FFE, D, FFE, W_MOEGU + (size_t)e * 2 * FFE * D, D, RmGU{0}, scr, gw, NGW, lane);
            tr_matrix(args.in[I_MOE_U] + (size_t)e * D * FFE, D, FFE, W_MOEGU + (size_t)e * 2 * FFE * D, D, RmGU{128}, scr, gw, NGW, lane);
            tr_matrix(args.in[I_MOE_D] + (size_t)e * FFE * D, FFE, D, W_MOED + (size_t)e * D * FFE, FFE, RmId{0}, scr, gw, NGW, lane);
        }
#endif
    }
    SEAM(16);
    STAMP_AT(16);
    REP(17) if (hi_ph > 17 && lo < 27) {
        MoeInfo mi; int acc_t = 0;
#pragma unroll
        for (int e = 0; e < NE; ++e) { const int c = (int)__builtin_amdgcn_readfirstlane(__hip_atomic_load(ctl + CW_ECNT + 64 * e, RLX_AGENT)); mi.cnt[e] = c; mi.ts[e] = acc_t; acc_t += (c + 255) >> 8; }
        mi.ts[NE] = acc_t;
        constexpr int MCH = MOE_FP8 ? 128 : 64, NCH = MOE_FP8 ? 2 : 5;
        for (int c = 0; c < NCH; ++c) {
            const int ct0 = MCH * c; int nM = acc_t - ct0; nM = nM < 0 ? 0 : ((c + 1 < NCH && nM > MCH) ? MCH : nM);
#if MOE_FP8
            if (IN(17 + 2 * c) && nM > 0) { pg8::Gemm g{X3F8, W_MOEGU8, D, D, D}; SchedMoeGU S; S.so.init(nM, 2 * FFE / 256, G, bx); S.mi = mi; S.ct0 = ct0; S.rowtok = ROWTOK; S.rowbytes = D;
                pg8::EpiGateUp<FSwigluF8> E{FSwigluF8{(unsigned char*)args.out, FFE, 1.f / MOE_GU_WS, MOE_H_S}}; pg8::gemm_phase<pg8::EpiGateUp<FSwigluF8>, SchedMoeGU, true, true, true>(lds, wave, g, S, E); }
            SEAM(17 + 2 * c);
            STAMP_AT(17 + 2 * c);
            if (IN(18 + 2 * c) && nM > 0) { pg8::Gemm g{(unsigned char*)args.out, W_MOED8, FFE, FFE, FFE}; SchedMoeD S; S.so.init(nM, 4, G, bx); S.mi = mi; S.ct0 = ct0;
                pg8::EpiRow8<FBf16S> E{FBf16S{DOUT, D, ct0 * 256, 1.f / (MOE_D_WS * MOE_H_S)}}; pg8::gemm_phase<pg8::EpiRow8<FBf16S>, SchedMoeD, true, false, true>(lds, wave, g, S, E); }
#else
            if (IN(17 + 2 * c) && nM > 0) { pg8::Gemm g{X3, W_MOEGU, (D) * 2, (D) * 2, (D) * 2}; SchedMoeGU S; S.so.init(nM, 2 * FFE / 256, G, bx); S.mi = mi; S.ct0 = ct0; S.rowtok = ROWTOK; S.rowbytes = D * 2;
                pg8::EpiGateUp<FSwiglu> E{FSwiglu{ACTC, FFE, 0}}; pg8::gemm_phase<pg8::EpiGateUp<FSwiglu>, SchedMoeGU, true, true>(lds, wave, g, S, E); }
            SEAM(17 + 2 * c);
            STAMP_AT(17 + 2 * c);
            if (IN(18 + 2 * c) && nM > 0) { pg8::Gemm g{ACTC, W_MOED, (FFE) * 2, (FFE) * 2, (FFE) * 2}; SchedMoeD S; S.so.init(nM, 4, G, bx); S.mi = mi; S.ct0 = ct0;
                pg8::EpiRow8<FBf16> E{FBf16{DOUT, D, ct0 * 256}}; pg8::gemm_phase<pg8::EpiRow8<FBf16>, SchedMoeD, true, false>(lds, wave, g, S, E); }
#endif
            SEAM(18 + 2 * c);
            STAMP_AT(18 + 2 * c);
        }
    }
    REP(27) if (IN(27)) {
        PH_LAUNDER();
        int ts[NE]; { int acc_t = 0;
#pragma unroll
            for (int e = 0; e < NE; ++e) { const int c = (int)__builtin_amdgcn_readfirstlane(__hip_atomic_load(ctl + CW_ECNT + 64 * e, RLX_AGENT)); ts[e] = acc_t; acc_t += (c + 255) >> 8; } }
        for (int m0 = gw; m0 < T; m0 += 4 * NGW) {
            unsigned i0[4], i1[4]; float w0[4], w1[4]; f32x4 v[4][4];
#pragma unroll
            for (int r = 0; r < 4; ++r) { const int m = m0 + r * NGW < T ? m0 + r * NGW : 0; i0[r] = TOKINFO[2 * m]; i1[r] = TOKINFO[2 * m + 1]; w0[r] = TOKW[2 * m]; w1[r] = TOKW[2 * m + 1]; }
#pragma unroll
            for (int r = 0; r < 4; ++r) { const int m = m0 + r * NGW < T ? m0 + r * NGW : 0; int t0 = 0, t1 = 0;
#pragma unroll
                for (int e = 0; e < NE; ++e) { t0 = ((int)(i0[r] >> 16) == e) ? ts[e] : t0; t1 = ((int)(i1[r] >> 16) == e) ? ts[e] : t1; }
                const size_t r0 = (size_t)t0 * 256 + (i0[r] & 0xffffu), r1 = (size_t)t1 * 256 + (i1[r] & 0xffffu);
                const u32x2* xr = (const u32x2*)(X3 + (size_t)m * D) + lane; const u32x2* d0 = (const u32x2*)(DOUT + r0 * D) + lane; const u32x2* d1 = (const u32x2*)(DOUT + r1 * D) + lane;
#pragma unroll
                for (int j = 0; j < 4; ++j) v[r][j] = bf4_to_f32(xr[64 * j]) * ALPHA + (bf4_to_f32(d0[64 * j]) * w0[r] + bf4_to_f32(d1[64 * j]) * w1[r]); }
#pragma unroll
            for (int r = 0; r < 4; ++r) { const int m = m0 + r * NGW; if (m >= T) continue;
                ln_inplace(v[r], args.in[I_LNF_G] + D, args.in[I_LNF_B] + D, lane);
                f32x4* orow = (f32x4*)(args.out + (size_t)m * D) + lane;
#pragma unroll
                for (int j = 0; j < 4; ++j) orow[64 * j] = v[r][j]; }
        }
    }


#if defined(STAMP_PH)
    {
        if (blockIdx.x == 0 && threadIdx.x == 0) __hip_atomic_store((float*)(ctl + 32768), (float)(st_t1 - st_t0) * 0.01f, RLX_AGENT);
        xcd_barrier(bar);
        const float us0 = __hip_atomic_load((float*)(ctl + 32768), RLX_AGENT); const float us = __expf(rintf(__logf(us0) * 12.5f + STAMP_SHIFT) * 0.08f - STAMP_SHIFT * 0.08f);
        const float A = sqrtf(us);
        for (long i = (long)vcu * 512 + threadIdx.x; i < (long)T * D / 4; i += (long)G * 512) ((f32x4*)args.out)[i] = (f32x4){A, A, A, A};
    }
#endif
#if defined(SELFTEST)
    {
        xcd_barrier(bar);
        const float e2 = __hip_atomic_load((float*)(ctl + st::CW_ERR), RLX_AGENT), r2 = __hip_atomic_load((float*)(ctl + st::CW_ERR + 1), RLX_AGENT);
        const float E = e2 / r2; float code = -log10f(E); code = code < 0.f ? 0.f : (code > 9.9f ? 9.9f : code);
        const float A = (E == E && r2 > 0.f) ? sqrtf(100.f * code) : 40.f;
        for (long i = (long)vcu * 512 + threadIdx.x; i < (long)T * D / 4; i += (long)G * 512) ((f32x4*)args.out)[i] = (f32x4){A, A, A, A};
    }
#endif
#undef IN
#undef SEAM
#undef STAMP_AT
#undef REP
#undef W_MLAIN
#undef W_QUP
#undef W_KVUP
#undef W_MLAOUT
#undef W_FFNGU
#undef W_FFND
#undef W_NSAIN
#undef W_NSAOUT
#undef W_C1K
#undef W_C1V
#undef W_C2K
#undef W_C2V
#undef ROPE_C
#undef CBIAS
#undef RBT
#undef ROWTOK
#undef TOKINFO
#undef TOKW
#undef XB
#undef LAT
#undef QN
#undef KVN
#undef KR
#undef Q
#undef KN
#undef V
#undef O
#undef X1
#undef ACT
#undef X2
#undef NQ
#undef KC
#undef VC
#undef KS
#undef VS
#undef KW
#undef VW
#undef GT
#undef HK
#undef HV
#undef KCMP
#undef VCMP
#undef ONSA
#undef X3
#undef W_MOEGU
#undef W_MOED
#undef DOUT
#undef ROPE_S
#undef P
#undef ACTC
#undef PH_LAUNDER
#endif
}

#ifndef MK_PER_PHASE
#define MK_PER_PHASE 0
#endif
extern "C" void kernel_launch(void* const* d_in, const int* in_sizes, int n_in, void* d_out, int out_size, void* d_ws, size_t ws_size, hipStream_t stream) {
    static int grid = 0;
    if (grid == 0) {
        if (n_in != 27 || out_size != T * D || ws_size < WS_END) { fprintf(stderr, "kernel_launch: unexpected shapes (n_in %d out %d ws %zu)\n", n_in, out_size, ws_size); grid = -1; return; }
        int dev = 0, cus = 0, per_cu = 0;
        if (hipGetDevice(&dev) != hipSuccess || hipDeviceGetAttribute(&cus, hipDeviceAttributeMultiprocessorCount, dev) != hipSuccess) { grid = -1; return; }
        if (hipFuncSetAttribute((const void*)fwd, hipFuncAttributeMaxDynamicSharedMemorySize, LDS_BYTES) != hipSuccess) { fprintf(stderr, "kernel_launch: hipFuncSetAttribute failed\n"); grid = -1; return; }
        if (hipOccupancyMaxActiveBlocksPerMultiprocessor(&per_cu, (const void*)fwd, NWAVES * 64, LDS_BYTES) != hipSuccess || per_cu < 1) { fprintf(stderr, "kernel_launch: occupancy query reports %d\n", per_cu); }
        (void)hipGetLastError();
        grid = cus;
    }
    if (grid < 0) return;
    if (hipMemsetAsync((char*)d_ws + WS_CTL, 0, CTL_ZERO_BYTES, stream) != hipSuccess) return;
    Args a{};
    for (int i = 0; i < 27; ++i) a.in[i] = (const float*)d_in[i];
    a.out = (float*)d_out; a.ws = (unsigned char*)d_ws;
#if MK_PER_PHASE
    for (int p = 0; p < N_PHASES; ++p) { a.ph_lo = p; a.ph_hi = p + 1; hipLaunchKernelGGL(fwd, dim3(grid), dim3(NWAVES * 64), LDS_BYTES, stream, a); }
#else
    a.ph_lo = 0; a.ph_hi = N_PHASES;
    hipLaunchKernelGGL(fwd, dim3(grid), dim3(NWAVES * 64), LDS_BYTES, stream, a);
#endif
}
```
